# Optimizing an MI355X kernel written in HIP

```python
import jax, jax.numpy as jnp
from jax import lax
import numpy as np

D_MODEL = 1024
BATCH = 8
SEQ = 4096
DEPTH = 2

ROPE_THETA = 10000.0
LN_EPS = 1e-5
RMS_EPS = 1e-6
DEEPNORM_ALPHA = (2 * DEPTH) ** 0.25
DEEPNORM_BETA = (8 * DEPTH) ** -0.25
NEG_BIG = -1e30
FORCE_SCORE = 1e4

HEAD_DIM = 64
SWA_Q_HEADS = 8
SWA_KV_HEADS = 2
SWA_WINDOW = 128
NSA_Q_HEADS = 8
NSA_KV_HEADS = 2
NSA_CMP_LEN = 32
NSA_CMP_STRIDE = 16
NSA_CMP_HIDDEN = 128
NSA_SEL_LEN = 64
NSA_N_SEL = 16
NSA_WINDOW = 512
NSA_QUERY_BLOCK = 64
BAND_QUERY_BLOCK = 128
MIX0_WIDTH = (SWA_Q_HEADS + NSA_Q_HEADS) * HEAD_DIM
MIX0_SPLITS = (
    SWA_Q_HEADS * HEAD_DIM,
    SWA_KV_HEADS * HEAD_DIM,
    SWA_KV_HEADS * HEAD_DIM,
    NSA_Q_HEADS * HEAD_DIM,
    NSA_KV_HEADS * HEAD_DIM,
    NSA_KV_HEADS * HEAD_DIM,
    NSA_KV_HEADS * HEAD_DIM,
    NSA_KV_HEADS * HEAD_DIM,
    NSA_KV_HEADS * HEAD_DIM,
    NSA_KV_HEADS * HEAD_DIM,
    3 * NSA_Q_HEADS,
)
MIX0_IN = sum(MIX0_SPLITS)

MLA_HEADS = 16
MLA_NOPE = 64
MLA_ROPE = 32
MLA_V = 64
MLA_Q_LORA = 384
MLA_KV_LORA = 256
MLA_QUERY_BLOCK = 128
MLA_IN = MLA_Q_LORA + MLA_KV_LORA + MLA_ROPE

N_EXPERTS = 64
MOE_GROUPS = 8
MOE_TOPK_GROUPS = 4
MOE_TOP_K = 6
D_EXPERT = 256
D_SHARED = 256
MOE_ROUTED_SCALE = 2.5
MOE_ROW_BLOCK = 256

N_EVEN = (DEPTH + 1) // 2
N_ODD = DEPTH // 2

kernel_name = "hybrid_swa_nsa_mla_moe_deepnorm"


def _rope(x, pos):
    d = x.shape[-1]
    half = d // 2
    inv_freq = ROPE_THETA ** (-2.0 * jnp.arange(half, dtype=jnp.float32) / d)
    ang = pos.astype(jnp.float32)[:, None] * inv_freq[None, :]
    cos = jnp.cos(ang)[:, None, :].astype(x.dtype)
    sin = jnp.sin(ang)[:, None, :].astype(x.dtype)
    x1, x2 = x[..., :half], x[..., half:]
    return jnp.concatenate([x1 * cos - x2 * sin, x1 * sin + x2 * cos], axis=-1)


def _layer_norm(x, g, b):
    xf = x.astype(jnp.float32)
    mu = xf.mean(-1, keepdims=True)
    xc = xf - mu
    var = (xc * xc).mean(-1, keepdims=True)
    return (xc * lax.rsqrt(var + LN_EPS) * g.astype(jnp.float32) + b.astype(jnp.float32)).astype(x.dtype)


def _rms_norm(x, g):
    xf = x.astype(jnp.float32)
    y = xf * lax.rsqrt((xf * xf).mean(-1, keepdims=True) + RMS_EPS)
    return (y * g.astype(jnp.float32)).astype(x.dtype)


def _banded_attention(q, k, v, window, sinks):
    B, S, G, R, d = q.shape
    C = BAND_QUERY_BLOCK
    n_blk = S // C
    L = window + C
    scale = d ** -0.5
    kp = jnp.pad(k, ((0, 0), (window, 0), (0, 0), (0, 0)))
    vp = jnp.pad(v, ((0, 0), (window, 0), (0, 0), (0, 0)))
    q_blocks = q.reshape(B, n_blk, C, G, R, d).swapaxes(0, 1)

    def step(args):
        i, qb = args
        start = i * C
        kb = lax.dynamic_slice_in_dim(kp, start, L, axis=1)
        vb = lax.dynamic_slice_in_dim(vp, start, L, axis=1)
        s = jnp.einsum('bqgrd,bkgd->bgrqk', qb, kb).astype(jnp.float32) * scale
        tq = start + jnp.arange(C)
        tk = start - window + jnp.arange(L)
        diff = tq[:, None] - tk[None, :]
        mask = (diff >= 0) & (diff < window) & (tk[None, :] >= 0)
        s = jnp.where(mask, s, -jnp.inf)
        if sinks is not None:
            sink = jnp.broadcast_to(sinks.astype(jnp.float32).reshape(1, G, R, 1, 1), s.shape[:-1] + (1,))
            p = jax.nn.softmax(jnp.concatenate([sink, s], axis=-1), axis=-1)[..., 1:]
        else:
            p = jax.nn.softmax(s, axis=-1)
        return jnp.einsum('bgrqk,bkgd->bqgrd', p.astype(vb.dtype), vb)

    o = lax.map(step, (jnp.arange(n_blk), q_blocks))
    return o.swapaxes(0, 1).reshape(B, S, G, R, d)


def _causal_attention(q, k, v):
    B, S, H, dq = q.shape
    dv = v.shape[-1]
    C = MLA_QUERY_BLOCK
    n_blk = S // C
    scale = dq ** -0.5
    q_blocks = q.reshape(B, n_blk, C, H, dq).swapaxes(0, 1)
    tk = jnp.arange(S)

    def step(args):
        i, qb = args
        tq = i * C + jnp.arange(C)
        s = jnp.einsum('bqhd,bkhd->bhqk', qb, k).astype(jnp.float32) * scale
        s = jnp.where(tk[None, :] <= tq[:, None], s, -jnp.inf)
        p = jax.nn.softmax(s, axis=-1)
        return jnp.einsum('bhqk,bkhd->bqhd', p.astype(v.dtype), v)

    o = lax.map(step, (jnp.arange(n_blk), q_blocks))
    return o.swapaxes(0, 1).reshape(B, S, H, dv)


def _compress(t, pe, w1, w2):
    B, S, G, d = t.shape
    n_cmp = (S - NSA_CMP_LEN) // NSA_CMP_STRIDE + 1
    idx = np.arange(n_cmp)[:, None] * NSA_CMP_STRIDE + np.arange(NSA_CMP_LEN)[None, :]
    blk = t[:, idx] + pe[:, None, :]
    blk = blk.transpose(0, 1, 3, 2, 4).reshape(B, n_cmp, G, NSA_CMP_LEN * d)
    return jax.nn.gelu(blk @ w1) @ w2


def _nsa_cmp_sel(q, kc, vc, ks, vs):
    B, S, G, R, d = q.shape
    n_cmp = kc.shape[1]
    n_sb = S // NSA_SEL_LEN
    n_sel = min(NSA_N_SEL, n_sb)
    C = NSA_QUERY_BLOCK
    n_qb = S // C
    scale = d ** -0.5
    cs = np.arange(n_cmp) * NSA_CMP_STRIDE
    bs = np.arange(n_sb) * NSA_SEL_LEN
    ov = np.clip(np.minimum(cs[:, None] + NSA_CMP_LEN, bs[None, :] + NSA_SEL_LEN)
                 - np.maximum(cs[:, None], bs[None, :]), 0, None) / NSA_CMP_LEN
    overlap = jnp.asarray(ov, dtype=jnp.float32)
    cmp_end = jnp.asarray(cs + NSA_CMP_LEN - 1)
    ks_blk = ks.reshape(B, n_sb, NSA_SEL_LEN, G, d).transpose(0, 3, 1, 2, 4)
    vs_blk = vs.reshape(B, n_sb, NSA_SEL_LEN, G, d).transpose(0, 3, 1, 2, 4)
    bi = jnp.arange(B)[:, None, None, None]
    gi = jnp.arange(G)[None, :, None, None]
    blk_ids = jnp.arange(n_sb)
    q_blocks = q.reshape(B, n_qb, C, G, R, d).swapaxes(0, 1)

    def step(args):
        i, qb = args
        tq = i * C + jnp.arange(C)
        s_c = jnp.einsum('bqgrd,bngd->bgrqn', qb, kc).astype(jnp.float32) * scale
        mask_c = cmp_end[None, :] <= tq[:, None]
        s_c = jnp.where(mask_c, s_c, NEG_BIG)
        p_c = jnp.exp(s_c - s_c.max(-1, keepdims=True)) * mask_c
        p_c = p_c / jnp.maximum(p_c.sum(-1, keepdims=True), 1e-30)
        o_c = jnp.einsum('bgrqn,bngd->bqgrd', p_c.astype(vc.dtype), vc)
        imp = jnp.einsum('bgrqn,nm->bgqm', p_c, overlap)
        cur = tq // NSA_SEL_LEN
        forced = ((blk_ids[None, :] == 0) | (blk_ids[None, :] == cur[:, None])
                  | (blk_ids[None, :] == cur[:, None] - 1))
        future = blk_ids[None, :] * NSA_SEL_LEN > tq[:, None]
        score = jnp.where(forced, FORCE_SCORE, jnp.where(future, -1.0, imp))
        _, idx = lax.top_k(score, n_sel)
        kg = ks_blk[bi, gi, idx]
        vg = vs_blk[bi, gi, idx]
        tk = idx[..., None] * NSA_SEL_LEN + jnp.arange(NSA_SEL_LEN)
        mask_s = (tk <= tq[None, None, :, None, None])[:, :, None]
        s_s = jnp.einsum('bqgrd,bgqnld->bgrqnl', qb, kg).astype(jnp.float32) * scale
        s_s = jnp.where(mask_s, s_s, -jnp.inf)
        p_s = jax.nn.softmax(s_s.reshape(B, G, R, C, n_sel * NSA_SEL_LEN), axis=-1).reshape(s_s.shape)
        o_s = jnp.einsum('bgrqnl,bgqnld->bqgrd', p_s.astype(vg.dtype), vg)
        return o_c, o_s

    o_c, o_s = lax.map(step, (jnp.arange(n_qb), q_blocks))
    o_c = o_c.swapaxes(0, 1).reshape(B, S, G, R, d)
    o_s = o_s.swapaxes(0, 1).reshape(B, S, G, R, d)
    return o_c, o_s


def _swa_nsa_mixer(x, w_in, sinks, pe_k, w_ck1, w_ck2, pe_v, w_cv1, w_cv2, w_out):
    B, S, _ = x.shape
    pos = jnp.arange(S)
    parts = jnp.split(x @ w_in, [int(c) for c in np.cumsum(MIX0_SPLITS)[:-1]], axis=-1)
    qa, ka, va, qb, kc, vc, ksl, vsl, kw, vw, gates = parts
    heads = lambda t, h: t.reshape(B, S, h, HEAD_DIM)
    ra = SWA_Q_HEADS // SWA_KV_HEADS
    rb = NSA_Q_HEADS // NSA_KV_HEADS
    qa = _rope(heads(qa, SWA_Q_HEADS), pos).reshape(B, S, SWA_KV_HEADS, ra, HEAD_DIM)
    ka = _rope(heads(ka, SWA_KV_HEADS), pos)
    o_swa = _banded_attention(qa, ka, heads(va, SWA_KV_HEADS), SWA_WINDOW, sinks)
    qb = _rope(heads(qb, NSA_Q_HEADS), pos).reshape(B, S, NSA_KV_HEADS, rb, HEAD_DIM)
    k_cmp = _compress(heads(kc, NSA_KV_HEADS), pe_k, w_ck1, w_ck2)
    n_cmp = k_cmp.shape[1]
    k_cmp = _rope(k_cmp, jnp.arange(n_cmp) * NSA_CMP_STRIDE + NSA_CMP_LEN - 1)
    v_cmp = _compress(heads(vc, NSA_KV_HEADS), pe_v, w_cv1, w_cv2)
    k_sel = _rope(heads(ksl, NSA_KV_HEADS), pos)
    o_cmp, o_sel = _nsa_cmp_sel(qb, k_cmp, v_cmp, k_sel, heads(vsl, NSA_KV_HEADS))
    o_win = _banded_attention(qb, _rope(heads(kw, NSA_KV_HEADS), pos), heads(vw, NSA_KV_HEADS),
                              NSA_WINDOW, None)
    g = jax.nn.sigmoid(gates.astype(jnp.float32)).astype(x.dtype).reshape(B, S, 3, NSA_KV_HEADS, rb, 1)
    o_nsa = g[:, :, 0] * o_cmp + g[:, :, 1] * o_sel + g[:, :, 2] * o_win
    o = jnp.concatenate([o_swa.reshape(B, S, -1), o_nsa.reshape(B, S, -1)], axis=-1)
    return o @ w_out


def _mla_mixer(x, w_in, q_norm, kv_norm, w_uq, w_ukv, w_out):
    B, S, _ = x.shape
    pos = jnp.arange(S)
    c_q, c_kv, k_r = jnp.split(x @ w_in, [MLA_Q_LORA, MLA_Q_LORA + MLA_KV_LORA], axis=-1)
    q = (_rms_norm(c_q, q_norm) @ w_uq).reshape(B, S, MLA_HEADS, MLA_NOPE + MLA_ROPE)
    kv = (_rms_norm(c_kv, kv_norm) @ w_ukv).reshape(B, S, MLA_HEADS, MLA_NOPE + MLA_V)
    q = jnp.concatenate([q[..., :MLA_NOPE], _rope(q[..., MLA_NOPE:], pos)], axis=-1)
    k_rope = _rope(k_r.reshape(B, S, 1, MLA_ROPE), pos)
    k = jnp.concatenate([kv[..., :MLA_NOPE], jnp.broadcast_to(k_rope, (B, S, MLA_HEADS, MLA_ROPE))], axis=-1)
    o = _causal_attention(q, k, kv[..., MLA_NOPE:])
    return o.reshape(B, S, MLA_HEADS * MLA_V) @ w_out


def _moe(x, router_w, router_bias, w_gate, w_up, w_down, sh_gate, sh_up, sh_down):
    B, S, D = x.shape
    n_tok = B * S
    xf = x.reshape(n_tok, D)
    s = jax.nn.sigmoid((xf @ router_w).astype(jnp.float32))
    sb = s + router_bias.astype(jnp.float32)
    grp = sb.reshape(n_tok, MOE_GROUPS, N_EXPERTS // MOE_GROUPS)
    grp_score = lax.top_k(grp, 2)[0].sum(-1)
    _, gidx = lax.top_k(grp_score, MOE_TOPK_GROUPS)
    gmask = jnp.any(gidx[:, :, None] == jnp.arange(MOE_GROUPS)[None, None, :], axis=1)
    emask = jnp.repeat(gmask, N_EXPERTS // MOE_GROUPS, axis=1)
    _, eidx = lax.top_k(jnp.where(emask, sb, -jnp.inf), MOE_TOP_K)
    gate = jnp.take_along_axis(s, eidx, axis=1)
    gate = gate / gate.sum(-1, keepdims=True) * MOE_ROUTED_SCALE
    n_rows = n_tok * MOE_TOP_K
    flat_e = eidx.reshape(-1)
    flat_t = jnp.repeat(jnp.arange(n_tok), MOE_TOP_K)
    order = jnp.argsort(flat_e)
    e_s = flat_e[order]
    counts = jnp.bincount(flat_e, length=N_EXPERTS)
    padded = (counts + MOE_ROW_BLOCK - 1) // MOE_ROW_BLOCK * MOE_ROW_BLOCK
    starts = jnp.cumsum(counts) - counts
    pad_ends = jnp.cumsum(padded)
    pad_starts = pad_ends - padded
    dest = pad_starts[e_s] + jnp.arange(n_rows) - starts[e_s]
    n_blk = -(-(n_rows + N_EXPERTS * (MOE_ROW_BLOCK - 1)) // MOE_ROW_BLOCK)
    n_pad_rows = n_blk * MOE_ROW_BLOCK
    row_tok = jnp.zeros((n_pad_rows,), jnp.int32).at[dest].set(flat_t[order])
    row_w = jnp.zeros((n_pad_rows,), x.dtype).at[dest].set(gate.reshape(-1)[order].astype(x.dtype))
    blk_exp = jnp.minimum(jnp.searchsorted(pad_ends, jnp.arange(n_blk) * MOE_ROW_BLOCK, side='right'),
                          N_EXPERTS - 1)

    def body(acc, blk):
        tok, w, e = blk
        xb = xf[tok]
        h = jax.nn.silu(xb @ w_gate[e]) * (xb @ w_up[e])
        return acc.at[tok].add((h @ w_down[e]) * w[:, None]), None

    routed, _ = lax.scan(body, jnp.zeros_like(xf),
                         (row_tok.reshape(n_blk, MOE_ROW_BLOCK), row_w.reshape(n_blk, MOE_ROW_BLOCK), blk_exp))
    shared = (jax.nn.silu(xf @ sh_gate) * (xf @ sh_up)) @ sh_down
    return (routed + shared).reshape(B, S, D)


def setup_inputs(seed: int = 0) -> dict:
    key = jax.random.key(seed)
    keys = iter(jax.random.split(key, 40))

    def nrm(shape, scale):
        return jax.random.normal(next(keys), shape, jnp.float32) * scale

    d = D_MODEL
    return {
        'x': nrm((BATCH, SEQ, d), 1.0),
        'swa_nsa_w_in': nrm((N_EVEN, d, MIX0_IN), d ** -0.5),
        'swa_sinks': nrm((N_EVEN, SWA_Q_HEADS), 1.0),
        'nsa_cmp_pe_k': nrm((N_EVEN, NSA_CMP_LEN, HEAD_DIM), 0.5),
        'nsa_cmp_k_w1': nrm((N_EVEN, NSA_CMP_LEN * HEAD_DIM, NSA_CMP_HIDDEN), (NSA_CMP_LEN * HEAD_DIM) ** -0.5),
        'nsa_cmp_k_w2': nrm((N_EVEN, NSA_CMP_HIDDEN, HEAD_DIM), NSA_CMP_HIDDEN ** -0.5),
        'nsa_cmp_pe_v': nrm((N_EVEN, NSA_CMP_LEN, HEAD_DIM), 0.5),
        'nsa_cmp_v_w1': nrm((N_EVEN, NSA_CMP_LEN * HEAD_DIM, NSA_CMP_HIDDEN), (NSA_CMP_LEN * HEAD_DIM) ** -0.5),
        'nsa_cmp_v_w2': nrm((N_EVEN, NSA_CMP_HIDDEN, HEAD_DIM), NSA_CMP_HIDDEN ** -0.5),
        'swa_nsa_w_out': nrm((N_EVEN, MIX0_WIDTH, d), MIX0_WIDTH ** -0.5 * DEEPNORM_BETA),
        'mla_w_in': nrm((N_ODD, d, MLA_IN), d ** -0.5),
        'mla_q_norm': 1.0 + nrm((N_ODD, MLA_Q_LORA), 0.01),
        'mla_kv_norm': 1.0 + nrm((N_ODD, MLA_KV_LORA), 0.01),
        'mla_w_uq': nrm((N_ODD, MLA_Q_LORA, MLA_HEADS * (MLA_NOPE + MLA_ROPE)), MLA_Q_LORA ** -0.5),
        'mla_w_ukv': nrm((N_ODD, MLA_KV_LORA, MLA_HEADS * (MLA_NOPE + MLA_V)), MLA_KV_LORA ** -0.5),
        'mla_w_out': nrm((N_ODD, MLA_HEADS * MLA_V, d), (MLA_HEADS * MLA_V) ** -0.5 * DEEPNORM_BETA),
        'ln_mix_g': 1.0 + nrm((DEPTH, d), 0.01),
        'ln_mix_b': nrm((DEPTH, d), 0.01),
        'ln_ffn_g': 1.0 + nrm((DEPTH, d), 0.01),
        'ln_ffn_b': nrm((DEPTH, d), 0.01),
        'router_w': nrm((DEPTH, d, N_EXPERTS), d ** -0.5),
        'router_bias': nrm((DEPTH, N_EXPERTS), 0.01),
        'expert_w_gate': nrm((DEPTH, N_EXPERTS, d, D_EXPERT), d ** -0.5),
        'expert_w_up': nrm((DEPTH, N_EXPERTS, d, D_EXPERT), d ** -0.5),
        'expert_w_down': nrm((DEPTH, N_EXPERTS, D_EXPERT, d), D_EXPERT ** -0.5 * DEEPNORM_BETA),
        'shared_w_gate': nrm((DEPTH, d, D_SHARED), d ** -0.5),
        'shared_w_up': nrm((DEPTH, d, D_SHARED), d ** -0.5),
        'shared_w_down': nrm((DEPTH, D_SHARED, d), D_SHARED ** -0.5 * DEEPNORM_BETA),
    }


def reference(x, swa_nsa_w_in, swa_sinks, nsa_cmp_pe_k, nsa_cmp_k_w1, nsa_cmp_k_w2, nsa_cmp_pe_v,
              nsa_cmp_v_w1, nsa_cmp_v_w2, swa_nsa_w_out, mla_w_in, mla_q_norm, mla_kv_norm, mla_w_uq,
              mla_w_ukv, mla_w_out, ln_mix_g, ln_mix_b, ln_ffn_g, ln_ffn_b, router_w, router_bias,
              expert_w_gate, expert_w_up, expert_w_down, shared_w_gate, shared_w_up, shared_w_down):
    for layer in range(DEPTH):
        j = layer // 2
        if layer % 2 == 0:
            h = _swa_nsa_mixer(x, swa_nsa_w_in[j], swa_sinks[j], nsa_cmp_pe_k[j], nsa_cmp_k_w1[j],
                               nsa_cmp_k_w2[j], nsa_cmp_pe_v[j], nsa_cmp_v_w1[j], nsa_cmp_v_w2[j],
                               swa_nsa_w_out[j])
        else:
            h = _mla_mixer(x, mla_w_in[j], mla_q_norm[j], mla_kv_norm[j], mla_w_uq[j], mla_w_ukv[j],
                           mla_w_out[j])
        x = _layer_norm(DEEPNORM_ALPHA * x + h, ln_mix_g[layer], ln_mix_b[layer])
        f = _moe(x, router_w[layer], router_bias[layer], expert_w_gate[layer], expert_w_up[layer],
                 expert_w_down[layer], shared_w_gate[layer], shared_w_up[layer], shared_w_down[layer])
        x = _layer_norm(DEEPNORM_ALPHA * x + f, ln_ffn_g[layer], ln_ffn_b[layer])
    return x
```

```cpp
#define MULTI_LAUNCH 1
#include <hip/hip_runtime.h>
#include <hip/hip_cooperative_groups.h>
#include <stdint.h>
#include <math.h>
#include <cstdio>
#include <cstring>
namespace cg = cooperative_groups;

#define LAS __attribute__((address_space(3)))
#define DI __device__ __forceinline__
typedef unsigned short bf16_t;
typedef short bf16x8 __attribute__((ext_vector_type(8)));
typedef float f32x4 __attribute__((ext_vector_type(4)));
typedef float f32x16 __attribute__((ext_vector_type(16)));
typedef unsigned u32x4 __attribute__((ext_vector_type(4)));
typedef unsigned u32x2 __attribute__((ext_vector_type(2)));

constexpr int NTOK = 32768, SEQ = 4096, NBATCH = 8, DM = 1024;
constexpr int NTHR = 512;
constexpr float ALPHA = 1.4142135623730951f;
constexpr float LOG2E = 1.4426950408889634f;

DI unsigned cvt_pk(float lo, float hi) { unsigned r; asm("v_cvt_pk_bf16_f32 %0, %1, %2" : "=v"(r) : "v"(lo), "v"(hi)); return r; }
DI bf16_t f2bf(float x) { return (bf16_t)(cvt_pk(x, 0.f) & 0xffffu); }
DI float bf2f(bf16_t b) { return __uint_as_float(((unsigned)b) << 16); }
DI float fast_exp2(float x) { return __builtin_amdgcn_exp2f(x); }
DI float sigmoidf_(float x) { return 1.0f / (1.0f + __expf(-x)); }
DI int crow(int r, int h) { return (r & 3) + 8 * (r >> 2) + 4 * h; }
DI int perm16(int t) { return (t & ~15) | (((t >> 2) & 1) << 3) | (((t >> 3) & 1) << 2) | (t & 3); }
DI void glds16(const void* g, LAS char* l) { __builtin_amdgcn_global_load_lds((const unsigned*)g, (LAS unsigned*)l, 16, 0, 0); }
#define WAIT_VM_BAR(N) asm volatile("s_waitcnt vmcnt(" #N ") lgkmcnt(0)\n\ts_barrier" ::: "memory")
#define LDS_BAR() asm volatile("s_waitcnt lgkmcnt(0)\n\ts_barrier" ::: "memory")
DI int thr() { int t = threadIdx.x; asm volatile("" : "+v"(t)); return t; }
DI float wave_sum(float v) {
#pragma unroll
  for (int o = 32; o > 0; o >>= 1) v += __shfl_xor(v, o);
  return v;
}

#define XB_TMO 128
#define XB_XCNT(j) (256 + 64 * (j))
#define XB_XSUB(j) (1280 + 64 * (j))
#define XB_XGEN(j) (2304 + 64 * (j))
#define XB_TOP 3328
#define XB_TOPGEN 3392
#define XCD_BAR_WORDS 3456
#define XB_SPIN_CAP (1u << 22)
DI unsigned xb_ld(unsigned* p) { return __hip_atomic_load(p, __ATOMIC_RELAXED, __HIP_MEMORY_SCOPE_AGENT); }
DI unsigned xb_add(unsigned* p, unsigned v) { return __hip_atomic_fetch_add(p, v, __ATOMIC_RELAXED, __HIP_MEMORY_SCOPE_AGENT); }
DI unsigned xb_xcc_id() { return (unsigned)__builtin_amdgcn_s_getreg((3 << 11) | 20) & 0xFu; }
#define XB_SPIN(cond, bar) do { unsigned _sp = 0; while (cond) { __builtin_amdgcn_s_sleep(1); \
    if ((++_sp & 255u) == 0u) { if (xb_ld(&(bar)[XB_TMO])) break; if (_sp > XB_SPIN_CAP) { atomicAdd(&(bar)[XB_TMO], 1u); break; } } } } while (0)
struct XcdBarrier { unsigned* bar; unsigned x; volatile LAS unsigned* st; };
DI XcdBarrier xcd_barrier_post(unsigned* bar, volatile LAS unsigned* st) {
  XcdBarrier b; b.bar = bar; b.x = xb_xcc_id(); b.st = st;
  if (threadIdx.x == 0) (void)xb_add(&bar[XB_XCNT(b.x)], 1u);
  return b;
}
DI void xcd_barrier_complete(unsigned* bar, unsigned x, unsigned& nloc, unsigned& nx) {
  const unsigned G = gridDim.x;
  unsigned sum, cnt, mine, sp = 0u;
  for (;;) {
    sum = 0u; cnt = 0u; mine = 0u;
#pragma unroll
    for (unsigned j = 0; j < 16; ++j) { const unsigned c = xb_ld(&bar[XB_XCNT(j)]); sum += c; cnt += (c > 0u) ? 1u : 0u; mine = (j == x) ? c : mine; }
    if (sum == G) break;
    __builtin_amdgcn_s_sleep(1);
    if ((++sp & 255u) == 0u) { if (xb_ld(&bar[XB_TMO])) break; if (sp > XB_SPIN_CAP) { atomicAdd(&bar[XB_TMO], 1u); break; } }
  }
  nloc = mine > 0u ? mine : 1u; nx = cnt > 0u ? cnt : 1u;
}
DI void xcd_barrier(const XcdBarrier& b) {
  asm volatile("s_waitcnt vmcnt(0)" ::: "memory");
  __syncthreads();
  if (threadIdx.x == 0) {
    unsigned* bar = b.bar;
    __builtin_amdgcn_s_waitcnt(0);
    unsigned nloc = b.st[0], nx = b.st[1];
    if (nloc == 0u) { xcd_barrier_complete(bar, b.x, nloc, nx); b.st[0] = nloc; b.st[1] = nx; }
    const unsigned old = xb_add(&bar[XB_XSUB(b.x)], 1u);
    const unsigned gen = old / nloc;
    if (old + 1u == (gen + 1u) * nloc) {
      __builtin_amdgcn_fence(__ATOMIC_RELEASE, "agent");
      asm volatile("s_waitcnt vmcnt(0)" ::: "memory");
      const unsigned og = xb_add(&bar[XB_TOP], 1u);
      const unsigned tg = og / nx;
      if (og + 1u == (tg + 1u) * nx) xb_add(&bar[XB_TOPGEN], 1u);
      else XB_SPIN(xb_ld(&bar[XB_TOPGEN]) == tg, bar);
      __builtin_amdgcn_fence(__ATOMIC_ACQUIRE, "agent");
      xb_add(&bar[XB_XGEN(b.x)], 1u);
      asm volatile("s_waitcnt vmcnt(0)" ::: "memory");
    } else {
      XB_SPIN(xb_ld(&bar[XB_XGEN(b.x)]) == gen, bar);
      __builtin_amdgcn_fence(__ATOMIC_ACQUIRE, "agent");
      asm volatile("s_waitcnt vmcnt(0)" ::: "memory");
    }
  }
  __syncthreads();
}

constexpr int G_BM = 256, G_BN = 128, G_BK = 32;
constexpr int G_STAGE = G_BM * G_BK * 2 + G_BN * G_BK * 2;
constexpr int G_LDS = 3 * G_STAGE;

DI void gemm_kloop(LAS char* lds, const char* a0, const char* a1, const char* bsrc, int nk  , f32x4 (&acc)[4][4]) {
  const int tid = thr(), lane = tid & 63, wid = __builtin_amdgcn_readfirstlane(tid >> 6);
  const int wr = wid >> 1, wc = wid & 1, fr = lane & 15, fq = lane >> 4;
  LAS char* dA0 = lds + tid * 16;
  const int aoff = (wr * 64 + fr) * 64 + fq * 16;
  const int boff = 16384 + (wc * 64 + fr) * 64 + fq * 16;
#define G_ISSUE(slot, kt) do { LAS char* _d = dA0 + (slot) * G_STAGE; const size_t _ko = (size_t)(kt) * 64; \
    glds16(a0 + _ko, _d); glds16(a1 + _ko, _d + 8192); glds16(bsrc + _ko, _d + 16384); } while (0)
  asm volatile("s_waitcnt vmcnt(0)" ::: "memory");
  G_ISSUE(0, 0);
  if (nk > 1) G_ISSUE(1, 1);
  int slot = 0;
  for (int t = 0; t < nk; ++t) {
    if (t + 1 < nk) { WAIT_VM_BAR(3); } else { WAIT_VM_BAR(0); }
    if (t + 2 < nk) { int s2 = slot + 2; if (s2 >= 3) s2 -= 3; G_ISSUE(s2, t + 2); }
    const LAS char* base = lds + slot * G_STAGE;
    bf16x8 af[4], bfr[4];
#pragma unroll
    for (int m = 0; m < 4; ++m) af[m] = *(const LAS bf16x8*)(base + aoff + m * 1024);
#pragma unroll
    for (int n = 0; n < 4; ++n) bfr[n] = *(const LAS bf16x8*)(base + boff + n * 1024);
#pragma unroll
    for (int m = 0; m < 4; ++m)
#pragma unroll
      for (int n = 0; n < 4; ++n) acc[m][n] = __builtin_amdgcn_mfma_f32_16x16x32_bf16(bfr[n], af[m], acc[m][n], 0, 0, 0);
    slot = (slot == 2) ? 0 : slot + 1;
  }
#undef G_ISSUE
  LDS_BAR();
}
DI void zero_acc(f32x4 (&acc)[4][4]) {
#pragma unroll
  for (int m = 0; m < 4; ++m)
#pragma unroll
    for (int n = 0; n < 4; ++n) acc[m][n] = (f32x4){0.f, 0.f, 0.f, 0.f};
}
constexpr int A_STAGE = 20480, A_RING = 3 * A_STAGE;
constexpr float NEGBIG = -1e30f;
#define MFMA32(a, b, c) __builtin_amdgcn_mfma_f32_32x32x16_bf16((a), (b), (c), 0, 0, 0)

template <bool HAS_ROPE>
DI void qk_tile(const LAS char* kt, const LAS char* krt, const bf16x8* qf, int r32, int h, f32x16& sA, f32x16& sB) {
  const int sw = (r32 >> 1) & 7;
  const LAS char* ra = kt + r32 * 128;
  const LAS char* rb = ra + 32 * 128;
  f32x16 z;
#pragma unroll
  for (int i = 0; i < 16; ++i) z[i] = 0.f;
  sA = z; sB = z;
#pragma unroll
  for (int ks = 0; ks < 4; ++ks) {
    const int c = ((2 * ks + h) ^ sw) << 4;
    const bf16x8 ka = *(const LAS bf16x8*)(ra + c);
    const bf16x8 kb = *(const LAS bf16x8*)(rb + c);
    sA = MFMA32(ka, qf[ks], sA);
    sB = MFMA32(kb, qf[ks], sB);
  }
  if (HAS_ROPE) {
    const int sw2 = (r32 >> 2) & 3;
    const LAS char* pa = krt + r32 * 64;
    const LAS char* pb = pa + 32 * 64;
#pragma unroll
    for (int ks = 0; ks < 2; ++ks) {
      const int c = ((2 * ks + h) ^ sw2) << 4;
      const bf16x8 ka = *(const LAS bf16x8*)(pa + c);
      const bf16x8 kb = *(const LAS bf16x8*)(pb + c);
      sA = MFMA32(ka, qf[4 + ks], sA);
      sB = MFMA32(kb, qf[4 + ks], sB);
    }
  }
}

DI bf16x8 pack8(const f32x16& p, int s) {
  u32x4 w;
  w.x = cvt_pk(p[8 * s + 0], p[8 * s + 1]); w.y = cvt_pk(p[8 * s + 2], p[8 * s + 3]);
  w.z = cvt_pk(p[8 * s + 4], p[8 * s + 5]); w.w = cvt_pk(p[8 * s + 6], p[8 * s + 7]);
  return __builtin_bit_cast(bf16x8, w);
}

DI void pv_tile(const LAS char* vt, const f32x16& pA, const f32x16& pB, int r32, int h, f32x16 (&o)[2]) {
  const int sw = (r32 >> 1) & 7;
  const LAS char* r0 = vt + r32 * 128;
  const LAS char* r1 = r0 + 32 * 128;
#pragma unroll
  for (int kk = 0; kk < 4; ++kk) {
    const bf16x8 pt = (kk < 2) ? pack8(pA, kk & 1) : pack8(pB, kk & 1);
    const int c = ((2 * kk + h) ^ sw) << 4;
    const bf16x8 v0 = *(const LAS bf16x8*)(r0 + c);
    const bf16x8 v1 = *(const LAS bf16x8*)(r1 + c);
    o[0] = MFMA32(v0, pt, o[0]);
    o[1] = MFMA32(v1, pt, o[1]);
  }
}

DI void mask_scores(f32x16& sA, f32x16& sB, int key0, int lo, int hi, int h) {
#pragma unroll
  for (int r = 0; r < 16; ++r) {
    const int ka = key0 + crow(r, h), kb = ka + 32;
    sA[r] = (ka > lo && ka <= hi) ? sA[r] : NEGBIG;
    sB[r] = (kb > lo && kb <= hi) ? sB[r] : NEGBIG;
  }
}
DI float row_max32(const f32x16& sA, const f32x16& sB) {
  float mx = fmaxf(sA[0], sB[0]);
#pragma unroll
  for (int r = 1; r < 16; ++r) mx = fmaxf(mx, fmaxf(sA[r], sB[r]));
  return fmaxf(mx, __shfl_xor(mx, 32));
}
DI void softmax_step(f32x16& sA, f32x16& sB, float c, float& m, float& l, f32x16 (&o)[2]) {
  const float mx = row_max32(sA, sB);
  const float mnew = fmaxf(m, mx);
  const float mc = (mnew < -1e29f) ? 0.f : mnew * c;
  const float alpha = fast_exp2(m * c - mc);
  m = mnew;
  float sum = 0.f;
#pragma unroll
  for (int r = 0; r < 16; ++r) {
    sA[r] = fast_exp2(__builtin_fmaf(sA[r], c, -mc));
    sB[r] = fast_exp2(__builtin_fmaf(sB[r], c, -mc));
    sum += sA[r] + sB[r];
  }
  l = l * alpha + sum;
  if (!__all(alpha == 1.0f)) {
#pragma unroll
    for (int r = 0; r < 16; ++r) { o[0][r] *= alpha; o[1][r] *= alpha; }
  }
}

template <bool HAS_ROPE, class F>
DI void kv_stream(LAS char* ring, const char* kb, const char* vb, size_t vstride, const char* krb, int tile_lo, int tile_hi, F&& per_tile) {
  const int tid = thr();
  const int row = tid >> 3, cs = ((tid & 7) ^ ((row >> 1) & 7)) << 4;
  const char* ksrc = kb + (size_t)row * 128 + cs;
  const char* vsrc = vb + (size_t)row * vstride + cs;
  const int t2 = tid & 255, row2 = t2 >> 2;
  const char* rsrc = krb + (size_t)row2 * 64 + (((t2 & 3) ^ ((row2 >> 2) & 3)) << 4);
  LAS char* dst = ring + tid * 16;
  LAS char* dst2 = ring + 16384 + t2 * 16;
#define A_ISSUE(slot, tl) do { glds16(ksrc + (size_t)(tl) * 8192, dst + (slot) * A_STAGE); glds16(vsrc + (size_t)(tl) * 128, dst + (slot) * A_STAGE + 8192); \
    if (HAS_ROPE) glds16(rsrc + (size_t)(tl) * 4096, dst2 + (slot) * A_STAGE); } while (0)
  asm volatile("s_waitcnt vmcnt(0)" ::: "memory");
  if (tile_lo <= tile_hi) A_ISSUE(0, tile_lo);
  if (tile_lo + 1 <= tile_hi) A_ISSUE(1, tile_lo + 1);
  int slot = 0;
  for (int t = tile_lo; t <= tile_hi; ++t) {
    if (t + 1 <= tile_hi) { if (HAS_ROPE) { WAIT_VM_BAR(3); } else { WAIT_VM_BAR(2); } } else { WAIT_VM_BAR(0); }
    if (t + 2 <= tile_hi) { int s2 = slot + 2; if (s2 >= 3) s2 -= 3; A_ISSUE(s2, t + 2); }
    per_tile(t, (const LAS char*)(ring + slot * A_STAGE));
    slot = (slot == 2) ? 0 : slot + 1;
  }
#undef A_ISSUE
  LDS_BAR();
}

DI float l_total(float l) { return l + __shfl_xor(l, 32); }

DI void store_o(char* rowp, const f32x16 (&o)[2], int h) {
#pragma unroll
  for (int dd = 0; dd < 2; ++dd)
#pragma unroll
    for (int g = 0; g < 4; ++g) {
      u32x2 w; w.x = cvt_pk(o[dd][4 * g + 0], o[dd][4 * g + 1]); w.y = cvt_pk(o[dd][4 * g + 2], o[dd][4 * g + 3]);
      *(u32x2*)(rowp + (32 * dd + 8 * g + 4 * h) * 2) = w;
    }
}
struct Params {
  const float* in[28];
  float* out;
  unsigned* bar;
  int* cnt;
  bf16_t *win0t, *wout0t, *cw1k, *cw1v, *cw2k, *cw2v, *win1t, *wuqt, *wukvt, *wout1t;
  bf16_t *rwh[2], *rwl[2], *shgu[2], *shd[2];
  bf16_t *egu, *ed;
  float *cb1k, *cb1v;
  float2 *cs64, *cs32;
  bf16_t *xb;
  bf16_t *q0, *ka, *ks, *kw, *kc0, *vc0, *vta, *vts, *vtw, *h1k, *h1v, *kcmp, *vcmpt, *obuf;
  float* gates;
  bf16_t *x1lo, *hbuf, *slab;
  int2* lists;
  float* cbuf;
  bf16_t *cqb, *ckvb, *krb, *q1, *kn, *vt1;
  int nsplit;
  int pad_;
};
enum { PH_PREP = 0, PH_INPROJ0, PH_SWA_CMP1, PH_CMP2, PH_NSA, PH_OUTPROJ, PH_LNSPLIT, PH_ROUTER, PH_EXP1, PH_EXP2, PH_COMBINE, PH_INPROJ1, PH_MLANORM, PH_MLAUP, PH_MLAATT };

DI void xpose_item(LAS float* tile, const float* src, int N, int k0, int n0, bf16_t* dst, int ldd, int mode, bf16_t* dst_lo) {
  const int tid = thr();
  {
    const int n = tid & 63, kk = tid >> 6;
    const bool ok = (n0 + n) < N;
#pragma unroll
    for (int i = 0; i < 8; ++i) { const int k = kk + 8 * i; tile[k * 65 + n] = ok ? src[(size_t)(k0 + k) * N + n0 + n] : 0.f; }
  }
  __syncthreads();
  {
    const int n = tid >> 3, kc = (tid & 7) * 8, gn = n0 + n;
    if (gn < N) {
      float v[8];
#pragma unroll
      for (int j = 0; j < 8; ++j) v[j] = tile[(kc + j) * 65 + n];
      int row = gn;
      if (mode == 1) row = 64 * (gn >> 5) + (gn & 31);
      if (mode == 2) row = 64 * (gn >> 5) + 32 + (gn & 31);
      u32x4 w; w.x = cvt_pk(v[0], v[1]); w.y = cvt_pk(v[2], v[3]); w.z = cvt_pk(v[4], v[5]); w.w = cvt_pk(v[6], v[7]);
      *(u32x4*)(dst + (size_t)row * ldd + k0 + kc) = w;
      if (dst_lo) {
        float r[8];
#pragma unroll
        for (int j = 0; j < 8; ++j) { const unsigned pk = (j & 1) ? (w[j >> 1] >> 16) : (w[j >> 1] & 0xffffu); r[j] = v[j] - __uint_as_float(pk << 16); }
        u32x4 w2; w2.x = cvt_pk(r[0], r[1]); w2.y = cvt_pk(r[2], r[3]); w2.z = cvt_pk(r[4], r[5]); w2.w = cvt_pk(r[6], r[7]);
        *(u32x4*)(dst_lo + (size_t)row * ldd + k0 + kc) = w2;
      }
    }
  }
  __syncthreads();
}
DI void xpose_matrix(LAS float* tile, const float* src, int K, int N, bf16_t* dst, int mode, bf16_t* dst_lo, int& itbase) {
  const int nkt = K / 64, nnt = (N + 63) / 64, total = nkt * nnt;
  int first = (int)((blockIdx.x + gridDim.x - (itbase % gridDim.x)) % gridDim.x);
  for (int i = first; i < total; i += gridDim.x) xpose_item(tile, src, N, (i % nkt) * 64, (i / nkt) * 64, dst, K, mode, dst_lo);
  itbase += total;
}
DI void zero_rows(bf16_t* dst, size_t nelem) {
  u32x4 z = (u32x4){0u, 0u, 0u, 0u};
  for (size_t i = ((size_t)blockIdx.x * NTHR + thr()) * 8; i < nelem; i += (size_t)gridDim.x * NTHR * 8) *(u32x4*)(dst + i) = z;
}
DI void expert_weights(const Params& p, LAS float* tile, int layer, int& it) {
  const size_t eo = (size_t)layer * 64 * 262144;
  for (int e = 0; e < 64; ++e) {
    xpose_matrix(tile, p.in[22] + eo + (size_t)e * 262144, 1024, 256, p.egu + (size_t)e * 524288, 1, nullptr, it);
    xpose_matrix(tile, p.in[23] + eo + (size_t)e * 262144, 1024, 256, p.egu + (size_t)e * 524288, 2, nullptr, it);
    xpose_matrix(tile, p.in[24] + eo + (size_t)e * 262144, 256, 1024, p.ed + (size_t)e * 262144, 0, nullptr, it);
  }
}
DI void phase_prep(const Params& p, LAS char* lds) {
  LAS float* tile = (LAS float*)lds;
  const int tid = thr();
  for (size_t i = ((size_t)blockIdx.x * NTHR + tid) * 8; i < (size_t)NTOK * DM; i += (size_t)gridDim.x * NTHR * 8) {
    const f32x4 a = *(const f32x4*)(p.in[0] + i), b = *(const f32x4*)(p.in[0] + i + 4);
    u32x4 w; w.x = cvt_pk(a[0], a[1]); w.y = cvt_pk(a[2], a[3]); w.z = cvt_pk(b[0], b[1]); w.w = cvt_pk(b[2], b[3]);
    *(u32x4*)(p.xb + i) = w;
  }
  zero_rows(p.win0t + (size_t)2072 * 1024, (size_t)104 * 1024);
  zero_rows(p.cw2k + 64 * 128, 64 * 128);
  zero_rows(p.cw2v + 64 * 128, 64 * 128);
  zero_rows(p.win1t + (size_t)672 * 1024, (size_t)96 * 1024);
  for (int l = 0; l < 2; ++l) { zero_rows(p.rwh[l] + 64 * 1024, 64 * 1024); zero_rows(p.rwl[l] + 64 * 1024, 64 * 1024); }
  if (blockIdx.x == 0 && tid < 256) p.cnt[tid] = 0;
  for (int i = blockIdx.x * NTHR + tid; i < 4096 * 32; i += gridDim.x * NTHR) {
    const int t = i >> 5, f = i & 31;
    const float ang = (float)t * powf(10000.0f, -2.0f * (float)f / 64.0f);
    p.cs64[i] = make_float2(cosf(ang), sinf(ang));
  }
  for (int i = blockIdx.x * NTHR + tid; i < 4096 * 16; i += gridDim.x * NTHR) {
    const int t = i >> 4, f = i & 15;
    const float ang = (float)t * powf(10000.0f, -2.0f * (float)f / 32.0f);
    p.cs32[i] = make_float2(cosf(ang), sinf(ang));
  }
  if (blockIdx.x == 1 || blockIdx.x == 2) {
    const float* pe = blockIdx.x == 1 ? p.in[3] : p.in[6];
    const float* w1 = blockIdx.x == 1 ? p.in[4] : p.in[7];
    float* dst = blockIdx.x == 1 ? p.cb1k : p.cb1v;
    const int j = tid & 127, part = tid >> 7;
    float s = 0.f;
    for (int k = part * 512; k < part * 512 + 512; ++k) s = fmaf(pe[k], w1[(size_t)k * 128 + j], s);
    tile[tid] = s;
    __syncthreads();
    if (tid < 128) dst[tid] = tile[tid] + tile[tid + 128] + tile[tid + 256] + tile[tid + 384];
    __syncthreads();
  }
  int it = 0;
  xpose_matrix(tile, p.in[1], 1024, 2072, p.win0t, 0, nullptr, it);
  xpose_matrix(tile, p.in[9], 1024, 1024, p.wout0t, 0, nullptr, it);
  xpose_matrix(tile, p.in[4], 2048, 128, p.cw1k, 0, nullptr, it);
  xpose_matrix(tile, p.in[7], 2048, 128, p.cw1v, 0, nullptr, it);
  xpose_matrix(tile, p.in[5], 128, 64, p.cw2k, 0, nullptr, it);
  xpose_matrix(tile, p.in[8], 128, 64, p.cw2v, 0, nullptr, it);
  xpose_matrix(tile, p.in[10], 1024, 672, p.win1t, 0, nullptr, it);
  xpose_matrix(tile, p.in[13], 384, 1536, p.wuqt, 0, nullptr, it);
  xpose_matrix(tile, p.in[14], 256, 2048, p.wukvt, 0, nullptr, it);
  xpose_matrix(tile, p.in[15], 1024, 1024, p.wout1t, 0, nullptr, it);
  for (int l = 0; l < 2; ++l) {
    xpose_matrix(tile, p.in[20] + (size_t)l * 65536, 1024, 64, p.rwh[l], 0, p.rwl[l], it);
    xpose_matrix(tile, p.in[25] + (size_t)l * 262144, 1024, 256, p.shgu[l], 1, nullptr, it);
    xpose_matrix(tile, p.in[26] + (size_t)l * 262144, 1024, 256, p.shgu[l], 2, nullptr, it);
    xpose_matrix(tile, p.in[27] + (size_t)l * 262144, 256, 1024, p.shd[l], 0, nullptr, it);
  }
  expert_weights(p, tile, 0, it);
}

DI void rope64_store(const f32x4 (&acc)[4][4], int m, const float2* cs, bf16_t* rowp, int fq) {
#pragma unroll
  for (int n = 0; n < 2; ++n) {
    const f32x4 c0 = *(const f32x4*)(cs + n * 16 + 4 * fq), c1 = *(const f32x4*)(cs + n * 16 + 4 * fq + 2);
    const float co[4] = {c0[0], c0[2], c1[0], c1[2]}, si[4] = {c0[1], c0[3], c1[1], c1[3]};
    float y1[4], y2[4];
#pragma unroll
    for (int j = 0; j < 4; ++j) { const float x1 = acc[m][n][j], x2 = acc[m][n + 2][j]; y1[j] = x1 * co[j] - x2 * si[j]; y2[j] = x1 * si[j] + x2 * co[j]; }
    u32x2 w1, w2; w1.x = cvt_pk(y1[0], y1[1]); w1.y = cvt_pk(y1[2], y1[3]); w2.x = cvt_pk(y2[0], y2[1]); w2.y = cvt_pk(y2[2], y2[3]);
    *(u32x2*)(rowp + n * 16 + 4 * fq) = w1;
    *(u32x2*)(rowp + 32 + n * 16 + 4 * fq) = w2;
  }
}
DI void plain64_store(const f32x4 (&acc)[4][4], int m, bf16_t* rowp, int fq) {
#pragma unroll
  for (int n = 0; n < 4; ++n) {
    u32x2 w; w.x = cvt_pk(acc[m][n][0], acc[m][n][1]); w.y = cvt_pk(acc[m][n][2], acc[m][n][3]);
    *(u32x2*)(rowp + n * 16 + 4 * fq) = w;
  }
}
DI void vt64_store(const f32x4 (&acc)[4][4], int m, bf16_t* vt_base  , int ld, int tperm, int fq) {
#pragma unroll
  for (int n = 0; n < 4; ++n)
#pragma unroll
    for (int j = 0; j < 4; ++j) vt_base[(size_t)(n * 16 + 4 * fq + j) * ld + tperm] = f2bf(acc[m][n][j]);
}

DI void phase_inproj0(const Params& p, LAS char* lds) {
  const int tid = thr(), lane = tid & 63, wid = __builtin_amdgcn_readfirstlane(tid >> 6);
  const int wr = wid >> 1, wc = wid & 1, fr = lane & 15, fq = lane >> 4;
  for (int u = blockIdx.x; u < 128 * 17; u += gridDim.x) {
    const int mt = u / 17, nt = u % 17, m0 = mt * 256, n0 = nt * 128;
    const char* a0 = (const char*)(p.xb + (size_t)(m0 + (tid >> 2)) * 1024) + (tid & 3) * 16;
    const char* a1 = a0 + (size_t)128 * 2048;
    const char* bs = (const char*)(p.win0t + (size_t)(n0 + (tid >> 2)) * 1024) + (tid & 3) * 16;
    f32x4 acc[4][4]; zero_acc(acc);
    gemm_kloop(lds, a0, a1, bs, 32, acc);
    const int G = (n0 + wc * 64) >> 6;
#pragma unroll
    for (int m = 0; m < 4; ++m) {
      const int row = m0 + wr * 64 + m * 16 + fr, b = row >> 12, t = row & 4095;
      const float2* cs = p.cs64 + t * 32;
      if (G < 8) rope64_store(acc, m, cs, p.q0 + ((size_t)(b * 16 + G) * 4096 + t) * 64, fq);
      else if (G < 10) rope64_store(acc, m, cs, p.ka + ((size_t)(b * 2 + (G - 8)) * 4096 + t) * 64, fq);
      else if (G < 12) vt64_store(acc, m, p.vta + (size_t)(b * 2 + (G - 10)) * 64 * 4096, 4096, perm16(t), fq);
      else if (G < 20) rope64_store(acc, m, cs, p.q0 + ((size_t)(b * 16 + 8 + (G - 12)) * 4096 + t) * 64, fq);
      else if (G < 22) plain64_store(acc, m, p.kc0 + ((size_t)(b * 2 + (G - 20)) * 4096 + t) * 64, fq);
      else if (G < 24) plain64_store(acc, m, p.vc0 + ((size_t)(b * 2 + (G - 22)) * 4096 + t) * 64, fq);
      else if (G < 26) rope64_store(acc, m, cs, p.ks + ((size_t)(b * 2 + (G - 24)) * 4096 + t) * 64, fq);
      else if (G < 28) vt64_store(acc, m, p.vts + (size_t)(b * 2 + (G - 26)) * 64 * 4096, 4096, perm16(t), fq);
      else if (G < 30) rope64_store(acc, m, cs, p.kw + ((size_t)(b * 2 + (G - 28)) * 4096 + t) * 64, fq);
      else if (G < 32) vt64_store(acc, m, p.vtw + (size_t)(b * 2 + (G - 30)) * 64 * 4096, 4096, perm16(t), fq);
      else if (G == 32) {
#pragma unroll
        for (int n = 0; n < 2; ++n)
#pragma unroll
          for (int j = 0; j < 4; ++j) { const int c = n * 16 + 4 * fq + j; if (c < 24) p.gates[(size_t)row * 24 + c] = sigmoidf_(acc[m][n][j]); }
      }
    }
  }
}

DI void phase_outproj(const Params& p, LAS char* lds, int layer) {
  const int tid = thr(), lane = tid & 63, wid = __builtin_amdgcn_readfirstlane(tid >> 6);
  const int wr = wid >> 1, wc = wid & 1, fr = lane & 15, fq = lane >> 4;
  const bf16_t* A = layer == 0 ? p.obuf : p.xb;
  const bf16_t* Bt = layer == 0 ? p.wout0t : p.wout1t;
  const float* resid = layer == 0 ? p.in[0] : p.out;
  for (int u = blockIdx.x; u < 128 * 8; u += gridDim.x) {
    const int mt = u >> 3, nt = u & 7, m0 = mt * 256, n0 = nt * 128;
    const char* a0 = (const char*)(A + (size_t)(m0 + (tid >> 2)) * 1024) + (tid & 3) * 16;
    const char* a1 = a0 + (size_t)128 * 2048;
    const char* bs = (const char*)(Bt + (size_t)(n0 + (tid >> 2)) * 1024) + (tid & 3) * 16;
    f32x4 acc[4][4]; zero_acc(acc);
    gemm_kloop(lds, a0, a1, bs, 32, acc);
#pragma unroll
    for (int m = 0; m < 4; ++m) {
      const size_t row = m0 + wr * 64 + m * 16 + fr;
#pragma unroll
      for (int n = 0; n < 4; ++n) {
        const size_t o = row * 1024 + n0 + wc * 64 + n * 16 + 4 * fq;
        const f32x4 r = *(const f32x4*)(resid + o);
        *(f32x4*)(p.out + o) = r * ALPHA + acc[m][n];
      }
    }
  }
}

DI float gelu_tanh_(float v) {
  const float u = 0.7978845608028654f * (v + 0.044715f * v * v * v);
  const float e = __expf(2.0f * u);
  const float th = 1.0f - 2.0f / (e + 1.0f);
  return 0.5f * v * (1.0f + th);
}

DI void cmp1_unit(const Params& p, LAS char* lds, int u) {
  const int tid = thr(), lane = tid & 63, wid = __builtin_amdgcn_readfirstlane(tid >> 6);
  const int wr = wid >> 1, wc = wid & 1, fr = lane & 15, fq = lane >> 4;
  const int tensor = u >> 4, bg = u & 15;
  const bf16_t* src = (tensor == 0 ? p.kc0 : p.vc0) + (size_t)bg * 4096 * 64;
  const bf16_t* w1 = tensor == 0 ? p.cw1k : p.cw1v;
  const float* bias = tensor == 0 ? p.cb1k : p.cb1v;
  bf16_t* hout = (tensor == 0 ? p.h1k : p.h1v) + (size_t)bg * 256 * 128;
  const int r0 = tid >> 2, r1 = r0 + 128;
  const char* a0 = (const char*)(src + (size_t)16 * (r0 < 254 ? r0 : 254) * 64) + (tid & 3) * 16;
  const char* a1 = (const char*)(src + (size_t)16 * (r1 < 254 ? r1 : 254) * 64) + (tid & 3) * 16;
  const char* bs = (const char*)(w1 + (size_t)(tid >> 2) * 2048) + (tid & 3) * 16;
  f32x4 acc[4][4]; zero_acc(acc);
  gemm_kloop(lds, a0, a1, bs, 64, acc);
#pragma unroll
  for (int m = 0; m < 4; ++m) {
    const int row = wr * 64 + m * 16 + fr;
#pragma unroll
    for (int n = 0; n < 4; ++n) {
      const int c = wc * 64 + n * 16 + 4 * fq;
      const f32x4 bv = *(const f32x4*)(bias + c);
      u32x2 w; w.x = cvt_pk(gelu_tanh_(acc[m][n][0] + bv[0]), gelu_tanh_(acc[m][n][1] + bv[1]));
      w.y = cvt_pk(gelu_tanh_(acc[m][n][2] + bv[2]), gelu_tanh_(acc[m][n][3] + bv[3]));
      *(u32x2*)(hout + (size_t)row * 128 + c) = w;
    }
  }
}
DI void phase_cmp2(const Params& p, LAS char* lds) {
  const int tid = thr(), lane = tid & 63, wid = __builtin_amdgcn_readfirstlane(tid >> 6);
  const int wr = wid >> 1, wc = wid & 1, fr = lane & 15, fq = lane >> 4;
  for (int u = blockIdx.x; u < 32; u += gridDim.x) {
    const int tensor = u >> 4, bg = u & 15;
    const bf16_t* hin = (tensor == 0 ? p.h1k : p.h1v) + (size_t)bg * 256 * 128;
    const bf16_t* w2 = tensor == 0 ? p.cw2k : p.cw2v;
    const char* a0 = (const char*)(hin + (size_t)(tid >> 2) * 128) + (tid & 3) * 16;
    const char* a1 = a0 + 128 * 256;
    const char* bs = (const char*)(w2 + (size_t)(tid >> 2) * 128) + (tid & 3) * 16;
    f32x4 acc[4][4]; zero_acc(acc);
    gemm_kloop(lds, a0, a1, bs, 4, acc);
    if (wc == 0) {
#pragma unroll
      for (int m = 0; m < 4; ++m) {
        const int n_row = wr * 64 + m * 16 + fr;
        const bool valid = n_row < 255;
        if (!valid) {
#pragma unroll
          for (int n = 0; n < 4; ++n) acc[m][n] = (f32x4){0.f, 0.f, 0.f, 0.f};
        }
        if (tensor == 0) {
          const int pos = valid ? 16 * n_row + 31 : 0;
          rope64_store(acc, m, p.cs64 + pos * 32, p.kcmp + ((size_t)bg * 256 + n_row) * 64, fq);
        } else {
          vt64_store(acc, m, p.vcmpt + (size_t)bg * 64 * 256, 256, perm16(n_row), fq);
        }
      }
    }
  }
}

DI void load_q4(bf16x8 (&qf)[6], const bf16_t* qrow, int h) {
#pragma unroll
  for (int ks = 0; ks < 4; ++ks) qf[ks] = *(const bf16x8*)(qrow + (2 * ks + h) * 8);
}
DI void zero_o(f32x16 (&o)[2]) {
#pragma unroll
  for (int r = 0; r < 16; ++r) { o[0][r] = 0.f; o[1][r] = 0.f; }
}

DI void swa_unit(const Params& p, LAS char* lds, int u) {
  const int tid = thr(), lane = tid & 63, wid = __builtin_amdgcn_readfirstlane(tid >> 6);
  const int r32 = lane & 31, h = lane >> 5;
  const int b = u >> 7, g = (u >> 6) & 1, qb = u & 63, t0 = qb * 64;
  const int hd = g * 4 + (wid & 3), t = t0 + 32 * (wid >> 2) + r32;
  bf16x8 qf[6];
  load_q4(qf, p.q0 + ((size_t)(b * 16 + hd) * 4096 + t) * 64, h);
  f32x16 o[2]; zero_o(o);
  float m = NEGBIG, l = 0.f;
  const float c = 0.125f * LOG2E;
  const int tlo = (t0 - 127) < 0 ? 0 : ((t0 - 127) >> 6);
  const char* kb = (const char*)(p.ka + (size_t)(b * 2 + g) * 4096 * 64);
  const char* vb = (const char*)(p.vta + (size_t)(b * 2 + g) * 64 * 4096);
  kv_stream<false>(lds, kb, vb, 8192, nullptr, tlo, qb, [&](int tile, const LAS char* st) {
    f32x16 sA, sB;
    qk_tile<false>(st, nullptr, qf, r32, h, sA, sB);
    mask_scores(sA, sB, tile * 64, t - 128, t, h);
    softmax_step(sA, sB, c, m, l, o);
    pv_tile(st + 8192, sA, sB, r32, h, o);
  });
  float lt = l_total(l);
  lt += fast_exp2(p.in[2][hd] * LOG2E - m * c);
  const float inv = 1.0f / lt;
#pragma unroll
  for (int r = 0; r < 16; ++r) { o[0][r] *= inv; o[1][r] *= inv; }
  store_o((char*)(p.obuf + (size_t)(b * 4096 + t) * 1024 + hd * 64), o, h);
}

constexpr int NSA_CMPK = A_RING, NSA_CMPV = NSA_CMPK + 32768, NSA_IMP = NSA_CMPV + 32768, NSA_SELM = NSA_IMP + 64 * 65 * 4, NSA_LDS = NSA_SELM + 512;

DI void nsa_unit(const Params& p, LAS char* lds, int b, int g, int qb) {
  const int tid = thr(), lane = tid & 63, wid = __builtin_amdgcn_readfirstlane(tid >> 6);
  const int r32 = lane & 31, h = lane >> 5;
  const int t0 = qb * 64, qh = wid >> 2, hd = g * 4 + (wid & 3), ql = 32 * qh + r32, t = t0 + ql;
  const int bg = b * 2 + g;
  bf16x8 qf[6];
  load_q4(qf, p.q0 + ((size_t)(b * 16 + 8 + hd) * 4096 + t) * 64, h);
  const float* gp = p.gates + (size_t)(b * 4096 + t) * 24 + hd;
  const float g_cmp = gp[0], g_sel = gp[8], g_win = gp[16];
  const float c = 0.125f * LOG2E;
  f32x16 ot[2]; zero_o(ot);
  LAS float* imp = (LAS float*)(lds + NSA_IMP);
  LAS unsigned long long* selm = (LAS unsigned long long*)(lds + NSA_SELM);
  {
    const char* ksrc = (const char*)(p.kcmp + (size_t)bg * 256 * 64);
    const char* vsrc = (const char*)(p.vcmpt + (size_t)bg * 64 * 256);
    asm volatile("s_waitcnt vmcnt(0)" ::: "memory");
#pragma unroll
    for (int i = 0; i < 4; ++i) {
      const int pc = tid + 512 * i, row = pc >> 3, cs = ((pc & 7) ^ ((row >> 1) & 7)) << 4;
      glds16(ksrc + (size_t)row * 128 + cs, lds + NSA_CMPK + pc * 16);
      const int d = tid >> 3, cv = ((tid & 7) ^ ((d >> 1) & 7)) << 4;
      glds16(vsrc + (size_t)d * 512 + i * 128 + cv, lds + NSA_CMPV + i * 8192 + tid * 16);
    }
    for (int i = tid; i < 64 * 65; i += NTHR) imp[i] = 0.f;
    WAIT_VM_BAR(0);
  }
  {
    const int hi_c = (t - 31) >> 4;
    const int nmax = (t0 + 63 - 31) >> 4;
    const int ntile = (nmax >> 6) + 1;
    float m = NEGBIG, l = 0.f;
    for (int j = 0; j < ntile; ++j) {
      f32x16 sA, sB;
      qk_tile<false>(lds + NSA_CMPK + j * 8192, nullptr, qf, r32, h, sA, sB);
      mask_scores(sA, sB, j * 64, -1000000, hi_c, h);
      const float mnew = fmaxf(m, row_max32(sA, sB));
      const float mc = (mnew < -1e29f) ? 0.f : mnew * c;
      float sum = 0.f;
#pragma unroll
      for (int r = 0; r < 16; ++r) sum += fast_exp2(__builtin_fmaf(sA[r], c, -mc)) + fast_exp2(__builtin_fmaf(sB[r], c, -mc));
      l = l * fast_exp2(m * c - mc) + sum;
      m = mnew;
    }
    const float lt = l_total(l);
    const float inv = lt > 0.f ? 1.0f / lt : 0.f;
    const float mc = (m < -1e29f) ? 0.f : m * c;
    f32x16 oc[2]; zero_o(oc);
    for (int j = 0; j < ntile; ++j) {
      f32x16 sA, sB;
      qk_tile<false>(lds + NSA_CMPK + j * 8192, nullptr, qf, r32, h, sA, sB);
      mask_scores(sA, sB, j * 64, -1000000, hi_c, h);
#pragma unroll
      for (int r = 0; r < 16; ++r) { sA[r] = fast_exp2(__builtin_fmaf(sA[r], c, -mc)) * inv; sB[r] = fast_exp2(__builtin_fmaf(sB[r], c, -mc)) * inv; }
#pragma unroll
      for (int q4 = 0; q4 < 4; ++q4) {
        const int mb = 16 * j + 2 * q4 + h;
        const float a0 = sA[4 * q4] + sA[4 * q4 + 1] + sA[4 * q4 + 2] + 0.5f * sA[4 * q4 + 3];
        const float a1 = sB[4 * q4] + sB[4 * q4 + 1] + sB[4 * q4 + 2] + 0.5f * sB[4 * q4 + 3];
        atomicAdd((float*)(imp + ql * 65 + mb), a0);
        atomicAdd((float*)(imp + ql * 65 + mb + 1), 0.5f * sA[4 * q4 + 3]);
        atomicAdd((float*)(imp + ql * 65 + mb + 8), a1);
        if (mb + 9 < 64) atomicAdd((float*)(imp + ql * 65 + mb + 9), 0.5f * sB[4 * q4 + 3]);
      }
      pv_tile(lds + NSA_CMPV + j * 8192, sA, sB, r32, h, oc);
    }
#pragma unroll
    for (int r = 0; r < 16; ++r) { ot[0][r] = g_cmp * oc[0][r]; ot[1][r] = g_cmp * oc[1][r]; }
  }
  LDS_BAR();
  for (int i = 0; i < 8; ++i) {
    const int q = wid * 8 + i, tq = t0 + q;
    const float iv = imp[q * 65 + lane];
    const bool forced = (lane == 0) || (lane == qb) || (lane == qb - 1);
    const bool future = lane * 64 > tq;
    const float score = forced ? 1e4f : (future ? -1.0f : iv);
    int rank = 0;
#pragma unroll 8
    for (int j = 0; j < 64; ++j) { const float sj = __shfl(score, j); rank += (sj > score || (sj == score && j < lane)) ? 1 : 0; }
    const unsigned long long bal = __ballot(rank < 16);
    if (lane == 0) selm[q] = bal;
  }
  LDS_BAR();
  const unsigned long long mysel = selm[ql];
  {
    f32x16 o[2]; zero_o(o);
    float m = NEGBIG, l = 0.f;
    const char* kb = (const char*)(p.ks + (size_t)bg * 4096 * 64);
    const char* vb = (const char*)(p.vts + (size_t)bg * 64 * 4096);
    kv_stream<false>(lds, kb, vb, 8192, nullptr, 0, qb, [&](int tile, const LAS char* st) {
      f32x16 sA, sB;
      qk_tile<false>(st, nullptr, qf, r32, h, sA, sB);
      const int hi = ((mysel >> tile) & 1ull) ? t : -1;
      mask_scores(sA, sB, tile * 64, -1000000, hi, h);
      softmax_step(sA, sB, c, m, l, o);
      pv_tile(st + 8192, sA, sB, r32, h, o);
    });
    const float lt = l_total(l);
    const float sc = lt > 0.f ? g_sel / lt : 0.f;
#pragma unroll
    for (int r = 0; r < 16; ++r) { ot[0][r] += sc * o[0][r]; ot[1][r] += sc * o[1][r]; }
  }
  {
    f32x16 o[2]; zero_o(o);
    float m = NEGBIG, l = 0.f;
    const char* kb = (const char*)(p.kw + (size_t)bg * 4096 * 64);
    const char* vb = (const char*)(p.vtw + (size_t)bg * 64 * 4096);
    const int tlo = (t0 - 511) < 0 ? 0 : ((t0 - 511) >> 6);
    kv_stream<false>(lds, kb, vb, 8192, nullptr, tlo, qb, [&](int tile, const LAS char* st) {
      f32x16 sA, sB;
      qk_tile<false>(st, nullptr, qf, r32, h, sA, sB);
      mask_scores(sA, sB, tile * 64, t - 512, t, h);
      softmax_step(sA, sB, c, m, l, o);
      pv_tile(st + 8192, sA, sB, r32, h, o);
    });
    const float lt = l_total(l);
    const float sc = lt > 0.f ? g_win / lt : 0.f;
#pragma unroll
    for (int r = 0; r < 16; ++r) { ot[0][r] += sc * o[0][r]; ot[1][r] += sc * o[1][r]; }
  }
  store_o((char*)(p.obuf + (size_t)(b * 4096 + t) * 1024 + 512 + hd * 64), ot, h);
}

DI void phase_swa_cmp1(const Params& p, LAS char* lds) {
  for (int u = blockIdx.x; u < 32 + 1024; u += gridDim.x) {
    if (u < 32) cmp1_unit(p, lds, u); else swa_unit(p, lds, u - 32);
  }
}
DI void phase_nsa(const Params& p, LAS char* lds) {
  const int G = gridDim.x;
  for (int j = 0;; ++j) {
    const int pos = (j & 1) ? j * G + (G - 1 - (int)blockIdx.x) : j * G + (int)blockIdx.x;
    if (j * G >= 1024) break;
    if (pos < 1024) nsa_unit(p, lds, (pos & 15) >> 1, pos & 1, 63 - (pos >> 4));
  }
}

DI void mla_unit(const Params& p, LAS char* lds, int b, int hd, int qb4) {
  const int tid = thr(), lane = tid & 63, wid = __builtin_amdgcn_readfirstlane(tid >> 6);
  const int r32 = lane & 31, h = lane >> 5;
  const int tw0 = qb4 * 256 + 32 * wid, t = tw0 + r32;
  const bf16_t* qrow = p.q1 + ((size_t)(b * 16 + hd) * 4096 + t) * 96;
  bf16x8 qf[6];
#pragma unroll
  for (int ks = 0; ks < 6; ++ks) qf[ks] = *(const bf16x8*)(qrow + (2 * ks + h) * 8);
  f32x16 o[2]; zero_o(o);
  float m = NEGBIG, l = 0.f;
  const float c = 0.10206207261596577f * LOG2E;
  const char* kb = (const char*)(p.kn + (size_t)(b * 16 + hd) * 4096 * 64);
  const char* vb = (const char*)(p.vt1 + (size_t)(b * 16 + hd) * 64 * 4096);
  const char* rb = (const char*)(p.krb + (size_t)b * 4096 * 32);
  kv_stream<true>(lds, kb, vb, 8192, rb, 0, qb4 * 4 + 3, [&](int tile, const LAS char* st) {
    if (tile * 64 <= tw0 + 31) {
      f32x16 sA, sB;
      qk_tile<true>(st, st + 16384, qf, r32, h, sA, sB);
      if (tile * 64 + 63 > tw0) mask_scores(sA, sB, tile * 64, -1000000, t, h);
      softmax_step(sA, sB, c, m, l, o);
      pv_tile(st + 8192, sA, sB, r32, h, o);
    }
  });
  const float inv = 1.0f / l_total(l);
#pragma unroll
  for (int r = 0; r < 16; ++r) { o[0][r] *= inv; o[1][r] *= inv; }
  store_o((char*)(p.xb + (size_t)(b * 4096 + t) * 1024 + hd * 64), o, h);
}
DI void phase_mla(const Params& p, LAS char* lds) {
  const int G = gridDim.x;
  for (int j = 0;; ++j) {
    const int pos = (j & 1) ? j * G + (G - 1 - (int)blockIdx.x) : j * G + (int)blockIdx.x;
    if (j * G >= 2048) break;
    if (pos < 2048) mla_unit(p, lds, (pos & 127) >> 4, pos & 15, 15 - (pos >> 7));
  }
}
DI void ln_row(const f32x4 (&v)[4], const float* gam, const float* bet, int lane, f32x4 (&y)[4]) {
  float s = 0.f;
#pragma unroll
  for (int j = 0; j < 4; ++j) s += (v[j][0] + v[j][1]) + (v[j][2] + v[j][3]);
  const float mu = wave_sum(s) * (1.0f / 1024.0f);
  float q = 0.f;
  f32x4 d[4];
#pragma unroll
  for (int j = 0; j < 4; ++j) { d[j] = v[j] - mu; q += (d[j][0] * d[j][0] + d[j][1] * d[j][1]) + (d[j][2] * d[j][2] + d[j][3] * d[j][3]); }
  const float rs = rsqrtf(wave_sum(q) * (1.0f / 1024.0f) + 1e-5f);
#pragma unroll
  for (int j = 0; j < 4; ++j) {
    const f32x4 gv = *(const f32x4*)(gam + 4 * lane + 256 * j), bv = *(const f32x4*)(bet + 4 * lane + 256 * j);
    y[j] = d[j] * rs * gv + bv;
  }
}
DI void phase_lnsplit(const Params& p, int layer) {
  const int lane = thr() & 63, gw = blockIdx.x * 8 + (thr() >> 6), nw = gridDim.x * 8;
  const float* gam = p.in[16] + layer * 1024;
  const float* bet = p.in[17] + layer * 1024;
  for (int row = gw; row < NTOK; row += nw) {
    float* xr = p.out + (size_t)row * 1024;
    f32x4 v[4], y[4];
#pragma unroll
    for (int j = 0; j < 4; ++j) v[j] = *(const f32x4*)(xr + 4 * lane + 256 * j);
    ln_row(v, gam, bet, lane, y);
#pragma unroll
    for (int j = 0; j < 4; ++j) {
      *(f32x4*)(xr + 4 * lane + 256 * j) = y[j];
      u32x2 hi; hi.x = cvt_pk(y[j][0], y[j][1]); hi.y = cvt_pk(y[j][2], y[j][3]);
      const float r0 = y[j][0] - __uint_as_float(hi.x << 16), r1 = y[j][1] - __uint_as_float(hi.x & 0xffff0000u);
      const float r2 = y[j][2] - __uint_as_float(hi.y << 16), r3 = y[j][3] - __uint_as_float(hi.y & 0xffff0000u);
      u32x2 lo; lo.x = cvt_pk(r0, r1); lo.y = cvt_pk(r2, r3);
      *(u32x2*)(p.xb + (size_t)row * 1024 + 4 * lane + 256 * j) = hi;
      *(u32x2*)(p.x1lo + (size_t)row * 1024 + 4 * lane + 256 * j) = lo;
    }
  }
}

constexpr int LIST_CAP = 32768;
DI void phase_router(const Params& p, LAS char* lds, int layer) {
  const int tid = thr(), lane = tid & 63, wid = __builtin_amdgcn_readfirstlane(tid >> 6);
  const int wr = wid >> 1, wc = wid & 1, fr = lane & 15, fq = lane >> 4;
  LAS float* lg = (LAS float*)(lds + G_LDS);
  LAS int* hist = (LAS int*)(lds + G_LDS + 256 * 65 * 4);
  LAS int* se = hist + 128;
  LAS float* sw = (LAS float*)(se + 256 * 6);
  const int half_tokens = NTOK / p.nsplit, cap = LIST_CAP / p.nsplit;
  const float* bias = p.in[21] + layer * 64;
  for (int u = blockIdx.x; u < 128; u += gridDim.x) {
    const int m0 = u * 256;
    const size_t aro = (size_t)(m0 + (tid >> 2)) * 2048 + (tid & 3) * 16;
    const size_t bro = (size_t)(tid >> 2) * 2048 + (tid & 3) * 16;
    f32x4 acc[4][4]; zero_acc(acc);
    gemm_kloop(lds, (const char*)p.xb + aro, (const char*)p.xb + aro + 128 * 2048, (const char*)p.rwh[layer] + bro, 32, acc);
    gemm_kloop(lds, (const char*)p.x1lo + aro, (const char*)p.x1lo + aro + 128 * 2048, (const char*)p.rwh[layer] + bro, 32, acc);
    gemm_kloop(lds, (const char*)p.xb + aro, (const char*)p.xb + aro + 128 * 2048, (const char*)p.rwl[layer] + bro, 32, acc);
    if (wc == 0) {
#pragma unroll
      for (int m = 0; m < 4; ++m)
#pragma unroll
        for (int n = 0; n < 4; ++n)
#pragma unroll
          for (int j = 0; j < 4; ++j) lg[(wr * 64 + m * 16 + fr) * 65 + n * 16 + 4 * fq + j] = acc[m][n][j];
    }
    if (tid < 64) hist[tid] = 0;
    LDS_BAR();
    const float be = bias[lane];
    for (int i = 0; i < 32; ++i) {
      const int r = wid * 32 + i;
      const float s = sigmoidf_(lg[r * 65 + lane]);
      const float sb = s + be;
      int r8 = 0;
      const int gb = lane & ~7;
#pragma unroll
      for (int j = 0; j < 8; ++j) { const float o = __shfl(sb, gb + j); r8 += (o > sb || (o == sb && (gb + j) < lane)) ? 1 : 0; }
      float gs = r8 < 2 ? sb : 0.f;
      gs += __shfl_xor(gs, 1); gs += __shfl_xor(gs, 2); gs += __shfl_xor(gs, 4);
      const int grp = lane >> 3;
      int gr = 0;
#pragma unroll
      for (int j = 0; j < 8; ++j) { const float o = __shfl(gs, j * 8); gr += (o > gs || (o == gs && j < grp)) ? 1 : 0; }
      const bool allowed = gr < 4;
      const float val = allowed ? sb : -INFINITY;
      int rank = 0;
#pragma unroll 8
      for (int j = 0; j < 64; ++j) { const float o = __shfl(val, j); rank += (o > val || (o == val && j < lane)) ? 1 : 0; }
      const bool sel = allowed && rank < 6;
      const float sum = wave_sum(sel ? s : 0.f);
      if (sel) {
        const int lp = atomicAdd((int*)(hist + lane), 1);
        se[r * 6 + rank] = lane | (lp << 8);
        sw[r * 6 + rank] = s / sum * 2.5f;
      }
    }
    LDS_BAR();
    const int half = m0 / half_tokens;
    if (tid < 64) hist[64 + tid] = atomicAdd(p.cnt + (layer * 2 + half) * 64 + tid, hist[tid]);
    LDS_BAR();
    for (int i = tid; i < 256 * 6; i += NTHR) {
      const int v = se[i], e = v & 255, lp = v >> 8, r = i / 6, slot = i - r * 6;
      const int tok = m0 + r;
      p.lists[((size_t)half * 64 + e) * cap + hist[64 + e] + lp] = make_int2(tok * 8 + slot, __float_as_int(sw[i]));
    }
    LDS_BAR();
  }
}

DI void expert_map(const Params& p, LAS int* tb, int layer, int half) {
  if (thr() < 64) {
    const int c = p.cnt[(layer * 2 + half) * 64 + thr()];
    int t = (c + 255) >> 8, incl = t;
#pragma unroll
    for (int o = 1; o < 64; o <<= 1) { const int v = __shfl_up(incl, o); if ((int)thr() >= o) incl += v; }
    tb[thr()] = incl - t;
    if (thr() == 63) tb[64] = incl;
    tb[65 + thr()] = c;
  }
  LDS_BAR();
}
DI int find_expert(const LAS int* tb, int mt) {
  int e = 0;
#pragma unroll 8
  for (int i = 1; i < 64; ++i) e = (tb[i] <= mt) ? i : e;
  return e;
}
DI void phase_exp1(const Params& p, LAS char* lds, int layer, int half) {
  const int tid = thr(), lane = tid & 63, wid = __builtin_amdgcn_readfirstlane(tid >> 6);
  const int wr = wid >> 1, wc = wid & 1, fr = lane & 15, fq = lane >> 4;
  LAS int* tb = (LAS int*)(lds + G_LDS);
  expert_map(p, tb, layer, half);
  const int half_tokens = NTOK / p.nsplit, cap = LIST_CAP / p.nsplit;
  const int TR = tb[64], TS = half_tokens / 256;
  for (int u = blockIdx.x; u < (TR + TS) * 4; u += gridDim.x) {
    const int mt = u >> 2, nt = u & 3;
    const bf16_t* W;
    int tok0, tok1;
    const int r0 = tid >> 2, r1 = r0 + 128;
    if (mt < TR) {
      const int e = find_expert(tb, mt), cnt = tb[65 + e];
      const int2* lst = p.lists + ((size_t)half * 64 + e) * cap;
      const int i0 = (mt - tb[e]) * 256 + r0, i1 = i0 + 128;
      tok0 = lst[i0 < cnt ? i0 : 0].x >> 3;
      tok1 = lst[i1 < cnt ? i1 : 0].x >> 3;
      W = p.egu + (size_t)e * 524288;
    } else {
      tok0 = half * half_tokens + (mt - TR) * 256 + r0; tok1 = tok0 + 128;
      W = p.shgu[layer];
    }
    const char* a0 = (const char*)(p.xb + (size_t)tok0 * 1024) + (tid & 3) * 16;
    const char* a1 = (const char*)(p.xb + (size_t)tok1 * 1024) + (tid & 3) * 16;
    const char* bs = (const char*)(W + (size_t)(nt * 128 + r0) * 1024) + (tid & 3) * 16;
    f32x4 acc[4][4]; zero_acc(acc);
    gemm_kloop(lds, a0, a1, bs, 32, acc);
#pragma unroll
    for (int m = 0; m < 4; ++m) {
      bf16_t* hrow = p.hbuf + (size_t)(mt * 256 + wr * 64 + m * 16 + fr) * 256 + (nt * 2 + wc) * 32 + 4 * fq;
#pragma unroll
      for (int n = 0; n < 2; ++n) {
        float hv[4];
#pragma unroll
        for (int j = 0; j < 4; ++j) { const float gt = acc[m][n][j]; hv[j] = gt / (1.0f + __expf(-gt)) * acc[m][n + 2][j]; }
        u32x2 w; w.x = cvt_pk(hv[0], hv[1]); w.y = cvt_pk(hv[2], hv[3]);
        *(u32x2*)(hrow + n * 16) = w;
      }
    }
  }
}
DI void phase_exp2(const Params& p, LAS char* lds, int layer, int half) {
  const int tid = thr(), lane = tid & 63, wid = __builtin_amdgcn_readfirstlane(tid >> 6);
  const int wr = wid >> 1, wc = wid & 1, fr = lane & 15, fq = lane >> 4;
  LAS int* tb = (LAS int*)(lds + G_LDS);
  expert_map(p, tb, layer, half);
  const int half_tokens = NTOK / p.nsplit, cap = LIST_CAP / p.nsplit;
  const int TR = tb[64], TS = half_tokens / 256;
  for (int u = blockIdx.x; u < (TR + TS) * 8; u += gridDim.x) {
    const int mt = u >> 3, nt = u & 7, r0 = tid >> 2;
    int e = 0, cnt = 0, ib = 0;
    const bf16_t* W;
    if (mt < TR) { e = find_expert(tb, mt); cnt = tb[65 + e]; ib = (mt - tb[e]) * 256; W = p.ed + (size_t)e * 262144; }
    else W = p.shd[layer];
    const char* a0 = (const char*)(p.hbuf + (size_t)(mt * 256 + r0) * 256) + (tid & 3) * 16;
    const char* a1 = a0 + 128 * 512;
    const char* bs = (const char*)(W + (size_t)(nt * 128 + r0) * 256) + (tid & 3) * 16;
    f32x4 acc[4][4]; zero_acc(acc);
    gemm_kloop(lds, a0, a1, bs, 8, acc);
    const int col0 = nt * 128 + wc * 64 + 4 * fq;
    if (mt < TR) {
      const int2* lst = p.lists + ((size_t)half * 64 + e) * cap;
#pragma unroll
      for (int m = 0; m < 4; ++m) {
        const int idx = ib + wr * 64 + m * 16 + fr;
        if (idx < cnt) {
          const int2 en = lst[idx];
          const float w = __int_as_float(en.y);
          const int tok = en.x >> 3, slot = en.x & 7;
          bf16_t* srow = p.slab + ((size_t)(tok - half * half_tokens) * 6 + slot) * 1024 + col0;
#pragma unroll
          for (int n = 0; n < 4; ++n) { u32x2 v; v.x = cvt_pk(acc[m][n][0] * w, acc[m][n][1] * w); v.y = cvt_pk(acc[m][n][2] * w, acc[m][n][3] * w); *(u32x2*)(srow + n * 16) = v; }
        }
      }
    } else {
#pragma unroll
      for (int m = 0; m < 4; ++m) {
        const size_t tok = (size_t)half * half_tokens + (mt - TR) * 256 + wr * 64 + m * 16 + fr;
        float* orow = p.out + tok * 1024 + col0;
#pragma unroll
        for (int n = 0; n < 4; ++n) { const f32x4 r = *(const f32x4*)(orow + n * 16); *(f32x4*)(orow + n * 16) = r * ALPHA + acc[m][n]; }
      }
    }
  }
}
DI void phase_combine(const Params& p, int layer, int half) {
  const int lane = thr() & 63, gw = blockIdx.x * 8 + (thr() >> 6), nw = gridDim.x * 8;
  const int half_tokens = NTOK / p.nsplit;
  const float* gam = p.in[18] + layer * 1024;
  const float* bet = p.in[19] + layer * 1024;
  for (int r = gw; r < half_tokens; r += nw) {
    const size_t row = (size_t)half * half_tokens + r;
    float* xr = p.out + row * 1024;
    f32x4 v[4], y[4];
#pragma unroll
    for (int j = 0; j < 4; ++j) v[j] = *(const f32x4*)(xr + 4 * lane + 256 * j);
#pragma unroll
    for (int s = 0; s < 6; ++s) {
      const bf16_t* sr = p.slab + ((size_t)r * 6 + s) * 1024;
#pragma unroll
      for (int j = 0; j < 4; ++j) {
        const u32x2 w = *(const u32x2*)(sr + 4 * lane + 256 * j);
        v[j][0] += __uint_as_float(w.x << 16); v[j][1] += __uint_as_float(w.x & 0xffff0000u);
        v[j][2] += __uint_as_float(w.y << 16); v[j][3] += __uint_as_float(w.y & 0xffff0000u);
      }
    }
    ln_row(v, gam, bet, lane, y);
#pragma unroll
    for (int j = 0; j < 4; ++j) {
      *(f32x4*)(xr + 4 * lane + 256 * j) = y[j];
      if (layer == 0) { u32x2 hi; hi.x = cvt_pk(y[j][0], y[j][1]); hi.y = cvt_pk(y[j][2], y[j][3]); *(u32x2*)(p.xb + row * 1024 + 4 * lane + 256 * j) = hi; }
    }
  }
}

DI void phase_inproj1(const Params& p, LAS char* lds) {
  const int tid = thr(), lane = tid & 63, wid = __builtin_amdgcn_readfirstlane(tid >> 6);
  const int wr = wid >> 1, wc = wid & 1, fr = lane & 15, fq = lane >> 4;
  for (int u = blockIdx.x; u < 128 * 6; u += gridDim.x) {
    const int mt = u / 6, nt = u % 6, m0 = mt * 256, n0 = nt * 128;
    const char* a0 = (const char*)(p.xb + (size_t)(m0 + (tid >> 2)) * 1024) + (tid & 3) * 16;
    const char* a1 = a0 + (size_t)128 * 2048;
    const char* bs = (const char*)(p.win1t + (size_t)(n0 + (tid >> 2)) * 1024) + (tid & 3) * 16;
    f32x4 acc[4][4]; zero_acc(acc);
    gemm_kloop(lds, a0, a1, bs, 32, acc);
#pragma unroll
    for (int m = 0; m < 4; ++m) {
      float* crow_ = p.cbuf + (size_t)(m0 + wr * 64 + m * 16 + fr) * 768 + n0 + wc * 64 + 4 * fq;
#pragma unroll
      for (int n = 0; n < 4; ++n) *(f32x4*)(crow_ + n * 16) = acc[m][n];
    }
  }
  int it = 0;
  expert_weights(p, (LAS float*)lds, 1, it);
}
DI void phase_mlanorm(const Params& p) {
  const int lane = thr() & 63, gw = blockIdx.x * 8 + (thr() >> 6), nw = gridDim.x * 8;
  for (int row = gw; row < NTOK; row += nw) {
    const float* cr = p.cbuf + (size_t)row * 768;
    float q[6], kv[4];
    float ss = 0.f;
#pragma unroll
    for (int j = 0; j < 6; ++j) { q[j] = cr[lane + 64 * j]; ss += q[j] * q[j]; }
    const float rq = rsqrtf(wave_sum(ss) * (1.0f / 384.0f) + 1e-6f);
#pragma unroll
    for (int j = 0; j < 6; ++j) p.cqb[(size_t)row * 384 + lane + 64 * j] = f2bf(q[j] * rq * p.in[11][lane + 64 * j]);
    ss = 0.f;
#pragma unroll
    for (int j = 0; j < 4; ++j) { kv[j] = cr[384 + lane + 64 * j]; ss += kv[j] * kv[j]; }
    const float rk = rsqrtf(wave_sum(ss) * (1.0f / 256.0f) + 1e-6f);
#pragma unroll
    for (int j = 0; j < 4; ++j) p.ckvb[(size_t)row * 256 + lane + 64 * j] = f2bf(kv[j] * rk * p.in[12][lane + 64 * j]);
    if (lane < 16) {
      const float x1 = cr[640 + lane], x2 = cr[656 + lane];
      const float2 cs = p.cs32[(row & 4095) * 16 + lane];
      p.krb[(size_t)row * 32 + lane] = f2bf(x1 * cs.x - x2 * cs.y);
      p.krb[(size_t)row * 32 + 16 + lane] = f2bf(x1 * cs.y + x2 * cs.x);
    }
  }
}
DI void phase_mlaup(const Params& p, LAS char* lds) {
  const int tid = thr(), lane = tid & 63, wid = __builtin_amdgcn_readfirstlane(tid >> 6);
  const int wr = wid >> 1, wc = wid & 1, fr = lane & 15, fq = lane >> 4;
  for (int u = blockIdx.x; u < 128 * 12 + 128 * 16; u += gridDim.x) {
    if (u < 128 * 12) {
      const int mt = u / 12, nt = u % 12, m0 = mt * 256, n0 = nt * 128;
      const char* a0 = (const char*)(p.cqb + (size_t)(m0 + (tid >> 2)) * 384) + (tid & 3) * 16;
      const char* a1 = a0 + (size_t)128 * 768;
      const char* bs = (const char*)(p.wuqt + (size_t)(n0 + (tid >> 2)) * 384) + (tid & 3) * 16;
      f32x4 acc[4][4]; zero_acc(acc);
      gemm_kloop(lds, a0, a1, bs, 12, acc);
#pragma unroll
      for (int m = 0; m < 4; ++m) {
        const int row = m0 + wr * 64 + m * 16 + fr, b = row >> 12, t = row & 4095;
#pragma unroll
        for (int pr = 0; pr < 2; ++pr) {
          const int gi = ((n0 + wc * 64) >> 5) + pr, head = gi / 3, part = gi - head * 3;
          bf16_t* dst = p.q1 + ((size_t)(b * 16 + head) * 4096 + t) * 96 + part * 32 + 4 * fq;
          if (part < 2) {
#pragma unroll
            for (int n = 0; n < 2; ++n) { u32x2 w; w.x = cvt_pk(acc[m][2 * pr + n][0], acc[m][2 * pr + n][1]); w.y = cvt_pk(acc[m][2 * pr + n][2], acc[m][2 * pr + n][3]); *(u32x2*)(dst + n * 16) = w; }
          } else {
            const f32x4 c0 = *(const f32x4*)(p.cs32 + t * 16 + 4 * fq), c1 = *(const f32x4*)(p.cs32 + t * 16 + 4 * fq + 2);
            const float co[4] = {c0[0], c0[2], c1[0], c1[2]}, si[4] = {c0[1], c0[3], c1[1], c1[3]};
            float y1[4], y2[4];
#pragma unroll
            for (int j = 0; j < 4; ++j) { const float x1 = acc[m][2 * pr][j], x2 = acc[m][2 * pr + 1][j]; y1[j] = x1 * co[j] - x2 * si[j]; y2[j] = x1 * si[j] + x2 * co[j]; }
            u32x2 w1, w2; w1.x = cvt_pk(y1[0], y1[1]); w1.y = cvt_pk(y1[2], y1[3]); w2.x = cvt_pk(y2[0], y2[1]); w2.y = cvt_pk(y2[2], y2[3]);
            *(u32x2*)(dst) = w1; *(u32x2*)(dst + 16) = w2;
          }
        }
      }
    } else {
      const int uu = u - 128 * 12, mt = uu >> 4, nt = uu & 15, m0 = mt * 256, n0 = nt * 128;
      const char* a0 = (const char*)(p.ckvb + (size_t)(m0 + (tid >> 2)) * 256) + (tid & 3) * 16;
      const char* a1 = a0 + (size_t)128 * 512;
      const char* bs = (const char*)(p.wukvt + (size_t)(n0 + (tid >> 2)) * 256) + (tid & 3) * 16;
      f32x4 acc[4][4]; zero_acc(acc);
      gemm_kloop(lds, a0, a1, bs, 8, acc);
      const int head = nt;
#pragma unroll
      for (int m = 0; m < 4; ++m) {
        const int row = m0 + wr * 64 + m * 16 + fr, b = row >> 12, t = row & 4095;
        if (wc == 0) plain64_store(acc, m, p.kn + ((size_t)(b * 16 + head) * 4096 + t) * 64, fq);
        else vt64_store(acc, m, p.vt1 + (size_t)(b * 16 + head) * 64 * 4096, 4096, perm16(t), fq);
      }
    }
  }
}

constexpr int LDS_BYTES = NSA_LDS > (G_LDS + 256 * 65 * 4 + 512 + 256 * 6 * 8) ? NSA_LDS : (G_LDS + 256 * 65 * 4 + 512 + 256 * 6 * 8);
constexpr int LDS_TOTAL = LDS_BYTES + 64;

DI void get_phase(int i, int nsplit, int& ph, int& layer, int& half) {
  const int moe_len = 2 + 3 * nsplit;
  layer = 0; half = 0;
  if (i < 6) { ph = i; return; }
  i -= 6;
  if (i >= moe_len) {
    i -= moe_len; layer = 1;
    if (i < 5) { ph = (i < 4) ? PH_INPROJ1 + i : PH_OUTPROJ; return; }
    i -= 5;
  }
  if (i < 2) { ph = PH_LNSPLIT + i; return; }
  i -= 2; half = i / 3; ph = PH_EXP1 + (i - half * 3);
}
DI int num_phases(int nsplit) { return 6 + 5 + 2 * (2 + 3 * nsplit); }

__global__ void __launch_bounds__(NTHR) fwd_kernel(Params p, int ph_lo, int ph_hi, int use_sync) {
  extern __shared__ __attribute__((aligned(16))) char smem_raw[];
  LAS char* lds = (LAS char*)smem_raw;
  volatile LAS unsigned* bst = (volatile LAS unsigned*)(lds + LDS_BYTES);
  cg::grid_group grid = cg::this_grid();
  XcdBarrier xb;
  if (use_sync) {
    if (threadIdx.x == 0) { bst[0] = 0u; bst[1] = 0u; bst[2] = 0u; bst[3] = 0u; }
    __syncthreads();
    xb = xcd_barrier_post(p.bar, bst);
  }
  for (int i = ph_lo; i < ph_hi; ++i) {
    int ph, layer, half;
    get_phase(i, p.nsplit, ph, layer, half);
    switch (ph) {
      case PH_PREP: phase_prep(p, lds); break;
      case PH_INPROJ0: phase_inproj0(p, lds); break;
      case PH_SWA_CMP1: phase_swa_cmp1(p, lds); break;
      case PH_CMP2: phase_cmp2(p, lds); break;
      case PH_NSA: phase_nsa(p, lds); break;
      case PH_OUTPROJ: phase_outproj(p, lds, layer); break;
      case PH_LNSPLIT: phase_lnsplit(p, layer); break;
      case PH_ROUTER: phase_router(p, lds, layer); break;
      case PH_EXP1: phase_exp1(p, lds, layer, half); break;
      case PH_EXP2: phase_exp2(p, lds, layer, half); break;
      case PH_COMBINE: phase_combine(p, layer, half); break;
      case PH_INPROJ1: phase_inproj1(p, lds); break;
      case PH_MLANORM: phase_mlanorm(p); break;
      case PH_MLAUP: phase_mlaup(p, lds); break;
      case PH_MLAATT: phase_mla(p, lds); break;
      default: break;
    }
    if (use_sync && i + 1 < ph_hi) { if (i == ph_lo) grid.sync(); else xcd_barrier(xb); }
  }
}

extern "C" void kernel_launch(void* const* d_in, const int* in_sizes, int n_in, void* d_out, int out_size, void* d_ws, size_t ws_size, hipStream_t stream) {
  static int grid_blocks = 0;
  if (grid_blocks == 0) {
    int dev = 0, cus = 0, per_cu = 0;
    hipGetDevice(&dev);
    hipDeviceGetAttribute(&cus, hipDeviceAttributeMultiprocessorCount, dev);
    hipFuncSetAttribute((const void*)fwd_kernel, hipFuncAttributeMaxDynamicSharedMemorySize, LDS_TOTAL);
    hipOccupancyMaxActiveBlocksPerMultiprocessor(&per_cu, (const void*)fwd_kernel, NTHR, LDS_TOTAL);
    if (per_cu < 1) { fprintf(stderr, "kernel_launch: occupancy query says %d blocks per CU\n", per_cu); per_cu = 1; }
    grid_blocks = cus;
    (void)hipGetLastError();
  }
  Params p;
  memset(&p, 0, sizeof(p));
  for (int i = 0; i < 28; ++i) p.in[i] = (const float*)d_in[i];
  p.out = (float*)d_out;
  char* ws = (char*)d_ws;
  size_t off = 0;
  auto take = [&](size_t bytes) { char* r = ws + off; off += (bytes + 255) & ~(size_t)255; return r; };
  p.bar = (unsigned*)take(XCD_BAR_WORDS * 4);
  p.cnt = (int*)take(256 * 4);
  p.win0t = (bf16_t*)take((size_t)2176 * 1024 * 2); p.wout0t = (bf16_t*)take((size_t)1024 * 1024 * 2);
  p.cw1k = (bf16_t*)take(128 * 2048 * 2); p.cw1v = (bf16_t*)take(128 * 2048 * 2);
  p.cw2k = (bf16_t*)take(128 * 128 * 2); p.cw2v = (bf16_t*)take(128 * 128 * 2);
  p.win1t = (bf16_t*)take((size_t)768 * 1024 * 2); p.wuqt = (bf16_t*)take((size_t)1536 * 384 * 2);
  p.wukvt = (bf16_t*)take((size_t)2048 * 256 * 2); p.wout1t = (bf16_t*)take((size_t)1024 * 1024 * 2);
  for (int l = 0; l < 2; ++l) {
    p.rwh[l] = (bf16_t*)take(128 * 1024 * 2); p.rwl[l] = (bf16_t*)take(128 * 1024 * 2);
    p.shgu[l] = (bf16_t*)take(512 * 1024 * 2); p.shd[l] = (bf16_t*)take(1024 * 256 * 2);
  }
  p.cb1k = (float*)take(128 * 4); p.cb1v = (float*)take(128 * 4);
  p.cs64 = (float2*)take(4096 * 32 * 8); p.cs32 = (float2*)take(4096 * 16 * 8);
  p.egu = (bf16_t*)take((size_t)64 * 524288 * 2); p.ed = (bf16_t*)take((size_t)64 * 262144 * 2);
  p.xb = (bf16_t*)take((size_t)NTOK * 1024 * 2);
  const size_t act0 = off;
  p.q0 = (bf16_t*)take((size_t)NBATCH * 16 * 4096 * 64 * 2);
  const size_t kvb = (size_t)NBATCH * 2 * 4096 * 64 * 2;
  p.ka = (bf16_t*)take(kvb); p.ks = (bf16_t*)take(kvb); p.kw = (bf16_t*)take(kvb); p.kc0 = (bf16_t*)take(kvb); p.vc0 = (bf16_t*)take(kvb);
  p.vta = (bf16_t*)take(kvb); p.vts = (bf16_t*)take(kvb); p.vtw = (bf16_t*)take(kvb);
  p.h1k = (bf16_t*)take(4096 * 128 * 2); p.h1v = (bf16_t*)take(4096 * 128 * 2);
  p.kcmp = (bf16_t*)take(16 * 256 * 64 * 2); p.vcmpt = (bf16_t*)take(16 * 64 * 256 * 2);
  p.gates = (float*)take((size_t)NTOK * 24 * 4);
  p.obuf = (bf16_t*)take((size_t)NTOK * 1024 * 2);
  const size_t end_l0 = off;
  const size_t need1 = act0 + (size_t)NTOK * 1024 * 2 + (size_t)64 * LIST_CAP * 8 + ((size_t)NTOK * 7 + 64 * 256) * 512 + (size_t)NTOK * 6 * 2048 + 4096;
  p.nsplit = ws_size >= need1 ? 1 : 2;
  off = act0;
  p.x1lo = (bf16_t*)take((size_t)NTOK * 1024 * 2);
  p.lists = (int2*)take((size_t)64 * LIST_CAP * 8);
  p.hbuf = (bf16_t*)take(((size_t)(NTOK / p.nsplit) * 7 + 64 * 256) * 512);
  p.slab = (bf16_t*)take((size_t)(NTOK / p.nsplit) * 6 * 2048);
  const size_t end_moe = off;
  off = act0;
  p.cqb = (bf16_t*)take((size_t)NTOK * 384 * 2); p.ckvb = (bf16_t*)take((size_t)NTOK * 256 * 2); p.krb = (bf16_t*)take((size_t)NTOK * 32 * 2);
  p.q1 = (bf16_t*)take((size_t)NTOK * 16 * 96 * 2);
  p.kn = (bf16_t*)take((size_t)NTOK * 16 * 64 * 2);
  p.cbuf = (float*)p.kn;
  p.vt1 = (bf16_t*)take((size_t)NTOK * 16 * 64 * 2);
  const size_t end_l1 = off;
  size_t need = end_l0 > end_moe ? end_l0 : end_moe; if (end_l1 > need) need = end_l1;
  if (need > ws_size) { fprintf(stderr, "kernel_launch: workspace too small: need %zu, have %zu\n", need, ws_size); return; }
  const int n = 6 + 5 + 2 * (2 + 3 * p.nsplit);
  hipMemsetAsync(p.bar, 0, XCD_BAR_WORDS * 4, stream);
#ifdef MULTI_LAUNCH
  for (int i = 0; i < n; ++i) hipLaunchKernelGGL(fwd_kernel, dim3(grid_blocks), dim3(NTHR), LDS_TOTAL, stream, p, i, i + 1, 0);
#else
  int lo = 0, hi = n, us = 1;
  void* args[] = {&p, &lo, &hi, &us};
  hipError_t e = hipLaunchCooperativeKernel((const void*)fwd_kernel, dim3(grid_blocks), dim3(NTHR), args, LDS_TOTAL, stream);
  if (e != hipSuccess) fprintf(stderr, "cooperative launch failed: %s (grid %d)\n", hipGetErrorString(e), grid_blocks);
#endif
}
```

```cpp
#include <hip/hip_runtime.h>
#include <hip/hip_cooperative_groups.h>
#include <stdint.h>
#include <math.h>
#include <cstdio>
#include <cstring>
namespace cg = cooperative_groups;

#define LAS __attribute__((address_space(3)))
#define DI __device__ __forceinline__
typedef unsigned short bf16_t;
typedef short bf16x8 __attribute__((ext_vector_type(8)));
typedef float f32x4 __attribute__((ext_vector_type(4)));
typedef float f32x16 __attribute__((ext_vector_type(16)));
typedef unsigned u32x4 __attribute__((ext_vector_type(4)));
typedef unsigned u32x2 __attribute__((ext_vector_type(2)));

constexpr int NTOK = 32768, SEQ = 4096, NBATCH = 8, DM = 1024;
constexpr int NTHR = 512;
constexpr float ALPHA = 1.4142135623730951f;
constexpr float LOG2E = 1.4426950408889634f;

DI unsigned cvt_pk(float lo, float hi) { unsigned r; asm("v_cvt_pk_bf16_f32 %0, %1, %2" : "=v"(r) : "v"(lo), "v"(hi)); return r; }
DI bf16_t f2bf(float x) { return (bf16_t)(cvt_pk(x, 0.f) & 0xffffu); }
DI float bf2f(bf16_t b) { return __uint_as_float(((unsigned)b) << 16); }
DI float fast_exp2(float x) { return __builtin_amdgcn_exp2f(x); }
DI float sigmoidf_(float x) { return 1.0f / (1.0f + __expf(-x)); }
DI int crow(int r, int h) { return (r & 3) + 8 * (r >> 2) + 4 * h; }
DI int perm16(int t) { return (t & ~15) | (((t >> 2) & 1) << 3) | (((t >> 3) & 1) << 2) | (t & 3); }
DI void glds16(const void* g, LAS char* l) { __builtin_amdgcn_global_load_lds((const unsigned*)g, (LAS unsigned*)l, 16, 0, 0); }
#define WAIT_VM_BAR(N) asm volatile("s_waitcnt vmcnt(" #N ") lgkmcnt(0)\n\ts_barrier" ::: "memory")
#define LDS_BAR() asm volatile("s_waitcnt lgkmcnt(0)\n\ts_barrier" ::: "memory")
DI int thr() { int t = threadIdx.x; asm volatile("" : "+v"(t)); return t; }
DI float wave_sum(float v) {
#pragma unroll
  for (int o = 32; o > 0; o >>= 1) v += __shfl_xor(v, o);
  return v;
}

#define XB_TMO 128
#define XB_XCNT(j) (256 + 64 * (j))
#define XB_XSUB(j) (1280 + 64 * (j))
#define XB_XGEN(j) (2304 + 64 * (j))
#define XB_TOP 3328
#define XB_TOPGEN 3392
#define XCD_BAR_WORDS 3456
#define XB_SPIN_CAP (1u << 22)
DI unsigned xb_ld(unsigned* p) { return __hip_atomic_load(p, __ATOMIC_RELAXED, __HIP_MEMORY_SCOPE_AGENT); }
DI unsigned xb_add(unsigned* p, unsigned v) { return __hip_atomic_fetch_add(p, v, __ATOMIC_RELAXED, __HIP_MEMORY_SCOPE_AGENT); }
DI unsigned xb_xcc_id() { return (unsigned)__builtin_amdgcn_s_getreg((3 << 11) | 20) & 0xFu; }
#define XB_SPIN(cond, bar) do { unsigned _sp = 0; while (cond) { __builtin_amdgcn_s_sleep(1); \
    if ((++_sp & 255u) == 0u) { if (xb_ld(&(bar)[XB_TMO])) break; if (_sp > XB_SPIN_CAP) { atomicAdd(&(bar)[XB_TMO], 1u); break; } } } } while (0)
struct XcdBarrier { unsigned* bar; unsigned x; volatile LAS unsigned* st; };
DI XcdBarrier xcd_barrier_post(unsigned* bar, volatile LAS unsigned* st) {
  XcdBarrier b; b.bar = bar; b.x = xb_xcc_id(); b.st = st;
  if (threadIdx.x == 0) (void)xb_add(&bar[XB_XCNT(b.x)], 1u);
  return b;
}
DI void xcd_barrier_complete(unsigned* bar, unsigned x, unsigned& nloc, unsigned& nx) {
  const unsigned G = gridDim.x;
  unsigned sum, cnt, mine, sp = 0u;
  for (;;) {
    sum = 0u; cnt = 0u; mine = 0u;
#pragma unroll
    for (unsigned j = 0; j < 16; ++j) { const unsigned c = xb_ld(&bar[XB_XCNT(j)]); sum += c; cnt += (c > 0u) ? 1u : 0u; mine = (j == x) ? c : mine; }
    if (sum == G) break;
    __builtin_amdgcn_s_sleep(1);
    if ((++sp & 255u) == 0u) { if (xb_ld(&bar[XB_TMO])) break; if (sp > XB_SPIN_CAP) { atomicAdd(&bar[XB_TMO], 1u); break; } }
  }
  nloc = mine > 0u ? mine : 1u; nx = cnt > 0u ? cnt : 1u;
}
DI void xcd_barrier(const XcdBarrier& b) {
  asm volatile("s_waitcnt vmcnt(0)" ::: "memory");
  __syncthreads();
  if (threadIdx.x == 0) {
    unsigned* bar = b.bar;
    __builtin_amdgcn_s_waitcnt(0);
    unsigned nloc = b.st[0], nx = b.st[1];
    if (nloc == 0u) { xcd_barrier_complete(bar, b.x, nloc, nx); b.st[0] = nloc; b.st[1] = nx; }
    const unsigned old = xb_add(&bar[XB_XSUB(b.x)], 1u);
    const unsigned gen = old / nloc;
    if (old + 1u == (gen + 1u) * nloc) {
      __builtin_amdgcn_fence(__ATOMIC_RELEASE, "agent");
      asm volatile("s_waitcnt vmcnt(0)" ::: "memory");
      const unsigned og = xb_add(&bar[XB_TOP], 1u);
      const unsigned tg = og / nx;
      if (og + 1u == (tg + 1u) * nx) xb_add(&bar[XB_TOPGEN], 1u);
      else XB_SPIN(xb_ld(&bar[XB_TOPGEN]) == tg, bar);
      __builtin_amdgcn_fence(__ATOMIC_ACQUIRE, "agent");
      xb_add(&bar[XB_XGEN(b.x)], 1u);
      asm volatile("s_waitcnt vmcnt(0)" ::: "memory");
    } else {
      XB_SPIN(xb_ld(&bar[XB_XGEN(b.x)]) == gen, bar);
      __builtin_amdgcn_fence(__ATOMIC_ACQUIRE, "agent");
      asm volatile("s_waitcnt vmcnt(0)" ::: "memory");
    }
  }
  __syncthreads();
}

constexpr int G_BM = 256, G_BN = 128, G_BK = 32;
constexpr int G_STAGE = G_BM * G_BK * 2 + G_BN * G_BK * 2;
constexpr int G_LDS = 3 * G_STAGE;

DI void gemm_kloop(LAS char* lds, const char* a0, const char* a1, const char* bsrc, int nk  , f32x4 (&acc)[4][4]) {
  const int tid = thr(), lane = tid & 63, wid = __builtin_amdgcn_readfirstlane(tid >> 6);
  const int wr = wid >> 1, wc = wid & 1, fr = lane & 15, fq = lane >> 4;
  LAS char* dA0 = lds + tid * 16;
  const int aoff = (wr * 64 + fr) * 64 + fq * 16;
  const int boff = 16384 + (wc * 64 + fr) * 64 + fq * 16;
#define G_ISSUE(slot, kt) do { LAS char* _d = dA0 + (slot) * G_STAGE; const size_t _ko = (size_t)(kt) * 64; \
    glds16(a0 + _ko, _d); glds16(a1 + _ko, _d + 8192); glds16(bsrc + _ko, _d + 16384); } while (0)
  asm volatile("s_waitcnt vmcnt(0)" ::: "memory");
  G_ISSUE(0, 0);
  if (nk > 1) G_ISSUE(1, 1);
  int slot = 0;
  for (int t = 0; t < nk; ++t) {
    if (t + 1 < nk) { WAIT_VM_BAR(3); } else { WAIT_VM_BAR(0); }
    if (t + 2 < nk) { int s2 = slot + 2; if (s2 >= 3) s2 -= 3; G_ISSUE(s2, t + 2); }
    const LAS char* base = lds + slot * G_STAGE;
    bf16x8 af[4], bfr[4];
#pragma unroll
    for (int m = 0; m < 4; ++m) af[m] = *(const LAS bf16x8*)(base + aoff + m * 1024);
#pragma unroll
    for (int n = 0; n < 4; ++n) bfr[n] = *(const LAS bf16x8*)(base + boff + n * 1024);
#pragma unroll
    for (int m = 0; m < 4; ++m)
#pragma unroll
      for (int n = 0; n < 4; ++n) acc[m][n] = __builtin_amdgcn_mfma_f32_16x16x32_bf16(bfr[n], af[m], acc[m][n], 0, 0, 0);
    slot = (slot == 2) ? 0 : slot + 1;
  }
#undef G_ISSUE
  LDS_BAR();
}
DI void zero_acc(f32x4 (&acc)[4][4]) {
#pragma unroll
  for (int m = 0; m < 4; ++m)
#pragma unroll
    for (int n = 0; n < 4; ++n) acc[m][n] = (f32x4){0.f, 0.f, 0.f, 0.f};
}
constexpr int A_STAGE = 20480, A_RING = 3 * A_STAGE;
constexpr float NEGBIG = -1e30f;
#define MFMA32(a, b, c) __builtin_amdgcn_mfma_f32_32x32x16_bf16((a), (b), (c), 0, 0, 0)

template <bool HAS_ROPE>
DI void qk_tile(const LAS char* kt, const LAS char* krt, const bf16x8* qf, int r32, int h, f32x16& sA, f32x16& sB) {
  const int sw = (r32 >> 1) & 7;
  const LAS char* ra = kt + r32 * 128;
  const LAS char* rb = ra + 32 * 128;
  f32x16 z;
#pragma unroll
  for (int i = 0; i < 16; ++i) z[i] = 0.f;
  sA = z; sB = z;
#pragma unroll
  for (int ks = 0; ks < 4; ++ks) {
    const int c = ((2 * ks + h) ^ sw) << 4;
    const bf16x8 ka = *(const LAS bf16x8*)(ra + c);
    const bf16x8 kb = *(const LAS bf16x8*)(rb + c);
    sA = MFMA32(ka, qf[ks], sA);
    sB = MFMA32(kb, qf[ks], sB);
  }
  if (HAS_ROPE) {
    const int sw2 = (r32 >> 2) & 3;
    const LAS char* pa = krt + r32 * 64;
    const LAS char* pb = pa + 32 * 64;
#pragma unroll
    for (int ks = 0; ks < 2; ++ks) {
      const int c = ((2 * ks + h) ^ sw2) << 4;
      const bf16x8 ka = *(const LAS bf16x8*)(pa + c);
      const bf16x8 kb = *(const LAS bf16x8*)(pb + c);
      sA = MFMA32(ka, qf[4 + ks], sA);
      sB = MFMA32(kb, qf[4 + ks], sB);
    }
  }
}

DI bf16x8 pack8(const f32x16& p, int s) {
  u32x4 w;
  w.x = cvt_pk(p[8 * s + 0], p[8 * s + 1]); w.y = cvt_pk(p[8 * s + 2], p[8 * s + 3]);
  w.z = cvt_pk(p[8 * s + 4], p[8 * s + 5]); w.w = cvt_pk(p[8 * s + 6], p[8 * s + 7]);
  return __builtin_bit_cast(bf16x8, w);
}

DI void pv_tile(const LAS char* vt, const f32x16& pA, const f32x16& pB, int r32, int h, f32x16 (&o)[2]) {
  const int sw = (r32 >> 1) & 7;
  const LAS char* r0 = vt + r32 * 128;
  const LAS char* r1 = r0 + 32 * 128;
#pragma unroll
  for (int kk = 0; kk < 4; ++kk) {
    const bf16x8 pt = (kk < 2) ? pack8(pA, kk & 1) : pack8(pB, kk & 1);
    const int c = ((2 * kk + h) ^ sw) << 4;
    const bf16x8 v0 = *(const LAS bf16x8*)(r0 + c);
    const bf16x8 v1 = *(const LAS bf16x8*)(r1 + c);
    o[0] = MFMA32(v0, pt, o[0]);
    o[1] = MFMA32(v1, pt, o[1]);
  }
}

DI void mask_scores(f32x16& sA, f32x16& sB, int key0, int lo, int hi, int h) {
#pragma unroll
  for (int r = 0; r < 16; ++r) {
    const int ka = key0 + crow(r, h), kb = ka + 32;
    sA[r] = (ka > lo && ka <= hi) ? sA[r] : NEGBIG;
    sB[r] = (kb > lo && kb <= hi) ? sB[r] : NEGBIG;
  }
}
DI float row_max32(const f32x16& sA, const f32x16& sB) {
  float mx = fmaxf(sA[0], sB[0]);
#pragma unroll
  for (int r = 1; r < 16; ++r) mx = fmaxf(mx, fmaxf(sA[r], sB[r]));
  return fmaxf(mx, __shfl_xor(mx, 32));
}
DI void softmax_step(f32x16& sA, f32x16& sB, float c, float& m, float& l, f32x16 (&o)[2]) {
  const float mx = row_max32(sA, sB);
  const float mnew = fmaxf(m, mx);
  const float mc = (mnew < -1e29f) ? 0.f : mnew * c;
  const float alpha = fast_exp2(m * c - mc);
  m = mnew;
  float sum = 0.f;
#pragma unroll
  for (int r = 0; r < 16; ++r) {
    sA[r] = fast_exp2(__builtin_fmaf(sA[r], c, -mc));
    sB[r] = fast_exp2(__builtin_fmaf(sB[r], c, -mc));
    sum += sA[r] + sB[r];
  }
  l = l * alpha + sum;
  if (!__all(alpha == 1.0f)) {
#pragma unroll
    for (int r = 0; r < 16; ++r) { o[0][r] *= alpha; o[1][r] *= alpha; }
  }
}

template <bool HAS_ROPE, class F>
DI void kv_stream(LAS char* ring, const char* kb, const char* vb, size_t vstride, const char* krb, int tile_lo, int tile_hi, F&& per_tile) {
  const int tid = thr();
  const int row = tid >> 3, cs = ((tid & 7) ^ ((row >> 1) & 7)) << 4;
  const char* ksrc = kb + (size_t)row * 128 + cs;
  const char* vsrc = vb + (size_t)row * vstride + cs;
  const int t2 = tid & 255, row2 = t2 >> 2;
  const char* rsrc = krb + (size_t)row2 * 64 + (((t2 & 3) ^ ((row2 >> 2) & 3)) << 4);
  LAS char* dst = ring + tid * 16;
  LAS char* dst2 = ring + 16384 + t2 * 16;
#define A_ISSUE(slot, tl) do { glds16(ksrc + (size_t)(tl) * 8192, dst + (slot) * A_STAGE); glds16(vsrc + (size_t)(tl) * 128, dst + (slot) * A_STAGE + 8192); \
    if (HAS_ROPE) glds16(rsrc + (size_t)(tl) * 4096, dst2 + (slot) * A_STAGE); } while (0)
  asm volatile("s_waitcnt vmcnt(0)" ::: "memory");
  if (tile_lo <= tile_hi) A_ISSUE(0, tile_lo);
  if (tile_lo + 1 <= tile_hi) A_ISSUE(1, tile_lo + 1);
  int slot = 0;
  for (int t = tile_lo; t <= tile_hi; ++t) {
    if (t + 1 <= tile_hi) { if (HAS_ROPE) { WAIT_VM_BAR(3); } else { WAIT_VM_BAR(2); } } else { WAIT_VM_BAR(0); }
    if (t + 2 <= tile_hi) { int s2 = slot + 2; if (s2 >= 3) s2 -= 3; A_ISSUE(s2, t + 2); }
    per_tile(t, (const LAS char*)(ring + slot * A_STAGE));
    slot = (slot == 2) ? 0 : slot + 1;
  }
#undef A_ISSUE
  LDS_BAR();
}

DI float l_total(float l) { return l + __shfl_xor(l, 32); }

DI void store_o(char* rowp, const f32x16 (&o)[2], int h) {
#pragma unroll
  for (int dd = 0; dd < 2; ++dd)
#pragma unroll
    for (int g = 0; g < 4; ++g) {
      u32x2 w; w.x = cvt_pk(o[dd][4 * g + 0], o[dd][4 * g + 1]); w.y = cvt_pk(o[dd][4 * g + 2], o[dd][4 * g + 3]);
      *(u32x2*)(rowp + (32 * dd + 8 * g + 4 * h) * 2) = w;
    }
}
struct Params {
  const float* in[28];
  float* out;
  unsigned* bar;
  int* cnt;
  bf16_t *win0t, *wout0t, *cw1k, *cw1v, *cw2k, *cw2v, *win1t, *wuqt, *wukvt, *wout1t;
  bf16_t *rwh[2], *rwl[2], *shgu[2], *shd[2];
  bf16_t *egu, *ed;
  float *cb1k, *cb1v;
  float2 *cs64, *cs32;
  bf16_t *xb;
  bf16_t *q0, *ka, *ks, *kw, *kc0, *vc0, *vta, *vts, *vtw, *h1k, *h1v, *kcmp, *vcmpt, *obuf;
  float* gates;
  bf16_t *x1lo, *hbuf, *slab;
  int2* lists;
  float* cbuf;
  bf16_t *cqb, *ckvb, *krb, *q1, *kn, *vt1;
  int nsplit;
  int pad_;
};
enum { PH_PREP = 0, PH_INPROJ0, PH_SWA_CMP1, PH_CMP2, PH_NSA, PH_OUTPROJ, PH_LNSPLIT, PH_ROUTER, PH_EXP1, PH_EXP2, PH_COMBINE, PH_INPROJ1, PH_MLANORM, PH_MLAUP, PH_MLAATT };

DI void xpose_item(LAS float* tile, const float* src, int N, int k0, int n0, bf16_t* dst, int ldd, int mode, bf16_t* dst_lo) {
  const int tid = thr();
  {
    const int n = tid & 63, kk = tid >> 6;
    const bool ok = (n0 + n) < N;
#pragma unroll
    for (int i = 0; i < 8; ++i) { const int k = kk + 8 * i; tile[k * 65 + n] = ok ? src[(size_t)(k0 + k) * N + n0 + n] : 0.f; }
  }
  __syncthreads();
  {
    const int n = tid >> 3, kc = (tid & 7) * 8, gn = n0 + n;
    if (gn < N) {
      float v[8];
#pragma unroll
      for (int j = 0; j < 8; ++j) v[j] = tile[(kc + j) * 65 + n];
      int row = gn;
      if (mode == 1) row = 64 * (gn >> 5) + (gn & 31);
      if (mode == 2) row = 64 * (gn >> 5) + 32 + (gn & 31);
      u32x4 w; w.x = cvt_pk(v[0], v[1]); w.y = cvt_pk(v[2], v[3]); w.z = cvt_pk(v[4], v[5]); w.w = cvt_pk(v[6], v[7]);
      *(u32x4*)(dst + (size_t)row * ldd + k0 + kc) = w;
      if (dst_lo) {
        float r[8];
#pragma unroll
        for (int j = 0; j < 8; ++j) { const unsigned pk = (j & 1) ? (w[j >> 1] >> 16) : (w[j >> 1] & 0xffffu); r[j] = v[j] - __uint_as_float(pk << 16); }
        u32x4 w2; w2.x = cvt_pk(r[0], r[1]); w2.y = cvt_pk(r[2], r[3]); w2.z = cvt_pk(r[4], r[5]); w2.w = cvt_pk(r[6], r[7]);
        *(u32x4*)(dst_lo + (size_t)row * ldd + k0 + kc) = w2;
      }
    }
  }
  __syncthreads();
}
DI void xpose_matrix(LAS float* tile, const float* src, int K, int N, bf16_t* dst, int mode, bf16_t* dst_lo, int& itbase) {
  const int nkt = K / 64, nnt = (N + 63) / 64, total = nkt * nnt;
  int first = (int)((blockIdx.x + gridDim.x - (itbase % gridDim.x)) % gridDim.x);
  for (int i = first; i < total; i += gridDim.x) xpose_item(tile, src, N, (i % nkt) * 64, (i / nkt) * 64, dst, K, mode, dst_lo);
  itbase += total;
}
DI void zero_rows(bf16_t* dst, size_t nelem) {
  u32x4 z = (u32x4){0u, 0u, 0u, 0u};
  for (size_t i = ((size_t)blockIdx.x * NTHR + thr()) * 8; i < nelem; i += (size_t)gridDim.x * NTHR * 8) *(u32x4*)(dst + i) = z;
}
DI void expert_weights(const Params& p, LAS float* tile, int layer, int& it) {
  const size_t eo = (size_t)layer * 64 * 262144;
  for (int e = 0; e < 64; ++e) {
    xpose_matrix(tile, p.in[22] + eo + (size_t)e * 262144, 1024, 256, p.egu + (size_t)e * 524288, 1, nullptr, it);
    xpose_matrix(tile, p.in[23] + eo + (size_t)e * 262144, 1024, 256, p.egu + (size_t)e * 524288, 2, nullptr, it);
    xpose_matrix(tile, p.in[24] + eo + (size_t)e * 262144, 256, 1024, p.ed + (size_t)e * 262144, 0, nullptr, it);
  }
}
DI void phase_prep(const Params& p, LAS char* lds) {
  LAS float* tile = (LAS float*)lds;
  const int tid = thr();
  for (size_t i = ((size_t)blockIdx.x * NTHR + tid) * 8; i < (size_t)NTOK * DM; i += (size_t)gridDim.x * NTHR * 8) {
    const f32x4 a = *(const f32x4*)(p.in[0] + i), b = *(const f32x4*)(p.in[0] + i + 4);
    u32x4 w; w.x = cvt_pk(a[0], a[1]); w.y = cvt_pk(a[2], a[3]); w.z = cvt_pk(b[0], b[1]); w.w = cvt_pk(b[2], b[3]);
    *(u32x4*)(p.xb + i) = w;
  }
  zero_rows(p.win0t + (size_t)2072 * 1024, (size_t)104 * 1024);
  zero_rows(p.cw2k + 64 * 128, 64 * 128);
  zero_rows(p.cw2v + 64 * 128, 64 * 128);
  zero_rows(p.win1t + (size_t)672 * 1024, (size_t)96 * 1024);
  for (int l = 0; l < 2; ++l) { zero_rows(p.rwh[l] + 64 * 1024, 64 * 1024); zero_rows(p.rwl[l] + 64 * 1024, 64 * 1024); }
  if (blockIdx.x == 0 && tid < 256) p.cnt[tid] = 0;
  for (int i = blockIdx.x * NTHR + tid; i < 4096 * 32; i += gridDim.x * NTHR) {
    const int t = i >> 5, f = i & 31;
    const float ang = (float)t * powf(10000.0f, -2.0f * (float)f / 64.0f);
    p.cs64[i] = make_float2(cosf(ang), sinf(ang));
  }
  for (int i = blockIdx.x * NTHR + tid; i < 4096 * 16; i += gridDim.x * NTHR) {
    const int t = i >> 4, f = i & 15;
    const float ang = (float)t * powf(10000.0f, -2.0f * (float)f / 32.0f);
    p.cs32[i] = make_float2(cosf(ang), sinf(ang));
  }
  if (blockIdx.x == 1 || blockIdx.x == 2) {
    const float* pe = blockIdx.x == 1 ? p.in[3] : p.in[6];
    const float* w1 = blockIdx.x == 1 ? p.in[4] : p.in[7];
    float* dst = blockIdx.x == 1 ? p.cb1k : p.cb1v;
    const int j = tid & 127, part = tid >> 7;
    float s = 0.f;
    for (int k = part * 512; k < part * 512 + 512; ++k) s = fmaf(pe[k], w1[(size_t)k * 128 + j], s);
    tile[tid] = s;
    __syncthreads();
    if (tid < 128) dst[tid] = tile[tid] + tile[tid + 128] + tile[tid + 256] + tile[tid + 384];
    __syncthreads();
  }
  int it = 0;
  xpose_matrix(tile, p.in[1], 1024, 2072, p.win0t, 0, nullptr, it);
  xpose_matrix(tile, p.in[9], 1024, 1024, p.wout0t, 0, nullptr, it);
  xpose_matrix(tile, p.in[4], 2048, 128, p.cw1k, 0, nullptr, it);
  xpose_matrix(tile, p.in[7], 2048, 128, p.cw1v, 0, nullptr, it);
  xpose_matrix(tile, p.in[5], 128, 64, p.cw2k, 0, nullptr, it);
  xpose_matrix(tile, p.in[8], 128, 64, p.cw2v, 0, nullptr, it);
  xpose_matrix(tile, p.in[10], 1024, 672, p.win1t, 0, nullptr, it);
  xpose_matrix(tile, p.in[13], 384, 1536, p.wuqt, 0, nullptr, it);
  xpose_matrix(tile, p.in[14], 256, 2048, p.wukvt, 0, nullptr, it);
  xpose_matrix(tile, p.in[15], 1024, 1024, p.wout1t, 0, nullptr, it);
  for (int l = 0; l < 2; ++l) {
    xpose_matrix(tile, p.in[20] + (size_t)l * 65536, 1024, 64, p.rwh[l], 0, p.rwl[l], it);
    xpose_matrix(tile, p.in[25] + (size_t)l * 262144, 1024, 256, p.shgu[l], 1, nullptr, it);
    xpose_matrix(tile, p.in[26] + (size_t)l * 262144, 1024, 256, p.shgu[l], 2, nullptr, it);
    xpose_matrix(tile, p.in[27] + (size_t)l * 262144, 256, 1024, p.shd[l], 0, nullptr, it);
  }
  expert_weights(p, tile, 0, it);
}

DI void rope64_store(const f32x4 (&acc)[4][4], int m, const float2* cs, bf16_t* rowp, int fq) {
#pragma unroll
  for (int n = 0; n < 2; ++n) {
    const f32x4 c0 = *(const f32x4*)(cs + n * 16 + 4 * fq), c1 = *(const f32x4*)(cs + n * 16 + 4 * fq + 2);
    const float co[4] = {c0[0], c0[2], c1[0], c1[2]}, si[4] = {c0[1], c0[3], c1[1], c1[3]};
    float y1[4], y2[4];
#pragma unroll
    for (int j = 0; j < 4; ++j) { const float x1 = acc[m][n][j], x2 = acc[m][n + 2][j]; y1[j] = x1 * co[j] - x2 * si[j]; y2[j] = x1 * si[j] + x2 * co[j]; }
    u32x2 w1, w2; w1.x = cvt_pk(y1[0], y1[1]); w1.y = cvt_pk(y1[2], y1[3]); w2.x = cvt_pk(y2[0], y2[1]); w2.y = cvt_pk(y2[2], y2[3]);
    *(u32x2*)(rowp + n * 16 + 4 * fq) = w1;
    *(u32x2*)(rowp + 32 + n * 16 + 4 * fq) = w2;
  }
}
DI void plain64_store(const f32x4 (&acc)[4][4], int m, bf16_t* rowp, int fq) {
#pragma unroll
  for (int n = 0; n < 4; ++n) {
    u32x2 w; w.x = cvt_pk(acc[m][n][0], acc[m][n][1]); w.y = cvt_pk(acc[m][n][2], acc[m][n][3]);
    *(u32x2*)(rowp + n * 16 + 4 * fq) = w;
  }
}
DI void vt64_store(const f32x4 (&acc)[4][4], int m, bf16_t* vt_base  , int ld, int tperm, int fq) {
#pragma unroll
  for (int n = 0; n < 4; ++n)
#pragma unroll
    for (int j = 0; j < 4; ++j) vt_base[(size_t)(n * 16 + 4 * fq + j) * ld + tperm] = f2bf(acc[m][n][j]);
}

DI void phase_inproj0(const Params& p, LAS char* lds) {
  const int tid = thr(), lane = tid & 63, wid = __builtin_amdgcn_readfirstlane(tid >> 6);
  const int wr = wid >> 1, wc = wid & 1, fr = lane & 15, fq = lane >> 4;
  for (int u = blockIdx.x; u < 128 * 17; u += gridDim.x) {
    const int mt = u / 17, nt = u % 17, m0 = mt * 256, n0 = nt * 128;
    const char* a0 = (const char*)(p.xb + (size_t)(m0 + (tid >> 2)) * 1024) + (tid & 3) * 16;
    const char* a1 = a0 + (size_t)128 * 2048;
    const char* bs = (const char*)(p.win0t + (size_t)(n0 + (tid >> 2)) * 1024) + (tid & 3) * 16;
    f32x4 acc[4][4]; zero_acc(acc);
    gemm_kloop(lds, a0, a1, bs, 32, acc);
    const int G = (n0 + wc * 64) >> 6;
#pragma unroll
    for (int m = 0; m < 4; ++m) {
      const int row = m0 + wr * 64 + m * 16 + fr, b = row >> 12, t = row & 4095;
      const float2* cs = p.cs64 + t * 32;
      if (G < 8) rope64_store(acc, m, cs, p.q0 + ((size_t)(b * 16 + G) * 4096 + t) * 64, fq);
      else if (G < 10) rope64_store(acc, m, cs, p.ka + ((size_t)(b * 2 + (G - 8)) * 4096 + t) * 64, fq);
      else if (G < 12) vt64_store(acc, m, p.vta + (size_t)(b * 2 + (G - 10)) * 64 * 4096, 4096, perm16(t), fq);
      else if (G < 20) rope64_store(acc, m, cs, p.q0 + ((size_t)(b * 16 + 8 + (G - 12)) * 4096 + t) * 64, fq);
      else if (G < 22) plain64_store(acc, m, p.kc0 + ((size_t)(b * 2 + (G - 20)) * 4096 + t) * 64, fq);
      else if (G < 24) plain64_store(acc, m, p.vc0 + ((size_t)(b * 2 + (G - 22)) * 4096 + t) * 64, fq);
      else if (G < 26) rope64_store(acc, m, cs, p.ks + ((size_t)(b * 2 + (G - 24)) * 4096 + t) * 64, fq);
      else if (G < 28) vt64_store(acc, m, p.vts + (size_t)(b * 2 + (G - 26)) * 64 * 4096, 4096, perm16(t), fq);
      else if (G < 30) rope64_store(acc, m, cs, p.kw + ((size_t)(b * 2 + (G - 28)) * 4096 + t) * 64, fq);
      else if (G < 32) vt64_store(acc, m, p.vtw + (size_t)(b * 2 + (G - 30)) * 64 * 4096, 4096, perm16(t), fq);
      else if (G == 32) {
#pragma unroll
        for (int n = 0; n < 2; ++n)
#pragma unroll
          for (int j = 0; j < 4; ++j) { const int c = n * 16 + 4 * fq + j; if (c < 24) p.gates[(size_t)row * 24 + c] = sigmoidf_(acc[m][n][j]); }
      }
    }
  }
}

DI void phase_outproj(const Params& p, LAS char* lds, int layer) {
  const int tid = thr(), lane = tid & 63, wid = __builtin_amdgcn_readfirstlane(tid >> 6);
  const int wr = wid >> 1, wc = wid & 1, fr = lane & 15, fq = lane >> 4;
  const bf16_t* A = layer == 0 ? p.obuf : p.xb;
  const bf16_t* Bt = layer == 0 ? p.wout0t : p.wout1t;
  const float* resid = layer == 0 ? p.in[0] : p.out;
  for (int u = blockIdx.x; u < 128 * 8; u += gridDim.x) {
    const int mt = u >> 3, nt = u & 7, m0 = mt * 256, n0 = nt * 128;
    const char* a0 = (const char*)(A + (size_t)(m0 + (tid >> 2)) * 1024) + (tid & 3) * 16;
    const char* a1 = a0 + (size_t)128 * 2048;
    const char* bs = (const char*)(Bt + (size_t)(n0 + (tid >> 2)) * 1024) + (tid & 3) * 16;
    f32x4 acc[4][4]; zero_acc(acc);
    gemm_kloop(lds, a0, a1, bs, 32, acc);
#pragma unroll
    for (int m = 0; m < 4; ++m) {
      const size_t row = m0 + wr * 64 + m * 16 + fr;
#pragma unroll
      for (int n = 0; n < 4; ++n) {
        const size_t o = row * 1024 + n0 + wc * 64 + n * 16 + 4 * fq;
        const f32x4 r = *(const f32x4*)(resid + o);
        *(f32x4*)(p.out + o) = r * ALPHA + acc[m][n];
      }
    }
  }
}

DI float gelu_tanh_(float v) {
  const float u = 0.7978845608028654f * (v + 0.044715f * v * v * v);
  const float e = __expf(2.0f * u);
  const float th = 1.0f - 2.0f / (e + 1.0f);
  return 0.5f * v * (1.0f + th);
}

DI void cmp1_unit(const Params& p, LAS char* lds, int u) {
  const int tid = thr(), lane = tid & 63, wid = __builtin_amdgcn_readfirstlane(tid >> 6);
  const int wr = wid >> 1, wc = wid & 1, fr = lane & 15, fq = lane >> 4;
  const int tensor = u >> 4, bg = u & 15;
  const bf16_t* src = (tensor == 0 ? p.kc0 : p.vc0) + (size_t)bg * 4096 * 64;
  const bf16_t* w1 = tensor == 0 ? p.cw1k : p.cw1v;
  const float* bias = tensor == 0 ? p.cb1k : p.cb1v;
  bf16_t* hout = (tensor == 0 ? p.h1k : p.h1v) + (size_t)bg * 256 * 128;
  const int r0 = tid >> 2, r1 = r0 + 128;
  const char* a0 = (const char*)(src + (size_t)16 * (r0 < 254 ? r0 : 254) * 64) + (tid & 3) * 16;
  const char* a1 = (const char*)(src + (size_t)16 * (r1 < 254 ? r1 : 254) * 64) + (tid & 3) * 16;
  const char* bs = (const char*)(w1 + (size_t)(tid >> 2) * 2048) + (tid & 3) * 16;
  f32x4 acc[4][4]; zero_acc(acc);
  gemm_kloop(lds, a0, a1, bs, 64, acc);
#pragma unroll
  for (int m = 0; m < 4; ++m) {
    const int row = wr * 64 + m * 16 + fr;
#pragma unroll
    for (int n = 0; n < 4; ++n) {
      const int c = wc * 64 + n * 16 + 4 * fq;
      const f32x4 bv = *(const f32x4*)(bias + c);
      u32x2 w; w.x = cvt_pk(gelu_tanh_(acc[m][n][0] + bv[0]), gelu_tanh_(acc[m][n][1] + bv[1]));
      w.y = cvt_pk(gelu_tanh_(acc[m][n][2] + bv[2]), gelu_tanh_(acc[m][n][3] + bv[3]));
      *(u32x2*)(hout + (size_t)row * 128 + c) = w;
    }
  }
}
DI void phase_cmp2(const Params& p, LAS char* lds) {
  const int tid = thr(), lane = tid & 63, wid = __builtin_amdgcn_readfirstlane(tid >> 6);
  const int wr = wid >> 1, wc = wid & 1, fr = lane & 15, fq = lane >> 4;
  for (int u = blockIdx.x; u < 32; u += gridDim.x) {
    const int tensor = u >> 4, bg = u & 15;
    const bf16_t* hin = (tensor == 0 ? p.h1k : p.h1v) + (size_t)bg * 256 * 128;
    const bf16_t* w2 = tensor == 0 ? p.cw2k : p.cw2v;
    const char* a0 = (const char*)(hin + (size_t)(tid >> 2) * 128) + (tid & 3) * 16;
    const char* a1 = a0 + 128 * 256;
    const char* bs = (const char*)(w2 + (size_t)(tid >> 2) * 128) + (tid & 3) * 16;
    f32x4 acc[4][4]; zero_acc(acc);
    gemm_kloop(lds, a0, a1, bs, 4, acc);
    if (wc == 0) {
#pragma unroll
      for (int m = 0; m < 4; ++m) {
        const int n_row = wr * 64 + m * 16 + fr;
        const bool valid = n_row < 255;
        if (!valid) {
#pragma unroll
          for (int n = 0; n < 4; ++n) acc[m][n] = (f32x4){0.f, 0.f, 0.f, 0.f};
        }
        if (tensor == 0) {
          const int pos = valid ? 16 * n_row + 31 : 0;
          rope64_store(acc, m, p.cs64 + pos * 32, p.kcmp + ((size_t)bg * 256 + n_row) * 64, fq);
        } else {
          vt64_store(acc, m, p.vcmpt + (size_t)bg * 64 * 256, 256, perm16(n_row), fq);
        }
      }
    }
  }
}

DI void load_q4(bf16x8 (&qf)[6], const bf16_t* qrow, int h) {
#pragma unroll
  for (int ks = 0; ks < 4; ++ks) qf[ks] = *(const bf16x8*)(qrow + (2 * ks + h) * 8);
}
DI void zero_o(f32x16 (&o)[2]) {
#pragma unroll
  for (int r = 0; r < 16; ++r) { o[0][r] = 0.f; o[1][r] = 0.f; }
}

DI void swa_unit(const Params& p, LAS char* lds, int u) {
  const int tid = thr(), lane = tid & 63, wid = __builtin_amdgcn_readfirstlane(tid >> 6);
  const int r32 = lane & 31, h = lane >> 5;
  const int b = u >> 7, g = (u >> 6) & 1, qb = u & 63, t0 = qb * 64;
  const int hd = g * 4 + (wid & 3), t = t0 + 32 * (wid >> 2) + r32;
  bf16x8 qf[6];
  load_q4(qf, p.q0 + ((size_t)(b * 16 + hd) * 4096 + t) * 64, h);
  f32x16 o[2]; zero_o(o);
  float m = NEGBIG, l = 0.f;
  const float c = 0.125f * LOG2E;
  const int tlo = (t0 - 127) < 0 ? 0 : ((t0 - 127) >> 6);
  const char* kb = (const char*)(p.ka + (size_t)(b * 2 + g) * 4096 * 64);
  const char* vb = (const char*)(p.vta + (size_t)(b * 2 + g) * 64 * 4096);
  kv_stream<false>(lds, kb, vb, 8192, nullptr, tlo, qb, [&](int tile, const LAS char* st) {
    f32x16 sA, sB;
    qk_tile<false>(st, nullptr, qf, r32, h, sA, sB);
    mask_scores(sA, sB, tile * 64, t - 128, t, h);
    softmax_step(sA, sB, c, m, l, o);
    pv_tile(st + 8192, sA, sB, r32, h, o);
  });
  float lt = l_total(l);
  lt += fast_exp2(p.in[2][hd] * LOG2E - m * c);
  const float inv = 1.0f / lt;
#pragma unroll
  for (int r = 0; r < 16; ++r) { o[0][r] *= inv; o[1][r] *= inv; }
  store_o((char*)(p.obuf + (size_t)(b * 4096 + t) * 1024 + hd * 64), o, h);
}

constexpr int NSA_CMPK = A_RING, NSA_CMPV = NSA_CMPK + 32768, NSA_IMP = NSA_CMPV + 32768, NSA_SELM = NSA_IMP + 64 * 65 * 4, NSA_LDS = NSA_SELM + 512;

DI void nsa_unit(const Params& p, LAS char* lds, int b, int g, int qb) {
  const int tid = thr(), lane = tid & 63, wid = __builtin_amdgcn_readfirstlane(tid >> 6);
  const int r32 = lane & 31, h = lane >> 5;
  const int t0 = qb * 64, qh = wid >> 2, hd = g * 4 + (wid & 3), ql = 32 * qh + r32, t = t0 + ql;
  const int bg = b * 2 + g;
  bf16x8 qf[6];
  load_q4(qf, p.q0 + ((size_t)(b * 16 + 8 + hd) * 4096 + t) * 64, h);
  const float* gp = p.gates + (size_t)(b * 4096 + t) * 24 + hd;
  const float g_cmp = gp[0], g_sel = gp[8], g_win = gp[16];
  const float c = 0.125f * LOG2E;
  f32x16 ot[2]; zero_o(ot);
  LAS float* imp = (LAS float*)(lds + NSA_IMP);
  LAS unsigned long long* selm = (LAS unsigned long long*)(lds + NSA_SELM);
  {
    const char* ksrc = (const char*)(p.kcmp + (size_t)bg * 256 * 64);
    const char* vsrc = (const char*)(p.vcmpt + (size_t)bg * 64 * 256);
    asm volatile("s_waitcnt vmcnt(0)" ::: "memory");
#pragma unroll
    for (int i = 0; i < 4; ++i) {
      const int pc = tid + 512 * i, row = pc >> 3, cs = ((pc & 7) ^ ((row >> 1) & 7)) << 4;
      glds16(ksrc + (size_t)row * 128 + cs, lds + NSA_CMPK + pc * 16);
      const int d = tid >> 3, cv = ((tid & 7) ^ ((d >> 1) & 7)) << 4;
      glds16(vsrc + (size_t)d * 512 + i * 128 + cv, lds + NSA_CMPV + i * 8192 + tid * 16);
    }
    for (int i = tid; i < 64 * 65; i += NTHR) imp[i] = 0.f;
    WAIT_VM_BAR(0);
  }
  {
    const int hi_c = (t - 31) >> 4;
    const int nmax = (t0 + 63 - 31) >> 4;
    const int ntile = (nmax >> 6) + 1;
    float m = NEGBIG, l = 0.f;
    for (int j = 0; j < ntile; ++j) {
      f32x16 sA, sB;
      qk_tile<false>(lds + NSA_CMPK + j * 8192, nullptr, qf, r32, h, sA, sB);
      mask_scores(sA, sB, j * 64, -1000000, hi_c, h);
      const float mnew = fmaxf(m, row_max32(sA, sB));
      const float mc = (mnew < -1e29f) ? 0.f : mnew * c;
      float sum = 0.f;
#pragma unroll
      for (int r = 0; r < 16; ++r) sum += fast_exp2(__builtin_fmaf(sA[r], c, -mc)) + fast_exp2(__builtin_fmaf(sB[r], c, -mc));
      l = l * fast_exp2(m * c - mc) + sum;
      m = mnew;
    }
    const float lt = l_total(l);
    const float inv = lt > 0.f ? 1.0f / lt : 0.f;
    const float mc = (m < -1e29f) ? 0.f : m * c;
    f32x16 oc[2]; zero_o(oc);
    for (int j = 0; j < ntile; ++j) {
      f32x16 sA, sB;
      qk_tile<false>(lds + NSA_CMPK + j * 8192, nullptr, qf, r32, h, sA, sB);
      mask_scores(sA, sB, j * 64, -1000000, hi_c, h);
#pragma unroll
      for (int r = 0; r < 16; ++r) { sA[r] = fast_exp2(__builtin_fmaf(sA[r], c, -mc)) * inv; sB[r] = fast_exp2(__builtin_fmaf(sB[r], c, -mc)) * inv; }
#pragma unroll
      for (int q4 = 0; q4 < 4; ++q4) {
        const int mb = 16 * j + 2 * q4 + h;
        const float a0 = sA[4 * q4] + sA[4 * q4 + 1] + sA[4 * q4 + 2] + 0.5f * sA[4 * q4 + 3];
        const float a1 = sB[4 * q4] + sB[4 * q4 + 1] + sB[4 * q4 + 2] + 0.5f * sB[4 * q4 + 3];
        atomicAdd((float*)(imp + ql * 65 + mb), a0);
        atomicAdd((float*)(imp + ql * 65 + mb + 1), 0.5f * sA[4 * q4 + 3]);
        atomicAdd((float*)(imp + ql * 65 + mb + 8), a1);
        if (mb + 9 < 64) atomicAdd((float*)(imp + ql * 65 + mb + 9), 0.5f * sB[4 * q4 + 3]);
      }
      pv_tile(lds + NSA_CMPV + j * 8192, sA, sB, r32, h, oc);
    }
#pragma unroll
    for (int r = 0; r < 16; ++r) { ot[0][r] = g_cmp * oc[0][r]; ot[1][r] = g_cmp * oc[1][r]; }
  }
  LDS_BAR();
  for (int i = 0; i < 8; ++i) {
    const int q = wid * 8 + i, tq = t0 + q;
    const float iv = imp[q * 65 + lane];
    const bool forced = (lane == 0) || (lane == qb) || (lane == qb - 1);
    const bool future = lane * 64 > tq;
    const float score = forced ? 1e4f : (future ? -1.0f : iv);
    int rank = 0;
#pragma unroll 8
    for (int j = 0; j < 64; ++j) { const float sj = __shfl(score, j); rank += (sj > score || (sj == score && j < lane)) ? 1 : 0; }
    const unsigned long long bal = __ballot(rank < 16);
    if (lane == 0) selm[q] = bal;
  }
  LDS_BAR();
  const unsigned long long mysel = selm[ql];
  {
    f32x16 o[2]; zero_o(o);
    float m = NEGBIG, l = 0.f;
    const char* kb = (const char*)(p.ks + (size_t)bg * 4096 * 64);
    const char* vb = (const char*)(p.vts + (size_t)bg * 64 * 4096);
    kv_stream<false>(lds, kb, vb, 8192, nullptr, 0, qb, [&](int tile, const LAS char* st) {
      f32x16 sA, sB;
      qk_tile<false>(st, nullptr, qf, r32, h, sA, sB);
      const int hi = ((mysel >> tile) & 1ull) ? t : -1;
      mask_scores(sA, sB, tile * 64, -1000000, hi, h);
      softmax_step(sA, sB, c, m, l, o);
      pv_tile(st + 8192, sA, sB, r32, h, o);
    });
    const float lt = l_total(l);
    const float sc = lt > 0.f ? g_sel / lt : 0.f;
#pragma unroll
    for (int r = 0; r < 16; ++r) { ot[0][r] += sc * o[0][r]; ot[1][r] += sc * o[1][r]; }
  }
  {
    f32x16 o[2]; zero_o(o);
    float m = NEGBIG, l = 0.f;
    const char* kb = (const char*)(p.kw + (size_t)bg * 4096 * 64);
    const char* vb = (const char*)(p.vtw + (size_t)bg * 64 * 4096);
    const int tlo = (t0 - 511) < 0 ? 0 : ((t0 - 511) >> 6);
    kv_stream<false>(lds, kb, vb, 8192, nullptr, tlo, qb, [&](int tile, const LAS char* st) {
      f32x16 sA, sB;
      qk_tile<false>(st, nullptr, qf, r32, h, sA, sB);
      mask_scores(sA, sB, tile * 64, t - 512, t, h);
      softmax_step(sA, sB, c, m, l, o);
      pv_tile(st + 8192, sA, sB, r32, h, o);
    });
    const float lt = l_total(l);
    const float sc = lt > 0.f ? g_win / lt : 0.f;
#pragma unroll
    for (int r = 0; r < 16; ++r) { ot[0][r] += sc * o[0][r]; ot[1][r] += sc * o[1][r]; }
  }
  store_o((char*)(p.obuf + (size_t)(b * 4096 + t) * 1024 + 512 + hd * 64), ot, h);
}

DI void phase_swa_cmp1(const Params& p, LAS char* lds) {
  for (int u = blockIdx.x; u < 32 + 1024; u += gridDim.x) {
    if (u < 32) cmp1_unit(p, lds, u); else swa_unit(p, lds, u - 32);
  }
}
DI void phase_nsa(const Params& p, LAS char* lds) {
  const int G = gridDim.x;
  for (int j = 0;; ++j) {
    const int pos = (j & 1) ? j * G + (G - 1 - (int)blockIdx.x) : j * G + (int)blockIdx.x;
    if (j * G >= 1024) break;
    if (pos < 1024) nsa_unit(p, lds, (pos & 15) >> 1, pos & 1, 63 - (pos >> 4));
  }
}

DI void mla_unit(const Params& p, LAS char* lds, int b, int hd, int qb4) {
  const int tid = thr(), lane = tid & 63, wid = __builtin_amdgcn_readfirstlane(tid >> 6);
  const int r32 = lane & 31, h = lane >> 5;
  const int tw0 = qb4 * 256 + 32 * wid, t = tw0 + r32;
  const bf16_t* qrow = p.q1 + ((size_t)(b * 16 + hd) * 4096 + t) * 96;
  bf16x8 qf[6];
#pragma unroll
  for (int ks = 0; ks < 6; ++ks) qf[ks] = *(const bf16x8*)(qrow + (2 * ks + h) * 8);
  f32x16 o[2]; zero_o(o);
  float m = NEGBIG, l = 0.f;
  const float c = 0.10206207261596577f * LOG2E;
  const char* kb = (const char*)(p.kn + (size_t)(b * 16 + hd) * 4096 * 64);
  const char* vb = (const char*)(p.vt1 + (size_t)(b * 16 + hd) * 64 * 4096);
  const char* rb = (const char*)(p.krb + (size_t)b * 4096 * 32);
  kv_stream<true>(lds, kb, vb, 8192, rb, 0, qb4 * 4 + 3, [&](int tile, const LAS char* st) {
    if (tile * 64 <= tw0 + 31) {
      f32x16 sA, sB;
      qk_tile<true>(st, st + 16384, qf, r32, h, sA, sB);
      if (tile * 64 + 63 > tw0) mask_scores(sA, sB, tile * 64, -1000000, t, h);
      softmax_step(sA, sB, c, m, l, o);
      pv_tile(st + 8192, sA, sB, r32, h, o);
    }
  });
  const float inv = 1.0f / l_total(l);
#pragma unroll
  for (int r = 0; r < 16; ++r) { o[0][r] *= inv; o[1][r] *= inv; }
  store_o((char*)(p.xb + (size_t)(b * 4096 + t) * 1024 + hd * 64), o, h);
}
DI void phase_mla(const Params& p, LAS char* lds) {
  const int G = gridDim.x;
  for (int j = 0;; ++j) {
    const int pos = (j & 1) ? j * G + (G - 1 - (int)blockIdx.x) : j * G + (int)blockIdx.x;
    if (j * G >= 2048) break;
    if (pos < 2048) mla_unit(p, lds, (pos & 127) >> 4, pos & 15, 15 - (pos >> 7));
  }
}
DI void ln_row(const f32x4 (&v)[4], const float* gam, const float* bet, int lane, f32x4 (&y)[4]) {
  float s = 0.f;
#pragma unroll
  for (int j = 0; j < 4; ++j) s += (v[j][0] + v[j][1]) + (v[j][2] + v[j][3]);
  const float mu = wave_sum(s) * (1.0f / 1024.0f);
  float q = 0.f;
  f32x4 d[4];
#pragma unroll
  for (int j = 0; j < 4; ++j) { d[j] = v[j] - mu; q += (d[j][0] * d[j][0] + d[j][1] * d[j][1]) + (d[j][2] * d[j][2] + d[j][3] * d[j][3]); }
  const float rs = rsqrtf(wave_sum(q) * (1.0f / 1024.0f) + 1e-5f);
#pragma unroll
  for (int j = 0; j < 4; ++j) {
    const f32x4 gv = *(const f32x4*)(gam + 4 * lane + 256 * j), bv = *(const f32x4*)(bet + 4 * lane + 256 * j);
    y[j] = d[j] * rs * gv + bv;
  }
}
DI void phase_lnsplit(const Params& p, int layer) {
  const int lane = thr() & 63, gw = blockIdx.x * 8 + (thr() >> 6), nw = gridDim.x * 8;
  const float* gam = p.in[16] + layer * 1024;
  const float* bet = p.in[17] + layer * 1024;
  for (int row = gw; row < NTOK; row += nw) {
    float* xr = p.out + (size_t)row * 1024;
    f32x4 v[4], y[4];
#pragma unroll
    for (int j = 0; j < 4; ++j) v[j] = *(const f32x4*)(xr + 4 * lane + 256 * j);
    ln_row(v, gam, bet, lane, y);
#pragma unroll
    for (int j = 0; j < 4; ++j) {
      *(f32x4*)(xr + 4 * lane + 256 * j) = y[j];
      u32x2 hi; hi.x = cvt_pk(y[j][0], y[j][1]); hi.y = cvt_pk(y[j][2], y[j][3]);
      const float r0 = y[j][0] - __uint_as_float(hi.x << 16), r1 = y[j][1] - __uint_as_float(hi.x & 0xffff0000u);
      const float r2 = y[j][2] - __uint_as_float(hi.y << 16), r3 = y[j][3] - __uint_as_float(hi.y & 0xffff0000u);
      u32x2 lo; lo.x = cvt_pk(r0, r1); lo.y = cvt_pk(r2, r3);
      *(u32x2*)(p.xb + (size_t)row * 1024 + 4 * lane + 256 * j) = hi;
      *(u32x2*)(p.x1lo + (size_t)row * 1024 + 4 * lane + 256 * j) = lo;
    }
  }
}

constexpr int LIST_CAP = 32768;
DI void phase_router(const Params& p, LAS char* lds, int layer) {
  const int tid = thr(), lane = tid & 63, wid = __builtin_amdgcn_readfirstlane(tid >> 6);
  const int wr = wid >> 1, wc = wid & 1, fr = lane & 15, fq = lane >> 4;
  LAS float* lg = (LAS float*)(lds + G_LDS);
  LAS int* hist = (LAS int*)(lds + G_LDS + 256 * 65 * 4);
  LAS int* se = hist + 128;
  LAS float* sw = (LAS float*)(se + 256 * 6);
  const int half_tokens = NTOK / p.nsplit, cap = LIST_CAP / p.nsplit;
  const float* bias = p.in[21] + layer * 64;
  for (int u = blockIdx.x; u < 128; u += gridDim.x) {
    const int m0 = u * 256;
    const size_t aro = (size_t)(m0 + (tid >> 2)) * 2048 + (tid & 3) * 16;
    const size_t bro = (size_t)(tid >> 2) * 2048 + (tid & 3) * 16;
    f32x4 acc[4][4]; zero_acc(acc);
    gemm_kloop(lds, (const char*)p.xb + aro, (const char*)p.xb + aro + 128 * 2048, (const char*)p.rwh[layer] + bro, 32, acc);
    gemm_kloop(lds, (const char*)p.x1lo + aro, (const char*)p.x1lo + aro + 128 * 2048, (const char*)p.rwh[layer] + bro, 32, acc);
    gemm_kloop(lds, (const char*)p.xb + aro, (const char*)p.xb + aro + 128 * 2048, (const char*)p.rwl[layer] + bro, 32, acc);
    if (wc == 0) {
#pragma unroll
      for (int m = 0; m < 4; ++m)
#pragma unroll
        for (int n = 0; n < 4; ++n)
#pragma unroll
          for (int j = 0; j < 4; ++j) lg[(wr * 64 + m * 16 + fr) * 65 + n * 16 + 4 * fq + j] = acc[m][n][j];
    }
    if (tid < 64) hist[tid] = 0;
    LDS_BAR();
    const float be = bias[lane];
    for (int i = 0; i < 32; ++i) {
      const int r = wid * 32 + i;
      const float s = sigmoidf_(lg[r * 65 + lane]);
      const float sb = s + be;
      int r8 = 0;
      const int gb = lane & ~7;
#pragma unroll
      for (int j = 0; j < 8; ++j) { const float o = __shfl(sb, gb + j); r8 += (o > sb || (o == sb && (gb + j) < lane)) ? 1 : 0; }
      float gs = r8 < 2 ? sb : 0.f;
      gs += __shfl_xor(gs, 1); gs += __shfl_xor(gs, 2); gs += __shfl_xor(gs, 4);
      const int grp = lane >> 3;
      int gr = 0;
#pragma unroll
      for (int j = 0; j < 8; ++j) { const float o = __shfl(gs, j * 8); gr += (o > gs || (o == gs && j < grp)) ? 1 : 0; }
      const bool allowed = gr < 4;
      const float val = allowed ? sb : -INFINITY;
      int rank = 0;
#pragma unroll 8
      for (int j = 0; j < 64; ++j) { const float o = __shfl(val, j); rank += (o > val || (o == val && j < lane)) ? 1 : 0; }
      const bool sel = allowed && rank < 6;
      const float sum = wave_sum(sel ? s : 0.f);
      if (sel) {
        const int lp = atomicAdd((int*)(hist + lane), 1);
        se[r * 6 + rank] = lane | (lp << 8);
        sw[r * 6 + rank] = s / sum * 2.5f;
      }
    }
    LDS_BAR();
    const int half = m0 / half_tokens;
    if (tid < 64) hist[64 + tid] = atomicAdd(p.cnt + (layer * 2 + half) * 64 + tid, hist[tid]);
    LDS_BAR();
    for (int i = tid; i < 256 * 6; i += NTHR) {
      const int v = se[i], e = v & 255, lp = v >> 8, r = i / 6, slot = i - r * 6;
      const int tok = m0 + r;
      p.lists[((size_t)half * 64 + e) * cap + hist[64 + e] + lp] = make_int2(tok * 8 + slot, __float_as_int(sw[i]));
    }
    LDS_BAR();
  }
}

DI void expert_map(const Params& p, LAS int* tb, int layer, int half) {
  if (thr() < 64) {
    const int c = p.cnt[(layer * 2 + half) * 64 + thr()];
    int t = (c + 255) >> 8, incl = t;
#pragma unroll
    for (int o = 1; o < 64; o <<= 1) { const int v = __shfl_up(incl, o); if ((int)thr() >= o) incl += v; }
    tb[thr()] = incl - t;
    if (thr() == 63) tb[64] = incl;
    tb[65 + thr()] = c;
  }
  LDS_BAR();
}
DI int find_expert(const LAS int* tb, int mt) {
  int e = 0;
#pragma unroll 8
  for (int i = 1; i < 64; ++i) e = (tb[i] <= mt) ? i : e;
  return e;
}
DI void phase_exp1(const Params& p, LAS char* lds, int layer, int half) {
  const int tid = thr(), lane = tid & 63, wid = __builtin_amdgcn_readfirstlane(tid >> 6);
  const int wr = wid >> 1, wc = wid & 1, fr = lane & 15, fq = lane >> 4;
  LAS int* tb = (LAS int*)(lds + G_LDS);
  expert_map(p, tb, layer, half);
  const int half_tokens = NTOK / p.nsplit, cap = LIST_CAP / p.nsplit;
  const int TR = tb[64], TS = half_tokens / 256;
  for (int u = blockIdx.x; u < (TR + TS) * 4; u += gridDim.x) {
    const int mt = u >> 2, nt = u & 3;
    const bf16_t* W;
    int tok0, tok1;
    const int r0 = tid >> 2, r1 = r0 + 128;
    if (mt < TR) {
      const int e = find_expert(tb, mt), cnt = tb[65 + e];
      const int2* lst = p.lists + ((size_t)half * 64 + e) * cap;
      const int i0 = (mt - tb[e]) * 256 + r0, i1 = i0 + 128;
      tok0 = lst[i0 < cnt ? i0 : 0].x >> 3;
      tok1 = lst[i1 < cnt ? i1 : 0].x >> 3;
      W = p.egu + (size_t)e * 524288;
    } else {
      tok0 = half * half_tokens + (mt - TR) * 256 + r0; tok1 = tok0 + 128;
      W = p.shgu[layer];
    }
    const char* a0 = (const char*)(p.xb + (size_t)tok0 * 1024) + (tid & 3) * 16;
    const char* a1 = (const char*)(p.xb + (size_t)tok1 * 1024) + (tid & 3) * 16;
    const char* bs = (const char*)(W + (size_t)(nt * 128 + r0) * 1024) + (tid & 3) * 16;
    f32x4 acc[4][4]; zero_acc(acc);
    gemm_kloop(lds, a0, a1, bs, 32, acc);
#pragma unroll
    for (int m = 0; m < 4; ++m) {
      bf16_t* hrow = p.hbuf + (size_t)(mt * 256 + wr * 64 + m * 16 + fr) * 256 + (nt * 2 + wc) * 32 + 4 * fq;
#pragma unroll
      for (int n = 0; n < 2; ++n) {
        float hv[4];
#pragma unroll
        for (int j = 0; j < 4; ++j) { const float gt = acc[m][n][j]; hv[j] = gt / (1.0f + __expf(-gt)) * acc[m][n + 2][j]; }
        u32x2 w; w.x = cvt_pk(hv[0], hv[1]); w.y = cvt_pk(hv[2], hv[3]);
        *(u32x2*)(hrow + n * 16) = w;
      }
    }
  }
}
DI void phase_exp2(const Params& p, LAS char* lds, int layer, int half) {
  const int tid = thr(), lane = tid & 63, wid = __builtin_amdgcn_readfirstlane(tid >> 6);
  const int wr = wid >> 1, wc = wid & 1, fr = lane & 15, fq = lane >> 4;
  LAS int* tb = (LAS int*)(lds + G_LDS);
  expert_map(p, tb, layer, half);
  const int half_tokens = NTOK / p.nsplit, cap = LIST_CAP / p.nsplit;
  const int TR = tb[64], TS = half_tokens / 256;
  for (int u = blockIdx.x; u < (TR + TS) * 8; u += gridDim.x) {
    const int mt = u >> 3, nt = u & 7, r0 = tid >> 2;
    int e = 0, cnt = 0, ib = 0;
    const bf16_t* W;
    if (mt < TR) { e = find_expert(tb, mt); cnt = tb[65 + e]; ib = (mt - tb[e]) * 256; W = p.ed + (size_t)e * 262144; }
    else W = p.shd[layer];
    const char* a0 = (const char*)(p.hbuf + (size_t)(mt * 256 + r0) * 256) + (tid & 3) * 16;
    const char* a1 = a0 + 128 * 512;
    const char* bs = (const char*)(W + (size_t)(nt * 128 + r0) * 256) + (tid & 3) * 16;
    f32x4 acc[4][4]; zero_acc(acc);
    gemm_kloop(lds, a0, a1, bs, 8, acc);
    const int col0 = nt * 128 + wc * 64 + 4 * fq;
    if (mt < TR) {
      const int2* lst = p.lists + ((size_t)half * 64 + e) * cap;
#pragma unroll
      for (int m = 0; m < 4; ++m) {
        const int idx = ib + wr * 64 + m * 16 + fr;
        if (idx < cnt) {
          const int2 en = lst[idx];
          const float w = __int_as_float(en.y);
          const int tok = en.x >> 3, slot = en.x & 7;
          bf16_t* srow = p.slab + ((size_t)(tok - half * half_tokens) * 6 + slot) * 1024 + col0;
#pragma unroll
          for (int n = 0; n < 4; ++n) { u32x2 v; v.x = cvt_pk(acc[m][n][0] * w, acc[m][n][1] * w); v.y = cvt_pk(acc[m][n][2] * w, acc[m][n][3] * w); *(u32x2*)(srow + n * 16) = v; }
        }
      }
    } else {
#pragma unroll
      for (int m = 0; m < 4; ++m) {
        const size_t tok = (size_t)half * half_tokens + (mt - TR) * 256 + wr * 64 + m * 16 + fr;
        float* orow = p.out + tok * 1024 + col0;
#pragma unroll
        for (int n = 0; n < 4; ++n) { const f32x4 r = *(const f32x4*)(orow + n * 16); *(f32x4*)(orow + n * 16) = r * ALPHA + acc[m][n]; }
      }
    }
  }
}
DI void phase_combine(const Params& p, int layer, int half) {
  const int lane = thr() & 63, gw = blockIdx.x * 8 + (thr() >> 6), nw = gridDim.x * 8;
  const int half_tokens = NTOK / p.nsplit;
  const float* gam = p.in[18] + layer * 1024;
  const float* bet = p.in[19] + layer * 1024;
  for (int r = gw; r < half_tokens; r += nw) {
    const size_t row = (size_t)half * half_tokens + r;
    float* xr = p.out + row * 1024;
    f32x4 v[4], y[4];
#pragma unroll
    for (int j = 0; j < 4; ++j) v[j] = *(const f32x4*)(xr + 4 * lane + 256 * j);
#pragma unroll
    for (int s = 0; s < 6; ++s) {
      const bf16_t* sr = p.slab + ((size_t)r * 6 + s) * 1024;
#pragma unroll
      for (int j = 0; j < 4; ++j) {
        const u32x2 w = *(const u32x2*)(sr + 4 * lane + 256 * j);
        v[j][0] += __uint_as_float(w.x << 16); v[j][1] += __uint_as_float(w.x & 0xffff0000u);
        v[j][2] += __uint_as_float(w.y << 16); v[j][3] += __uint_as_float(w.y & 0xffff0000u);
      }
    }
    ln_row(v, gam, bet, lane, y);
#pragma unroll
    for (int j = 0; j < 4; ++j) {
      *(f32x4*)(xr + 4 * lane + 256 * j) = y[j];
      if (layer == 0) { u32x2 hi; hi.x = cvt_pk(y[j][0], y[j][1]); hi.y = cvt_pk(y[j][2], y[j][3]); *(u32x2*)(p.xb + row * 1024 + 4 * lane + 256 * j) = hi; }
    }
  }
}

DI void phase_inproj1(const Params& p, LAS char* lds) {
  const int tid = thr(), lane = tid & 63, wid = __builtin_amdgcn_readfirstlane(tid >> 6);
  const int wr = wid >> 1, wc = wid & 1, fr = lane & 15, fq = lane >> 4;
  for (int u = blockIdx.x; u < 128 * 6; u += gridDim.x) {
    const int mt = u / 6, nt = u % 6, m0 = mt * 256, n0 = nt * 128;
    const char* a0 = (const char*)(p.xb + (size_t)(m0 + (tid >> 2)) * 1024) + (tid & 3) * 16;
    const char* a1 = a0 + (size_t)128 * 2048;
    const char* bs = (const char*)(p.win1t + (size_t)(n0 + (tid >> 2)) * 1024) + (tid & 3) * 16;
    f32x4 acc[4][4]; zero_acc(acc);
    gemm_kloop(lds, a0, a1, bs, 32, acc);
#pragma unroll
    for (int m = 0; m < 4; ++m) {
      float* crow_ = p.cbuf + (size_t)(m0 + wr * 64 + m * 16 + fr) * 768 + n0 + wc * 64 + 4 * fq;
#pragma unroll
      for (int n = 0; n < 4; ++n) *(f32x4*)(crow_ + n * 16) = acc[m][n];
    }
  }
  int it = 0;
  expert_weights(p, (LAS float*)lds, 1, it);
}
DI void phase_mlanorm(const Params& p) {
  const int lane = thr() & 63, gw = blockIdx.x * 8 + (thr() >> 6), nw = gridDim.x * 8;
  for (int row = gw; row < NTOK; row += nw) {
    const float* cr = p.cbuf + (size_t)row * 768;
    float q[6], kv[4];
    float ss = 0.f;
#pragma unroll
    for (int j = 0; j < 6; ++j) { q[j] = cr[lane + 64 * j]; ss += q[j] * q[j]; }
    const float rq = rsqrtf(wave_sum(ss) * (1.0f / 384.0f) + 1e-6f);
#pragma unroll
    for (int j = 0; j < 6; ++j) p.cqb[(size_t)row * 384 + lane + 64 * j] = f2bf(q[j] * rq * p.in[11][lane + 64 * j]);
    ss = 0.f;
#pragma unroll
    for (int j = 0; j < 4; ++j) { kv[j] = cr[384 + lane + 64 * j]; ss += kv[j] * kv[j]; }
    const float rk = rsqrtf(wave_sum(ss) * (1.0f / 256.0f) + 1e-6f);
#pragma unroll
    for (int j = 0; j < 4; ++j) p.ckvb[(size_t)row * 256 + lane + 64 * j] = f2bf(kv[j] * rk * p.in[12][lane + 64 * j]);
    if (lane < 16) {
      const float x1 = cr[640 + lane], x2 = cr[656 + lane];
      const float2 cs = p.cs32[(row & 4095) * 16 + lane];
      p.krb[(size_t)row * 32 + lane] = f2bf(x1 * cs.x - x2 * cs.y);
      p.krb[(size_t)row * 32 + 16 + lane] = f2bf(x1 * cs.y + x2 * cs.x);
    }
  }
}
DI void phase_mlaup(const Params& p, LAS char* lds) {
  const int tid = thr(), lane = tid & 63, wid = __builtin_amdgcn_readfirstlane(tid >> 6);
  const int wr = wid >> 1, wc = wid & 1, fr = lane & 15, fq = lane >> 4;
  for (int u = blockIdx.x; u < 128 * 12 + 128 * 16; u += gridDim.x) {
    if (u < 128 * 12) {
      const int mt = u / 12, nt = u % 12, m0 = mt * 256, n0 = nt * 128;
      const char* a0 = (const char*)(p.cqb + (size_t)(m0 + (tid >> 2)) * 384) + (tid & 3) * 16;
      const char* a1 = a0 + (size_t)128 * 768;
      const char* bs = (const char*)(p.wuqt + (size_t)(n0 + (tid >> 2)) * 384) + (tid & 3) * 16;
      f32x4 acc[4][4]; zero_acc(acc);
      gemm_kloop(lds, a0, a1, bs, 12, acc);
#pragma unroll
      for (int m = 0; m < 4; ++m) {
        const int row = m0 + wr * 64 + m * 16 + fr, b = row >> 12, t = row & 4095;
#pragma unroll
        for (int pr = 0; pr < 2; ++pr) {
          const int gi = ((n0 + wc * 64) >> 5) + pr, head = gi / 3, part = gi - head * 3;
          bf16_t* dst = p.q1 + ((size_t)(b * 16 + head) * 4096 + t) * 96 + part * 32 + 4 * fq;
          if (part < 2) {
#pragma unroll
            for (int n = 0; n < 2; ++n) { u32x2 w; w.x = cvt_pk(acc[m][2 * pr + n][0], acc[m][2 * pr + n][1]); w.y = cvt_pk(acc[m][2 * pr + n][2], acc[m][2 * pr + n][3]); *(u32x2*)(dst + n * 16) = w; }
          } else {
            const f32x4 c0 = *(const f32x4*)(p.cs32 + t * 16 + 4 * fq), c1 = *(const f32x4*)(p.cs32 + t * 16 + 4 * fq + 2);
            const float co[4] = {c0[0], c0[2], c1[0], c1[2]}, si[4] = {c0[1], c0[3], c1[1], c1[3]};
            float y1[4], y2[4];
#pragma unroll
            for (int j = 0; j < 4; ++j) { const float x1 = acc[m][2 * pr][j], x2 = acc[m][2 * pr + 1][j]; y1[j] = x1 * co[j] - x2 * si[j]; y2[j] = x1 * si[j] + x2 * co[j]; }
            u32x2 w1, w2; w1.x = cvt_pk(y1[0], y1[1]); w1.y = cvt_pk(y1[2], y1[3]); w2.x = cvt_pk(y2[0], y2[1]); w2.y = cvt_pk(y2[2], y2[3]);
            *(u32x2*)(dst) = w1; *(u32x2*)(dst + 16) = w2;
          }
        }
      }
    } else {
      const int uu = u - 128 * 12, mt = uu >> 4, nt = uu & 15, m0 = mt * 256, n0 = nt * 128;
      const char* a0 = (const char*)(p.ckvb + (size_t)(m0 + (tid >> 2)) * 256) + (tid & 3) * 16;
      const char* a1 = a0 + (size_t)128 * 512;
      const char* bs = (const char*)(p.wukvt + (size_t)(n0 + (tid >> 2)) * 256) + (tid & 3) * 16;
      f32x4 acc[4][4]; zero_acc(acc);
      gemm_kloop(lds, a0, a1, bs, 8, acc);
      const int head = nt;
#pragma unroll
      for (int m = 0; m < 4; ++m) {
        const int row = m0 + wr * 64 + m * 16 + fr, b = row >> 12, t = row & 4095;
        if (wc == 0) plain64_store(acc, m, p.kn + ((size_t)(b * 16 + head) * 4096 + t) * 64, fq);
        else vt64_store(acc, m, p.vt1 + (size_t)(b * 16 + head) * 64 * 4096, 4096, perm16(t), fq);
      }
    }
  }
}

constexpr int LDS_BYTES = NSA_LDS > (G_LDS + 256 * 65 * 4 + 512 + 256 * 6 * 8) ? NSA_LDS : (G_LDS + 256 * 65 * 4 + 512 + 256 * 6 * 8);
constexpr int LDS_TOTAL = LDS_BYTES + 64;

DI void get_phase(int i, int nsplit, int& ph, int& layer, int& half) {
  const int moe_len = 2 + 3 * nsplit;
  layer = 0; half = 0;
  if (i < 6) { ph = i; return; }
  i -= 6;
  if (i >= moe_len) {
    i -= moe_len; layer = 1;
    if (i < 5) { ph = (i < 4) ? PH_INPROJ1 + i : PH_OUTPROJ; return; }
    i -= 5;
  }
  if (i < 2) { ph = PH_LNSPLIT + i; return; }
  i -= 2; half = i / 3; ph = PH_EXP1 + (i - half * 3);
}
DI int num_phases(int nsplit) { return 6 + 5 + 2 * (2 + 3 * nsplit); }

__global__ void __launch_bounds__(NTHR) fwd_kernel(Params p, int ph_lo, int ph_hi, int use_sync) {
  extern __shared__ __attribute__((aligned(16))) char smem_raw[];
  LAS char* lds = (LAS char*)smem_raw;
  volatile LAS unsigned* bst = (volatile LAS unsigned*)(lds + LDS_BYTES);
  cg::grid_group grid = cg::this_grid();
  XcdBarrier xb;
  if (use_sync) {
    if (threadIdx.x == 0) { bst[0] = 0u; bst[1] = 0u; bst[2] = 0u; bst[3] = 0u; }
    __syncthreads();
    xb = xcd_barrier_post(p.bar, bst);
  }
  for (int i = ph_lo; i < ph_hi; ++i) {
    int ph, layer, half;
    get_phase(i, p.nsplit, ph, layer, half);
    switch (ph) {
      case PH_PREP: phase_prep(p, lds); break;
      case PH_INPROJ0: phase_inproj0(p, lds); break;
      case PH_SWA_CMP1: phase_swa_cmp1(p, lds); break;
      case PH_CMP2: phase_cmp2(p, lds); break;
      case PH_NSA: phase_nsa(p, lds); break;
      case PH_OUTPROJ: phase_outproj(p, lds, layer); break;
      case PH_LNSPLIT: phase_lnsplit(p, layer); break;
      case PH_ROUTER: phase_router(p, lds, layer); break;
      case PH_EXP1: phase_exp1(p, lds, layer, half); break;
      case PH_EXP2: phase_exp2(p, lds, layer, half); break;
      case PH_COMBINE: phase_combine(p, layer, half); break;
      case PH_INPROJ1: phase_inproj1(p, lds); break;
      case PH_MLANORM: phase_mlanorm(p); break;
      case PH_MLAUP: phase_mlaup(p, lds); break;
      case PH_MLAATT: phase_mla(p, lds); break;
      default: break;
    }
    if (use_sync && i + 1 < ph_hi) { if (i == ph_lo) grid.sync(); else xcd_barrier(xb); }
  }
}

extern "C" void kernel_launch(void* const* d_in, const int* in_sizes, int n_in, void* d_out, int out_size, void* d_ws, size_t ws_size, hipStream_t stream) {
  static int grid_blocks = 0;
  if (grid_blocks == 0) {
    int dev = 0, cus = 0, per_cu = 0;
    hipGetDevice(&dev);
    hipDeviceGetAttribute(&cus, hipDeviceAttributeMultiprocessorCount, dev);
    hipFuncSetAttribute((const void*)fwd_kernel, hipFuncAttributeMaxDynamicSharedMemorySize, LDS_TOTAL);
    hipOccupancyMaxActiveBlocksPerMultiprocessor(&per_cu, (const void*)fwd_kernel, NTHR, LDS_TOTAL);
    if (per_cu < 1) { fprintf(stderr, "kernel_launch: occupancy query says %d blocks per CU\n", per_cu); per_cu = 1; }
    grid_blocks = cus;
    (void)hipGetLastError();
  }
  Params p;
  memset(&p, 0, sizeof(p));
  for (int i = 0; i < 28; ++i) p.in[i] = (const float*)d_in[i];
  p.out = (float*)d_out;
  char* ws = (char*)d_ws;
  size_t off = 0;
  auto take = [&](size_t bytes) { char* r = ws + off; off += (bytes + 255) & ~(size_t)255; return r; };
  p.bar = (unsigned*)take(XCD_BAR_WORDS * 4);
  p.cnt = (int*)take(256 * 4);
  p.win0t = (bf16_t*)take((size_t)2176 * 1024 * 2); p.wout0t = (bf16_t*)take((size_t)1024 * 1024 * 2);
  p.cw1k = (bf16_t*)take(128 * 2048 * 2); p.cw1v = (bf16_t*)take(128 * 2048 * 2);
  p.cw2k = (bf16_t*)take(128 * 128 * 2); p.cw2v = (bf16_t*)take(128 * 128 * 2);
  p.win1t = (bf16_t*)take((size_t)768 * 1024 * 2); p.wuqt = (bf16_t*)take((size_t)1536 * 384 * 2);
  p.wukvt = (bf16_t*)take((size_t)2048 * 256 * 2); p.wout1t = (bf16_t*)take((size_t)1024 * 1024 * 2);
  for (int l = 0; l < 2; ++l) {
    p.rwh[l] = (bf16_t*)take(128 * 1024 * 2); p.rwl[l] = (bf16_t*)take(128 * 1024 * 2);
    p.shgu[l] = (bf16_t*)take(512 * 1024 * 2); p.shd[l] = (bf16_t*)take(1024 * 256 * 2);
  }
  p.cb1k = (float*)take(128 * 4); p.cb1v = (float*)take(128 * 4);
  p.cs64 = (float2*)take(4096 * 32 * 8); p.cs32 = (float2*)take(4096 * 16 * 8);
  p.egu = (bf16_t*)take((size_t)64 * 524288 * 2); p.ed = (bf16_t*)take((size_t)64 * 262144 * 2);
  p.xb = (bf16_t*)take((size_t)NTOK * 1024 * 2);
  const size_t act0 = off;
  p.q0 = (bf16_t*)take((size_t)NBATCH * 16 * 4096 * 64 * 2);
  const size_t kvb = (size_t)NBATCH * 2 * 4096 * 64 * 2;
  p.ka = (bf16_t*)take(kvb); p.ks = (bf16_t*)take(kvb); p.kw = (bf16_t*)take(kvb); p.kc0 = (bf16_t*)take(kvb); p.vc0 = (bf16_t*)take(kvb);
  p.vta = (bf16_t*)take(kvb); p.vts = (bf16_t*)take(kvb); p.vtw = (bf16_t*)take(kvb);
  p.h1k = (bf16_t*)take(4096 * 128 * 2); p.h1v = (bf16_t*)take(4096 * 128 * 2);
  p.kcmp = (bf16_t*)take(16 * 256 * 64 * 2); p.vcmpt = (bf16_t*)take(16 * 64 * 256 * 2);
  p.gates = (float*)take((size_t)NTOK * 24 * 4);
  p.obuf = (bf16_t*)take((size_t)NTOK * 1024 * 2);
  const size_t end_l0 = off;
  const size_t need1 = act0 + (size_t)NTOK * 1024 * 2 + (size_t)64 * LIST_CAP * 8 + ((size_t)NTOK * 7 + 64 * 256) * 512 + (size_t)NTOK * 6 * 2048 + 4096;
  p.nsplit = ws_size >= need1 ? 1 : 2;
  off = act0;
  p.x1lo = (bf16_t*)take((size_t)NTOK * 1024 * 2);
  p.lists = (int2*)take((size_t)64 * LIST_CAP * 8);
  p.hbuf = (bf16_t*)take(((size_t)(NTOK / p.nsplit) * 7 + 64 * 256) * 512);
  p.slab = (bf16_t*)take((size_t)(NTOK / p.nsplit) * 6 * 2048);
  const size_t end_moe = off;
  off = act0;
  p.cqb = (bf16_t*)take((size_t)NTOK * 384 * 2); p.ckvb = (bf16_t*)take((size_t)NTOK * 256 * 2); p.krb = (bf16_t*)take((size_t)NTOK * 32 * 2);
  p.q1 = (bf16_t*)take((size_t)NTOK * 16 * 96 * 2);
  p.kn = (bf16_t*)take((size_t)NTOK * 16 * 64 * 2);
  p.cbuf = (float*)p.kn;
  p.vt1 = (bf16_t*)take((size_t)NTOK * 16 * 64 * 2);
  const size_t end_l1 = off;
  size_t need = end_l0 > end_moe ? end_l0 : end_moe; if (end_l1 > need) need = end_l1;
  if (need > ws_size) { fprintf(stderr, "kernel_launch: workspace too small: need %zu, have %zu\n", need, ws_size); return; }
  const int n = 6 + 5 + 2 * (2 + 3 * p.nsplit);
  hipMemsetAsync(p.bar, 0, XCD_BAR_WORDS * 4, stream);
#ifdef MULTI_LAUNCH
  for (int i = 0; i < n; ++i) hipLaunchKernelGGL(fwd_kernel, dim3(grid_blocks), dim3(NTHR), LDS_TOTAL, stream, p, i, i + 1, 0);
#else
  int lo = 0, hi = n, us = 1;
  void* args[] = {&p, &lo, &hi, &us};
  hipError_t e = hipLaunchCooperativeKernel((const void*)fwd_kernel, dim3(grid_blocks), dim3(NTHR), args, LDS_TOTAL, stream);
  if (e != hipSuccess) fprintf(stderr, "cooperative launch failed: %s (grid %d)\n", hipGetErrorString(e), grid_blocks);
#endif
}
```

```cpp
#include <hip/hip_runtime.h>
#include <hip/hip_cooperative_groups.h>
#include <stdint.h>
#include <math.h>
#include <cstdio>
#include <cstring>
namespace cg = cooperative_groups;

#define LAS __attribute__((address_space(3)))
#define DI __device__ __forceinline__
typedef unsigned short bf16_t;
typedef short bf16x8 __attribute__((ext_vector_type(8)));
typedef float f32x4 __attribute__((ext_vector_type(4)));
typedef float f32x16 __attribute__((ext_vector_type(16)));
typedef unsigned u32x4 __attribute__((ext_vector_type(4)));
typedef unsigned u32x2 __attribute__((ext_vector_type(2)));

constexpr int NTOK = 32768, SEQ = 4096, NBATCH = 8, DM = 1024;
constexpr int NTHR = 512;
constexpr float ALPHA = 1.4142135623730951f;
constexpr float LOG2E = 1.4426950408889634f;

typedef __bf16 bf16x2_t __attribute__((ext_vector_type(2)));
typedef float f32x2_t __attribute__((ext_vector_type(2)));
DI unsigned cvt_pk(float lo, float hi) { const f32x2_t f = {lo, hi}; return __builtin_bit_cast(unsigned, __builtin_convertvector(f, bf16x2_t)); }
DI bf16_t f2bf(float x) { return (bf16_t)(cvt_pk(x, 0.f) & 0xffffu); }
DI float bf2f(bf16_t b) { return __uint_as_float(((unsigned)b) << 16); }
DI float fast_exp2(float x) { return __builtin_amdgcn_exp2f(x); }
DI float sigmoidf_(float x) { return 1.0f / (1.0f + __expf(-x)); }
DI int crow(int r, int h) { return (r & 3) + 8 * (r >> 2) + 4 * h; }
DI int perm16(int t) { return (t & ~15) | (((t >> 2) & 1) << 3) | (((t >> 3) & 1) << 2) | (t & 3); }
DI void glds16(const void* g, LAS char* l) { __builtin_amdgcn_global_load_lds((const unsigned*)g, (LAS unsigned*)l, 16, 0, 0); }
#define WAIT_VM_BAR(N) asm volatile("s_waitcnt vmcnt(" #N ") lgkmcnt(0)\n\ts_barrier" ::: "memory")
#define LDS_BAR() asm volatile("s_waitcnt lgkmcnt(0)\n\ts_barrier" ::: "memory")
DI int thr() { int t = threadIdx.x; asm volatile("" : "+v"(t)); return t; }
DI float wave_sum(float v) {
#pragma unroll
  for (int o = 32; o > 0; o >>= 1) v += __shfl_xor(v, o);
  return v;
}

#define XB_TMO 0
#define XB_XCNT(j) (16 + 16 * (j))
#define XB_XSUB(j) (272 + 16 * (j))
#define XB_XGEN(j) (528 + 16 * (j))
#define XB_TOP 784
#define XB_TOPGEN 800
#define XCD_BAR_WORDS 1024
#define XB_SPIN_CAP (1u << 22)
typedef __attribute__((address_space(1))) unsigned gu32;
DI unsigned xb_ld(gu32* p) { return __hip_atomic_load(p, __ATOMIC_RELAXED, __HIP_MEMORY_SCOPE_AGENT); }
DI unsigned xb_add(gu32* p, unsigned v) { return __hip_atomic_fetch_add(p, v, __ATOMIC_RELAXED, __HIP_MEMORY_SCOPE_AGENT); }
DI unsigned xb_xcc_id() { return (unsigned)__builtin_amdgcn_s_getreg((3 << 11) | 20) & 0xFu; }
#define XB_SPIN(cond, bar) do { unsigned _sp = 0; while (cond) { __builtin_amdgcn_s_sleep(1); \
    if ((++_sp & 255u) == 0u) { if (xb_ld(&(bar)[XB_TMO])) break; if (_sp > XB_SPIN_CAP) { xb_add(&(bar)[XB_TMO], 1u); break; } } } } while (0)
struct XcdBarrier { gu32* bar; unsigned x; volatile LAS unsigned* st; };
DI XcdBarrier xcd_barrier_post(unsigned* bar_, volatile LAS unsigned* st) {
  gu32* bar = (gu32*)bar_;
  XcdBarrier b; b.bar = bar; b.x = xb_xcc_id(); b.st = st;
  if (threadIdx.x == 0) (void)xb_add(&bar[XB_XCNT(b.x)], 1u);
  return b;
}
DI void xcd_barrier_complete(gu32* bar, unsigned x, unsigned& nloc, unsigned& nx) {
  const unsigned G = gridDim.x;
  unsigned sum, cnt, mine, sp = 0u;
  for (;;) {
    sum = 0u; cnt = 0u; mine = 0u;
#pragma unroll
    for (unsigned j = 0; j < 16; ++j) { const unsigned c = xb_ld(&bar[XB_XCNT(j)]); sum += c; cnt += (c > 0u) ? 1u : 0u; mine = (j == x) ? c : mine; }
    if (sum == G) break;
    __builtin_amdgcn_s_sleep(1);
    if ((++sp & 255u) == 0u) { if (xb_ld(&bar[XB_TMO])) break; if (sp > XB_SPIN_CAP) { xb_add(&bar[XB_TMO], 1u); break; } }
  }
  nloc = mine > 0u ? mine : 1u; nx = cnt > 0u ? cnt : 1u;
}
DI void xcd_barrier(const XcdBarrier& b) {
  asm volatile("s_waitcnt vmcnt(0)" ::: "memory");
  __syncthreads();
  if (threadIdx.x == 0) {
    gu32* bar = b.bar;
    __builtin_amdgcn_s_waitcnt(0);
    unsigned nloc = b.st[0], nx = b.st[1];
    if (nloc == 0u) { xcd_barrier_complete(bar, b.x, nloc, nx); b.st[0] = nloc; b.st[1] = nx; }
    const unsigned old = xb_add(&bar[XB_XSUB(b.x)], 1u);
    const unsigned gen = old / nloc;
    if (old + 1u == (gen + 1u) * nloc) {
      __builtin_amdgcn_fence(__ATOMIC_RELEASE, "agent");
      asm volatile("s_waitcnt vmcnt(0)" ::: "memory");
      const unsigned og = xb_add(&bar[XB_TOP], 1u);
      const unsigned tg = og / nx;
      if (og + 1u == (tg + 1u) * nx) xb_add(&bar[XB_TOPGEN], 1u);
      else XB_SPIN(xb_ld(&bar[XB_TOPGEN]) == tg, bar);
      __builtin_amdgcn_fence(__ATOMIC_ACQUIRE, "agent");
      xb_add(&bar[XB_XGEN(b.x)], 1u);
      asm volatile("s_waitcnt vmcnt(0)" ::: "memory");
    } else {
      XB_SPIN(xb_ld(&bar[XB_XGEN(b.x)]) == gen, bar);
      __builtin_amdgcn_fence(__ATOMIC_ACQUIRE, "agent");
      asm volatile("s_waitcnt vmcnt(0)" ::: "memory");
    }
  }
  __syncthreads();
}

constexpr int G_BM = 256, G_BN = 128, G_BK = 32;
constexpr int G_STAGE = G_BM * G_BK * 2 + G_BN * G_BK * 2;
constexpr int G_LDS = 3 * G_STAGE;

DI void gemm_kloop(LAS char* lds, const char* a0, const char* a1, const char* bsrc, int nk  , f32x4 (&acc)[4][4]) {
  const int tid = thr(), lane = tid & 63, wid = __builtin_amdgcn_readfirstlane(tid >> 6);
  const int wr = wid >> 1, wc = wid & 1, fr = lane & 15, fq = lane >> 4;
  LAS char* dA0 = lds + tid * 16;
  const int aoff = (wr * 64 + fr) * 64 + fq * 16;
  const int boff = 16384 + (wc * 64 + fr) * 64 + fq * 16;
#define G_ISSUE(slot, kt) do { LAS char* _d = dA0 + (slot) * G_STAGE; const size_t _ko = (size_t)(kt) * 64; \
    glds16(a0 + _ko, _d); glds16(a1 + _ko, _d + 8192); glds16(bsrc + _ko, _d + 16384); } while (0)
  asm volatile("s_waitcnt vmcnt(0)" ::: "memory");
  G_ISSUE(0, 0);
  if (nk > 1) G_ISSUE(1, 1);
  int slot = 0;
  for (int t = 0; t < nk; ++t) {
    if (t + 1 < nk) { WAIT_VM_BAR(3); } else { WAIT_VM_BAR(0); }
    if (t + 2 < nk) { int s2 = slot + 2; if (s2 >= 3) s2 -= 3; G_ISSUE(s2, t + 2); }
    const LAS char* base = lds + slot * G_STAGE;
    bf16x8 af[4], bfr[4];
#pragma unroll
    for (int m = 0; m < 4; ++m) af[m] = *(const LAS bf16x8*)(base + aoff + m * 1024);
#pragma unroll
    for (int n = 0; n < 4; ++n) bfr[n] = *(const LAS bf16x8*)(base + boff + n * 1024);
#pragma unroll
    for (int m = 0; m < 4; ++m)
#pragma unroll
      for (int n = 0; n < 4; ++n) acc[m][n] = __builtin_amdgcn_mfma_f32_16x16x32_bf16(bfr[n], af[m], acc[m][n], 0, 0, 0);
    slot = (slot == 2) ? 0 : slot + 1;
  }
#undef G_ISSUE
  LDS_BAR();
}
DI void zero_acc(f32x4 (&acc)[4][4]) {
#pragma unroll
  for (int m = 0; m < 4; ++m)
#pragma unroll
    for (int n = 0; n < 4; ++n) acc[m][n] = (f32x4){0.f, 0.f, 0.f, 0.f};
}
constexpr int A_STAGE = 20480, A_RING = 3 * A_STAGE;
constexpr float NEGBIG = -1e30f;
#define MFMA32(a, b, c) __builtin_amdgcn_mfma_f32_32x32x16_bf16((a), (b), (c), 0, 0, 0)

template <bool HAS_ROPE>
DI void qk_tile(const LAS char* kt, const LAS char* krt, const bf16x8* qf, int r32, int h, f32x16& sA, f32x16& sB) {
  const int sw = (r32 >> 1) & 7;
  const LAS char* ra = kt + r32 * 128;
  const LAS char* rb = ra + 32 * 128;
  f32x16 z;
#pragma unroll
  for (int i = 0; i < 16; ++i) z[i] = 0.f;
  sA = z; sB = z;
#pragma unroll
  for (int ks = 0; ks < 4; ++ks) {
    const int c = ((2 * ks + h) ^ sw) << 4;
    const bf16x8 ka = *(const LAS bf16x8*)(ra + c);
    const bf16x8 kb = *(const LAS bf16x8*)(rb + c);
    sA = MFMA32(ka, qf[ks], sA);
    sB = MFMA32(kb, qf[ks], sB);
  }
  if (HAS_ROPE) {
    const int sw2 = (r32 >> 2) & 3;
    const LAS char* pa = krt + r32 * 64;
    const LAS char* pb = pa + 32 * 64;
#pragma unroll
    for (int ks = 0; ks < 2; ++ks) {
      const int c = ((2 * ks + h) ^ sw2) << 4;
      const bf16x8 ka = *(const LAS bf16x8*)(pa + c);
      const bf16x8 kb = *(const LAS bf16x8*)(pb + c);
      sA = MFMA32(ka, qf[4 + ks], sA);
      sB = MFMA32(kb, qf[4 + ks], sB);
    }
  }
}

DI bf16x8 pack8(const f32x16& p, int s) {
  u32x4 w;
  w.x = cvt_pk(p[8 * s + 0], p[8 * s + 1]); w.y = cvt_pk(p[8 * s + 2], p[8 * s + 3]);
  w.z = cvt_pk(p[8 * s + 4], p[8 * s + 5]); w.w = cvt_pk(p[8 * s + 6], p[8 * s + 7]);
  return __builtin_bit_cast(bf16x8, w);
}

DI void pv_tile(const LAS char* vt, const f32x16& pA, const f32x16& pB, int r32, int h, f32x16 (&o)[2]) {
  const int sw = (r32 >> 1) & 7;
  const LAS char* r0 = vt + r32 * 128;
  const LAS char* r1 = r0 + 32 * 128;
#pragma unroll
  for (int kk = 0; kk < 4; ++kk) {
    const bf16x8 pt = (kk < 2) ? pack8(pA, kk & 1) : pack8(pB, kk & 1);
    const int c = ((2 * kk + h) ^ sw) << 4;
    const bf16x8 v0 = *(const LAS bf16x8*)(r0 + c);
    const bf16x8 v1 = *(const LAS bf16x8*)(r1 + c);
    o[0] = MFMA32(v0, pt, o[0]);
    o[1] = MFMA32(v1, pt, o[1]);
  }
}

DI void mask_scores(f32x16& sA, f32x16& sB, int key0, int lo, int hi, int h) {
#pragma unroll
  for (int r = 0; r < 16; ++r) {
    const int ka = key0 + crow(r, h), kb = ka + 32;
    sA[r] = (ka > lo && ka <= hi) ? sA[r] : NEGBIG;
    sB[r] = (kb > lo && kb <= hi) ? sB[r] : NEGBIG;
  }
}
DI float row_max32(const f32x16& sA, const f32x16& sB) {
  float mx = fmaxf(sA[0], sB[0]);
#pragma unroll
  for (int r = 1; r < 16; ++r) mx = fmaxf(mx, fmaxf(sA[r], sB[r]));
  return fmaxf(mx, __shfl_xor(mx, 32));
}
DI void softmax_step(f32x16& sA, f32x16& sB, float c, float& m, float& l, f32x16 (&o)[2]) {
  const float mx = row_max32(sA, sB);
  const float mnew = fmaxf(m, mx);
  const float mc = (mnew < -1e29f) ? 0.f : mnew * c;
  const float alpha = fast_exp2(m * c - mc);
  m = mnew;
  float sum = 0.f;
#pragma unroll
  for (int r = 0; r < 16; ++r) {
    sA[r] = fast_exp2(__builtin_fmaf(sA[r], c, -mc));
    sB[r] = fast_exp2(__builtin_fmaf(sB[r], c, -mc));
    sum += sA[r] + sB[r];
  }
  l = l * alpha + sum;
  if (!__all(alpha == 1.0f)) {
#pragma unroll
    for (int r = 0; r < 16; ++r) { o[0][r] *= alpha; o[1][r] *= alpha; }
  }
}

template <bool HAS_ROPE, class F>
DI void kv_stream(LAS char* ring, const char* kb, const char* vb, size_t vstride, const char* krb, int tile_lo, int tile_hi, F&& per_tile) {
  const int tid = thr();
  const int row = tid >> 3, cs = ((tid & 7) ^ ((row >> 1) & 7)) << 4;
  const char* ksrc = kb + (size_t)row * 128 + cs;
  const char* vsrc = vb + (size_t)row * vstride + cs;
  const int t2 = tid & 255, row2 = t2 >> 2;
  const char* rsrc = krb + (size_t)row2 * 64 + (((t2 & 3) ^ ((row2 >> 2) & 3)) << 4);
  LAS char* dst = ring + tid * 16;
  LAS char* dst2 = ring + 16384 + t2 * 16;
#define A_ISSUE(slot, tl) do { glds16(ksrc + (size_t)(tl) * 8192, dst + (slot) * A_STAGE); glds16(vsrc + (size_t)(tl) * 128, dst + (slot) * A_STAGE + 8192); \
    if (HAS_ROPE) glds16(rsrc + (size_t)(tl) * 4096, dst2 + (slot) * A_STAGE); } while (0)
  asm volatile("s_waitcnt vmcnt(0)" ::: "memory");
  if (tile_lo <= tile_hi) A_ISSUE(0, tile_lo);
  if (tile_lo + 1 <= tile_hi) A_ISSUE(1, tile_lo + 1);
  int slot = 0;
  for (int t = tile_lo; t <= tile_hi; ++t) {
    if (t + 1 <= tile_hi) { if (HAS_ROPE) { WAIT_VM_BAR(3); } else { WAIT_VM_BAR(2); } } else { WAIT_VM_BAR(0); }
    if (t + 2 <= tile_hi) { int s2 = slot + 2; if (s2 >= 3) s2 -= 3; A_ISSUE(s2, t + 2); }
    per_tile(t, (const LAS char*)(ring + slot * A_STAGE));
    slot = (slot == 2) ? 0 : slot + 1;
  }
#undef A_ISSUE
  LDS_BAR();
}

DI float l_total(float l) { return l + __shfl_xor(l, 32); }

DI void store_o(char* rowp, const f32x16 (&o)[2], int h) {
#pragma unroll
  for (int dd = 0; dd < 2; ++dd)
#pragma unroll
    for (int g = 0; g < 4; ++g) {
      u32x2 w; w.x = cvt_pk(o[dd][4 * g + 0], o[dd][4 * g + 1]); w.y = cvt_pk(o[dd][4 * g + 2], o[dd][4 * g + 3]);
      *(u32x2*)(rowp + (32 * dd + 8 * g + 4 * h) * 2) = w;
    }
}
struct Params {
  const float* in[28];
  float* out;
  unsigned* bar;
  int* cnt;
  bf16_t *win0t, *wout0t, *cw1k, *cw1v, *cw2k, *cw2v, *win1t, *wuqt, *wukvt, *wout1t;
  bf16_t *rwh[2], *rwl[2], *shgu[2], *shd[2];
  bf16_t *egu, *ed;
  float *cb1k, *cb1v;
  float2 *cs64, *cs32;
  bf16_t *xb;
  bf16_t *q0, *ka, *ks, *kw, *kc0, *vc0, *vta, *vts, *vtw, *h1k, *h1v, *kcmp, *vcmpt, *obuf;
  float* gates;
  bf16_t *x1lo, *hbuf, *slab;
  int2* lists;
  float* cbuf;
  bf16_t *cqb, *ckvb, *krb, *q1, *kn, *vt1;
  int nsplit;
  int pad_;
};
enum { PH_PREP = 0, PH_INPROJ0, PH_SWA_CMP1, PH_CMP2, PH_NSA, PH_OUTPROJ, PH_LNSPLIT, PH_ROUTER, PH_EXP1, PH_EXP2, PH_COMBINE, PH_INPROJ1, PH_MLANORM, PH_MLAUP, PH_MLAATT };

DI void xpose_item(LAS float* tile, const float* src, int N, int k0, int n0, bf16_t* dst, int ldd, int mode, bf16_t* dst_lo) {
  const int tid = thr();
  {
    const int n = tid & 63, kk = tid >> 6;
    const bool ok = (n0 + n) < N;
#pragma unroll
    for (int i = 0; i < 8; ++i) { const int k = kk + 8 * i; tile[k * 65 + n] = ok ? src[(size_t)(k0 + k) * N + n0 + n] : 0.f; }
  }
  __syncthreads();
  {
    const int n = tid >> 3, kc = (tid & 7) * 8, gn = n0 + n;
    if (gn < N) {
      float v[8];
#pragma unroll
      for (int j = 0; j < 8; ++j) v[j] = tile[(kc + j) * 65 + n];
      int row = gn;
      if (mode == 1) row = 64 * (gn >> 5) + (gn & 31);
      if (mode == 2) row = 64 * (gn >> 5) + 32 + (gn & 31);
      u32x4 w; w.x = cvt_pk(v[0], v[1]); w.y = cvt_pk(v[2], v[3]); w.z = cvt_pk(v[4], v[5]); w.w = cvt_pk(v[6], v[7]);
      *(u32x4*)(dst + (size_t)row * ldd + k0 + kc) = w;
      if (dst_lo) {
        float r[8];
#pragma unroll
        for (int j = 0; j < 8; ++j) { const unsigned pk = (j & 1) ? (w[j >> 1] >> 16) : (w[j >> 1] & 0xffffu); r[j] = v[j] - __uint_as_float(pk << 16); }
        u32x4 w2; w2.x = cvt_pk(r[0], r[1]); w2.y = cvt_pk(r[2], r[3]); w2.z = cvt_pk(r[4], r[5]); w2.w = cvt_pk(r[6], r[7]);
        *(u32x4*)(dst_lo + (size_t)row * ldd + k0 + kc) = w2;
      }
    }
  }
  __syncthreads();
}
DI void xpose_item256(LAS float* tile, const float* src, int N, int k0, int n0, bf16_t* dst, int ldd, int mode) {
  const int tid = thr();
  {
    const int n4 = (tid & 63) * 4, kk = tid >> 6;
    f32x4 v[8];
#pragma unroll
    for (int i = 0; i < 8; ++i) v[i] = *(const f32x4*)(src + (size_t)(k0 + kk + 8 * i) * N + n0 + n4);
#pragma unroll
    for (int i = 0; i < 8; ++i) {
      LAS float* tp = tile + (kk + 8 * i) * 257 + n4;
      tp[0] = v[i][0]; tp[1] = v[i][1]; tp[2] = v[i][2]; tp[3] = v[i][3];
    }
  }
  __syncthreads();
#pragma unroll
  for (int j = 0; j < 4; ++j) {
    const int c = tid + 512 * j, n = c >> 3, kc = (c & 7) * 8, gn = n0 + n;
    float v[8];
#pragma unroll
    for (int e = 0; e < 8; ++e) v[e] = tile[(kc + e) * 257 + n];
    int row = gn;
    if (mode == 1) row = 64 * (gn >> 5) + (gn & 31);
    if (mode == 2) row = 64 * (gn >> 5) + 32 + (gn & 31);
    u32x4 w; w.x = cvt_pk(v[0], v[1]); w.y = cvt_pk(v[2], v[3]); w.z = cvt_pk(v[4], v[5]); w.w = cvt_pk(v[6], v[7]);
    *(u32x4*)(dst + (size_t)row * ldd + k0 + kc) = w;
  }
  __syncthreads();
}
DI void xpose_matrix(LAS float* tile, const float* src, int K, int N, bf16_t* dst, int mode, bf16_t* dst_lo, int& itbase) {
  const bool wide = (N % 256 == 0) && dst_lo == nullptr;
  const int nkt = K / 64, nnt = wide ? N / 256 : (N + 63) / 64, total = nkt * nnt;
  int first = (int)((blockIdx.x + gridDim.x - (itbase % gridDim.x)) % gridDim.x);
  for (int i = first; i < total; i += gridDim.x) {
    if (wide) xpose_item256(tile, src, N, (i % nkt) * 64, (i / nkt) * 256, dst, K, mode);
    else xpose_item(tile, src, N, (i % nkt) * 64, (i / nkt) * 64, dst, K, mode, dst_lo);
  }
  itbase += total;
}
DI void zero_rows(bf16_t* dst, size_t nelem) {
  u32x4 z = (u32x4){0u, 0u, 0u, 0u};
  for (size_t i = ((size_t)blockIdx.x * NTHR + thr()) * 8; i < nelem; i += (size_t)gridDim.x * NTHR * 8) *(u32x4*)(dst + i) = z;
}
DI void expert_weights(const Params& p, LAS float* tile, int layer, int& it) {
  const size_t eo = (size_t)layer * 64 * 262144;
  for (int e = 0; e < 64; ++e) {
    xpose_matrix(tile, p.in[22] + eo + (size_t)e * 262144, 1024, 256, p.egu + (size_t)e * 524288, 1, nullptr, it);
    xpose_matrix(tile, p.in[23] + eo + (size_t)e * 262144, 1024, 256, p.egu + (size_t)e * 524288, 2, nullptr, it);
    xpose_matrix(tile, p.in[24] + eo + (size_t)e * 262144, 256, 1024, p.ed + (size_t)e * 262144, 0, nullptr, it);
  }
}
DI void phase_prep(const Params& p, LAS char* lds) {
  LAS float* tile = (LAS float*)lds;
  const int tid = thr();
  for (size_t i = ((size_t)blockIdx.x * NTHR + tid) * 8; i < (size_t)NTOK * DM; i += (size_t)gridDim.x * NTHR * 8) {
    const f32x4 a = *(const f32x4*)(p.in[0] + i), b = *(const f32x4*)(p.in[0] + i + 4);
    u32x4 w; w.x = cvt_pk(a[0], a[1]); w.y = cvt_pk(a[2], a[3]); w.z = cvt_pk(b[0], b[1]); w.w = cvt_pk(b[2], b[3]);
    *(u32x4*)(p.xb + i) = w;
  }
  zero_rows(p.win0t + (size_t)2072 * 1024, (size_t)104 * 1024);
  zero_rows(p.cw2k + 64 * 128, 64 * 128);
  zero_rows(p.cw2v + 64 * 128, 64 * 128);
  zero_rows(p.win1t + (size_t)672 * 1024, (size_t)96 * 1024);
  for (int l = 0; l < 2; ++l) { zero_rows(p.rwh[l] + 64 * 1024, 64 * 1024); zero_rows(p.rwl[l] + 64 * 1024, 64 * 1024); }
  if (blockIdx.x == 0 && tid < 256) p.cnt[tid] = 0;
  for (int i = blockIdx.x * NTHR + tid; i < 4096 * 32; i += gridDim.x * NTHR) {
    const int t = i >> 5, f = i & 31;
    const float ang = (float)t * powf(10000.0f, -2.0f * (float)f / 64.0f);
    p.cs64[i] = make_float2(cosf(ang), sinf(ang));
  }
  for (int i = blockIdx.x * NTHR + tid; i < 4096 * 16; i += gridDim.x * NTHR) {
    const int t = i >> 4, f = i & 15;
    const float ang = (float)t * powf(10000.0f, -2.0f * (float)f / 32.0f);
    p.cs32[i] = make_float2(cosf(ang), sinf(ang));
  }
  if (blockIdx.x == 1 || blockIdx.x == 2) {
    const float* pe = blockIdx.x == 1 ? p.in[3] : p.in[6];
    const float* w1 = blockIdx.x == 1 ? p.in[4] : p.in[7];
    float* dst = blockIdx.x == 1 ? p.cb1k : p.cb1v;
    const int j = tid & 127, part = tid >> 7;
    float s = 0.f;
    for (int k = part * 512; k < part * 512 + 512; ++k) s = fmaf(pe[k], w1[(size_t)k * 128 + j], s);
    tile[tid] = s;
    __syncthreads();
    if (tid < 128) dst[tid] = tile[tid] + tile[tid + 128] + tile[tid + 256] + tile[tid + 384];
    __syncthreads();
  }
  int it = 0;
  xpose_matrix(tile, p.in[1], 1024, 2072, p.win0t, 0, nullptr, it);
  xpose_matrix(tile, p.in[9], 1024, 1024, p.wout0t, 0, nullptr, it);
  xpose_matrix(tile, p.in[4], 2048, 128, p.cw1k, 0, nullptr, it);
  xpose_matrix(tile, p.in[7], 2048, 128, p.cw1v, 0, nullptr, it);
  xpose_matrix(tile, p.in[5], 128, 64, p.cw2k, 0, nullptr, it);
  xpose_matrix(tile, p.in[8], 128, 64, p.cw2v, 0, nullptr, it);
  xpose_matrix(tile, p.in[10], 1024, 672, p.win1t, 0, nullptr, it);
  xpose_matrix(tile, p.in[13], 384, 1536, p.wuqt, 0, nullptr, it);
  xpose_matrix(tile, p.in[14], 256, 2048, p.wukvt, 0, nullptr, it);
  xpose_matrix(tile, p.in[15], 1024, 1024, p.wout1t, 0, nullptr, it);
  for (int l = 0; l < 2; ++l) {
    xpose_matrix(tile, p.in[20] + (size_t)l * 65536, 1024, 64, p.rwh[l], 0, p.rwl[l], it);
    xpose_matrix(tile, p.in[25] + (size_t)l * 262144, 1024, 256, p.shgu[l], 1, nullptr, it);
    xpose_matrix(tile, p.in[26] + (size_t)l * 262144, 1024, 256, p.shgu[l], 2, nullptr, it);
    xpose_matrix(tile, p.in[27] + (size_t)l * 262144, 256, 1024, p.shd[l], 0, nullptr, it);
  }
  expert_weights(p, tile, 0, it);
}

DI void rope64_store(const f32x4 (&acc)[4][4], int m, const float2* cs, bf16_t* rowp, int fq) {
#pragma unroll
  for (int n = 0; n < 2; ++n) {
    const f32x4 c0 = *(const f32x4*)(cs + n * 16 + 4 * fq), c1 = *(const f32x4*)(cs + n * 16 + 4 * fq + 2);
    const float co[4] = {c0[0], c0[2], c1[0], c1[2]}, si[4] = {c0[1], c0[3], c1[1], c1[3]};
    float y1[4], y2[4];
#pragma unroll
    for (int j = 0; j < 4; ++j) { const float x1 = acc[m][n][j], x2 = acc[m][n + 2][j]; y1[j] = x1 * co[j] - x2 * si[j]; y2[j] = x1 * si[j] + x2 * co[j]; }
    u32x2 w1, w2; w1.x = cvt_pk(y1[0], y1[1]); w1.y = cvt_pk(y1[2], y1[3]); w2.x = cvt_pk(y2[0], y2[1]); w2.y = cvt_pk(y2[2], y2[3]);
    *(u32x2*)(rowp + n * 16 + 4 * fq) = w1;
    *(u32x2*)(rowp + 32 + n * 16 + 4 * fq) = w2;
  }
}
DI void plain64_store(const f32x4 (&acc)[4][4], int m, bf16_t* rowp, int fq) {
#pragma unroll
  for (int n = 0; n < 4; ++n) {
    u32x2 w; w.x = cvt_pk(acc[m][n][0], acc[m][n][1]); w.y = cvt_pk(acc[m][n][2], acc[m][n][3]);
    *(u32x2*)(rowp + n * 16 + 4 * fq) = w;
  }
}
DI void vt64_store(const f32x4 (&acc)[4][4], int m, bf16_t* vt_base  , int ld, int tperm, int fq) {
#pragma unroll
  for (int n = 0; n < 4; ++n)
#pragma unroll
    for (int j = 0; j < 4; ++j) vt_base[(size_t)(n * 16 + 4 * fq + j) * ld + tperm] = f2bf(acc[m][n][j]);
}

DI void phase_inproj0(const Params& p, LAS char* lds) {
  const int tid = thr(), lane = tid & 63, wid = __builtin_amdgcn_readfirstlane(tid >> 6);
  const int wr = wid >> 1, wc = wid & 1, fr = lane & 15, fq = lane >> 4;
  for (int u = blockIdx.x; u < 128 * 17; u += gridDim.x) {
    const int mt = u / 17, nt = u % 17, m0 = mt * 256, n0 = nt * 128;
    const char* a0 = (const char*)(p.xb + (size_t)(m0 + (tid >> 2)) * 1024) + (tid & 3) * 16;
    const char* a1 = a0 + (size_t)128 * 2048;
    const char* bs = (const char*)(p.win0t + (size_t)(n0 + (tid >> 2)) * 1024) + (tid & 3) * 16;
    f32x4 acc[4][4]; zero_acc(acc);
    gemm_kloop(lds, a0, a1, bs, 32, acc);
    const int G = (n0 + wc * 64) >> 6;
#pragma unroll
    for (int m = 0; m < 4; ++m) {
      const int row = m0 + wr * 64 + m * 16 + fr, b = row >> 12, t = row & 4095;
      const float2* cs = p.cs64 + t * 32;
      if (G < 8) rope64_store(acc, m, cs, p.q0 + ((size_t)(b * 16 + G) * 4096 + t) * 64, fq);
      else if (G < 10) rope64_store(acc, m, cs, p.ka + ((size_t)(b * 2 + (G - 8)) * 4096 + t) * 64, fq);
      else if (G < 12) vt64_store(acc, m, p.vta + (size_t)(b * 2 + (G - 10)) * 64 * 4096, 4096, perm16(t), fq);
      else if (G < 20) rope64_store(acc, m, cs, p.q0 + ((size_t)(b * 16 + 8 + (G - 12)) * 4096 + t) * 64, fq);
      else if (G < 22) plain64_store(acc, m, p.kc0 + ((size_t)(b * 2 + (G - 20)) * 4096 + t) * 64, fq);
      else if (G < 24) plain64_store(acc, m, p.vc0 + ((size_t)(b * 2 + (G - 22)) * 4096 + t) * 64, fq);
      else if (G < 26) rope64_store(acc, m, cs, p.ks + ((size_t)(b * 2 + (G - 24)) * 4096 + t) * 64, fq);
      else if (G < 28) vt64_store(acc, m, p.vts + (size_t)(b * 2 + (G - 26)) * 64 * 4096, 4096, perm16(t), fq);
      else if (G < 30) rope64_store(acc, m, cs, p.kw + ((size_t)(b * 2 + (G - 28)) * 4096 + t) * 64, fq);
      else if (G < 32) vt64_store(acc, m, p.vtw + (size_t)(b * 2 + (G - 30)) * 64 * 4096, 4096, perm16(t), fq);
      else if (G == 32) {
#pragma unroll
        for (int n = 0; n < 2; ++n)
#pragma unroll
          for (int j = 0; j < 4; ++j) { const int c = n * 16 + 4 * fq + j; if (c < 24) p.gates[(size_t)row * 24 + c] = sigmoidf_(acc[m][n][j]); }
      }
    }
  }
}

DI void phase_outproj(const Params& p, LAS char* lds, int layer) {
  const int tid = thr(), lane = tid & 63, wid = __builtin_amdgcn_readfirstlane(tid >> 6);
  const int wr = wid >> 1, wc = wid & 1, fr = lane & 15, fq = lane >> 4;
  const bf16_t* A = layer == 0 ? p.obuf : p.xb;
  const bf16_t* Bt = layer == 0 ? p.wout0t : p.wout1t;
  const float* resid = layer == 0 ? p.in[0] : p.out;
  for (int u = blockIdx.x; u < 128 * 8; u += gridDim.x) {
    const int mt = u >> 3, nt = u & 7, m0 = mt * 256, n0 = nt * 128;
    const char* a0 = (const char*)(A + (size_t)(m0 + (tid >> 2)) * 1024) + (tid & 3) * 16;
    const char* a1 = a0 + (size_t)128 * 2048;
    const char* bs = (const char*)(Bt + (size_t)(n0 + (tid >> 2)) * 1024) + (tid & 3) * 16;
    f32x4 acc[4][4]; zero_acc(acc);
    gemm_kloop(lds, a0, a1, bs, 32, acc);
#pragma unroll
    for (int m = 0; m < 4; ++m) {
      const size_t row = m0 + wr * 64 + m * 16 + fr;
#pragma unroll
      for (int n = 0; n < 4; ++n) {
        const size_t o = row * 1024 + n0 + wc * 64 + n * 16 + 4 * fq;
        const f32x4 r = *(const f32x4*)(resid + o);
        *(f32x4*)(p.out + o) = r * ALPHA + acc[m][n];
      }
    }
  }
}

DI float gelu_tanh_(float v) {
  const float u = 0.7978845608028654f * (v + 0.044715f * v * v * v);
  const float e = __expf(2.0f * u);
  const float th = 1.0f - 2.0f / (e + 1.0f);
  return 0.5f * v * (1.0f + th);
}

DI void cmp1_unit(const Params& p, LAS char* lds, int u) {
  const int tid = thr(), lane = tid & 63, wid = __builtin_amdgcn_readfirstlane(tid >> 6);
  const int wr = wid >> 1, wc = wid & 1, fr = lane & 15, fq = lane >> 4;
  const int tensor = u >> 4, bg = u & 15;
  const bf16_t* src = (tensor == 0 ? p.kc0 : p.vc0) + (size_t)bg * 4096 * 64;
  const bf16_t* w1 = tensor == 0 ? p.cw1k : p.cw1v;
  const float* bias = tensor == 0 ? p.cb1k : p.cb1v;
  bf16_t* hout = (tensor == 0 ? p.h1k : p.h1v) + (size_t)bg * 256 * 128;
  const int r0 = tid >> 2, r1 = r0 + 128;
  const char* a0 = (const char*)(src + (size_t)16 * (r0 < 254 ? r0 : 254) * 64) + (tid & 3) * 16;
  const char* a1 = (const char*)(src + (size_t)16 * (r1 < 254 ? r1 : 254) * 64) + (tid & 3) * 16;
  const char* bs = (const char*)(w1 + (size_t)(tid >> 2) * 2048) + (tid & 3) * 16;
  f32x4 acc[4][4]; zero_acc(acc);
  gemm_kloop(lds, a0, a1, bs, 64, acc);
#pragma unroll
  for (int m = 0; m < 4; ++m) {
    const int row = wr * 64 + m * 16 + fr;
#pragma unroll
    for (int n = 0; n < 4; ++n) {
      const int c = wc * 64 + n * 16 + 4 * fq;
      const f32x4 bv = *(const f32x4*)(bias + c);
      u32x2 w; w.x = cvt_pk(gelu_tanh_(acc[m][n][0] + bv[0]), gelu_tanh_(acc[m][n][1] + bv[1]));
      w.y = cvt_pk(gelu_tanh_(acc[m][n][2] + bv[2]), gelu_tanh_(acc[m][n][3] + bv[3]));
      *(u32x2*)(hout + (size_t)row * 128 + c) = w;
    }
  }
}
DI void phase_cmp2(const Params& p, LAS char* lds) {
  const int tid = thr(), lane = tid & 63, wid = __builtin_amdgcn_readfirstlane(tid >> 6);
  const int wr = wid >> 1, wc = wid & 1, fr = lane & 15, fq = lane >> 4;
  for (int u = blockIdx.x; u < 32; u += gridDim.x) {
    const int tensor = u >> 4, bg = u & 15;
    const bf16_t* hin = (tensor == 0 ? p.h1k : p.h1v) + (size_t)bg * 256 * 128;
    const bf16_t* w2 = tensor == 0 ? p.cw2k : p.cw2v;
    const char* a0 = (const char*)(hin + (size_t)(tid >> 2) * 128) + (tid & 3) * 16;
    const char* a1 = a0 + 128 * 256;
    const char* bs = (const char*)(w2 + (size_t)(tid >> 2) * 128) + (tid & 3) * 16;
    f32x4 acc[4][4]; zero_acc(acc);
    gemm_kloop(lds, a0, a1, bs, 4, acc);
    if (wc == 0) {
#pragma unroll
      for (int m = 0; m < 4; ++m) {
        const int n_row = wr * 64 + m * 16 + fr;
        const bool valid = n_row < 255;
        if (!valid) {
#pragma unroll
          for (int n = 0; n < 4; ++n) acc[m][n] = (f32x4){0.f, 0.f, 0.f, 0.f};
        }
        if (tensor == 0) {
          const int pos = valid ? 16 * n_row + 31 : 0;
          rope64_store(acc, m, p.cs64 + pos * 32, p.kcmp + ((size_t)bg * 256 + n_row) * 64, fq);
        } else {
          vt64_store(acc, m, p.vcmpt + (size_t)bg * 64 * 256, 256, perm16(n_row), fq);
        }
      }
    }
  }
}

DI void load_q4(bf16x8 (&qf)[6], const bf16_t* qrow, int h) {
#pragma unroll
  for (int ks = 0; ks < 4; ++ks) qf[ks] = *(const bf16x8*)(qrow + (2 * ks + h) * 8);
}
DI void zero_o(f32x16 (&o)[2]) {
#pragma unroll
  for (int r = 0; r < 16; ++r) { o[0][r] = 0.f; o[1][r] = 0.f; }
}

DI void swa_unit(const Params& p, LAS char* lds, int u) {
  const int tid = thr(), lane = tid & 63, wid = __builtin_amdgcn_readfirstlane(tid >> 6);
  const int r32 = lane & 31, h = lane >> 5;
  const int b = u >> 7, g = (u >> 6) & 1, qb = u & 63, t0 = qb * 64;
  const int hd = g * 4 + (wid & 3), t = t0 + 32 * (wid >> 2) + r32;
  bf16x8 qf[6];
  load_q4(qf, p.q0 + ((size_t)(b * 16 + hd) * 4096 + t) * 64, h);
  f32x16 o[2]; zero_o(o);
  float m = NEGBIG, l = 0.f;
  const float c = 0.125f * LOG2E;
  const int tlo = (t0 - 127) < 0 ? 0 : ((t0 - 127) >> 6);
  const char* kb = (const char*)(p.ka + (size_t)(b * 2 + g) * 4096 * 64);
  const char* vb = (const char*)(p.vta + (size_t)(b * 2 + g) * 64 * 4096);
  kv_stream<false>(lds, kb, vb, 8192, nullptr, tlo, qb, [&](int tile, const LAS char* st) {
    f32x16 sA, sB;
    qk_tile<false>(st, nullptr, qf, r32, h, sA, sB);
    mask_scores(sA, sB, tile * 64, t - 128, t, h);
    softmax_step(sA, sB, c, m, l, o);
    pv_tile(st + 8192, sA, sB, r32, h, o);
  });
  float lt = l_total(l);
  lt += fast_exp2(p.in[2][hd] * LOG2E - m * c);
  const float inv = 1.0f / lt;
#pragma unroll
  for (int r = 0; r < 16; ++r) { o[0][r] *= inv; o[1][r] *= inv; }
  store_o((char*)(p.obuf + (size_t)(b * 4096 + t) * 1024 + hd * 64), o, h);
}

constexpr int NSA_CMPK = A_RING, NSA_CMPV = NSA_CMPK + 32768, NSA_IMP = NSA_CMPV + 32768, NSA_SELM = NSA_IMP + 64 * 65 * 4, NSA_LDS = NSA_SELM + 512;

DI void nsa_unit(const Params& p, LAS char* lds, int b, int g, int qb) {
  const int tid = thr(), lane = tid & 63, wid = __builtin_amdgcn_readfirstlane(tid >> 6);
  const int r32 = lane & 31, h = lane >> 5;
  const int t0 = qb * 64, qh = wid >> 2, hd = g * 4 + (wid & 3), ql = 32 * qh + r32, t = t0 + ql;
  const int bg = b * 2 + g;
  bf16x8 qf[6];
  load_q4(qf, p.q0 + ((size_t)(b * 16 + 8 + hd) * 4096 + t) * 64, h);
  const float* gp = p.gates + (size_t)(b * 4096 + t) * 24 + hd;
  const float g_cmp = gp[0], g_sel = gp[8], g_win = gp[16];
  const float c = 0.125f * LOG2E;
  f32x16 ot[2]; zero_o(ot);
  LAS int* imp = (LAS int*)(lds + NSA_IMP);
  LAS unsigned long long* selm = (LAS unsigned long long*)(lds + NSA_SELM);
  {
    const char* ksrc = (const char*)(p.kcmp + (size_t)bg * 256 * 64);
    const char* vsrc = (const char*)(p.vcmpt + (size_t)bg * 64 * 256);
    asm volatile("s_waitcnt vmcnt(0)" ::: "memory");
#pragma unroll
    for (int i = 0; i < 4; ++i) {
      const int pc = tid + 512 * i, row = pc >> 3, cs = ((pc & 7) ^ ((row >> 1) & 7)) << 4;
      glds16(ksrc + (size_t)row * 128 + cs, lds + NSA_CMPK + pc * 16);
      const int d = tid >> 3, cv = ((tid & 7) ^ ((d >> 1) & 7)) << 4;
      glds16(vsrc + (size_t)d * 512 + i * 128 + cv, lds + NSA_CMPV + i * 8192 + tid * 16);
    }
    for (int i = tid; i < 64 * 65; i += NTHR) imp[i] = 0;
    WAIT_VM_BAR(0);
  }
  {
    const int hi_c = (t - 31) >> 4;
    const int nmax = (t0 + 63 - 31) >> 4;
    const int ntile = (nmax >> 6) + 1;
    float m = NEGBIG, l = 0.f;
    for (int j = 0; j < ntile; ++j) {
      f32x16 sA, sB;
      qk_tile<false>(lds + NSA_CMPK + j * 8192, nullptr, qf, r32, h, sA, sB);
      mask_scores(sA, sB, j * 64, -1000000, hi_c, h);
      const float mnew = fmaxf(m, row_max32(sA, sB));
      const float mc = (mnew < -1e29f) ? 0.f : mnew * c;
      float sum = 0.f;
#pragma unroll
      for (int r = 0; r < 16; ++r) sum += fast_exp2(__builtin_fmaf(sA[r], c, -mc)) + fast_exp2(__builtin_fmaf(sB[r], c, -mc));
      l = l * fast_exp2(m * c - mc) + sum;
      m = mnew;
    }
    const float lt = l_total(l);
    const float inv = lt > 0.f ? 1.0f / lt : 0.f;
    const float mc = (m < -1e29f) ? 0.f : m * c;
    f32x16 oc[2]; zero_o(oc);
    for (int j = 0; j < ntile; ++j) {
      f32x16 sA, sB;
      qk_tile<false>(lds + NSA_CMPK + j * 8192, nullptr, qf, r32, h, sA, sB);
      mask_scores(sA, sB, j * 64, -1000000, hi_c, h);
#pragma unroll
      for (int r = 0; r < 16; ++r) { sA[r] = fast_exp2(__builtin_fmaf(sA[r], c, -mc)) * inv; sB[r] = fast_exp2(__builtin_fmaf(sB[r], c, -mc)) * inv; }
#pragma unroll
      for (int q4 = 0; q4 < 4; ++q4) {
        const int mb = 16 * j + 2 * q4 + h;
        const float a0 = sA[4 * q4] + sA[4 * q4 + 1] + sA[4 * q4 + 2] + 0.5f * sA[4 * q4 + 3];
        const float a1 = sB[4 * q4] + sB[4 * q4 + 1] + sB[4 * q4 + 2] + 0.5f * sB[4 * q4 + 3];
        const float FX = 16777216.0f;
        atomicAdd((int*)(imp + ql * 65 + mb), __float2int_rn(a0 * FX));
        atomicAdd((int*)(imp + ql * 65 + mb + 1), __float2int_rn(0.5f * sA[4 * q4 + 3] * FX));
        atomicAdd((int*)(imp + ql * 65 + mb + 8), __float2int_rn(a1 * FX));
        if (mb + 9 < 64) atomicAdd((int*)(imp + ql * 65 + mb + 9), __float2int_rn(0.5f * sB[4 * q4 + 3] * FX));
      }
      pv_tile(lds + NSA_CMPV + j * 8192, sA, sB, r32, h, oc);
    }
#pragma unroll
    for (int r = 0; r < 16; ++r) { ot[0][r] = g_cmp * oc[0][r]; ot[1][r] = g_cmp * oc[1][r]; }
  }
  LDS_BAR();
  for (int i = 0; i < 8; ++i) {
    const int q = wid * 8 + i, tq = t0 + q;
    const int iv = imp[q * 65 + lane];
    const bool forced = (lane == 0) || (lane == qb) || (lane == qb - 1);
    const bool future = lane * 64 > tq;
    const int score = forced ? 0x7fffffff : (future ? -1 : iv);
    int rank = 0;
#pragma unroll
    for (int j = 0; j < 64; ++j) { const int sj = __builtin_amdgcn_readlane(score, j); rank += (sj > score || (sj == score && j < lane)) ? 1 : 0; }
    const unsigned long long bal = __ballot(rank < 16);
    if (lane == 0) selm[q] = bal;
  }
  LDS_BAR();
  const unsigned long long mysel = selm[ql];
  {
    f32x16 o[2]; zero_o(o);
    float m = NEGBIG, l = 0.f;
    const char* kb = (const char*)(p.ks + (size_t)bg * 4096 * 64);
    const char* vb = (const char*)(p.vts + (size_t)bg * 64 * 4096);
    kv_stream<false>(lds, kb, vb, 8192, nullptr, 0, qb, [&](int tile, const LAS char* st) {
      f32x16 sA, sB;
      qk_tile<false>(st, nullptr, qf, r32, h, sA, sB);
      const int hi = ((mysel >> tile) & 1ull) ? t : -1;
      mask_scores(sA, sB, tile * 64, -1000000, hi, h);
      softmax_step(sA, sB, c, m, l, o);
      pv_tile(st + 8192, sA, sB, r32, h, o);
    });
    const float lt = l_total(l);
    const float sc = lt > 0.f ? g_sel / lt : 0.f;
#pragma unroll
    for (int r = 0; r < 16; ++r) { ot[0][r] += sc * o[0][r]; ot[1][r] += sc * o[1][r]; }
  }
  {
    f32x16 o[2]; zero_o(o);
    float m = NEGBIG, l = 0.f;
    const char* kb = (const char*)(p.kw + (size_t)bg * 4096 * 64);
    const char* vb = (const char*)(p.vtw + (size_t)bg * 64 * 4096);
    const int tlo = (t0 - 511) < 0 ? 0 : ((t0 - 511) >> 6);
    kv_stream<false>(lds, kb, vb, 8192, nullptr, tlo, qb, [&](int tile, const LAS char* st) {
      f32x16 sA, sB;
      qk_tile<false>(st, nullptr, qf, r32, h, sA, sB);
      mask_scores(sA, sB, tile * 64, t - 512, t, h);
      softmax_step(sA, sB, c, m, l, o);
      pv_tile(st + 8192, sA, sB, r32, h, o);
    });
    const float lt = l_total(l);
    const float sc = lt > 0.f ? g_win / lt : 0.f;
#pragma unroll
    for (int r = 0; r < 16; ++r) { ot[0][r] += sc * o[0][r]; ot[1][r] += sc * o[1][r]; }
  }
  store_o((char*)(p.obuf + (size_t)(b * 4096 + t) * 1024 + 512 + hd * 64), ot, h);
}

DI void phase_swa_cmp1(const Params& p, LAS char* lds) {
  for (int u = blockIdx.x; u < 32 + 1024; u += gridDim.x) {
    if (u < 32) cmp1_unit(p, lds, u); else swa_unit(p, lds, u - 32);
  }
}
DI void phase_nsa(const Params& p, LAS char* lds) {
  const int G = gridDim.x;
  for (int j = 0;; ++j) {
    const int pos = (j & 1) ? j * G + (G - 1 - (int)blockIdx.x) : j * G + (int)blockIdx.x;
    if (j * G >= 1024) break;
    if (pos < 1024) nsa_unit(p, lds, (pos & 15) >> 1, pos & 1, 63 - (pos >> 4));
  }
}

DI void mla_unit(const Params& p, LAS char* lds, int b, int hd, int qb4) {
  const int tid = thr(), lane = tid & 63, wid = __builtin_amdgcn_readfirstlane(tid >> 6);
  const int r32 = lane & 31, h = lane >> 5;
  const int tw0 = qb4 * 256 + 32 * wid, t = tw0 + r32;
  const bf16_t* qrow = p.q1 + ((size_t)(b * 16 + hd) * 4096 + t) * 96;
  bf16x8 qf[6];
#pragma unroll
  for (int ks = 0; ks < 6; ++ks) qf[ks] = *(const bf16x8*)(qrow + (2 * ks + h) * 8);
  f32x16 o[2]; zero_o(o);
  float m = NEGBIG, l = 0.f;
  const float c = 0.10206207261596577f * LOG2E;
  const char* kb = (const char*)(p.kn + (size_t)(b * 16 + hd) * 4096 * 64);
  const char* vb = (const char*)(p.vt1 + (size_t)(b * 16 + hd) * 64 * 4096);
  const char* rb = (const char*)(p.krb + (size_t)b * 4096 * 32);
  kv_stream<true>(lds, kb, vb, 8192, rb, 0, qb4 * 4 + 3, [&](int tile, const LAS char* st) {
    if (tile * 64 <= tw0 + 31) {
      f32x16 sA, sB;
      qk_tile<true>(st, st + 16384, qf, r32, h, sA, sB);
      if (tile * 64 + 63 > tw0) mask_scores(sA, sB, tile * 64, -1000000, t, h);
      softmax_step(sA, sB, c, m, l, o);
      pv_tile(st + 8192, sA, sB, r32, h, o);
    }
  });
  const float inv = 1.0f / l_total(l);
#pragma unroll
  for (int r = 0; r < 16; ++r) { o[0][r] *= inv; o[1][r] *= inv; }
  store_o((char*)(p.xb + (size_t)(b * 4096 + t) * 1024 + hd * 64), o, h);
}
DI void phase_mla(const Params& p, LAS char* lds) {
  const int G = gridDim.x;
  for (int j = 0;; ++j) {
    const int pos = (j & 1) ? j * G + (G - 1 - (int)blockIdx.x) : j * G + (int)blockIdx.x;
    if (j * G >= 2048) break;
    if (pos < 2048) mla_unit(p, lds, (pos & 127) >> 4, pos & 15, 15 - (pos >> 7));
  }
}
DI void ln_row(const f32x4 (&v)[4], const float* gam, const float* bet, int lane, f32x4 (&y)[4]) {
  float s = 0.f;
#pragma unroll
  for (int j = 0; j < 4; ++j) s += (v[j][0] + v[j][1]) + (v[j][2] + v[j][3]);
  const float mu = wave_sum(s) * (1.0f / 1024.0f);
  float q = 0.f;
  f32x4 d[4];
#pragma unroll
  for (int j = 0; j < 4; ++j) { d[j] = v[j] - mu; q += (d[j][0] * d[j][0] + d[j][1] * d[j][1]) + (d[j][2] * d[j][2] + d[j][3] * d[j][3]); }
  const float rs = rsqrtf(wave_sum(q) * (1.0f / 1024.0f) + 1e-5f);
#pragma unroll
  for (int j = 0; j < 4; ++j) {
    const f32x4 gv = *(const f32x4*)(gam + 4 * lane + 256 * j), bv = *(const f32x4*)(bet + 4 * lane + 256 * j);
    y[j] = d[j] * rs * gv + bv;
  }
}
DI void phase_lnsplit(const Params& p, int layer) {
  const int lane = thr() & 63, gw = blockIdx.x * 8 + (thr() >> 6), nw = gridDim.x * 8;
  const float* gam = p.in[16] + layer * 1024;
  const float* bet = p.in[17] + layer * 1024;
  for (int row = gw; row < NTOK; row += nw) {
    float* xr = p.out + (size_t)row * 1024;
    f32x4 v[4], y[4];
#pragma unroll
    for (int j = 0; j < 4; ++j) v[j] = *(const f32x4*)(xr + 4 * lane + 256 * j);
    ln_row(v, gam, bet, lane, y);
#pragma unroll
    for (int j = 0; j < 4; ++j) {
      *(f32x4*)(xr + 4 * lane + 256 * j) = y[j];
      u32x2 hi; hi.x = cvt_pk(y[j][0], y[j][1]); hi.y = cvt_pk(y[j][2], y[j][3]);
      const float r0 = y[j][0] - __uint_as_float(hi.x << 16), r1 = y[j][1] - __uint_as_float(hi.x & 0xffff0000u);
      const float r2 = y[j][2] - __uint_as_float(hi.y << 16), r3 = y[j][3] - __uint_as_float(hi.y & 0xffff0000u);
      u32x2 lo; lo.x = cvt_pk(r0, r1); lo.y = cvt_pk(r2, r3);
      *(u32x2*)(p.xb + (size_t)row * 1024 + 4 * lane + 256 * j) = hi;
      *(u32x2*)(p.x1lo + (size_t)row * 1024 + 4 * lane + 256 * j) = lo;
    }
  }
}

constexpr int LIST_CAP = 32768;
DI void phase_router(const Params& p, LAS char* lds, int layer) {
  const int tid = thr(), lane = tid & 63, wid = __builtin_amdgcn_readfirstlane(tid >> 6);
  const int wr = wid >> 1, wc = wid & 1, fr = lane & 15, fq = lane >> 4;
  LAS float* lg = (LAS float*)(lds + G_LDS);
  LAS int* hist = (LAS int*)(lds + G_LDS + 256 * 65 * 4);
  LAS int* se = hist + 128;
  LAS float* sw = (LAS float*)(se + 256 * 6);
  const int half_tokens = NTOK / p.nsplit, cap = LIST_CAP / p.nsplit;
  const float* bias = p.in[21] + layer * 64;
  for (int u = blockIdx.x; u < 128; u += gridDim.x) {
    const int m0 = u * 256;
    const size_t aro = (size_t)(m0 + (tid >> 2)) * 2048 + (tid & 3) * 16;
    const size_t bro = (size_t)(tid >> 2) * 2048 + (tid & 3) * 16;
    f32x4 acc[4][4]; zero_acc(acc);
    gemm_kloop(lds, (const char*)p.xb + aro, (const char*)p.xb + aro + 128 * 2048, (const char*)p.rwh[layer] + bro, 32, acc);
    gemm_kloop(lds, (const char*)p.x1lo + aro, (const char*)p.x1lo + aro + 128 * 2048, (const char*)p.rwh[layer] + bro, 32, acc);
    gemm_kloop(lds, (const char*)p.xb + aro, (const char*)p.xb + aro + 128 * 2048, (const char*)p.rwl[layer] + bro, 32, acc);
    if (wc == 0) {
#pragma unroll
      for (int m = 0; m < 4; ++m)
#pragma unroll
        for (int n = 0; n < 4; ++n)
#pragma unroll
          for (int j = 0; j < 4; ++j) lg[(wr * 64 + m * 16 + fr) * 65 + n * 16 + 4 * fq + j] = acc[m][n][j];
    }
    if (tid < 64) hist[tid] = 0;
    LDS_BAR();
    const float be = bias[lane];
    for (int i = 0; i < 32; ++i) {
      const int r = wid * 32 + i;
      const float s = sigmoidf_(lg[r * 65 + lane]);
      const float sb = s + be;
      int r8 = 0;
      const int gb = lane & ~7;
#pragma unroll
      for (int j = 0; j < 8; ++j) { const float o = __shfl(sb, gb + j); r8 += (o > sb || (o == sb && (gb + j) < lane)) ? 1 : 0; }
      float gs = r8 < 2 ? sb : 0.f;
      gs += __shfl_xor(gs, 1); gs += __shfl_xor(gs, 2); gs += __shfl_xor(gs, 4);
      const int grp = lane >> 3;
      int gr = 0;
#pragma unroll
      for (int j = 0; j < 8; ++j) { const float o = __builtin_bit_cast(float, __builtin_amdgcn_readlane(__builtin_bit_cast(int, gs), j * 8)); gr += (o > gs || (o == gs && j < grp)) ? 1 : 0; }
      const bool allowed = gr < 4;
      const float val = allowed ? sb : -INFINITY;
      int rank = 0;
#pragma unroll
      for (int j = 0; j < 64; ++j) { const float o = __builtin_bit_cast(float, __builtin_amdgcn_readlane(__builtin_bit_cast(int, val), j)); rank += (o > val || (o == val && j < lane)) ? 1 : 0; }
      const bool sel = allowed && rank < 6;
      const float sum = wave_sum(sel ? s : 0.f);
      if (sel) {
        const int lp = atomicAdd((int*)(hist + lane), 1);
        se[r * 6 + rank] = lane | (lp << 8);
        sw[r * 6 + rank] = s / sum * 2.5f;
      }
    }
    LDS_BAR();
    const int half = m0 / half_tokens;
    if (tid < 64) hist[64 + tid] = atomicAdd(p.cnt + (layer * 2 + half) * 64 + tid, hist[tid]);
    LDS_BAR();
    for (int i = tid; i < 256 * 6; i += NTHR) {
      const int v = se[i], e = v & 255, lp = v >> 8, r = i / 6, slot = i - r * 6;
      const int tok = m0 + r;
      p.lists[((size_t)half * 64 + e) * cap + hist[64 + e] + lp] = make_int2(tok * 8 + slot, __float_as_int(sw[i]));
    }
    LDS_BAR();
  }
}

DI void expert_map(const Params& p, LAS int* tb, int layer, int half) {
  if (thr() < 64) {
    const int c = p.cnt[(layer * 2 + half) * 64 + thr()];
    int t = (c + 255) >> 8, incl = t;
#pragma unroll
    for (int o = 1; o < 64; o <<= 1) { const int v = __shfl_up(incl, o); if ((int)thr() >= o) incl += v; }
    tb[thr()] = incl - t;
    if (thr() == 63) tb[64] = incl;
    tb[65 + thr()] = c;
  }
  LDS_BAR();
}
DI int find_expert(const LAS int* tb, int mt) {
  int e = 0;
#pragma unroll 8
  for (int i = 1; i < 64; ++i) e = (tb[i] <= mt) ? i : e;
  return e;
}
DI void phase_exp1(const Params& p, LAS char* lds, int layer, int half) {
  const int tid = thr(), lane = tid & 63, wid = __builtin_amdgcn_readfirstlane(tid >> 6);
  const int wr = wid >> 1, wc = wid & 1, fr = lane & 15, fq = lane >> 4;
  LAS int* tb = (LAS int*)(lds + G_LDS);
  expert_map(p, tb, layer, half);
  const int half_tokens = NTOK / p.nsplit, cap = LIST_CAP / p.nsplit;
  const int TR = tb[64], TS = half_tokens / 256;
  for (int u = blockIdx.x; u < (TR + TS) * 4; u += gridDim.x) {
    const int mt = u >> 2, nt = u & 3;
    const bf16_t* W;
    int tok0, tok1;
    const int r0 = tid >> 2, r1 = r0 + 128;
    if (mt < TR) {
      const int e = find_expert(tb, mt), cnt = tb[65 + e];
      const int2* lst = p.lists + ((size_t)half * 64 + e) * cap;
      const int i0 = (mt - tb[e]) * 256 + r0, i1 = i0 + 128;
      tok0 = lst[i0 < cnt ? i0 : 0].x >> 3;
      tok1 = lst[i1 < cnt ? i1 : 0].x >> 3;
      W = p.egu + (size_t)e * 524288;
    } else {
      tok0 = half * half_tokens + (mt - TR) * 256 + r0; tok1 = tok0 + 128;
      W = p.shgu[layer];
    }
    const char* a0 = (const char*)(p.xb + (size_t)tok0 * 1024) + (tid & 3) * 16;
    const char* a1 = (const char*)(p.xb + (size_t)tok1 * 1024) + (tid & 3) * 16;
    const char* bs = (const char*)(W + (size_t)(nt * 128 + r0) * 1024) + (tid & 3) * 16;
    f32x4 acc[4][4]; zero_acc(acc);
    gemm_kloop(lds, a0, a1, bs, 32, acc);
    {
#pragma unroll
      for (int m = 0; m < 4; ++m) {
        LAS char* hr = lds + (wr * 64 + m * 16 + fr) * 144 + (wc * 32 + 4 * fq) * 2;
#pragma unroll
        for (int n = 0; n < 2; ++n) {
          float hv[4];
#pragma unroll
          for (int j = 0; j < 4; ++j) { const float gt = acc[m][n][j]; hv[j] = gt / (1.0f + __expf(-gt)) * acc[m][n + 2][j]; }
          u32x2 w; w.x = cvt_pk(hv[0], hv[1]); w.y = cvt_pk(hv[2], hv[3]);
          *(LAS u32x2*)(hr + n * 32) = w;
        }
      }
      LDS_BAR();
#pragma unroll
      for (int i = 0; i < 4; ++i) {
        const int c = tid + 512 * i, row = c >> 3, ch = c & 7;
        *(u32x4*)((char*)(p.hbuf + (size_t)(mt * 256 + row) * 256 + nt * 64) + ch * 16) = *(const LAS u32x4*)(lds + row * 144 + ch * 16);
      }
      LDS_BAR();
    }
  }
}
DI void phase_exp2(const Params& p, LAS char* lds, int layer, int half) {
  const int tid = thr(), lane = tid & 63, wid = __builtin_amdgcn_readfirstlane(tid >> 6);
  const int wr = wid >> 1, wc = wid & 1, fr = lane & 15, fq = lane >> 4;
  LAS int* tb = (LAS int*)(lds + G_LDS);
  expert_map(p, tb, layer, half);
  const int half_tokens = NTOK / p.nsplit, cap = LIST_CAP / p.nsplit;
  const int TR = tb[64], TS = half_tokens / 256;
  for (int u = blockIdx.x; u < (TR + TS) * 8; u += gridDim.x) {
    const int mt = u >> 3, nt = u & 7, r0 = tid >> 2;
    int e = 0, cnt = 0, ib = 0;
    const bf16_t* W;
    if (mt < TR) { e = find_expert(tb, mt); cnt = tb[65 + e]; ib = (mt - tb[e]) * 256; W = p.ed + (size_t)e * 262144; }
    else W = p.shd[layer];
    const char* a0 = (const char*)(p.hbuf + (size_t)(mt * 256 + r0) * 256) + (tid & 3) * 16;
    const char* a1 = a0 + 128 * 512;
    const char* bs = (const char*)(W + (size_t)(nt * 128 + r0) * 256) + (tid & 3) * 16;
    f32x4 acc[4][4]; zero_acc(acc);
    gemm_kloop(lds, a0, a1, bs, 8, acc);
    const int col0 = nt * 128 + wc * 64 + 4 * fq;
    if (mt < TR) {
      const int2* lst = p.lists + ((size_t)half * 64 + e) * cap;
      LAS int* ri = (LAS int*)(lds + G_LDS + 1024);
      if (tid < 256) { const int idx = ib + tid; int2 en = make_int2(-1, 0); if (idx < cnt) en = lst[idx]; ri[2 * tid] = en.x; ri[2 * tid + 1] = en.y; }
      LDS_BAR();
#pragma unroll
      for (int m = 0; m < 4; ++m) {
        const int r = wr * 64 + m * 16 + fr;
        const float w = __int_as_float(ri[2 * r + 1]);
        LAS char* cr = lds + r * 272 + (wc * 64 + 4 * fq) * 2;
#pragma unroll
        for (int n = 0; n < 4; ++n) { u32x2 v; v.x = cvt_pk(acc[m][n][0] * w, acc[m][n][1] * w); v.y = cvt_pk(acc[m][n][2] * w, acc[m][n][3] * w); *(LAS u32x2*)(cr + n * 32) = v; }
      }
      LDS_BAR();
#pragma unroll
      for (int i = 0; i < 8; ++i) {
        const int c = tid + 512 * i, row = c >> 4, ch = c & 15;
        const int ex = ri[2 * row];
        if (ex >= 0) {
          const int tok = ex >> 3, slot = ex & 7;
          *(u32x4*)((char*)(p.slab + ((size_t)(tok - half * half_tokens) * 6 + slot) * 1024 + nt * 128) + ch * 16) = *(const LAS u32x4*)(lds + row * 272 + ch * 16);
        }
      }
      LDS_BAR();
    } else {
#pragma unroll
      for (int m = 0; m < 4; ++m) {
        const size_t tok = (size_t)half * half_tokens + (mt - TR) * 256 + wr * 64 + m * 16 + fr;
        float* orow = p.out + tok * 1024 + col0;
#pragma unroll
        for (int n = 0; n < 4; ++n) { const f32x4 r = *(const f32x4*)(orow + n * 16); *(f32x4*)(orow + n * 16) = r * ALPHA + acc[m][n]; }
      }
    }
  }
}
DI void phase_combine(const Params& p, int layer, int half) {
  const int lane = thr() & 63, gw = blockIdx.x * 8 + (thr() >> 6), nw = gridDim.x * 8;
  const int half_tokens = NTOK / p.nsplit;
  const float* gam = p.in[18] + layer * 1024;
  const float* bet = p.in[19] + layer * 1024;
  for (int r = gw; r < half_tokens; r += nw) {
    const size_t row = (size_t)half * half_tokens + r;
    float* xr = p.out + row * 1024;
    f32x4 v[4], y[4];
#pragma unroll
    for (int j = 0; j < 4; ++j) v[j] = *(const f32x4*)(xr + 4 * lane + 256 * j);
#pragma unroll
    for (int s = 0; s < 6; ++s) {
      const bf16_t* sr = p.slab + ((size_t)r * 6 + s) * 1024;
#pragma unroll
      for (int j = 0; j < 4; ++j) {
        const u32x2 w = *(const u32x2*)(sr + 4 * lane + 256 * j);
        v[j][0] += __uint_as_float(w.x << 16); v[j][1] += __uint_as_float(w.x & 0xffff0000u);
        v[j][2] += __uint_as_float(w.y << 16); v[j][3] += __uint_as_float(w.y & 0xffff0000u);
      }
    }
    ln_row(v, gam, bet, lane, y);
#pragma unroll
    for (int j = 0; j < 4; ++j) {
      *(f32x4*)(xr + 4 * lane + 256 * j) = y[j];
      if (layer == 0) { u32x2 hi; hi.x = cvt_pk(y[j][0], y[j][1]); hi.y = cvt_pk(y[j][2], y[j][3]); *(u32x2*)(p.xb + row * 1024 + 4 * lane + 256 * j) = hi; }
    }
  }
}

DI void phase_inproj1(const Params& p, LAS char* lds) {
  const int tid = thr(), lane = tid & 63, wid = __builtin_amdgcn_readfirstlane(tid >> 6);
  const int wr = wid >> 1, wc = wid & 1, fr = lane & 15, fq = lane >> 4;
  for (int u = blockIdx.x; u < 128 * 6; u += gridDim.x) {
    const int mt = u / 6, nt = u % 6, m0 = mt * 256, n0 = nt * 128;
    const char* a0 = (const char*)(p.xb + (size_t)(m0 + (tid >> 2)) * 1024) + (tid & 3) * 16;
    const char* a1 = a0 + (size_t)128 * 2048;
    const char* bs = (const char*)(p.win1t + (size_t)(n0 + (tid >> 2)) * 1024) + (tid & 3) * 16;
    f32x4 acc[4][4]; zero_acc(acc);
    gemm_kloop(lds, a0, a1, bs, 32, acc);
#pragma unroll
    for (int m = 0; m < 4; ++m) {
      float* crow_ = p.cbuf + (size_t)(m0 + wr * 64 + m * 16 + fr) * 768 + n0 + wc * 64 + 4 * fq;
#pragma unroll
      for (int n = 0; n < 4; ++n) *(f32x4*)(crow_ + n * 16) = acc[m][n];
    }
  }
  int it = 0;
  expert_weights(p, (LAS float*)lds, 1, it);
}
DI void phase_mlanorm(const Params& p) {
  const int lane = thr() & 63, gw = blockIdx.x * 8 + (thr() >> 6), nw = gridDim.x * 8;
  for (int row = gw; row < NTOK; row += nw) {
    const float* cr = p.cbuf + (size_t)row * 768;
    float q[6], kv[4];
    float ss = 0.f;
#pragma unroll
    for (int j = 0; j < 6; ++j) { q[j] = cr[lane + 64 * j]; ss += q[j] * q[j]; }
    const float rq = rsqrtf(wave_sum(ss) * (1.0f / 384.0f) + 1e-6f);
#pragma unroll
    for (int j = 0; j < 6; ++j) p.cqb[(size_t)row * 384 + lane + 64 * j] = f2bf(q[j] * rq * p.in[11][lane + 64 * j]);
    ss = 0.f;
#pragma unroll
    for (int j = 0; j < 4; ++j) { kv[j] = cr[384 + lane + 64 * j]; ss += kv[j] * kv[j]; }
    const float rk = rsqrtf(wave_sum(ss) * (1.0f / 256.0f) + 1e-6f);
#pragma unroll
    for (int j = 0; j < 4; ++j) p.ckvb[(size_t)row * 256 + lane + 64 * j] = f2bf(kv[j] * rk * p.in[12][lane + 64 * j]);
    if (lane < 16) {
      const float x1 = cr[640 + lane], x2 = cr[656 + lane];
      const float2 cs = p.cs32[(row & 4095) * 16 + lane];
      p.krb[(size_t)row * 32 + lane] = f2bf(x1 * cs.x - x2 * cs.y);
      p.krb[(size_t)row * 32 + 16 + lane] = f2bf(x1 * cs.y + x2 * cs.x);
    }
  }
}
DI void phase_mlaup(const Params& p, LAS char* lds) {
  const int tid = thr(), lane = tid & 63, wid = __builtin_amdgcn_readfirstlane(tid >> 6);
  const int wr = wid >> 1, wc = wid & 1, fr = lane & 15, fq = lane >> 4;
  for (int u = blockIdx.x; u < 128 * 12 + 128 * 16; u += gridDim.x) {
    if (u < 128 * 12) {
      const int mt = u / 12, nt = u % 12, m0 = mt * 256, n0 = nt * 128;
      const char* a0 = (const char*)(p.cqb + (size_t)(m0 + (tid >> 2)) * 384) + (tid & 3) * 16;
      const char* a1 = a0 + (size_t)128 * 768;
      const char* bs = (const char*)(p.wuqt + (size_t)(n0 + (tid >> 2)) * 384) + (tid & 3) * 16;
      f32x4 acc[4][4]; zero_acc(acc);
      gemm_kloop(lds, a0, a1, bs, 12, acc);
#pragma unroll
      for (int m = 0; m < 4; ++m) {
        const int row = m0 + wr * 64 + m * 16 + fr, b = row >> 12, t = row & 4095;
#pragma unroll
        for (int pr = 0; pr < 2; ++pr) {
          const int gi = ((n0 + wc * 64) >> 5) + pr, head = gi / 3, part = gi - head * 3;
          bf16_t* dst = p.q1 + ((size_t)(b * 16 + head) * 4096 + t) * 96 + part * 32 + 4 * fq;
          if (part < 2) {
#pragma unroll
            for (int n = 0; n < 2; ++n) { u32x2 w; w.x = cvt_pk(acc[m][2 * pr + n][0], acc[m][2 * pr + n][1]); w.y = cvt_pk(acc[m][2 * pr + n][2], acc[m][2 * pr + n][3]); *(u32x2*)(dst + n * 16) = w; }
          } else {
            const f32x4 c0 = *(const f32x4*)(p.cs32 + t * 16 + 4 * fq), c1 = *(const f32x4*)(p.cs32 + t * 16 + 4 * fq + 2);
            const float co[4] = {c0[0], c0[2], c1[0], c1[2]}, si[4] = {c0[1], c0[3], c1[1], c1[3]};
            float y1[4], y2[4];
#pragma unroll
            for (int j = 0; j < 4; ++j) { const float x1 = acc[m][2 * pr][j], x2 = acc[m][2 * pr + 1][j]; y1[j] = x1 * co[j] - x2 * si[j]; y2[j] = x1 * si[j] + x2 * co[j]; }
            u32x2 w1, w2; w1.x = cvt_pk(y1[0], y1[1]); w1.y = cvt_pk(y1[2], y1[3]); w2.x = cvt_pk(y2[0], y2[1]); w2.y = cvt_pk(y2[2], y2[3]);
            *(u32x2*)(dst) = w1; *(u32x2*)(dst + 16) = w2;
          }
        }
      }
    } else {
      const int uu = u - 128 * 12, mt = uu >> 4, nt = uu & 15, m0 = mt * 256, n0 = nt * 128;
      const char* a0 = (const char*)(p.ckvb + (size_t)(m0 + (tid >> 2)) * 256) + (tid & 3) * 16;
      const char* a1 = a0 + (size_t)128 * 512;
      const char* bs = (const char*)(p.wukvt + (size_t)(n0 + (tid >> 2)) * 256) + (tid & 3) * 16;
      f32x4 acc[4][4]; zero_acc(acc);
      gemm_kloop(lds, a0, a1, bs, 8, acc);
      const int head = nt;
#pragma unroll
      for (int m = 0; m < 4; ++m) {
        const int row = m0 + wr * 64 + m * 16 + fr, b = row >> 12, t = row & 4095;
        if (wc == 0) plain64_store(acc, m, p.kn + ((size_t)(b * 16 + head) * 4096 + t) * 64, fq);
        else vt64_store(acc, m, p.vt1 + (size_t)(b * 16 + head) * 64 * 4096, 4096, perm16(t), fq);
      }
    }
  }
}

constexpr int LDS_BYTES = NSA_LDS > (G_LDS + 256 * 65 * 4 + 512 + 256 * 6 * 8) ? NSA_LDS : (G_LDS + 256 * 65 * 4 + 512 + 256 * 6 * 8);
constexpr int LDS_TOTAL = LDS_BYTES + 64;
#ifndef ALLCG
#define ALLCG 0
#endif

DI void get_phase(int i, int nsplit, int& ph, int& layer, int& half) {
  const int moe_len = 2 + 3 * nsplit;
  layer = 0; half = 0;
  if (i < 6) { ph = i; return; }
  i -= 6;
  if (i >= moe_len) {
    i -= moe_len; layer = 1;
    if (i < 5) { ph = (i < 4) ? PH_INPROJ1 + i : PH_OUTPROJ; return; }
    i -= 5;
  }
  if (i < 2) { ph = PH_LNSPLIT + i; return; }
  i -= 2; half = i / 3; ph = PH_EXP1 + (i - half * 3);
}
DI int num_phases(int nsplit) { return 6 + 5 + 2 * (2 + 3 * nsplit); }

__global__ void __launch_bounds__(NTHR) fwd_kernel(Params p, int ph_lo, int ph_hi, int use_sync) {
  extern __shared__ __attribute__((aligned(16))) char smem_raw[];
  LAS char* lds = (LAS char*)smem_raw;
  volatile LAS unsigned* bst = (volatile LAS unsigned*)(lds + LDS_BYTES);
  cg::grid_group grid = cg::this_grid();
  XcdBarrier xb;
  if (use_sync) {
    if (threadIdx.x == 0) { bst[0] = 0u; bst[1] = 0u; bst[2] = 0u; bst[3] = 0u; }
    __syncthreads();
    xb = xcd_barrier_post(p.bar, bst);
  }
#ifdef PROBE
  unsigned long long* stamps = (unsigned long long*)(p.cnt + 256);
#endif
  for (int i = ph_lo; i < ph_hi; ++i) {
    int ph, layer, half;
    get_phase(i, p.nsplit, ph, layer, half);
#ifdef PROBE
    if (blockIdx.x == 0 && threadIdx.x == 0) __hip_atomic_store(stamps + i, __builtin_amdgcn_s_memrealtime(), __ATOMIC_RELAXED, __HIP_MEMORY_SCOPE_AGENT);
#endif
    switch (ph) {
      case PH_PREP: phase_prep(p, lds); break;
      case PH_INPROJ0: phase_inproj0(p, lds); break;
      case PH_SWA_CMP1: phase_swa_cmp1(p, lds); break;
      case PH_CMP2: phase_cmp2(p, lds); break;
      case PH_NSA: phase_nsa(p, lds); break;
      case PH_OUTPROJ: phase_outproj(p, lds, layer); break;
      case PH_LNSPLIT: phase_lnsplit(p, layer); break;
      case PH_ROUTER: phase_router(p, lds, layer); break;
      case PH_EXP1: phase_exp1(p, lds, layer, half); break;
      case PH_EXP2: phase_exp2(p, lds, layer, half); break;
      case PH_COMBINE: phase_combine(p, layer, half); break;
      case PH_INPROJ1: phase_inproj1(p, lds); break;
      case PH_MLANORM: phase_mlanorm(p); break;
      case PH_MLAUP: phase_mlaup(p, lds); break;
      case PH_MLAATT: phase_mla(p, lds); break;
      default: break;
    }
    if (use_sync && i + 1 < ph_hi) { if (i == ph_lo || ALLCG) grid.sync(); else xcd_barrier(xb); }
  }
#ifdef PROBE
  {
    if (blockIdx.x == 0 && threadIdx.x == 0) __hip_atomic_store(stamps + ph_hi, __builtin_amdgcn_s_memrealtime(), __ATOMIC_RELAXED, __HIP_MEMORY_SCOPE_AGENT);
    xcd_barrier(xb);
    unsigned long long td = 0, tr = 0;
    for (int i = ph_lo; i < ph_hi; ++i) {
      const unsigned long long d = __hip_atomic_load(stamps + i + 1, __ATOMIC_RELAXED, __HIP_MEMORY_SCOPE_AGENT) - __hip_atomic_load(stamps + i, __ATOMIC_RELAXED, __HIP_MEMORY_SCOPE_AGENT);
      if ((PROBE_DUR >> i) & 1ull) td += d;
      if ((PROBE_RVR >> i) & 1ull) tr += d;
    }
    const float eps = (float)tr * 0.01f / 3000.0f;
    if (PROBE_RVR != 0ull) {
      for (size_t i = ((size_t)blockIdx.x * NTHR + threadIdx.x) * 4; i < (size_t)NTOK * 1024; i += (size_t)gridDim.x * NTHR * 4) {
        f32x4 v = *(f32x4*)(p.out + i); v = v * (1.0f + eps); *(f32x4*)(p.out + i) = v;
      }
    }
    if (blockIdx.x == 0 && threadIdx.x == 0 && td != 0ull) {
      const unsigned long long t0 = __builtin_amdgcn_s_memrealtime();
      while (__builtin_amdgcn_s_memrealtime() - t0 < 9ull * td) __builtin_amdgcn_s_sleep(8);
    }
  }
#endif
}

extern "C" void kernel_launch(void* const* d_in, const int* in_sizes, int n_in, void* d_out, int out_size, void* d_ws, size_t ws_size, hipStream_t stream) {
  static int grid_blocks = 0;
  if (grid_blocks == 0) {
    int dev = 0, cus = 0, per_cu = 0;
    hipGetDevice(&dev);
    hipDeviceGetAttribute(&cus, hipDeviceAttributeMultiprocessorCount, dev);
    hipFuncSetAttribute((const void*)fwd_kernel, hipFuncAttributeMaxDynamicSharedMemorySize, LDS_TOTAL);
    hipOccupancyMaxActiveBlocksPerMultiprocessor(&per_cu, (const void*)fwd_kernel, NTHR, LDS_TOTAL);
    if (per_cu < 1) { fprintf(stderr, "kernel_launch: occupancy query says %d blocks per CU\n", per_cu); per_cu = 1; }
    grid_blocks = cus;
    (void)hipGetLastError();
  }
  Params p;
  memset(&p, 0, sizeof(p));
  for (int i = 0; i < 28; ++i) p.in[i] = (const float*)d_in[i];
  p.out = (float*)d_out;
  char* ws = (char*)d_ws;
  size_t off = 0;
  auto take = [&](size_t bytes) { char* r = ws + off; off += (bytes + 255) & ~(size_t)255; return r; };
  p.bar = (unsigned*)take(XCD_BAR_WORDS * 4);
  p.cnt = (int*)take(256 * 4 + 64 * 8);
  p.win0t = (bf16_t*)take((size_t)2176 * 1024 * 2); p.wout0t = (bf16_t*)take((size_t)1024 * 1024 * 2);
  p.cw1k = (bf16_t*)take(128 * 2048 * 2); p.cw1v = (bf16_t*)take(128 * 2048 * 2);
  p.cw2k = (bf16_t*)take(128 * 128 * 2); p.cw2v = (bf16_t*)take(128 * 128 * 2);
  p.win1t = (bf16_t*)take((size_t)768 * 1024 * 2); p.wuqt = (bf16_t*)take((size_t)1536 * 384 * 2);
  p.wukvt = (bf16_t*)take((size_t)2048 * 256 * 2); p.wout1t = (bf16_t*)take((size_t)1024 * 1024 * 2);
  for (int l = 0; l < 2; ++l) {
    p.rwh[l] = (bf16_t*)take(128 * 1024 * 2); p.rwl[l] = (bf16_t*)take(128 * 1024 * 2);
    p.shgu[l] = (bf16_t*)take(512 * 1024 * 2); p.shd[l] = (bf16_t*)take(1024 * 256 * 2);
  }
  p.cb1k = (float*)take(128 * 4); p.cb1v = (float*)take(128 * 4);
  p.cs64 = (float2*)take(4096 * 32 * 8); p.cs32 = (float2*)take(4096 * 16 * 8);
  p.egu = (bf16_t*)take((size_t)64 * 524288 * 2); p.ed = (bf16_t*)take((size_t)64 * 262144 * 2);
  p.xb = (bf16_t*)take((size_t)NTOK * 1024 * 2);
  const size_t act0 = off;
  p.q0 = (bf16_t*)take((size_t)NBATCH * 16 * 4096 * 64 * 2);
  const size_t kvb = (size_t)NBATCH * 2 * 4096 * 64 * 2;
  p.ka = (bf16_t*)take(kvb); p.ks = (bf16_t*)take(kvb); p.kw = (bf16_t*)take(kvb); p.kc0 = (bf16_t*)take(kvb); p.vc0 = (bf16_t*)take(kvb);
  p.vta = (bf16_t*)take(kvb); p.vts = (bf16_t*)take(kvb); p.vtw = (bf16_t*)take(kvb);
  p.h1k = (bf16_t*)take(4096 * 128 * 2); p.h1v = (bf16_t*)take(4096 * 128 * 2);
  p.kcmp = (bf16_t*)take(16 * 256 * 64 * 2); p.vcmpt = (bf16_t*)take(16 * 64 * 256 * 2);
  p.gates = (float*)take((size_t)NTOK * 24 * 4);
  p.obuf = (bf16_t*)take((size_t)NTOK * 1024 * 2);
  const size_t end_l0 = off;
  const size_t need1 = act0 + (size_t)NTOK * 1024 * 2 + (size_t)64 * LIST_CAP * 8 + ((size_t)NTOK * 7 + 64 * 256) * 512 + (size_t)NTOK * 6 * 2048 + 4096;
  p.nsplit = ws_size >= need1 ? 1 : 2;
  off = act0;
  p.x1lo = (bf16_t*)take((size_t)NTOK * 1024 * 2);
  p.lists = (int2*)take((size_t)64 * LIST_CAP * 8);
  p.hbuf = (bf16_t*)take(((size_t)(NTOK / p.nsplit) * 7 + 64 * 256) * 512);
  p.slab = (bf16_t*)take((size_t)(NTOK / p.nsplit) * 6 * 2048);
  const size_t end_moe = off;
  off = act0;
  p.cqb = (bf16_t*)take((size_t)NTOK * 384 * 2); p.ckvb = (bf16_t*)take((size_t)NTOK * 256 * 2); p.krb = (bf16_t*)take((size_t)NTOK * 32 * 2);
  p.q1 = (bf16_t*)take((size_t)NTOK * 16 * 96 * 2);
  p.kn = (bf16_t*)take((size_t)NTOK * 16 * 64 * 2);
  p.cbuf = (float*)p.kn;
  p.vt1 = (bf16_t*)take((size_t)NTOK * 16 * 64 * 2);
  const size_t end_l1 = off;
  size_t need = end_l0 > end_moe ? end_l0 : end_moe; if (end_l1 > need) need = end_l1;
  if (need > ws_size) { fprintf(stderr, "kernel_launch: workspace too small: need %zu, have %zu\n", need, ws_size); return; }
  const int n = 6 + 5 + 2 * (2 + 3 * p.nsplit);
  hipMemsetAsync(p.bar, 0, XCD_BAR_WORDS * 4, stream);
#ifdef MULTI_LAUNCH
  for (int i = 0; i < n; ++i) hipLaunchKernelGGL(fwd_kernel, dim3(grid_blocks), dim3(NTHR), LDS_TOTAL, stream, p, i, i + 1, 0);
#else
  int lo = 0, hi = n, us = 1;
  void* args[] = {&p, &lo, &hi, &us};
  hipError_t e = hipLaunchCooperativeKernel((const void*)fwd_kernel, dim3(grid_blocks), dim3(NTHR), args, LDS_TOTAL, stream);
  if (e != hipSuccess) fprintf(stderr, "cooperative launch failed: %s (grid %d)\n", hipGetErrorString(e), grid_blocks);
#endif
}
```

```cpp
#include <hip/hip_runtime.h>
#include <hip/hip_cooperative_groups.h>
#include <stdint.h>
#include <math.h>
#include <cstdio>
#include <cstring>
namespace cg = cooperative_groups;

#define LAS __attribute__((address_space(3)))
#define DI __device__ __forceinline__
typedef unsigned short bf16_t;
typedef short bf16x8 __attribute__((ext_vector_type(8)));
typedef float f32x4 __attribute__((ext_vector_type(4)));
typedef float f32x16 __attribute__((ext_vector_type(16)));
typedef unsigned u32x4 __attribute__((ext_vector_type(4)));
typedef unsigned u32x2 __attribute__((ext_vector_type(2)));

constexpr int NTOK = 32768, SEQ = 4096, NBATCH = 8, DM = 1024;
constexpr int NTHR = 512;
constexpr float ALPHA = 1.4142135623730951f;
constexpr float LOG2E = 1.4426950408889634f;

typedef __bf16 bf16x2_t __attribute__((ext_vector_type(2)));
typedef float f32x2_t __attribute__((ext_vector_type(2)));
DI unsigned cvt_pk(float lo, float hi) { const f32x2_t f = {lo, hi}; return __builtin_bit_cast(unsigned, __builtin_convertvector(f, bf16x2_t)); }
DI bf16_t f2bf(float x) { return (bf16_t)(cvt_pk(x, 0.f) & 0xffffu); }
DI float bf2f(bf16_t b) { return __uint_as_float(((unsigned)b) << 16); }
DI float fast_exp2(float x) { return __builtin_amdgcn_exp2f(x); }
DI float sigmoidf_(float x) { return 1.0f / (1.0f + __expf(-x)); }
DI int crow(int r, int h) { return (r & 3) + 8 * (r >> 2) + 4 * h; }
DI int perm16(int t) { return (t & ~15) | (((t >> 2) & 1) << 3) | (((t >> 3) & 1) << 2) | (t & 3); }
DI void glds16(const void* g, LAS char* l) { __builtin_amdgcn_global_load_lds((const unsigned*)g, (LAS unsigned*)l, 16, 0, 0); }
#define WAIT_VM_BAR(N) asm volatile("s_waitcnt vmcnt(" #N ") lgkmcnt(0)\n\ts_barrier" ::: "memory")
#define LDS_BAR() asm volatile("s_waitcnt lgkmcnt(0)\n\ts_barrier" ::: "memory")
DI int thr() { int t = threadIdx.x; asm volatile("" : "+v"(t)); return t; }
DI float wave_sum(float v) {
#pragma unroll
  for (int o = 32; o > 0; o >>= 1) v += __shfl_xor(v, o);
  return v;
}

#define XB_TMO 0
#define XB_XCNT(j) (16 + 16 * (j))
#define XB_XSUB(j) (272 + 16 * (j))
#define XB_XGEN(j) (528 + 16 * (j))
#define XB_TOP 784
#define XB_TOPGEN 800
#define XCD_BAR_WORDS 1024
#define XB_SPIN_CAP (1u << 22)
typedef __attribute__((address_space(1))) unsigned gu32;
DI unsigned xb_ld(gu32* p) { return __hip_atomic_load(p, __ATOMIC_RELAXED, __HIP_MEMORY_SCOPE_AGENT); }
DI unsigned xb_add(gu32* p, unsigned v) { return __hip_atomic_fetch_add(p, v, __ATOMIC_RELAXED, __HIP_MEMORY_SCOPE_AGENT); }
DI unsigned xb_xcc_id() { return (unsigned)__builtin_amdgcn_s_getreg((3 << 11) | 20) & 0xFu; }
#define XB_SPIN(cond, bar) do { unsigned _sp = 0; while (cond) { __builtin_amdgcn_s_sleep(1); \
    if ((++_sp & 255u) == 0u) { if (xb_ld(&(bar)[XB_TMO])) break; if (_sp > XB_SPIN_CAP) { xb_add(&(bar)[XB_TMO], 1u); break; } } } } while (0)
struct XcdBarrier { gu32* bar; unsigned x; volatile LAS unsigned* st; };
DI XcdBarrier xcd_barrier_post(unsigned* bar_, volatile LAS unsigned* st) {
  gu32* bar = (gu32*)bar_;
  XcdBarrier b; b.bar = bar; b.x = xb_xcc_id(); b.st = st;
  if (threadIdx.x == 0) (void)xb_add(&bar[XB_XCNT(b.x)], 1u);
  return b;
}
DI void xcd_barrier_complete(gu32* bar, unsigned x, unsigned& nloc, unsigned& nx) {
  const unsigned G = gridDim.x;
  unsigned sum, cnt, mine, sp = 0u;
  for (;;) {
    sum = 0u; cnt = 0u; mine = 0u;
#pragma unroll
    for (unsigned j = 0; j < 16; ++j) { const unsigned c = xb_ld(&bar[XB_XCNT(j)]); sum += c; cnt += (c > 0u) ? 1u : 0u; mine = (j == x) ? c : mine; }
    if (sum == G) break;
    __builtin_amdgcn_s_sleep(1);
    if ((++sp & 255u) == 0u) { if (xb_ld(&bar[XB_TMO])) break; if (sp > XB_SPIN_CAP) { xb_add(&bar[XB_TMO], 1u); break; } }
  }
  nloc = mine > 0u ? mine : 1u; nx = cnt > 0u ? cnt : 1u;
}
DI void xcd_barrier(const XcdBarrier& b) {
  asm volatile("s_waitcnt vmcnt(0)" ::: "memory");
  __syncthreads();
  if (threadIdx.x == 0) {
    unsigned long long bar_i = (unsigned long long)b.bar;
    asm volatile("" : "+s"(bar_i));
    gu32* bar = (gu32*)bar_i;
    __builtin_amdgcn_s_waitcnt(0);
    unsigned nloc = b.st[0], nx = b.st[1];
    if (nloc == 0u) { xcd_barrier_complete(bar, b.x, nloc, nx); b.st[0] = nloc; b.st[1] = nx; }
    const unsigned old = xb_add(&bar[XB_XSUB(b.x)], 1u);
    const unsigned gen = old / nloc;
    if (old + 1u == (gen + 1u) * nloc) {
      __builtin_amdgcn_fence(__ATOMIC_RELEASE, "agent");
      asm volatile("s_waitcnt vmcnt(0)" ::: "memory");
      const unsigned og = xb_add(&bar[XB_TOP], 1u);
      const unsigned tg = og / nx;
      if (og + 1u == (tg + 1u) * nx) xb_add(&bar[XB_TOPGEN], 1u);
      else XB_SPIN(xb_ld(&bar[XB_TOPGEN]) == tg, bar);
      __builtin_amdgcn_fence(__ATOMIC_ACQUIRE, "agent");
      xb_add(&bar[XB_XGEN(b.x)], 1u);
      asm volatile("s_waitcnt vmcnt(0)" ::: "memory");
    } else {
      XB_SPIN(xb_ld(&bar[XB_XGEN(b.x)]) == gen, bar);
      __builtin_amdgcn_fence(__ATOMIC_ACQUIRE, "agent");
      asm volatile("s_waitcnt vmcnt(0)" ::: "memory");
    }
  }
  __syncthreads();
}

constexpr int G_STAGE = 32768;
constexpr int G_LDS = 4 * G_STAGE;
constexpr int MISC_OFF = 135168;

DI void gemm_kloop(LAS char* lds, const char* a0, const char* a1, const char* b0, const char* b1, int nk  , f32x4 (&acc)[4][8]) {
  const int tid = thr(), lane = tid & 63, wid = __builtin_amdgcn_readfirstlane(tid >> 6);
  const int wr = wid >> 1, wc = wid & 1, fr = lane & 15, fq = lane >> 4;
  LAS char* dA0 = lds + tid * 16;
  const int aoff = (wr * 64 + fr) * 64 + fq * 16;
  const int boff = 16384 + (wc * 128 + fr) * 64 + fq * 16;
#define G_ISSUE(slot, kt) do { LAS char* _d = dA0 + (slot) * G_STAGE; const size_t _ko = (size_t)(kt) * 64; \
    glds16(a0 + _ko, _d); glds16(a1 + _ko, _d + 8192); glds16(b0 + _ko, _d + 16384); glds16(b1 + _ko, _d + 24576); } while (0)
  asm volatile("s_waitcnt vmcnt(0)" ::: "memory");
  G_ISSUE(0, 0);
  if (nk > 1) G_ISSUE(1, 1);
  if (nk > 2) G_ISSUE(2, 2);
  int slot = 0;
  for (int t = 0; t < nk; ++t) {
    if (t + 2 < nk) { WAIT_VM_BAR(8); } else if (t + 1 < nk) { WAIT_VM_BAR(4); } else { WAIT_VM_BAR(0); }
    if (t + 3 < nk) { G_ISSUE((slot + 3) & 3, t + 3); }
    const LAS char* base = lds + slot * G_STAGE;
    bf16x8 af[4];
#pragma unroll
    for (int m = 0; m < 4; ++m) af[m] = *(const LAS bf16x8*)(base + aoff + m * 1024);
#pragma unroll
    for (int nh = 0; nh < 2; ++nh) {
      bf16x8 bfr[4];
#pragma unroll
      for (int n = 0; n < 4; ++n) bfr[n] = *(const LAS bf16x8*)(base + boff + (4 * nh + n) * 1024);
#pragma unroll
      for (int m = 0; m < 4; ++m)
#pragma unroll
        for (int n = 0; n < 4; ++n) acc[m][4 * nh + n] = __builtin_amdgcn_mfma_f32_16x16x32_bf16(bfr[n], af[m], acc[m][4 * nh + n], 0, 0, 0);
    }
    slot = (slot + 1) & 3;
  }
#undef G_ISSUE
  LDS_BAR();
}
DI void zero_acc(f32x4 (&acc)[4][8]) {
#pragma unroll
  for (int m = 0; m < 4; ++m)
#pragma unroll
    for (int n = 0; n < 8; ++n) acc[m][n] = (f32x4){0.f, 0.f, 0.f, 0.f};
}
constexpr int A_STAGE = 20480, A_RING = 3 * A_STAGE;
constexpr float NEGBIG = -1e30f;
#define MFMA32(a, b, c) __builtin_amdgcn_mfma_f32_32x32x16_bf16((a), (b), (c), 0, 0, 0)

template <bool HAS_ROPE>
DI void qk_tile(const LAS char* kt, const LAS char* krt, const bf16x8* qf, int r32, int h, f32x16& sA, f32x16& sB) {
  const int sw = (r32 >> 1) & 7;
  const LAS char* ra = kt + r32 * 128;
  const LAS char* rb = ra + 32 * 128;
  f32x16 z;
#pragma unroll
  for (int i = 0; i < 16; ++i) z[i] = 0.f;
  sA = z; sB = z;
#pragma unroll
  for (int ks = 0; ks < 4; ++ks) {
    const int c = ((2 * ks + h) ^ sw) << 4;
    const bf16x8 ka = *(const LAS bf16x8*)(ra + c);
    const bf16x8 kb = *(const LAS bf16x8*)(rb + c);
    sA = MFMA32(ka, qf[ks], sA);
    sB = MFMA32(kb, qf[ks], sB);
  }
  if (HAS_ROPE) {
    const int sw2 = (r32 >> 2) & 3;
    const LAS char* pa = krt + r32 * 64;
    const LAS char* pb = pa + 32 * 64;
#pragma unroll
    for (int ks = 0; ks < 2; ++ks) {
      const int c = ((2 * ks + h) ^ sw2) << 4;
      const bf16x8 ka = *(const LAS bf16x8*)(pa + c);
      const bf16x8 kb = *(const LAS bf16x8*)(pb + c);
      sA = MFMA32(ka, qf[4 + ks], sA);
      sB = MFMA32(kb, qf[4 + ks], sB);
    }
  }
}

DI bf16x8 pack8(const f32x16& p, int s) {
  u32x4 w;
  w.x = cvt_pk(p[8 * s + 0], p[8 * s + 1]); w.y = cvt_pk(p[8 * s + 2], p[8 * s + 3]);
  w.z = cvt_pk(p[8 * s + 4], p[8 * s + 5]); w.w = cvt_pk(p[8 * s + 6], p[8 * s + 7]);
  return __builtin_bit_cast(bf16x8, w);
}

DI void pv_tile(const LAS char* vt, const f32x16& pA, const f32x16& pB, int r32, int h, f32x16 (&o)[2]) {
  const int sw = (r32 >> 1) & 7;
  const LAS char* r0 = vt + r32 * 128;
  const LAS char* r1 = r0 + 32 * 128;
#pragma unroll
  for (int kk = 0; kk < 4; ++kk) {
    const bf16x8 pt = (kk < 2) ? pack8(pA, kk & 1) : pack8(pB, kk & 1);
    const int c = ((2 * kk + h) ^ sw) << 4;
    const bf16x8 v0 = *(const LAS bf16x8*)(r0 + c);
    const bf16x8 v1 = *(const LAS bf16x8*)(r1 + c);
    o[0] = MFMA32(v0, pt, o[0]);
    o[1] = MFMA32(v1, pt, o[1]);
  }
}

DI void mask_scores(f32x16& sA, f32x16& sB, int key0, int lo, int hi, int h) {
#pragma unroll
  for (int r = 0; r < 16; ++r) {
    const int ka = key0 + crow(r, h), kb = ka + 32;
    sA[r] = (ka > lo && ka <= hi) ? sA[r] : NEGBIG;
    sB[r] = (kb > lo && kb <= hi) ? sB[r] : NEGBIG;
  }
}
DI float row_max32(const f32x16& sA, const f32x16& sB) {
  float mx = fmaxf(sA[0], sB[0]);
#pragma unroll
  for (int r = 1; r < 16; ++r) mx = fmaxf(mx, fmaxf(sA[r], sB[r]));
  return fmaxf(mx, __shfl_xor(mx, 32));
}
DI void softmax_step(f32x16& sA, f32x16& sB, float c, float& m, float& l, f32x16 (&o)[2]) {
  const float mx = row_max32(sA, sB);
  const float mnew = fmaxf(m, mx);
  const float mc = (mnew < -1e29f) ? 0.f : mnew * c;
  const float alpha = fast_exp2(m * c - mc);
  m = mnew;
  float sum = 0.f;
#pragma unroll
  for (int r = 0; r < 16; ++r) {
    sA[r] = fast_exp2(__builtin_fmaf(sA[r], c, -mc));
    sB[r] = fast_exp2(__builtin_fmaf(sB[r], c, -mc));
    sum += sA[r] + sB[r];
  }
  l = l * alpha + sum;
  if (!__all(alpha == 1.0f)) {
#pragma unroll
    for (int r = 0; r < 16; ++r) { o[0][r] *= alpha; o[1][r] *= alpha; }
  }
}

template <bool HAS_ROPE, class F>
DI void kv_stream(LAS char* ring, const char* kb, const char* vb, size_t vstride, const char* krb, int tile_lo, int tile_hi, F&& per_tile) {
  const int tid = thr();
  const int row = tid >> 3, cs = ((tid & 7) ^ ((row >> 1) & 7)) << 4;
  const char* ksrc = kb + (size_t)row * 128 + cs;
  const char* vsrc = vb + (size_t)row * vstride + cs;
  const int t2 = tid & 255, row2 = t2 >> 2;
  const char* rsrc = krb + (size_t)row2 * 64 + (((t2 & 3) ^ ((row2 >> 2) & 3)) << 4);
  LAS char* dst = ring + tid * 16;
  LAS char* dst2 = ring + 16384 + t2 * 16;
#define A_ISSUE(slot, tl) do { glds16(ksrc + (size_t)(tl) * 8192, dst + (slot) * A_STAGE); glds16(vsrc + (size_t)(tl) * 128, dst + (slot) * A_STAGE + 8192); \
    if (HAS_ROPE) glds16(rsrc + (size_t)(tl) * 4096, dst2 + (slot) * A_STAGE); } while (0)
  asm volatile("s_waitcnt vmcnt(0)" ::: "memory");
  if (tile_lo <= tile_hi) A_ISSUE(0, tile_lo);
  if (tile_lo + 1 <= tile_hi) A_ISSUE(1, tile_lo + 1);
  int slot = 0;
  for (int t = tile_lo; t <= tile_hi; ++t) {
    if (t + 1 <= tile_hi) { if (HAS_ROPE) { WAIT_VM_BAR(3); } else { WAIT_VM_BAR(2); } } else { WAIT_VM_BAR(0); }
    if (t + 2 <= tile_hi) { int s2 = slot + 2; if (s2 >= 3) s2 -= 3; A_ISSUE(s2, t + 2); }
    per_tile(t, (const LAS char*)(ring + slot * A_STAGE));
    slot = (slot == 2) ? 0 : slot + 1;
  }
#undef A_ISSUE
  LDS_BAR();
}

DI float l_total(float l) { return l + __shfl_xor(l, 32); }

DI void store_o(char* rowp, const f32x16 (&o)[2], int h) {
#pragma unroll
  for (int dd = 0; dd < 2; ++dd)
#pragma unroll
    for (int g = 0; g < 4; ++g) {
      u32x2 w; w.x = cvt_pk(o[dd][4 * g + 0], o[dd][4 * g + 1]); w.y = cvt_pk(o[dd][4 * g + 2], o[dd][4 * g + 3]);
      *(u32x2*)(rowp + (32 * dd + 8 * g + 4 * h) * 2) = w;
    }
}
struct Params {
  const float* in[28];
  float* out;
  unsigned* bar;
  int* cnt;
  bf16_t *win0t, *wout0t, *cw1k, *cw1v, *cw2k, *cw2v, *win1t, *wuqt, *wukvt, *wout1t;
  bf16_t *rwh[2], *rwl[2], *shgu[2], *shd[2];
  bf16_t *egu, *ed;
  float *cb1k, *cb1v;
  float2 *cs64, *cs32;
  bf16_t *xb;
  bf16_t *q0, *ka, *ks, *kw, *kc0, *vc0, *vta, *vts, *vtw, *h1k, *h1v, *kcmp, *vcmpt, *obuf;
  float* gates;
  bf16_t *x1lo, *hbuf, *slab;
  int2* lists;
  float* cbuf;
  bf16_t *cqb, *ckvb, *krb, *q1, *kn, *vt1;
  int nsplit;
  int pad_;
};
enum { PH_PREP = 0, PH_INPROJ0, PH_SWA_CMP1, PH_CMP2, PH_NSA, PH_OUTPROJ, PH_LNSPLIT, PH_ROUTER, PH_EXP1, PH_EXP2, PH_COMBINE, PH_INPROJ1, PH_MLANORM, PH_MLAUP, PH_MLAATT };

DI void xpose_item(LAS float* tile, const float* src, int N, int k0, int n0, bf16_t* dst, int ldd, int mode, bf16_t* dst_lo) {
  const int tid = thr();
  {
    const int n = tid & 63, kk = tid >> 6;
    const bool ok = (n0 + n) < N;
#pragma unroll
    for (int i = 0; i < 8; ++i) { const int k = kk + 8 * i; tile[k * 65 + n] = ok ? src[(size_t)(k0 + k) * N + n0 + n] : 0.f; }
  }
  __syncthreads();
  {
    const int n = tid >> 3, kc = (tid & 7) * 8, gn = n0 + n;
    if (gn < N) {
      float v[8];
#pragma unroll
      for (int j = 0; j < 8; ++j) v[j] = tile[(kc + j) * 65 + n];
      int row = gn;
      if (mode == 1) row = 64 * (gn >> 5) + (gn & 31);
      if (mode == 2) row = 64 * (gn >> 5) + 32 + (gn & 31);
      u32x4 w; w.x = cvt_pk(v[0], v[1]); w.y = cvt_pk(v[2], v[3]); w.z = cvt_pk(v[4], v[5]); w.w = cvt_pk(v[6], v[7]);
      *(u32x4*)(dst + (size_t)row * ldd + k0 + kc) = w;
      if (dst_lo) {
        float r[8];
#pragma unroll
        for (int j = 0; j < 8; ++j) { const unsigned pk = (j & 1) ? (w[j >> 1] >> 16) : (w[j >> 1] & 0xffffu); r[j] = v[j] - __uint_as_float(pk << 16); }
        u32x4 w2; w2.x = cvt_pk(r[0], r[1]); w2.y = cvt_pk(r[2], r[3]); w2.z = cvt_pk(r[4], r[5]); w2.w = cvt_pk(r[6], r[7]);
        *(u32x4*)(dst_lo + (size_t)row * ldd + k0 + kc) = w2;
      }
    }
  }
  __syncthreads();
}
DI void xpose_item256(LAS float* tile, const float* src, int N, int k0, int n0, bf16_t* dst, int ldd, int mode) {
  const int tid = thr();
  {
    const int n4 = (tid & 63) * 4, kk = tid >> 6;
    f32x4 v[8];
#pragma unroll
    for (int i = 0; i < 8; ++i) v[i] = *(const f32x4*)(src + (size_t)(k0 + kk + 8 * i) * N + n0 + n4);
#pragma unroll
    for (int i = 0; i < 8; ++i) {
      LAS float* tp = tile + (kk + 8 * i) * 257 + n4;
      tp[0] = v[i][0]; tp[1] = v[i][1]; tp[2] = v[i][2]; tp[3] = v[i][3];
    }
  }
  __syncthreads();
#pragma unroll
  for (int j = 0; j < 4; ++j) {
    const int c = tid + 512 * j, n = c >> 3, kc = (c & 7) * 8, gn = n0 + n;
    float v[8];
#pragma unroll
    for (int e = 0; e < 8; ++e) v[e] = tile[(kc + e) * 257 + n];
    int row = gn;
    if (mode == 1) row = 64 * (gn >> 5) + (gn & 31);
    if (mode == 2) row = 64 * (gn >> 5) + 32 + (gn & 31);
    u32x4 w; w.x = cvt_pk(v[0], v[1]); w.y = cvt_pk(v[2], v[3]); w.z = cvt_pk(v[4], v[5]); w.w = cvt_pk(v[6], v[7]);
    *(u32x4*)(dst + (size_t)row * ldd + k0 + kc) = w;
  }
  __syncthreads();
}
DI void xpose_matrix(LAS float* tile, const float* src, int K, int N, bf16_t* dst, int mode, bf16_t* dst_lo, int& itbase) {
  const bool wide = (N % 256 == 0) && dst_lo == nullptr;
  const int nkt = K / 64, nnt = wide ? N / 256 : (N + 63) / 64, total = nkt * nnt;
  int first = (int)((blockIdx.x + gridDim.x - (itbase % gridDim.x)) % gridDim.x);
  for (int i = first; i < total; i += gridDim.x) {
    if (wide) xpose_item256(tile, src, N, (i % nkt) * 64, (i / nkt) * 256, dst, K, mode);
    else xpose_item(tile, src, N, (i % nkt) * 64, (i / nkt) * 64, dst, K, mode, dst_lo);
  }
  itbase += total;
}
DI void zero_rows(bf16_t* dst, size_t nelem) {
  u32x4 z = (u32x4){0u, 0u, 0u, 0u};
  for (size_t i = ((size_t)blockIdx.x * NTHR + thr()) * 8; i < nelem; i += (size_t)gridDim.x * NTHR * 8) *(u32x4*)(dst + i) = z;
}
DI void expert_weights(const Params& p, LAS float* tile, int layer, int& it) {
  const size_t eo = (size_t)layer * 64 * 262144;
  for (int e = 0; e < 64; ++e) {
    xpose_matrix(tile, p.in[22] + eo + (size_t)e * 262144, 1024, 256, p.egu + (size_t)e * 524288, 1, nullptr, it);
    xpose_matrix(tile, p.in[23] + eo + (size_t)e * 262144, 1024, 256, p.egu + (size_t)e * 524288, 2, nullptr, it);
    xpose_matrix(tile, p.in[24] + eo + (size_t)e * 262144, 256, 1024, p.ed + (size_t)e * 262144, 0, nullptr, it);
  }
}
DI void phase_prep(const Params& p, LAS char* lds) {
  LAS float* tile = (LAS float*)lds;
  const int tid = thr();
  for (size_t i = ((size_t)blockIdx.x * NTHR + tid) * 8; i < (size_t)NTOK * DM; i += (size_t)gridDim.x * NTHR * 8) {
    const f32x4 a = *(const f32x4*)(p.in[0] + i), b = *(const f32x4*)(p.in[0] + i + 4);
    u32x4 w; w.x = cvt_pk(a[0], a[1]); w.y = cvt_pk(a[2], a[3]); w.z = cvt_pk(b[0], b[1]); w.w = cvt_pk(b[2], b[3]);
    *(u32x4*)(p.xb + i) = w;
  }
  zero_rows(p.win0t + (size_t)2072 * 1024, (size_t)232 * 1024);
  zero_rows(p.cw2k + 64 * 128, 192 * 128);
  zero_rows(p.cw2v + 64 * 128, 192 * 128);
  zero_rows(p.cw1k + (size_t)128 * 2048, (size_t)128 * 2048);
  zero_rows(p.cw1v + (size_t)128 * 2048, (size_t)128 * 2048);
  zero_rows(p.win1t + (size_t)672 * 1024, (size_t)96 * 1024);
  for (int l = 0; l < 2; ++l) { zero_rows(p.rwh[l] + 64 * 1024, 192 * 1024); zero_rows(p.rwl[l] + 64 * 1024, 192 * 1024); }
  if (blockIdx.x == 0 && tid < 256) p.cnt[tid] = 0;
  for (int i = blockIdx.x * NTHR + tid; i < 4096 * 32; i += gridDim.x * NTHR) {
    const int t = i >> 5, f = i & 31;
    const float ang = (float)t * powf(10000.0f, -2.0f * (float)f / 64.0f);
    p.cs64[i] = make_float2(cosf(ang), sinf(ang));
  }
  for (int i = blockIdx.x * NTHR + tid; i < 4096 * 16; i += gridDim.x * NTHR) {
    const int t = i >> 4, f = i & 15;
    const float ang = (float)t * powf(10000.0f, -2.0f * (float)f / 32.0f);
    p.cs32[i] = make_float2(cosf(ang), sinf(ang));
  }
  if (blockIdx.x == 1 || blockIdx.x == 2) {
    const float* pe = blockIdx.x == 1 ? p.in[3] : p.in[6];
    const float* w1 = blockIdx.x == 1 ? p.in[4] : p.in[7];
    float* dst = blockIdx.x == 1 ? p.cb1k : p.cb1v;
    const int j = tid & 127, part = tid >> 7;
    float s = 0.f;
    for (int k = part * 512; k < part * 512 + 512; ++k) s = fmaf(pe[k], w1[(size_t)k * 128 + j], s);
    tile[tid] = s;
    __syncthreads();
    if (tid < 128) dst[tid] = tile[tid] + tile[tid + 128] + tile[tid + 256] + tile[tid + 384];
    __syncthreads();
  }
  int it = 0;
  xpose_matrix(tile, p.in[1], 1024, 2072, p.win0t, 0, nullptr, it);
  xpose_matrix(tile, p.in[9], 1024, 1024, p.wout0t, 0, nullptr, it);
  xpose_matrix(tile, p.in[4], 2048, 128, p.cw1k, 0, nullptr, it);
  xpose_matrix(tile, p.in[7], 2048, 128, p.cw1v, 0, nullptr, it);
  xpose_matrix(tile, p.in[5], 128, 64, p.cw2k, 0, nullptr, it);
  xpose_matrix(tile, p.in[8], 128, 64, p.cw2v, 0, nullptr, it);
  xpose_matrix(tile, p.in[10], 1024, 672, p.win1t, 0, nullptr, it);
  xpose_matrix(tile, p.in[13], 384, 1536, p.wuqt, 0, nullptr, it);
  xpose_matrix(tile, p.in[14], 256, 2048, p.wukvt, 0, nullptr, it);
  xpose_matrix(tile, p.in[15], 1024, 1024, p.wout1t, 0, nullptr, it);
  for (int l = 0; l < 2; ++l) {
    xpose_matrix(tile, p.in[20] + (size_t)l * 65536, 1024, 64, p.rwh[l], 0, p.rwl[l], it);
    xpose_matrix(tile, p.in[25] + (size_t)l * 262144, 1024, 256, p.shgu[l], 1, nullptr, it);
    xpose_matrix(tile, p.in[26] + (size_t)l * 262144, 1024, 256, p.shgu[l], 2, nullptr, it);
    xpose_matrix(tile, p.in[27] + (size_t)l * 262144, 256, 1024, p.shd[l], 0, nullptr, it);
  }
  expert_weights(p, tile, 0, it);
}

DI void rope64_store(const f32x4* a, const float2* cs, bf16_t* rowp, int fq) {
#pragma unroll
  for (int n = 0; n < 2; ++n) {
    const f32x4 c0 = *(const f32x4*)(cs + n * 16 + 4 * fq), c1 = *(const f32x4*)(cs + n * 16 + 4 * fq + 2);
    const float co[4] = {c0[0], c0[2], c1[0], c1[2]}, si[4] = {c0[1], c0[3], c1[1], c1[3]};
    float y1[4], y2[4];
#pragma unroll
    for (int j = 0; j < 4; ++j) { const float x1 = a[n][j], x2 = a[n + 2][j]; y1[j] = x1 * co[j] - x2 * si[j]; y2[j] = x1 * si[j] + x2 * co[j]; }
    u32x2 w1, w2; w1.x = cvt_pk(y1[0], y1[1]); w1.y = cvt_pk(y1[2], y1[3]); w2.x = cvt_pk(y2[0], y2[1]); w2.y = cvt_pk(y2[2], y2[3]);
    *(u32x2*)(rowp + n * 16 + 4 * fq) = w1;
    *(u32x2*)(rowp + 32 + n * 16 + 4 * fq) = w2;
  }
}
DI void plain64_store(const f32x4* a, bf16_t* rowp, int fq) {
#pragma unroll
  for (int n = 0; n < 4; ++n) {
    u32x2 w; w.x = cvt_pk(a[n][0], a[n][1]); w.y = cvt_pk(a[n][2], a[n][3]);
    *(u32x2*)(rowp + n * 16 + 4 * fq) = w;
  }
}
DI void vt64_store(const f32x4* a, bf16_t* vt_base  , int ld, int tperm, int fq) {
#pragma unroll
  for (int n = 0; n < 4; ++n)
#pragma unroll
    for (int j = 0; j < 4; ++j) vt_base[(size_t)(n * 16 + 4 * fq + j) * ld + tperm] = f2bf(a[n][j]);
}
#define GEMM_IDS() const int tid = thr(), lane = tid & 63, wid = __builtin_amdgcn_readfirstlane(tid >> 6); \
  const int wr = wid >> 1, wc = wid & 1, fr = lane & 15, fq = lane >> 4; const int r0 = tid >> 2, ck = (tid & 3) * 16; (void)lane; (void)wr; (void)wc; (void)fr; (void)fq

DI void phase_inproj0(const Params& p, LAS char* lds) {
  GEMM_IDS();
  for (int u = blockIdx.x; u < 128 * 9; u += gridDim.x) {
    const int mt = u / 9, nt = u % 9, m0 = mt * 256, n0 = nt * 256;
    const char* a0 = (const char*)(p.xb + (size_t)(m0 + r0) * 1024) + ck;
    const char* b0 = (const char*)(p.win0t + (size_t)(n0 + r0) * 1024) + ck;
    f32x4 acc[4][8]; zero_acc(acc);
    gemm_kloop(lds, a0, a0 + (size_t)128 * 2048, b0, b0 + (size_t)128 * 2048, 32, acc);
#pragma unroll
    for (int g2 = 0; g2 < 2; ++g2) {
      const int G = ((n0 + wc * 128) >> 6) + g2;
#pragma unroll
      for (int m = 0; m < 4; ++m) {
        const int row = m0 + wr * 64 + m * 16 + fr, b = row >> 12, t = row & 4095;
        const float2* cs = p.cs64 + t * 32;
        const f32x4* a = &acc[m][4 * g2];
        if (G < 8) rope64_store(a, cs, p.q0 + ((size_t)(b * 16 + G) * 4096 + t) * 64, fq);
        else if (G < 10) rope64_store(a, cs, p.ka + ((size_t)(b * 2 + (G - 8)) * 4096 + t) * 64, fq);
        else if (G < 12) vt64_store(a, p.vta + (size_t)(b * 2 + (G - 10)) * 64 * 4096, 4096, perm16(t), fq);
        else if (G < 20) rope64_store(a, cs, p.q0 + ((size_t)(b * 16 + 8 + (G - 12)) * 4096 + t) * 64, fq);
        else if (G < 22) plain64_store(a, p.kc0 + ((size_t)(b * 2 + (G - 20)) * 4096 + t) * 64, fq);
        else if (G < 24) plain64_store(a, p.vc0 + ((size_t)(b * 2 + (G - 22)) * 4096 + t) * 64, fq);
        else if (G < 26) rope64_store(a, cs, p.ks + ((size_t)(b * 2 + (G - 24)) * 4096 + t) * 64, fq);
        else if (G < 28) vt64_store(a, p.vts + (size_t)(b * 2 + (G - 26)) * 64 * 4096, 4096, perm16(t), fq);
        else if (G < 30) rope64_store(a, cs, p.kw + ((size_t)(b * 2 + (G - 28)) * 4096 + t) * 64, fq);
        else if (G < 32) vt64_store(a, p.vtw + (size_t)(b * 2 + (G - 30)) * 64 * 4096, 4096, perm16(t), fq);
        else if (G == 32) {
#pragma unroll
          for (int n = 0; n < 2; ++n)
#pragma unroll
            for (int j = 0; j < 4; ++j) { const int cc = n * 16 + 4 * fq + j; if (cc < 24) p.gates[(size_t)row * 24 + cc] = sigmoidf_(a[n][j]); }
        }
        asm volatile("" ::: "memory");
      }
    }
  }
}

DI void phase_outproj(const Params& p, LAS char* lds, int layer) {
  GEMM_IDS();
  const bf16_t* A = layer == 0 ? p.obuf : p.xb;
  const bf16_t* Bt = layer == 0 ? p.wout0t : p.wout1t;
  const float* resid = layer == 0 ? p.in[0] : p.out;
  for (int u = blockIdx.x; u < 128 * 4; u += gridDim.x) {
    const int mt = u >> 2, nt = u & 3, m0 = mt * 256, n0 = nt * 256;
    const char* a0 = (const char*)(A + (size_t)(m0 + r0) * 1024) + ck;
    const char* b0 = (const char*)(Bt + (size_t)(n0 + r0) * 1024) + ck;
    f32x4 acc[4][8]; zero_acc(acc);
    gemm_kloop(lds, a0, a0 + (size_t)128 * 2048, b0, b0 + (size_t)128 * 2048, 32, acc);
#pragma unroll
    for (int m = 0; m < 4; ++m) {
      const size_t row = m0 + wr * 64 + m * 16 + fr;
#pragma unroll
      for (int n = 0; n < 8; ++n) {
        const size_t o = row * 1024 + n0 + wc * 128 + n * 16 + 4 * fq;
        const f32x4 r = *(const f32x4*)(resid + o);
        *(f32x4*)(p.out + o) = r * ALPHA + acc[m][n];
      }
      asm volatile("" ::: "memory");
    }
  }
}

DI float gelu_tanh_(float v) {
  const float u = 0.7978845608028654f * (v + 0.044715f * v * v * v);
  const float e = __expf(2.0f * u);
  const float th = 1.0f - 2.0f / (e + 1.0f);
  return 0.5f * v * (1.0f + th);
}

DI void cmp1_unit(const Params& p, LAS char* lds, int u) {
  GEMM_IDS();
  const int tensor = u >> 4, bg = u & 15;
  const bf16_t* src = (tensor == 0 ? p.kc0 : p.vc0) + (size_t)bg * 4096 * 64;
  const bf16_t* w1 = tensor == 0 ? p.cw1k : p.cw1v;
  const float* bias = tensor == 0 ? p.cb1k : p.cb1v;
  bf16_t* hout = (tensor == 0 ? p.h1k : p.h1v) + (size_t)bg * 256 * 128;
  const int r1 = r0 + 128;
  const char* a0 = (const char*)(src + (size_t)16 * (r0 < 254 ? r0 : 254) * 64) + ck;
  const char* a1 = (const char*)(src + (size_t)16 * (r1 < 254 ? r1 : 254) * 64) + ck;
  const char* b0 = (const char*)(w1 + (size_t)r0 * 2048) + ck;
  f32x4 acc[4][8]; zero_acc(acc);
  gemm_kloop(lds, a0, a1, b0, b0 + (size_t)128 * 4096, 64, acc);
  if (wc == 0) {
#pragma unroll
    for (int m = 0; m < 4; ++m) {
      const int row = wr * 64 + m * 16 + fr;
#pragma unroll
      for (int n = 0; n < 8; ++n) {
        const int cc = n * 16 + 4 * fq;
        const f32x4 bv = *(const f32x4*)(bias + cc);
        u32x2 w; w.x = cvt_pk(gelu_tanh_(acc[m][n][0] + bv[0]), gelu_tanh_(acc[m][n][1] + bv[1]));
        w.y = cvt_pk(gelu_tanh_(acc[m][n][2] + bv[2]), gelu_tanh_(acc[m][n][3] + bv[3]));
        *(u32x2*)(hout + (size_t)row * 128 + cc) = w;
      }
    }
  }
}
DI void phase_cmp2(const Params& p, LAS char* lds) {
  GEMM_IDS();
  for (int u = blockIdx.x; u < 32; u += gridDim.x) {
    const int tensor = u >> 4, bg = u & 15;
    const bf16_t* hin = (tensor == 0 ? p.h1k : p.h1v) + (size_t)bg * 256 * 128;
    const bf16_t* w2 = tensor == 0 ? p.cw2k : p.cw2v;
    const char* a0 = (const char*)(hin + (size_t)r0 * 128) + ck;
    const char* b0 = (const char*)(w2 + (size_t)r0 * 128) + ck;
    f32x4 acc[4][8]; zero_acc(acc);
    gemm_kloop(lds, a0, a0 + 128 * 256, b0, b0 + 128 * 256, 4, acc);
    if (wc == 0) {
#pragma unroll
      for (int m = 0; m < 4; ++m) {
        const int n_row = wr * 64 + m * 16 + fr;
        const bool valid = n_row < 255;
        if (!valid) {
#pragma unroll
          for (int n = 0; n < 4; ++n) acc[m][n] = (f32x4){0.f, 0.f, 0.f, 0.f};
        }
        if (tensor == 0) {
          const int pos = valid ? 16 * n_row + 31 : 0;
          rope64_store(&acc[m][0], p.cs64 + pos * 32, p.kcmp + ((size_t)bg * 256 + n_row) * 64, fq);
        } else {
          vt64_store(&acc[m][0], p.vcmpt + (size_t)bg * 64 * 256, 256, perm16(n_row), fq);
        }
      }
    }
  }
}

DI void load_q4(bf16x8 (&qf)[6], const bf16_t* qrow, int h) {
#pragma unroll
  for (int ks = 0; ks < 4; ++ks) qf[ks] = *(const bf16x8*)(qrow + (2 * ks + h) * 8);
}
DI void zero_o(f32x16 (&o)[2]) {
#pragma unroll
  for (int r = 0; r < 16; ++r) { o[0][r] = 0.f; o[1][r] = 0.f; }
}

DI void swa_unit(const Params& p, LAS char* lds, int u) {
  const int tid = thr(), lane = tid & 63, wid = __builtin_amdgcn_readfirstlane(tid >> 6);
  const int r32 = lane & 31, h = lane >> 5;
  const int b = u >> 7, g = (u >> 6) & 1, qb = u & 63, t0 = qb * 64;
  const int hd = g * 4 + (wid & 3), t = t0 + 32 * (wid >> 2) + r32;
  bf16x8 qf[6];
  load_q4(qf, p.q0 + ((size_t)(b * 16 + hd) * 4096 + t) * 64, h);
  f32x16 o[2]; zero_o(o);
  float m = NEGBIG, l = 0.f;
  const float c = 0.125f * LOG2E;
  const int tlo = (t0 - 127) < 0 ? 0 : ((t0 - 127) >> 6);
  const char* kb = (const char*)(p.ka + (size_t)(b * 2 + g) * 4096 * 64);
  const char* vb = (const char*)(p.vta + (size_t)(b * 2 + g) * 64 * 4096);
  kv_stream<false>(lds, kb, vb, 8192, nullptr, tlo, qb, [&](int tile, const LAS char* st) {
    f32x16 sA, sB;
    qk_tile<false>(st, nullptr, qf, r32, h, sA, sB);
    mask_scores(sA, sB, tile * 64, t - 128, t, h);
    softmax_step(sA, sB, c, m, l, o);
    pv_tile(st + 8192, sA, sB, r32, h, o);
  });
  float lt = l_total(l);
  lt += fast_exp2(p.in[2][hd] * LOG2E - m * c);
  const float inv = 1.0f / lt;
#pragma unroll
  for (int r = 0; r < 16; ++r) { o[0][r] *= inv; o[1][r] *= inv; }
  store_o((char*)(p.obuf + (size_t)(b * 4096 + t) * 1024 + hd * 64), o, h);
}

constexpr int NSA_CMPK = A_RING, NSA_CMPV = NSA_CMPK + 32768, NSA_IMP = NSA_CMPV + 32768, NSA_SELM = NSA_IMP + 64 * 65 * 4, NSA_LDS = NSA_SELM + 512;

DI void nsa_unit(const Params& p, LAS char* lds, int b, int g, int qb) {
  const int tid = thr(), lane = tid & 63, wid = __builtin_amdgcn_readfirstlane(tid >> 6);
  const int r32 = lane & 31, h = lane >> 5;
  const int t0 = qb * 64, qh = wid >> 2, hd = g * 4 + (wid & 3), ql = 32 * qh + r32, t = t0 + ql;
  const int bg = b * 2 + g;
  bf16x8 qf[6];
  load_q4(qf, p.q0 + ((size_t)(b * 16 + 8 + hd) * 4096 + t) * 64, h);
  const float* gp = p.gates + (size_t)(b * 4096 + t) * 24 + hd;
  const float g_cmp = gp[0], g_sel = gp[8], g_win = gp[16];
  const float c = 0.125f * LOG2E;
  f32x16 ot[2]; zero_o(ot);
  LAS int* imp = (LAS int*)(lds + NSA_IMP);
  LAS unsigned long long* selm = (LAS unsigned long long*)(lds + NSA_SELM);
  {
    const char* ksrc = (const char*)(p.kcmp + (size_t)bg * 256 * 64);
    const char* vsrc = (const char*)(p.vcmpt + (size_t)bg * 64 * 256);
    asm volatile("s_waitcnt vmcnt(0)" ::: "memory");
#pragma unroll
    for (int i = 0; i < 4; ++i) {
      const int pc = tid + 512 * i, row = pc >> 3, cs = ((pc & 7) ^ ((row >> 1) & 7)) << 4;
      glds16(ksrc + (size_t)row * 128 + cs, lds + NSA_CMPK + pc * 16);
      const int d = tid >> 3, cv = ((tid & 7) ^ ((d >> 1) & 7)) << 4;
      glds16(vsrc + (size_t)d * 512 + i * 128 + cv, lds + NSA_CMPV + i * 8192 + tid * 16);
    }
    for (int i = tid; i < 64 * 65; i += NTHR) imp[i] = 0;
    WAIT_VM_BAR(0);
  }
  {
    const int hi_c = (t - 31) >> 4;
    const int nmax = (t0 + 63 - 31) >> 4;
    const int ntile = (nmax >> 6) + 1;
    float m = NEGBIG, l = 0.f;
    for (int j = 0; j < ntile; ++j) {
      f32x16 sA, sB;
      qk_tile<false>(lds + NSA_CMPK + j * 8192, nullptr, qf, r32, h, sA, sB);
      mask_scores(sA, sB, j * 64, -1000000, hi_c, h);
      const float mnew = fmaxf(m, row_max32(sA, sB));
      const float mc = (mnew < -1e29f) ? 0.f : mnew * c;
      float sum = 0.f;
#pragma unroll
      for (int r = 0; r < 16; ++r) sum += fast_exp2(__builtin_fmaf(sA[r], c, -mc)) + fast_exp2(__builtin_fmaf(sB[r], c, -mc));
      l = l * fast_exp2(m * c - mc) + sum;
      m = mnew;
    }
    const float lt = l_total(l);
    const float inv = lt > 0.f ? 1.0f / lt : 0.f;
    const float mc = (m < -1e29f) ? 0.f : m * c;
    f32x16 oc[2]; zero_o(oc);
    for (int j = 0; j < ntile; ++j) {
      f32x16 sA, sB;
      qk_tile<false>(lds + NSA_CMPK + j * 8192, nullptr, qf, r32, h, sA, sB);
      mask_scores(sA, sB, j * 64, -1000000, hi_c, h);
#pragma unroll
      for (int r = 0; r < 16; ++r) { sA[r] = fast_exp2(__builtin_fmaf(sA[r], c, -mc)) * inv; sB[r] = fast_exp2(__builtin_fmaf(sB[r], c, -mc)) * inv; }
#pragma unroll
      for (int q4 = 0; q4 < 4; ++q4) {
        const int mb = 16 * j + 2 * q4 + h;
        const float a0 = sA[4 * q4] + sA[4 * q4 + 1] + sA[4 * q4 + 2] + 0.5f * sA[4 * q4 + 3];
        const float a1 = sB[4 * q4] + sB[4 * q4 + 1] + sB[4 * q4 + 2] + 0.5f * sB[4 * q4 + 3];
        const float FX = 16777216.0f;
        atomicAdd((int*)(imp + ql * 65 + mb), __float2int_rn(a0 * FX));
        atomicAdd((int*)(imp + ql * 65 + mb + 1), __float2int_rn(0.5f * sA[4 * q4 + 3] * FX));
        atomicAdd((int*)(imp + ql * 65 + mb + 8), __float2int_rn(a1 * FX));
        if (mb + 9 < 64) atomicAdd((int*)(imp + ql * 65 + mb + 9), __float2int_rn(0.5f * sB[4 * q4 + 3] * FX));
      }
      pv_tile(lds + NSA_CMPV + j * 8192, sA, sB, r32, h, oc);
    }
#pragma unroll
    for (int r = 0; r < 16; ++r) { ot[0][r] = g_cmp * oc[0][r]; ot[1][r] = g_cmp * oc[1][r]; }
  }
  LDS_BAR();
  for (int i = 0; i < 8; ++i) {
    const int q = wid * 8 + i, tq = t0 + q;
    const int iv = imp[q * 65 + lane];
    const bool forced = (lane == 0) || (lane == qb) || (lane == qb - 1);
    const bool future = lane * 64 > tq;
    const int score = forced ? 0x7fffffff : (future ? -1 : iv);
    int rank = 0;
#pragma unroll
    for (int j = 0; j < 64; ++j) { const int sj = __builtin_amdgcn_readlane(score, j); rank += (sj > score || (sj == score && j < lane)) ? 1 : 0; }
    const unsigned long long bal = __ballot(rank < 16);
    if (lane == 0) selm[q] = bal;
  }
  LDS_BAR();
  const unsigned long long mysel = selm[ql];
  {
    f32x16 o[2]; zero_o(o);
    float m = NEGBIG, l = 0.f;
    const char* kb = (const char*)(p.ks + (size_t)bg * 4096 * 64);
    const char* vb = (const char*)(p.vts + (size_t)bg * 64 * 4096);
    kv_stream<false>(lds, kb, vb, 8192, nullptr, 0, qb, [&](int tile, const LAS char* st) {
      f32x16 sA, sB;
      qk_tile<false>(st, nullptr, qf, r32, h, sA, sB);
      const int hi = ((mysel >> tile) & 1ull) ? t : -1;
      mask_scores(sA, sB, tile * 64, -1000000, hi, h);
      softmax_step(sA, sB, c, m, l, o);
      pv_tile(st + 8192, sA, sB, r32, h, o);
    });
    const float lt = l_total(l);
    const float sc = lt > 0.f ? g_sel / lt : 0.f;
#pragma unroll
    for (int r = 0; r < 16; ++r) { ot[0][r] += sc * o[0][r]; ot[1][r] += sc * o[1][r]; }
  }
  {
    f32x16 o[2]; zero_o(o);
    float m = NEGBIG, l = 0.f;
    const char* kb = (const char*)(p.kw + (size_t)bg * 4096 * 64);
    const char* vb = (const char*)(p.vtw + (size_t)bg * 64 * 4096);
    const int tlo = (t0 - 511) < 0 ? 0 : ((t0 - 511) >> 6);
    kv_stream<false>(lds, kb, vb, 8192, nullptr, tlo, qb, [&](int tile, const LAS char* st) {
      f32x16 sA, sB;
      qk_tile<false>(st, nullptr, qf, r32, h, sA, sB);
      mask_scores(sA, sB, tile * 64, t - 512, t, h);
      softmax_step(sA, sB, c, m, l, o);
      pv_tile(st + 8192, sA, sB, r32, h, o);
    });
    const float lt = l_total(l);
    const float sc = lt > 0.f ? g_win / lt : 0.f;
#pragma unroll
    for (int r = 0; r < 16; ++r) { ot[0][r] += sc * o[0][r]; ot[1][r] += sc * o[1][r]; }
  }
  store_o((char*)(p.obuf + (size_t)(b * 4096 + t) * 1024 + 512 + hd * 64), ot, h);
}

DI void phase_swa_cmp1(const Params& p, LAS char* lds) {
  for (int u = blockIdx.x; u < 32 + 1024; u += gridDim.x) {
    if (u < 32) cmp1_unit(p, lds, u); else swa_unit(p, lds, u - 32);
  }
}
DI void phase_nsa(const Params& p, LAS char* lds) {
  const int G = gridDim.x;
  for (int j = 0;; ++j) {
    const int pos = (j & 1) ? j * G + (G - 1 - (int)blockIdx.x) : j * G + (int)blockIdx.x;
    if (j * G >= 1024) break;
    if (pos < 1024) nsa_unit(p, lds, (pos & 15) >> 1, pos & 1, 63 - (pos >> 4));
  }
}

DI void mla_unit(const Params& p, LAS char* lds, int b, int hd, int qb4) {
  const int tid = thr(), lane = tid & 63, wid = __builtin_amdgcn_readfirstlane(tid >> 6);
  const int r32 = lane & 31, h = lane >> 5;
  const int tw0 = qb4 * 256 + 32 * wid, t = tw0 + r32;
  const bf16_t* qrow = p.q1 + ((size_t)(b * 16 + hd) * 4096 + t) * 96;
  bf16x8 qf[6];
#pragma unroll
  for (int ks = 0; ks < 6; ++ks) qf[ks] = *(const bf16x8*)(qrow + (2 * ks + h) * 8);
  f32x16 o[2]; zero_o(o);
  float m = NEGBIG, l = 0.f;
  const float c = 0.10206207261596577f * LOG2E;
  const char* kb = (const char*)(p.kn + (size_t)(b * 16 + hd) * 4096 * 64);
  const char* vb = (const char*)(p.vt1 + (size_t)(b * 16 + hd) * 64 * 4096);
  const char* rb = (const char*)(p.krb + (size_t)b * 4096 * 32);
  kv_stream<true>(lds, kb, vb, 8192, rb, 0, qb4 * 4 + 3, [&](int tile, const LAS char* st) {
    if (tile * 64 <= tw0 + 31) {
      f32x16 sA, sB;
      qk_tile<true>(st, st + 16384, qf, r32, h, sA, sB);
      if (tile * 64 + 63 > tw0) mask_scores(sA, sB, tile * 64, -1000000, t, h);
      softmax_step(sA, sB, c, m, l, o);
      pv_tile(st + 8192, sA, sB, r32, h, o);
    }
  });
  const float inv = 1.0f / l_total(l);
#pragma unroll
  for (int r = 0; r < 16; ++r) { o[0][r] *= inv; o[1][r] *= inv; }
  store_o((char*)(p.xb + (size_t)(b * 4096 + t) * 1024 + hd * 64), o, h);
}
DI void phase_mla(const Params& p, LAS char* lds) {
  const int G = gridDim.x;
  for (int j = 0;; ++j) {
    const int pos = (j & 1) ? j * G + (G - 1 - (int)blockIdx.x) : j * G + (int)blockIdx.x;
    if (j * G >= 2048) break;
    if (pos < 2048) mla_unit(p, lds, (pos & 127) >> 4, pos & 15, 15 - (pos >> 7));
  }
}
DI void ln_row(const f32x4 (&v)[4], const float* gam, const float* bet, int lane, f32x4 (&y)[4]) {
  float s = 0.f;
#pragma unroll
  for (int j = 0; j < 4; ++j) s += (v[j][0] + v[j][1]) + (v[j][2] + v[j][3]);
  const float mu = wave_sum(s) * (1.0f / 1024.0f);
  float q = 0.f;
  f32x4 d[4];
#pragma unroll
  for (int j = 0; j < 4; ++j) { d[j] = v[j] - mu; q += (d[j][0] * d[j][0] + d[j][1] * d[j][1]) + (d[j][2] * d[j][2] + d[j][3] * d[j][3]); }
  const float rs = rsqrtf(wave_sum(q) * (1.0f / 1024.0f) + 1e-5f);
#pragma unroll
  for (int j = 0; j < 4; ++j) {
    const f32x4 gv = *(const f32x4*)(gam + 4 * lane + 256 * j), bv = *(const f32x4*)(bet + 4 * lane + 256 * j);
    y[j] = d[j] * rs * gv + bv;
  }
}
DI void phase_lnsplit(const Params& p, int layer) {
  const int lane = thr() & 63, gw = blockIdx.x * 8 + (thr() >> 6), nw = gridDim.x * 8;
  const float* gam = p.in[16] + layer * 1024;
  const float* bet = p.in[17] + layer * 1024;
  for (int row = gw; row < NTOK; row += nw) {
    float* xr = p.out + (size_t)row * 1024;
    f32x4 v[4], y[4];
#pragma unroll
    for (int j = 0; j < 4; ++j) v[j] = *(const f32x4*)(xr + 4 * lane + 256 * j);
    ln_row(v, gam, bet, lane, y);
#pragma unroll
    for (int j = 0; j < 4; ++j) {
      *(f32x4*)(xr + 4 * lane + 256 * j) = y[j];
      u32x2 hi; hi.x = cvt_pk(y[j][0], y[j][1]); hi.y = cvt_pk(y[j][2], y[j][3]);
      const float r0 = y[j][0] - __uint_as_float(hi.x << 16), r1 = y[j][1] - __uint_as_float(hi.x & 0xffff0000u);
      const float r2 = y[j][2] - __uint_as_float(hi.y << 16), r3 = y[j][3] - __uint_as_float(hi.y & 0xffff0000u);
      u32x2 lo; lo.x = cvt_pk(r0, r1); lo.y = cvt_pk(r2, r3);
      *(u32x2*)(p.xb + (size_t)row * 1024 + 4 * lane + 256 * j) = hi;
      *(u32x2*)(p.x1lo + (size_t)row * 1024 + 4 * lane + 256 * j) = lo;
    }
  }
}

constexpr int LIST_CAP = 32768;
DI void phase_router(const Params& p, LAS char* lds, int layer) {
  GEMM_IDS();
  LAS float* lg = (LAS float*)lds;
  LAS int* hist = (LAS int*)(lds + 256 * 65 * 4);
  LAS int* se = hist + 128;
  LAS float* sw = (LAS float*)(se + 256 * 6);
  const int half_tokens = NTOK / p.nsplit, cap = LIST_CAP / p.nsplit;
  const float* bias = p.in[21] + layer * 64;
  for (int u = blockIdx.x; u < 128; u += gridDim.x) {
    const int m0 = u * 256;
    const size_t aro = (size_t)(m0 + r0) * 2048 + ck, bro = (size_t)r0 * 2048 + ck, h128 = (size_t)128 * 2048;
    f32x4 acc[4][8]; zero_acc(acc);
    gemm_kloop(lds, (const char*)p.xb + aro, (const char*)p.xb + aro + h128, (const char*)p.rwh[layer] + bro, (const char*)p.rwh[layer] + bro + h128, 32, acc);
    gemm_kloop(lds, (const char*)p.x1lo + aro, (const char*)p.x1lo + aro + h128, (const char*)p.rwh[layer] + bro, (const char*)p.rwh[layer] + bro + h128, 32, acc);
    gemm_kloop(lds, (const char*)p.xb + aro, (const char*)p.xb + aro + h128, (const char*)p.rwl[layer] + bro, (const char*)p.rwl[layer] + bro + h128, 32, acc);
    if (wc == 0) {
#pragma unroll
      for (int m = 0; m < 4; ++m)
#pragma unroll
        for (int n = 0; n < 4; ++n)
#pragma unroll
          for (int j = 0; j < 4; ++j) lg[(wr * 64 + m * 16 + fr) * 65 + n * 16 + 4 * fq + j] = acc[m][n][j];
    }
    if (tid < 64) hist[tid] = 0;
    LDS_BAR();
    const float be = bias[lane];
    for (int i = 0; i < 32; ++i) {
      const int r = wid * 32 + i;
      const float s = sigmoidf_(lg[r * 65 + lane]);
      const float sb = s + be;
      int r8 = 0;
      const int gb = lane & ~7;
#pragma unroll
      for (int j = 0; j < 8; ++j) { const float o = __shfl(sb, gb + j); r8 += (o > sb || (o == sb && (gb + j) < lane)) ? 1 : 0; }
      float gs = r8 < 2 ? sb : 0.f;
      gs += __shfl_xor(gs, 1); gs += __shfl_xor(gs, 2); gs += __shfl_xor(gs, 4);
      const int grp = lane >> 3;
      int gr = 0;
#pragma unroll
      for (int j = 0; j < 8; ++j) { const float o = __shfl(gs, j * 8); gr += (o > gs || (o == gs && j < grp)) ? 1 : 0; }
      const bool allowed = gr < 4;
      const float val = allowed ? sb : -INFINITY;
      int rank = 0;
#pragma unroll 8
      for (int j = 0; j < 64; ++j) { const float o = __shfl(val, j); rank += (o > val || (o == val && j < lane)) ? 1 : 0; }
      const bool sel = allowed && rank < 6;
      const float sum = wave_sum(sel ? s : 0.f);
      if (sel) {
        const int lp = atomicAdd((int*)(hist + lane), 1);
        se[r * 6 + rank] = lane | (lp << 8);
        sw[r * 6 + rank] = s / sum * 2.5f;
      }
    }
    LDS_BAR();
    const int half = m0 / half_tokens;
    if (tid < 64) hist[64 + tid] = atomicAdd(p.cnt + (layer * 2 + half) * 64 + tid, hist[tid]);
    LDS_BAR();
    for (int i = tid; i < 256 * 6; i += NTHR) {
      const int v = se[i], e = v & 255, lp = v >> 8, r = i / 6, slot = i - r * 6;
      const int tok = m0 + r;
      p.lists[((size_t)half * 64 + e) * cap + hist[64 + e] + lp] = make_int2(tok * 8 + slot, __float_as_int(sw[i]));
    }
    LDS_BAR();
  }
}

DI void expert_map(const Params& p, LAS int* tb, int layer, int half) {
  if (thr() < 64) {
    const int c = p.cnt[(layer * 2 + half) * 64 + thr()];
    int t = (c + 255) >> 8, incl = t;
#pragma unroll
    for (int o = 1; o < 64; o <<= 1) { const int v = __shfl_up(incl, o); if ((int)thr() >= o) incl += v; }
    tb[thr()] = incl - t;
    if (thr() == 63) tb[64] = incl;
    tb[65 + thr()] = c;
  }
  LDS_BAR();
}
DI int find_expert(const LAS int* tb, int mt) {
  int e = 0;
#pragma unroll 8
  for (int i = 1; i < 64; ++i) e = (tb[i] <= mt) ? i : e;
  return e;
}
DI void phase_exp1(const Params& p, LAS char* lds, int layer, int half) {
  GEMM_IDS();
  LAS int* tb = (LAS int*)(lds + MISC_OFF);
  expert_map(p, tb, layer, half);
  const int half_tokens = NTOK / p.nsplit, cap = LIST_CAP / p.nsplit;
  const int TR = tb[64], TS = half_tokens / 256;
  for (int u = blockIdx.x; u < (TR + TS) * 2; u += gridDim.x) {
    const int mt = u >> 1, nt = u & 1;
    const bf16_t* W;
    int tok0, tok1;
    if (mt < TR) {
      const int e = find_expert(tb, mt), cnt = tb[65 + e];
      const int2* lst = p.lists + ((size_t)half * 64 + e) * cap;
      const int i0 = (mt - tb[e]) * 256 + r0, i1 = i0 + 128;
      tok0 = lst[i0 < cnt ? i0 : 0].x >> 3;
      tok1 = lst[i1 < cnt ? i1 : 0].x >> 3;
      W = p.egu + (size_t)e * 524288;
    } else {
      tok0 = half * half_tokens + (mt - TR) * 256 + r0; tok1 = tok0 + 128;
      W = p.shgu[layer];
    }
    const char* a0 = (const char*)(p.xb + (size_t)tok0 * 1024) + ck;
    const char* a1 = (const char*)(p.xb + (size_t)tok1 * 1024) + ck;
    const char* b0 = (const char*)(W + (size_t)(nt * 256 + r0) * 1024) + ck;
    f32x4 acc[4][8]; zero_acc(acc);
    gemm_kloop(lds, a0, a1, b0, b0 + (size_t)128 * 2048, 32, acc);
    {
#pragma unroll
      for (int m = 0; m < 4; ++m) {
        LAS char* hr = lds + (wr * 64 + m * 16 + fr) * 272 + (wc * 64 + 4 * fq) * 2;
#pragma unroll
        for (int g2 = 0; g2 < 2; ++g2)
#pragma unroll
          for (int n = 0; n < 2; ++n) {
            float hv[4];
#pragma unroll
            for (int j = 0; j < 4; ++j) { const float gt = acc[m][4 * g2 + n][j]; hv[j] = gt / (1.0f + __expf(-gt)) * acc[m][4 * g2 + n + 2][j]; }
            u32x2 w; w.x = cvt_pk(hv[0], hv[1]); w.y = cvt_pk(hv[2], hv[3]);
            *(LAS u32x2*)(hr + g2 * 64 + n * 32) = w;
          }
      }
      LDS_BAR();
#pragma unroll 2
      for (int i = 0; i < 8; ++i) {
        const int c = tid + 512 * i, row = c >> 4, ch = c & 15;
        *(u32x4*)((char*)(p.hbuf + (size_t)(mt * 256 + row) * 256 + nt * 128) + ch * 16) = *(const LAS u32x4*)(lds + row * 272 + ch * 16);
      }
      LDS_BAR();
    }
  }
}
DI void phase_exp2(const Params& p, LAS char* lds, int layer, int half) {
  GEMM_IDS();
  LAS int* tb = (LAS int*)(lds + MISC_OFF);
  expert_map(p, tb, layer, half);
  const int half_tokens = NTOK / p.nsplit, cap = LIST_CAP / p.nsplit;
  const int TR = tb[64], TS = half_tokens / 256;
  for (int u = blockIdx.x; u < (TR + TS) * 4; u += gridDim.x) {
    const int mt = u >> 2, nt = u & 3;
    int e = 0, cnt = 0, ib = 0;
    const bf16_t* W;
    if (mt < TR) { e = find_expert(tb, mt); cnt = tb[65 + e]; ib = (mt - tb[e]) * 256; W = p.ed + (size_t)e * 262144; }
    else W = p.shd[layer];
    const char* a0 = (const char*)(p.hbuf + (size_t)(mt * 256 + r0) * 256) + ck;
    const char* b0 = (const char*)(W + (size_t)(nt * 256 + r0) * 256) + ck;
    f32x4 acc[4][8]; zero_acc(acc);
    gemm_kloop(lds, a0, a0 + 128 * 512, b0, b0 + 128 * 512, 8, acc);
    if (mt < TR) {
      const int2* lst = p.lists + ((size_t)half * 64 + e) * cap;
      LAS int* ri = (LAS int*)(lds + MISC_OFF + 1024);
      if (tid < 256) { const int idx = ib + tid; int2 en = make_int2(-1, 0); if (idx < cnt) en = lst[idx]; ri[2 * tid] = en.x; ri[2 * tid + 1] = en.y; }
      LDS_BAR();
#pragma unroll
      for (int m = 0; m < 4; ++m) {
        const int r = wr * 64 + m * 16 + fr;
        const float w = __int_as_float(ri[2 * r + 1]);
        LAS char* cr = lds + r * 528 + (wc * 128 + 4 * fq) * 2;
#pragma unroll
        for (int n = 0; n < 8; ++n) { u32x2 v; v.x = cvt_pk(acc[m][n][0] * w, acc[m][n][1] * w); v.y = cvt_pk(acc[m][n][2] * w, acc[m][n][3] * w); *(LAS u32x2*)(cr + n * 32) = v; }
      asm volatile("" ::: "memory");
      }
      LDS_BAR();
#pragma unroll 2
      for (int i = 0; i < 16; ++i) {
        const int c = tid + 512 * i, row = c >> 5, ch = c & 31;
        const int ex = ri[2 * row];
        if (ex >= 0) {
          const int tok = ex >> 3, slot = ex & 7;
          *(u32x4*)((char*)(p.slab + ((size_t)(tok - half * half_tokens) * 6 + slot) * 1024 + nt * 256) + ch * 16) = *(const LAS u32x4*)(lds + row * 528 + ch * 16);
        }
      }
      LDS_BAR();
    } else {
#pragma unroll
      for (int m = 0; m < 4; ++m) {
        const size_t tok = (size_t)half * half_tokens + (mt - TR) * 256 + wr * 64 + m * 16 + fr;
        float* orow = p.out + tok * 1024 + nt * 256 + wc * 128 + 4 * fq;
#pragma unroll
        for (int n = 0; n < 8; ++n) { const f32x4 r = *(const f32x4*)(orow + n * 16); *(f32x4*)(orow + n * 16) = r * ALPHA + acc[m][n]; if (n & 1) asm volatile("" ::: "memory"); }
      asm volatile("" ::: "memory");
      }
    }
  }
}
DI void phase_combine(const Params& p, int layer, int half) {
  const int lane = thr() & 63, gw = blockIdx.x * 8 + (thr() >> 6), nw = gridDim.x * 8;
  const int half_tokens = NTOK / p.nsplit;
  const float* gam = p.in[18] + layer * 1024;
  const float* bet = p.in[19] + layer * 1024;
  for (int r = gw; r < half_tokens; r += nw) {
    const size_t row = (size_t)half * half_tokens + r;
    float* xr = p.out + row * 1024;
    f32x4 v[4], y[4];
#pragma unroll
    for (int j = 0; j < 4; ++j) v[j] = *(const f32x4*)(xr + 4 * lane + 256 * j);
#pragma unroll
    for (int s = 0; s < 6; ++s) {
      const bf16_t* sr = p.slab + ((size_t)r * 6 + s) * 1024;
#pragma unroll
      for (int j = 0; j < 4; ++j) {
        const u32x2 w = *(const u32x2*)(sr + 4 * lane + 256 * j);
        v[j][0] += __uint_as_float(w.x << 16); v[j][1] += __uint_as_float(w.x & 0xffff0000u);
        v[j][2] += __uint_as_float(w.y << 16); v[j][3] += __uint_as_float(w.y & 0xffff0000u);
      }
    }
    ln_row(v, gam, bet, lane, y);
#pragma unroll
    for (int j = 0; j < 4; ++j) {
      *(f32x4*)(xr + 4 * lane + 256 * j) = y[j];
      if (layer == 0) { u32x2 hi; hi.x = cvt_pk(y[j][0], y[j][1]); hi.y = cvt_pk(y[j][2], y[j][3]); *(u32x2*)(p.xb + row * 1024 + 4 * lane + 256 * j) = hi; }
    }
  }
}

DI void phase_inproj1(const Params& p, LAS char* lds) {
  GEMM_IDS();
  for (int u = blockIdx.x; u < 128 * 3; u += gridDim.x) {
    const int mt = u / 3, nt = u % 3, m0 = mt * 256, n0 = nt * 256;
    const char* a0 = (const char*)(p.xb + (size_t)(m0 + r0) * 1024) + ck;
    const char* b0 = (const char*)(p.win1t + (size_t)(n0 + r0) * 1024) + ck;
    f32x4 acc[4][8]; zero_acc(acc);
    gemm_kloop(lds, a0, a0 + (size_t)128 * 2048, b0, b0 + (size_t)128 * 2048, 32, acc);
#pragma unroll
    for (int m = 0; m < 4; ++m) {
      float* crow_ = p.cbuf + (size_t)(m0 + wr * 64 + m * 16 + fr) * 768 + n0 + wc * 128 + 4 * fq;
#pragma unroll
      for (int n = 0; n < 8; ++n) *(f32x4*)(crow_ + n * 16) = acc[m][n];
      asm volatile("" ::: "memory");
    }
  }
  int it = 0;
  expert_weights(p, (LAS float*)lds, 1, it);
}
DI void phase_mlanorm(const Params& p) {
  const int lane = thr() & 63, gw = blockIdx.x * 8 + (thr() >> 6), nw = gridDim.x * 8;
  for (int row = gw; row < NTOK; row += nw) {
    const float* cr = p.cbuf + (size_t)row * 768;
    float q[6], kv[4];
    float ss = 0.f;
#pragma unroll
    for (int j = 0; j < 6; ++j) { q[j] = cr[lane + 64 * j]; ss += q[j] * q[j]; }
    const float rq = rsqrtf(wave_sum(ss) * (1.0f / 384.0f) + 1e-6f);
#pragma unroll
    for (int j = 0; j < 6; ++j) p.cqb[(size_t)row * 384 + lane + 64 * j] = f2bf(q[j] * rq * p.in[11][lane + 64 * j]);
    ss = 0.f;
#pragma unroll
    for (int j = 0; j < 4; ++j) { kv[j] = cr[384 + lane + 64 * j]; ss += kv[j] * kv[j]; }
    const float rk = rsqrtf(wave_sum(ss) * (1.0f / 256.0f) + 1e-6f);
#pragma unroll
    for (int j = 0; j < 4; ++j) p.ckvb[(size_t)row * 256 + lane + 64 * j] = f2bf(kv[j] * rk * p.in[12][lane + 64 * j]);
    if (lane < 16) {
      const float x1 = cr[640 + lane], x2 = cr[656 + lane];
      const float2 cs = p.cs32[(row & 4095) * 16 + lane];
      p.krb[(size_t)row * 32 + lane] = f2bf(x1 * cs.x - x2 * cs.y);
      p.krb[(size_t)row * 32 + 16 + lane] = f2bf(x1 * cs.y + x2 * cs.x);
    }
  }
}
DI void phase_mlaup(const Params& p, LAS char* lds) {
  GEMM_IDS();
  for (int u = blockIdx.x; u < 128 * 6 + 128 * 8; u += gridDim.x) {
    if (u < 128 * 6) {
      const int mt = u / 6, nt = u % 6, m0 = mt * 256, n0 = nt * 256;
      const char* a0 = (const char*)(p.cqb + (size_t)(m0 + r0) * 384) + ck;
      const char* b0 = (const char*)(p.wuqt + (size_t)(n0 + r0) * 384) + ck;
      f32x4 acc[4][8]; zero_acc(acc);
      gemm_kloop(lds, a0, a0 + (size_t)128 * 768, b0, b0 + (size_t)128 * 768, 12, acc);
#pragma unroll
      for (int m = 0; m < 4; ++m) {
        const int row = m0 + wr * 64 + m * 16 + fr, b = row >> 12, t = row & 4095;
#pragma unroll
        for (int pr = 0; pr < 4; ++pr) {
          const int gi = ((n0 + wc * 128) >> 5) + pr, head = gi / 3, part = gi - head * 3;
          bf16_t* dst = p.q1 + ((size_t)(b * 16 + head) * 4096 + t) * 96 + part * 32 + 4 * fq;
          if (part < 2) {
#pragma unroll
            for (int n = 0; n < 2; ++n) { u32x2 w; w.x = cvt_pk(acc[m][2 * pr + n][0], acc[m][2 * pr + n][1]); w.y = cvt_pk(acc[m][2 * pr + n][2], acc[m][2 * pr + n][3]); *(u32x2*)(dst + n * 16) = w; }
          } else {
            const f32x4 c0 = *(const f32x4*)(p.cs32 + t * 16 + 4 * fq), c1 = *(const f32x4*)(p.cs32 + t * 16 + 4 * fq + 2);
            const float co[4] = {c0[0], c0[2], c1[0], c1[2]}, si[4] = {c0[1], c0[3], c1[1], c1[3]};
            float y1[4], y2[4];
#pragma unroll
            for (int j = 0; j < 4; ++j) { const float x1 = acc[m][2 * pr][j], x2 = acc[m][2 * pr + 1][j]; y1[j] = x1 * co[j] - x2 * si[j]; y2[j] = x1 * si[j] + x2 * co[j]; }
            u32x2 w1, w2; w1.x = cvt_pk(y1[0], y1[1]); w1.y = cvt_pk(y1[2], y1[3]); w2.x = cvt_pk(y2[0], y2[1]); w2.y = cvt_pk(y2[2], y2[3]);
            *(u32x2*)(dst) = w1; *(u32x2*)(dst + 16) = w2;
          }
        }
        asm volatile("" ::: "memory");
      }
    } else {
      const int uu = u - 128 * 6, mt = uu >> 3, nt = uu & 7, m0 = mt * 256, n0 = nt * 256;
      const char* a0 = (const char*)(p.ckvb + (size_t)(m0 + r0) * 256) + ck;
      const char* b0 = (const char*)(p.wukvt + (size_t)(n0 + r0) * 256) + ck;
      f32x4 acc[4][8]; zero_acc(acc);
      gemm_kloop(lds, a0, a0 + (size_t)128 * 512, b0, b0 + (size_t)128 * 512, 8, acc);
      const int head = nt * 2 + wc;
#pragma unroll
      for (int m = 0; m < 4; ++m) {
        const int row = m0 + wr * 64 + m * 16 + fr, b = row >> 12, t = row & 4095;
        plain64_store(&acc[m][0], p.kn + ((size_t)(b * 16 + head) * 4096 + t) * 64, fq);
        vt64_store(&acc[m][4], p.vt1 + (size_t)(b * 16 + head) * 64 * 4096, 4096, perm16(t), fq);
      asm volatile("" ::: "memory");
      }
    }
  }
}

constexpr int LDS_BYTES = NSA_LDS > (MISC_OFF + 4096) ? NSA_LDS : (MISC_OFF + 4096);
constexpr int LDS_TOTAL = LDS_BYTES + 64;
#ifndef ALLCG
#define ALLCG 0
#endif

DI void get_phase(int i, int nsplit, int& ph, int& layer, int& half) {
  const int moe_len = 2 + 3 * nsplit;
  layer = 0; half = 0;
  if (i < 6) { ph = i; return; }
  i -= 6;
  if (i >= moe_len) {
    i -= moe_len; layer = 1;
    if (i < 5) { ph = (i < 4) ? PH_INPROJ1 + i : PH_OUTPROJ; return; }
    i -= 5;
  }
  if (i < 2) { ph = PH_LNSPLIT + i; return; }
  i -= 2; half = i / 3; ph = PH_EXP1 + (i - half * 3);
}
DI int num_phases(int nsplit) { return 6 + 5 + 2 * (2 + 3 * nsplit); }

__global__ void __launch_bounds__(NTHR) fwd_kernel(Params p, int ph_lo, int ph_hi, int use_sync) {
  extern __shared__ __attribute__((aligned(16))) char smem_raw[];
  LAS char* lds = (LAS char*)smem_raw;
  volatile LAS unsigned* bst = (volatile LAS unsigned*)(lds + LDS_BYTES);
  cg::grid_group grid = cg::this_grid();
  XcdBarrier xb;
  if (use_sync) {
    if (threadIdx.x == 0) { bst[0] = 0u; bst[1] = 0u; bst[2] = 0u; bst[3] = 0u; }
    __syncthreads();
    xb = xcd_barrier_post(p.bar, bst);
  }
#ifdef PROBE
  unsigned long long* stamps = (unsigned long long*)(p.cnt + 256);
#endif
  for (int i = ph_lo; i < ph_hi; ++i) {
    int ph, layer, half;
    get_phase(i, p.nsplit, ph, layer, half);
#ifdef PROBE
    if (blockIdx.x == 0 && threadIdx.x == 0) __hip_atomic_store(stamps + i, __builtin_amdgcn_s_memrealtime(), __ATOMIC_RELAXED, __HIP_MEMORY_SCOPE_AGENT);
#endif
    switch (ph) {
      case PH_PREP: phase_prep(p, lds); break;
      case PH_INPROJ0: phase_inproj0(p, lds); break;
      case PH_SWA_CMP1: phase_swa_cmp1(p, lds); break;
      case PH_CMP2: phase_cmp2(p, lds); break;
      case PH_NSA: phase_nsa(p, lds); break;
      case PH_OUTPROJ: phase_outproj(p, lds, layer); break;
      case PH_LNSPLIT: phase_lnsplit(p, layer); break;
      case PH_ROUTER: phase_router(p, lds, layer); break;
      case PH_EXP1: phase_exp1(p, lds, layer, half); break;
      case PH_EXP2: phase_exp2(p, lds, layer, half); break;
      case PH_COMBINE: phase_combine(p, layer, half); break;
      case PH_INPROJ1: phase_inproj1(p, lds); break;
      case PH_MLANORM: phase_mlanorm(p); break;
      case PH_MLAUP: phase_mlaup(p, lds); break;
      case PH_MLAATT: phase_mla(p, lds); break;
      default: break;
    }
    if (use_sync && i + 1 < ph_hi) { if (i == ph_lo || ALLCG) grid.sync(); else xcd_barrier(xb); }
  }
#ifdef PROBE
  {
    if (blockIdx.x == 0 && threadIdx.x == 0) __hip_atomic_store(stamps + ph_hi, __builtin_amdgcn_s_memrealtime(), __ATOMIC_RELAXED, __HIP_MEMORY_SCOPE_AGENT);
    xcd_barrier(xb);
    unsigned long long td = 0, tr = 0;
    for (int i = ph_lo; i < ph_hi; ++i) {
      const unsigned long long d = __hip_atomic_load(stamps + i + 1, __ATOMIC_RELAXED, __HIP_MEMORY_SCOPE_AGENT) - __hip_atomic_load(stamps + i, __ATOMIC_RELAXED, __HIP_MEMORY_SCOPE_AGENT);
      if ((PROBE_DUR >> i) & 1ull) td += d;
      if ((PROBE_RVR >> i) & 1ull) tr += d;
    }
    const float eps = (float)tr * 0.01f / 3000.0f;
    if (PROBE_RVR != 0ull) {
      for (size_t i = ((size_t)blockIdx.x * NTHR + threadIdx.x) * 4; i < (size_t)NTOK * 1024; i += (size_t)gridDim.x * NTHR * 4) {
        f32x4 v = *(f32x4*)(p.out + i); v = v * (1.0f + eps); *(f32x4*)(p.out + i) = v;
      }
    }
    if (blockIdx.x == 0 && threadIdx.x == 0 && td != 0ull) {
      const unsigned long long t0 = __builtin_amdgcn_s_memrealtime();
      while (__builtin_amdgcn_s_memrealtime() - t0 < 9ull * td) __builtin_amdgcn_s_sleep(8);
    }
  }
#endif
}

extern "C" void kernel_launch(void* const* d_in, const int* in_sizes, int n_in, void* d_out, int out_size, void* d_ws, size_t ws_size, hipStream_t stream) {
  static int grid_blocks = 0;
  if (grid_blocks == 0) {
    int dev = 0, cus = 0, per_cu = 0;
    hipGetDevice(&dev);
    hipDeviceGetAttribute(&cus, hipDeviceAttributeMultiprocessorCount, dev);
    hipFuncSetAttribute((const void*)fwd_kernel, hipFuncAttributeMaxDynamicSharedMemorySize, LDS_TOTAL);
    hipOccupancyMaxActiveBlocksPerMultiprocessor(&per_cu, (const void*)fwd_kernel, NTHR, LDS_TOTAL);
    if (per_cu < 1) { fprintf(stderr, "kernel_launch: occupancy query says %d blocks per CU\n", per_cu); per_cu = 1; }
    grid_blocks = cus;
    (void)hipGetLastError();
  }
  Params p;
  memset(&p, 0, sizeof(p));
  for (int i = 0; i < 28; ++i) p.in[i] = (const float*)d_in[i];
  p.out = (float*)d_out;
  char* ws = (char*)d_ws;
  size_t off = 0;
  auto take = [&](size_t bytes) { char* r = ws + off; off += (bytes + 255) & ~(size_t)255; return r; };
  p.bar = (unsigned*)take(XCD_BAR_WORDS * 4);
  p.cnt = (int*)take(256 * 4 + 64 * 8);
  p.win0t = (bf16_t*)take((size_t)2304 * 1024 * 2); p.wout0t = (bf16_t*)take((size_t)1024 * 1024 * 2);
  p.cw1k = (bf16_t*)take(256 * 2048 * 2); p.cw1v = (bf16_t*)take(256 * 2048 * 2);
  p.cw2k = (bf16_t*)take(256 * 128 * 2); p.cw2v = (bf16_t*)take(256 * 128 * 2);
  p.win1t = (bf16_t*)take((size_t)768 * 1024 * 2); p.wuqt = (bf16_t*)take((size_t)1536 * 384 * 2);
  p.wukvt = (bf16_t*)take((size_t)2048 * 256 * 2); p.wout1t = (bf16_t*)take((size_t)1024 * 1024 * 2);
  for (int l = 0; l < 2; ++l) {
    p.rwh[l] = (bf16_t*)take(256 * 1024 * 2); p.rwl[l] = (bf16_t*)take(256 * 1024 * 2);
    p.shgu[l] = (bf16_t*)take(512 * 1024 * 2); p.shd[l] = (bf16_t*)take(1024 * 256 * 2);
  }
  p.cb1k = (float*)take(128 * 4); p.cb1v = (float*)take(128 * 4);
  p.cs64 = (float2*)take(4096 * 32 * 8); p.cs32 = (float2*)take(4096 * 16 * 8);
  p.egu = (bf16_t*)take((size_t)64 * 524288 * 2); p.ed = (bf16_t*)take((size_t)64 * 262144 * 2);
  p.xb = (bf16_t*)take((size_t)NTOK * 1024 * 2);
  const size_t act0 = off;
  p.q0 = (bf16_t*)take((size_t)NBATCH * 16 * 4096 * 64 * 2);
  const size_t kvb = (size_t)NBATCH * 2 * 4096 * 64 * 2;
  p.ka = (bf16_t*)take(kvb); p.ks = (bf16_t*)take(kvb); p.kw = (bf16_t*)take(kvb); p.kc0 = (bf16_t*)take(kvb); p.vc0 = (bf16_t*)take(kvb);
  p.vta = (bf16_t*)take(kvb); p.vts = (bf16_t*)take(kvb); p.vtw = (bf16_t*)take(kvb);
  p.h1k = (bf16_t*)take(4096 * 128 * 2); p.h1v = (bf16_t*)take(4096 * 128 * 2);
  p.kcmp = (bf16_t*)take(16 * 256 * 64 * 2); p.vcmpt = (bf16_t*)take(16 * 64 * 256 * 2);
  p.gates = (float*)take((size_t)NTOK * 24 * 4);
  p.obuf = (bf16_t*)take((size_t)NTOK * 1024 * 2);
  const size_t end_l0 = off;
  const size_t need1 = act0 + (size_t)NTOK * 1024 * 2 + (size_t)64 * LIST_CAP * 8 + ((size_t)NTOK * 7 + 64 * 256) * 512 + (size_t)NTOK * 6 * 2048 + 4096;
  p.nsplit = ws_size >= need1 ? 1 : 2;
  off = act0;
  p.x1lo = (bf16_t*)take((size_t)NTOK * 1024 * 2);
  p.lists = (int2*)take((size_t)64 * LIST_CAP * 8);
  p.hbuf = (bf16_t*)take(((size_t)(NTOK / p.nsplit) * 7 + 64 * 256) * 512);
  p.slab = (bf16_t*)take((size_t)(NTOK / p.nsplit) * 6 * 2048);
  const size_t end_moe = off;
  off = act0;
  p.cqb = (bf16_t*)take((size_t)NTOK * 384 * 2); p.ckvb = (bf16_t*)take((size_t)NTOK * 256 * 2); p.krb = (bf16_t*)take((size_t)NTOK * 32 * 2);
  p.q1 = (bf16_t*)take((size_t)NTOK * 16 * 96 * 2);
  p.kn = (bf16_t*)take((size_t)NTOK * 16 * 64 * 2);
  p.cbuf = (float*)p.kn;
  p.vt1 = (bf16_t*)take((size_t)NTOK * 16 * 64 * 2);
  const size_t end_l1 = off;
  size_t need = end_l0 > end_moe ? end_l0 : end_moe; if (end_l1 > need) need = end_l1;
  if (need > ws_size) { fprintf(stderr, "kernel_launch: workspace too small: need %zu, have %zu\n", need, ws_size); return; }
  const int n = 6 + 5 + 2 * (2 + 3 * p.nsplit);
  hipMemsetAsync(p.bar, 0, XCD_BAR_WORDS * 4, stream);
#ifdef MULTI_LAUNCH
  for (int i = 0; i < n; ++i) hipLaunchKernelGGL(fwd_kernel, dim3(grid_blocks), dim3(NTHR), LDS_TOTAL, stream, p, i, i + 1, 0);
#else
  int lo = 0, hi = n, us = 1;
  void* args[] = {&p, &lo, &hi, &us};
  hipError_t e = hipLaunchCooperativeKernel((const void*)fwd_kernel, dim3(grid_blocks), dim3(NTHR), args, LDS_TOTAL, stream);
  if (e != hipSuccess) fprintf(stderr, "cooperative launch failed: %s (grid %d)\n", hipGetErrorString(e), grid_blocks);
#endif
}
```

```cpp
#include <hip/hip_runtime.h>
#include <hip/hip_cooperative_groups.h>
#include <stdint.h>
#include <math.h>
#include <cstdio>
#include <cstring>
namespace cg = cooperative_groups;

#define LAS __attribute__((address_space(3)))
#define DI __device__ __forceinline__
typedef unsigned short bf16_t;
typedef short bf16x8 __attribute__((ext_vector_type(8)));
typedef float f32x4 __attribute__((ext_vector_type(4)));
typedef float f32x16 __attribute__((ext_vector_type(16)));
typedef unsigned u32x4 __attribute__((ext_vector_type(4)));
typedef unsigned u32x2 __attribute__((ext_vector_type(2)));

constexpr int NTOK = 32768, SEQ = 4096, NBATCH = 8, DM = 1024;
constexpr int NTHR = 512;
constexpr int PROBE_LDS_OFF = 163840 - 32;
constexpr float ALPHA = 1.4142135623730951f;
constexpr float LOG2E = 1.4426950408889634f;

typedef __bf16 bf16x2_t __attribute__((ext_vector_type(2)));
typedef float f32x2_t __attribute__((ext_vector_type(2)));
DI unsigned cvt_pk(float lo, float hi) { const f32x2_t f = {lo, hi}; return __builtin_bit_cast(unsigned, __builtin_convertvector(f, bf16x2_t)); }
DI bf16_t f2bf(float x) { return (bf16_t)(cvt_pk(x, 0.f) & 0xffffu); }
DI float bf2f(bf16_t b) { return __uint_as_float(((unsigned)b) << 16); }
DI float fast_exp2(float x) { return __builtin_amdgcn_exp2f(x); }
DI float sigmoidf_(float x) { return 1.0f / (1.0f + __expf(-x)); }
DI int crow(int r, int h) { return (r & 3) + 8 * (r >> 2) + 4 * h; }
DI int perm16(int t) { return (t & ~15) | (((t >> 2) & 1) << 3) | (((t >> 3) & 1) << 2) | (t & 3); }
DI void glds16(const void* g, LAS char* l) { __builtin_amdgcn_global_load_lds((const unsigned*)g, (LAS unsigned*)l, 16, 0, 0); }
#define WAIT_VM_BAR(N) asm volatile("s_waitcnt vmcnt(" #N ") lgkmcnt(0)\n\ts_barrier" ::: "memory")
#define LDS_BAR() asm volatile("s_waitcnt lgkmcnt(0)\n\ts_barrier" ::: "memory")
DI int thr() { int t = threadIdx.x; asm volatile("" : "+v"(t)); return t; }
DI int bid() { int b = blockIdx.x; asm volatile("" : "+s"(b)); return b; }
DI unsigned dpp_max_u32(unsigned k, const int ctrl) { return k; }
#define DPP_MAX_STEP(k, ctrl) do { const unsigned o_ = (unsigned)__builtin_amdgcn_update_dpp(0, (int)(k), (ctrl), 0xF, 0xF, true); (k) = (k) > o_ ? (k) : o_; } while (0)
DI unsigned wave_max_u32(unsigned k) {
  DPP_MAX_STEP(k, 0xB1);
  DPP_MAX_STEP(k, 0x4E);
  DPP_MAX_STEP(k, 0x141);
  DPP_MAX_STEP(k, 0x140);
  const unsigned m0 = (unsigned)__builtin_amdgcn_readlane((int)k, 0), m1 = (unsigned)__builtin_amdgcn_readlane((int)k, 16);
  const unsigned m2 = (unsigned)__builtin_amdgcn_readlane((int)k, 32), m3 = (unsigned)__builtin_amdgcn_readlane((int)k, 48);
  const unsigned a = m0 > m1 ? m0 : m1, b = m2 > m3 ? m2 : m3;
  return a > b ? a : b;
}
DI unsigned fkey(float x) { const unsigned u = __float_as_uint(x); return (u & 0x80000000u) ? ~u : (u | 0x80000000u); }
DI float wave_sum(float v) {
#pragma unroll
  for (int o = 32; o > 0; o >>= 1) v += __shfl_xor(v, o);
  return v;
}

#if defined(PROBE) && defined(PROBE_SUBID)
#define SUB_BEGIN(id) do { if ((id) == PROBE_SUBID && blockIdx.x == 0 && threadIdx.x == 0) { volatile LAS unsigned long long* q_ = (volatile LAS unsigned long long*)(lds + PROBE_LDS_OFF); q_[2] = __builtin_amdgcn_s_memrealtime(); } } while (0)
#define SUB_END(id) do { if ((id) == PROBE_SUBID && blockIdx.x == 0 && threadIdx.x == 0) { volatile LAS unsigned long long* q_ = (volatile LAS unsigned long long*)(lds + PROBE_LDS_OFF); q_[0] = q_[0] + (__builtin_amdgcn_s_memrealtime() - q_[2]); } } while (0)
#else
#define SUB_BEGIN(id) do { } while (0)
#define SUB_END(id) do { } while (0)
#endif
#define XB_TMO 0
#define XB_XCNT(j) (16 + 16 * (j))
#define XB_XSUB(j) (272 + 16 * (j))
#define XB_XGEN(j) (528 + 16 * (j))
#define XB_TOP 784
#define XB_TOPGEN 800
#define XCD_BAR_WORDS 1024
#define XB_SPIN_CAP (1u << 22)
typedef __attribute__((address_space(1))) unsigned gu32;
DI unsigned xb_ld(gu32* p) { return __hip_atomic_load(p, __ATOMIC_RELAXED, __HIP_MEMORY_SCOPE_AGENT); }
DI unsigned xb_add(gu32* p, unsigned v) { return __hip_atomic_fetch_add(p, v, __ATOMIC_RELAXED, __HIP_MEMORY_SCOPE_AGENT); }
DI unsigned xb_xcc_id() { return (unsigned)__builtin_amdgcn_s_getreg((3 << 11) | 20) & 0xFu; }
#define XB_SPIN(cond, bar) do { unsigned _sp = 0; while (cond) { __builtin_amdgcn_s_sleep(1); \
    if ((++_sp & 255u) == 0u) { if (xb_ld(&(bar)[XB_TMO])) break; if (_sp > XB_SPIN_CAP) { xb_add(&(bar)[XB_TMO], 1u); break; } } } } while (0)
struct XcdBarrier { gu32* bar; unsigned x; volatile LAS unsigned* st; };
DI XcdBarrier xcd_barrier_post(unsigned* bar_, volatile LAS unsigned* st) {
  gu32* bar = (gu32*)bar_;
  XcdBarrier b; b.bar = bar; b.x = xb_xcc_id(); b.st = st;
  if (threadIdx.x == 0) (void)xb_add(&bar[XB_XCNT(b.x)], 1u);
  return b;
}
DI void xcd_barrier_complete(gu32* bar, unsigned x, unsigned& nloc, unsigned& nx) {
  const unsigned G = gridDim.x;
  unsigned sum, cnt, mine, sp = 0u;
  for (;;) {
    sum = 0u; cnt = 0u; mine = 0u;
#pragma unroll
    for (unsigned j = 0; j < 16; ++j) { const unsigned c = xb_ld(&bar[XB_XCNT(j)]); sum += c; cnt += (c > 0u) ? 1u : 0u; mine = (j == x) ? c : mine; }
    if (sum == G) break;
    __builtin_amdgcn_s_sleep(1);
    if ((++sp & 255u) == 0u) { if (xb_ld(&bar[XB_TMO])) break; if (sp > XB_SPIN_CAP) { xb_add(&bar[XB_TMO], 1u); break; } }
  }
  nloc = mine > 0u ? mine : 1u; nx = cnt > 0u ? cnt : 1u;
}
DI void xcd_barrier(const XcdBarrier& b) {
  asm volatile("s_waitcnt vmcnt(0)" ::: "memory");
  __syncthreads();
  if (threadIdx.x == 0) {
    unsigned long long bar_i = (unsigned long long)b.bar;
    asm volatile("" : "+s"(bar_i));
    gu32* bar = (gu32*)bar_i;
    __builtin_amdgcn_s_waitcnt(0);
    unsigned nloc = b.st[0], nx = b.st[1];
    if (nloc == 0u) { xcd_barrier_complete(bar, b.x, nloc, nx); b.st[0] = nloc; b.st[1] = nx; }
    const unsigned old = xb_add(&bar[XB_XSUB(b.x)], 1u);
    const unsigned gen = old / nloc;
    if (old + 1u == (gen + 1u) * nloc) {
      __builtin_amdgcn_fence(__ATOMIC_RELEASE, "agent");
      asm volatile("s_waitcnt vmcnt(0)" ::: "memory");
      const unsigned og = xb_add(&bar[XB_TOP], 1u);
      const unsigned tg = og / nx;
      if (og + 1u == (tg + 1u) * nx) xb_add(&bar[XB_TOPGEN], 1u);
      else XB_SPIN(xb_ld(&bar[XB_TOPGEN]) == tg, bar);
      __builtin_amdgcn_fence(__ATOMIC_ACQUIRE, "agent");
      xb_add(&bar[XB_XGEN(b.x)], 1u);
      asm volatile("s_waitcnt vmcnt(0)" ::: "memory");
    } else {
      XB_SPIN(xb_ld(&bar[XB_XGEN(b.x)]) == gen, bar);
      __builtin_amdgcn_fence(__ATOMIC_ACQUIRE, "agent");
      asm volatile("s_waitcnt vmcnt(0)" ::: "memory");
    }
  }
  __syncthreads();
}

constexpr int G_STAGE = 32768;
constexpr int G_LDS = 4 * G_STAGE;
constexpr int MISC_OFF = 135168;

DI void gemm_kloop(LAS char* lds, const char* a0, const char* a1, const char* b0, const char* b1, int nk  , f32x4 (&acc)[4][8]) {
  const int tid = thr(), lane = tid & 63, wid = __builtin_amdgcn_readfirstlane(tid >> 6);
  const int wr = wid >> 1, wc = wid & 1, fr = lane & 15, fq = lane >> 4;
  LAS char* dA0 = lds + tid * 16;
  const int aoff = (wr * 64 + fr) * 64 + fq * 16;
  const int boff = 16384 + (wc * 128 + fr) * 64 + fq * 16;
#define G_ISSUE(slot, kt) do { LAS char* _d = dA0 + (slot) * G_STAGE; const size_t _ko = (size_t)(kt) * 64; \
    glds16(a0 + _ko, _d); glds16(a1 + _ko, _d + 8192); glds16(b0 + _ko, _d + 16384); glds16(b1 + _ko, _d + 24576); } while (0)
  G_ISSUE(0, 0);
  if (nk > 1) G_ISSUE(1, 1);
  if (nk > 2) G_ISSUE(2, 2);
  int slot = 0;
  for (int t = 0; t < nk; ++t) {
    if (t + 2 < nk) { WAIT_VM_BAR(8); } else if (t + 1 < nk) { WAIT_VM_BAR(4); } else { WAIT_VM_BAR(0); }
    if (t + 3 < nk) { G_ISSUE((slot + 3) & 3, t + 3); }
    const LAS char* base = lds + slot * G_STAGE;
    bf16x8 af[4];
#pragma unroll
    for (int m = 0; m < 4; ++m) af[m] = *(const LAS bf16x8*)(base + aoff + m * 1024);
#pragma unroll
    for (int nh = 0; nh < 2; ++nh) {
      bf16x8 bfr[4];
#pragma unroll
      for (int n = 0; n < 4; ++n) bfr[n] = *(const LAS bf16x8*)(base + boff + (4 * nh + n) * 1024);
#pragma unroll
      for (int m = 0; m < 4; ++m)
#pragma unroll
        for (int n = 0; n < 4; ++n) acc[m][4 * nh + n] = __builtin_amdgcn_mfma_f32_16x16x32_bf16(bfr[n], af[m], acc[m][4 * nh + n], 0, 0, 0);
    }
    slot = (slot + 1) & 3;
  }
#undef G_ISSUE
  LDS_BAR();
}
DI void zero_acc(f32x4 (&acc)[4][8]) {
#pragma unroll
  for (int m = 0; m < 4; ++m)
#pragma unroll
    for (int n = 0; n < 8; ++n) acc[m][n] = (f32x4){0.f, 0.f, 0.f, 0.f};
}
constexpr int A_STAGE = 20480, A_RING = 3 * A_STAGE;
constexpr float NEGBIG = -1e30f;
#define MFMA32(a, b, c) __builtin_amdgcn_mfma_f32_32x32x16_bf16((a), (b), (c), 0, 0, 0)

template <bool HAS_ROPE>
DI void qk_tile(const LAS char* kt, const LAS char* krt, const bf16x8* qf, int r32, int h, f32x16& sA, f32x16& sB) {
  const int sw = (r32 >> 1) & 7;
  const LAS char* ra = kt + r32 * 128;
  const LAS char* rb = ra + 32 * 128;
  f32x16 z;
#pragma unroll
  for (int i = 0; i < 16; ++i) z[i] = 0.f;
  sA = z; sB = z;
#pragma unroll
  for (int ks = 0; ks < 4; ++ks) {
    const int c = ((2 * ks + h) ^ sw) << 4;
    const bf16x8 ka = *(const LAS bf16x8*)(ra + c);
    const bf16x8 kb = *(const LAS bf16x8*)(rb + c);
    sA = MFMA32(ka, qf[ks], sA);
    sB = MFMA32(kb, qf[ks], sB);
  }
  if (HAS_ROPE) {
    const int sw2 = (r32 >> 2) & 3;
    const LAS char* pa = krt + r32 * 64;
    const LAS char* pb = pa + 32 * 64;
#pragma unroll
    for (int ks = 0; ks < 2; ++ks) {
      const int c = ((2 * ks + h) ^ sw2) << 4;
      const bf16x8 ka = *(const LAS bf16x8*)(pa + c);
      const bf16x8 kb = *(const LAS bf16x8*)(pb + c);
      sA = MFMA32(ka, qf[4 + ks], sA);
      sB = MFMA32(kb, qf[4 + ks], sB);
    }
  }
}

DI bf16x8 pack8(const f32x16& p, int s) {
  u32x4 w;
  w.x = cvt_pk(p[8 * s + 0], p[8 * s + 1]); w.y = cvt_pk(p[8 * s + 2], p[8 * s + 3]);
  w.z = cvt_pk(p[8 * s + 4], p[8 * s + 5]); w.w = cvt_pk(p[8 * s + 6], p[8 * s + 7]);
  return __builtin_bit_cast(bf16x8, w);
}

DI void pv_tile(const LAS char* vt, const f32x16& pA, const f32x16& pB, int r32, int h, f32x16 (&o)[2]) {
  const int sw = (r32 >> 1) & 7;
  const LAS char* r0 = vt + r32 * 128;
  const LAS char* r1 = r0 + 32 * 128;
#pragma unroll
  for (int kk = 0; kk < 4; ++kk) {
    const bf16x8 pt = (kk < 2) ? pack8(pA, kk & 1) : pack8(pB, kk & 1);
    const int c = ((2 * kk + h) ^ sw) << 4;
    const bf16x8 v0 = *(const LAS bf16x8*)(r0 + c);
    const bf16x8 v1 = *(const LAS bf16x8*)(r1 + c);
    o[0] = MFMA32(v0, pt, o[0]);
    o[1] = MFMA32(v1, pt, o[1]);
  }
}

DI void mask_scores(f32x16& sA, f32x16& sB, int key0, int lo, int hi, int h) {
#pragma unroll
  for (int r = 0; r < 16; ++r) {
    const int ka = key0 + crow(r, h), kb = ka + 32;
    sA[r] = (ka > lo && ka <= hi) ? sA[r] : NEGBIG;
    sB[r] = (kb > lo && kb <= hi) ? sB[r] : NEGBIG;
  }
}
DI float row_max32(const f32x16& sA, const f32x16& sB) {
  float mx = fmaxf(sA[0], sB[0]);
#pragma unroll
  for (int r = 1; r < 16; ++r) mx = fmaxf(mx, fmaxf(sA[r], sB[r]));
  return fmaxf(mx, __shfl_xor(mx, 32));
}
DI void softmax_step(f32x16& sA, f32x16& sB, float c, float& m, float& l, f32x16 (&o)[2]) {
  const float mx = row_max32(sA, sB);
  const float mnew = fmaxf(m, mx);
  const float mc = (mnew < -1e29f) ? 0.f : mnew * c;
  const float alpha = fast_exp2(m * c - mc);
  m = mnew;
  float sum = 0.f;
#pragma unroll
  for (int r = 0; r < 16; ++r) {
    sA[r] = fast_exp2(__builtin_fmaf(sA[r], c, -mc));
    sB[r] = fast_exp2(__builtin_fmaf(sB[r], c, -mc));
    sum += sA[r] + sB[r];
  }
  l = l * alpha + sum;
  if (!__all(alpha == 1.0f)) {
#pragma unroll
    for (int r = 0; r < 16; ++r) { o[0][r] *= alpha; o[1][r] *= alpha; }
  }
}

template <bool HAS_ROPE, class F>
DI void kv_stream(LAS char* ring, const char* kb, const char* vb, size_t vstride, const char* krb, int tile_lo, int tile_hi, F&& per_tile) {
  const int tid = thr();
  const int row = tid >> 3, cs = ((tid & 7) ^ ((row >> 1) & 7)) << 4;
  const char* ksrc = kb + (size_t)row * 128 + cs;
  const char* vsrc = vb + (size_t)row * vstride + cs;
  const int t2 = tid & 255, row2 = t2 >> 2;
  const char* rsrc = krb + (size_t)row2 * 64 + (((t2 & 3) ^ ((row2 >> 2) & 3)) << 4);
  LAS char* dst = ring + tid * 16;
  LAS char* dst2 = ring + 16384 + t2 * 16;
#define A_ISSUE(slot, tl) do { glds16(ksrc + (size_t)(tl) * 8192, dst + (slot) * A_STAGE); glds16(vsrc + (size_t)(tl) * 128, dst + (slot) * A_STAGE + 8192); \
    if (HAS_ROPE) glds16(rsrc + (size_t)(tl) * 4096, dst2 + (slot) * A_STAGE); } while (0)
  if (tile_lo <= tile_hi) A_ISSUE(0, tile_lo);
  if (tile_lo + 1 <= tile_hi) A_ISSUE(1, tile_lo + 1);
  int slot = 0;
  for (int t = tile_lo; t <= tile_hi; ++t) {
    if (t + 1 <= tile_hi) { if (HAS_ROPE) { WAIT_VM_BAR(3); } else { WAIT_VM_BAR(2); } } else { WAIT_VM_BAR(0); }
    if (t + 2 <= tile_hi) { int s2 = slot + 2; if (s2 >= 3) s2 -= 3; A_ISSUE(s2, t + 2); }
    per_tile(t, (const LAS char*)(ring + slot * A_STAGE));
    slot = (slot == 2) ? 0 : slot + 1;
  }
#undef A_ISSUE
  LDS_BAR();
}

DI float l_total(float l) { return l + __shfl_xor(l, 32); }

DI void store_o(char* rowp, const f32x16 (&o)[2], int h) {
#pragma unroll
  for (int dd = 0; dd < 2; ++dd)
#pragma unroll
    for (int g = 0; g < 4; ++g) {
      u32x2 w; w.x = cvt_pk(o[dd][4 * g + 0], o[dd][4 * g + 1]); w.y = cvt_pk(o[dd][4 * g + 2], o[dd][4 * g + 3]);
      *(u32x2*)(rowp + (32 * dd + 8 * g + 4 * h) * 2) = w;
    }
}
struct Params {
  const float* in[28];
  float* out;
  unsigned* bar;
  int* cnt;
  bf16_t *win0t, *wout0t, *cw1k, *cw1v, *cw2k, *cw2v, *win1t, *wuqt, *wukvt, *wout1t;
  bf16_t *rwh[2], *rwl[2], *shgu[2], *shd[2];
  bf16_t *egu, *ed;
  float *cb1k, *cb1v;
  float2 *cs64, *cs32;
  bf16_t *xb;
  bf16_t *q0, *ka, *ks, *kw, *kc0, *vc0, *vta, *vts, *vtw, *h1k, *h1v, *kcmp, *vcmpt, *obuf;
  float* gates;
  bf16_t *x1lo, *hbuf, *slab;
  int2* lists;
  float* cbuf;
  bf16_t *cqb, *ckvb, *krb, *q1, *kn, *vt1;
  int nsplit;
  int pad_;
};
enum { PH_PREP = 0, PH_INPROJ0, PH_SWA_CMP1, PH_CMP2, PH_NSA, PH_OUTPROJ, PH_LNSPLIT, PH_ROUTER, PH_EXP1, PH_EXP2, PH_COMBINE, PH_INPROJ1, PH_MLANORM, PH_MLAUP, PH_MLAATT };

DI void xpose_item(LAS float* tile, const float* src, int N, int k0, int n0, bf16_t* dst, int ldd, int mode, bf16_t* dst_lo) {
  const int tid = thr();
  {
    const int n = tid & 63, kk = tid >> 6;
    const bool ok = (n0 + n) < N;
#pragma unroll
    for (int i = 0; i < 8; ++i) { const int k = kk + 8 * i; tile[k * 65 + n] = ok ? src[(size_t)(k0 + k) * N + n0 + n] : 0.f; }
  }
  __syncthreads();
  {
    const int n = tid >> 3, kc = (tid & 7) * 8, gn = n0 + n;
    if (gn < N) {
      float v[8];
#pragma unroll
      for (int j = 0; j < 8; ++j) v[j] = tile[(kc + j) * 65 + n];
      int row = gn;
      if (mode == 1) row = 64 * (gn >> 5) + (gn & 31);
      if (mode == 2) row = 64 * (gn >> 5) + 32 + (gn & 31);
      u32x4 w; w.x = cvt_pk(v[0], v[1]); w.y = cvt_pk(v[2], v[3]); w.z = cvt_pk(v[4], v[5]); w.w = cvt_pk(v[6], v[7]);
      *(u32x4*)(dst + (size_t)row * ldd + k0 + kc) = w;
      if (dst_lo) {
        float r[8];
#pragma unroll
        for (int j = 0; j < 8; ++j) { const unsigned pk = (j & 1) ? (w[j >> 1] >> 16) : (w[j >> 1] & 0xffffu); r[j] = v[j] - __uint_as_float(pk << 16); }
        u32x4 w2; w2.x = cvt_pk(r[0], r[1]); w2.y = cvt_pk(r[2], r[3]); w2.z = cvt_pk(r[4], r[5]); w2.w = cvt_pk(r[6], r[7]);
        *(u32x4*)(dst_lo + (size_t)row * ldd + k0 + kc) = w2;
      }
    }
  }
  __syncthreads();
}
DI void xpose_item256(LAS float* tile, const float* src, int N, int k0, int n0, bf16_t* dst, int ldd, int mode) {
  const int tid = thr();
  {
    const int n4 = (tid & 63) * 4, kk = tid >> 6;
    f32x4 v[8];
#pragma unroll
    for (int i = 0; i < 8; ++i) v[i] = *(const f32x4*)(src + (size_t)(k0 + kk + 8 * i) * N + n0 + n4);
#pragma unroll
    for (int i = 0; i < 8; ++i) {
      LAS float* tp = tile + (kk + 8 * i) * 257 + n4;
      tp[0] = v[i][0]; tp[1] = v[i][1]; tp[2] = v[i][2]; tp[3] = v[i][3];
    }
  }
  __syncthreads();
#pragma unroll
  for (int j = 0; j < 4; ++j) {
    const int c = tid + 512 * j, n = c >> 3, kc = (c & 7) * 8, gn = n0 + n;
    float v[8];
#pragma unroll
    for (int e = 0; e < 8; ++e) v[e] = tile[(kc + e) * 257 + n];
    int row = gn;
    if (mode == 1) row = 64 * (gn >> 5) + (gn & 31);
    if (mode == 2) row = 64 * (gn >> 5) + 32 + (gn & 31);
    u32x4 w; w.x = cvt_pk(v[0], v[1]); w.y = cvt_pk(v[2], v[3]); w.z = cvt_pk(v[4], v[5]); w.w = cvt_pk(v[6], v[7]);
    *(u32x4*)(dst + (size_t)row * ldd + k0 + kc) = w;
  }
  __syncthreads();
}
DI void xpose_matrix(LAS float* tile, const float* src, int K, int N, bf16_t* dst, int mode, bf16_t* dst_lo, int& itbase) {
  const bool wide = (N % 256 == 0) && dst_lo == nullptr;
  const int nkt = K / 64, nnt = wide ? N / 256 : (N + 63) / 64, total = nkt * nnt;
  int first = (int)((bid() + gridDim.x - (itbase % gridDim.x)) % gridDim.x);
  for (int i = first; i < total; i += gridDim.x) {
    if (wide) xpose_item256(tile, src, N, (i % nkt) * 64, (i / nkt) * 256, dst, K, mode);
    else xpose_item(tile, src, N, (i % nkt) * 64, (i / nkt) * 64, dst, K, mode, dst_lo);
  }
  itbase += total;
}
DI void zero_rows(bf16_t* dst, size_t nelem) {
  u32x4 z = (u32x4){0u, 0u, 0u, 0u};
  for (size_t i = ((size_t)bid() * NTHR + thr()) * 8; i < nelem; i += (size_t)gridDim.x * NTHR * 8) *(u32x4*)(dst + i) = z;
}
DI void expert_weights(const Params& p, LAS float* tile, int layer, int& it) {
  const size_t eo = (size_t)layer * 64 * 262144;
  for (int e = 0; e < 64; ++e) {
    xpose_matrix(tile, p.in[22] + eo + (size_t)e * 262144, 1024, 256, p.egu + (size_t)e * 524288, 1, nullptr, it);
    xpose_matrix(tile, p.in[23] + eo + (size_t)e * 262144, 1024, 256, p.egu + (size_t)e * 524288, 2, nullptr, it);
    xpose_matrix(tile, p.in[24] + eo + (size_t)e * 262144, 256, 1024, p.ed + (size_t)e * 262144, 0, nullptr, it);
  }
}
DI void phase_prep(const Params& p, LAS char* lds) {
  LAS float* tile = (LAS float*)lds;
  const int tid = thr();
  for (size_t i = ((size_t)bid() * NTHR + tid) * 8; i < (size_t)NTOK * DM; i += (size_t)gridDim.x * NTHR * 8) {
    const f32x4 a = *(const f32x4*)(p.in[0] + i), b = *(const f32x4*)(p.in[0] + i + 4);
    u32x4 w; w.x = cvt_pk(a[0], a[1]); w.y = cvt_pk(a[2], a[3]); w.z = cvt_pk(b[0], b[1]); w.w = cvt_pk(b[2], b[3]);
    *(u32x4*)(p.xb + i) = w;
  }
  zero_rows(p.win0t + (size_t)2072 * 1024, (size_t)232 * 1024);
  zero_rows(p.cw2k + 64 * 128, 192 * 128);
  zero_rows(p.cw2v + 64 * 128, 192 * 128);
  zero_rows(p.cw1k + (size_t)128 * 2048, (size_t)128 * 2048);
  zero_rows(p.cw1v + (size_t)128 * 2048, (size_t)128 * 2048);
  zero_rows(p.win1t + (size_t)672 * 1024, (size_t)96 * 1024);
  for (int l = 0; l < 2; ++l) { zero_rows(p.rwh[l] + 64 * 1024, 192 * 1024); zero_rows(p.rwl[l] + 64 * 1024, 192 * 1024); }
  if (bid() == 0 && tid < 256) p.cnt[tid] = 0;
  for (int i = bid() * NTHR + tid; i < 4096 * 32; i += gridDim.x * NTHR) {
    const int t = i >> 5, f = i & 31;
    const float ang = (float)t * powf(10000.0f, -2.0f * (float)f / 64.0f);
    p.cs64[i] = make_float2(cosf(ang), sinf(ang));
  }
  for (int i = bid() * NTHR + tid; i < 4096 * 16; i += gridDim.x * NTHR) {
    const int t = i >> 4, f = i & 15;
    const float ang = (float)t * powf(10000.0f, -2.0f * (float)f / 32.0f);
    p.cs32[i] = make_float2(cosf(ang), sinf(ang));
  }
  if (bid() == 1 || bid() == 2) {
    const float* pe = bid() == 1 ? p.in[3] : p.in[6];
    const float* w1 = bid() == 1 ? p.in[4] : p.in[7];
    float* dst = bid() == 1 ? p.cb1k : p.cb1v;
    const int j = tid & 127, part = tid >> 7;
    float s = 0.f;
    for (int k = part * 512; k < part * 512 + 512; ++k) s = fmaf(pe[k], w1[(size_t)k * 128 + j], s);
    tile[tid] = s;
    __syncthreads();
    if (tid < 128) dst[tid] = tile[tid] + tile[tid + 128] + tile[tid + 256] + tile[tid + 384];
    __syncthreads();
  }
  int it = 0;
  xpose_matrix(tile, p.in[1], 1024, 2072, p.win0t, 0, nullptr, it);
  xpose_matrix(tile, p.in[9], 1024, 1024, p.wout0t, 0, nullptr, it);
  xpose_matrix(tile, p.in[4], 2048, 128, p.cw1k, 0, nullptr, it);
  xpose_matrix(tile, p.in[7], 2048, 128, p.cw1v, 0, nullptr, it);
  xpose_matrix(tile, p.in[5], 128, 64, p.cw2k, 0, nullptr, it);
  xpose_matrix(tile, p.in[8], 128, 64, p.cw2v, 0, nullptr, it);
  xpose_matrix(tile, p.in[10], 1024, 672, p.win1t, 0, nullptr, it);
  xpose_matrix(tile, p.in[13], 384, 1536, p.wuqt, 0, nullptr, it);
  xpose_matrix(tile, p.in[14], 256, 2048, p.wukvt, 0, nullptr, it);
  xpose_matrix(tile, p.in[15], 1024, 1024, p.wout1t, 0, nullptr, it);
  for (int l = 0; l < 2; ++l) {
    xpose_matrix(tile, p.in[20] + (size_t)l * 65536, 1024, 64, p.rwh[l], 0, p.rwl[l], it);
    xpose_matrix(tile, p.in[25] + (size_t)l * 262144, 1024, 256, p.shgu[l], 1, nullptr, it);
    xpose_matrix(tile, p.in[26] + (size_t)l * 262144, 1024, 256, p.shgu[l], 2, nullptr, it);
    xpose_matrix(tile, p.in[27] + (size_t)l * 262144, 256, 1024, p.shd[l], 0, nullptr, it);
  }
  expert_weights(p, tile, 0, it);
}

DI void rope64_store(const f32x4* a, const float2* cs, bf16_t* rowp, int fq) {
#pragma unroll
  for (int n = 0; n < 2; ++n) {
    const f32x4 c0 = *(const f32x4*)(cs + n * 16 + 4 * fq), c1 = *(const f32x4*)(cs + n * 16 + 4 * fq + 2);
    const float co[4] = {c0[0], c0[2], c1[0], c1[2]}, si[4] = {c0[1], c0[3], c1[1], c1[3]};
    float y1[4], y2[4];
#pragma unroll
    for (int j = 0; j < 4; ++j) { const float x1 = a[n][j], x2 = a[n + 2][j]; y1[j] = x1 * co[j] - x2 * si[j]; y2[j] = x1 * si[j] + x2 * co[j]; }
    u32x2 w1, w2; w1.x = cvt_pk(y1[0], y1[1]); w1.y = cvt_pk(y1[2], y1[3]); w2.x = cvt_pk(y2[0], y2[1]); w2.y = cvt_pk(y2[2], y2[3]);
    *(u32x2*)(rowp + n * 16 + 4 * fq) = w1;
    *(u32x2*)(rowp + 32 + n * 16 + 4 * fq) = w2;
  }
}
DI void plain64_store(const f32x4* a, bf16_t* rowp, int fq) {
#pragma unroll
  for (int n = 0; n < 4; ++n) {
    u32x2 w; w.x = cvt_pk(a[n][0], a[n][1]); w.y = cvt_pk(a[n][2], a[n][3]);
    *(u32x2*)(rowp + n * 16 + 4 * fq) = w;
  }
}
DI void vt64_store(const f32x4* a, bf16_t* vt_base  , int ld, int tperm, int fq) {
#pragma unroll
  for (int n = 0; n < 4; ++n)
#pragma unroll
    for (int j = 0; j < 4; ++j) vt_base[(size_t)(n * 16 + 4 * fq + j) * ld + tperm] = f2bf(a[n][j]);
}
#define GEMM_IDS() const int tid = thr(), lane = tid & 63, wid = __builtin_amdgcn_readfirstlane(tid >> 6); \
  const int wr = wid >> 1, wc = wid & 1, fr = lane & 15, fq = lane >> 4; const int r0 = tid >> 2, ck = (tid & 3) * 16; (void)lane; (void)wr; (void)wc; (void)fr; (void)fq

DI void phase_inproj0(const Params& p, LAS char* lds) {
  GEMM_IDS();
  for (int u = bid(); u < 128 * 9; u += gridDim.x) {
    const int mt = u / 9, nt = u % 9, m0 = mt * 256, n0 = nt * 256;
    const char* a0 = (const char*)(p.xb + (size_t)(m0 + r0) * 1024) + ck;
    const char* b0 = (const char*)(p.win0t + (size_t)(n0 + r0) * 1024) + ck;
    f32x4 acc[4][8]; zero_acc(acc);
    gemm_kloop(lds, a0, a0 + (size_t)128 * 2048, b0, b0 + (size_t)128 * 2048, 32, acc);
#pragma unroll
    for (int g2 = 0; g2 < 2; ++g2) {
      const int G = ((n0 + wc * 128) >> 6) + g2;
#pragma unroll
      for (int m = 0; m < 4; ++m) {
        const int row = m0 + wr * 64 + m * 16 + fr, b = row >> 12, t = row & 4095;
        const float2* cs = p.cs64 + t * 32;
        const f32x4* a = &acc[m][4 * g2];
        if (G < 8) rope64_store(a, cs, p.q0 + ((size_t)(b * 16 + G) * 4096 + t) * 64, fq);
        else if (G < 10) rope64_store(a, cs, p.ka + ((size_t)(b * 2 + (G - 8)) * 4096 + t) * 64, fq);
        else if (G < 12) vt64_store(a, p.vta + (size_t)(b * 2 + (G - 10)) * 64 * 4096, 4096, perm16(t), fq);
        else if (G < 20) rope64_store(a, cs, p.q0 + ((size_t)(b * 16 + 8 + (G - 12)) * 4096 + t) * 64, fq);
        else if (G < 22) plain64_store(a, p.kc0 + ((size_t)(b * 2 + (G - 20)) * 4096 + t) * 64, fq);
        else if (G < 24) plain64_store(a, p.vc0 + ((size_t)(b * 2 + (G - 22)) * 4096 + t) * 64, fq);
        else if (G < 26) rope64_store(a, cs, p.ks + ((size_t)(b * 2 + (G - 24)) * 4096 + t) * 64, fq);
        else if (G < 28) vt64_store(a, p.vts + (size_t)(b * 2 + (G - 26)) * 64 * 4096, 4096, perm16(t), fq);
        else if (G < 30) rope64_store(a, cs, p.kw + ((size_t)(b * 2 + (G - 28)) * 4096 + t) * 64, fq);
        else if (G < 32) vt64_store(a, p.vtw + (size_t)(b * 2 + (G - 30)) * 64 * 4096, 4096, perm16(t), fq);
        else if (G == 32) {
#pragma unroll
          for (int n = 0; n < 2; ++n)
#pragma unroll
            for (int j = 0; j < 4; ++j) { const int cc = n * 16 + 4 * fq + j; if (cc < 24) p.gates[(size_t)row * 24 + cc] = sigmoidf_(a[n][j]); }
        }
        asm volatile("" ::: "memory");
      }
    }
  }
}

DI void phase_outproj(const Params& p, LAS char* lds, int layer) {
  GEMM_IDS();
  const bf16_t* A = layer == 0 ? p.obuf : p.xb;
  const bf16_t* Bt = layer == 0 ? p.wout0t : p.wout1t;
  const float* resid = layer == 0 ? p.in[0] : p.out;
  for (int u = bid(); u < 128 * 4; u += gridDim.x) {
    const int mt = u >> 2, nt = u & 3, m0 = mt * 256, n0 = nt * 256;
    const char* a0 = (const char*)(A + (size_t)(m0 + r0) * 1024) + ck;
    const char* b0 = (const char*)(Bt + (size_t)(n0 + r0) * 1024) + ck;
    f32x4 acc[4][8]; zero_acc(acc);
    gemm_kloop(lds, a0, a0 + (size_t)128 * 2048, b0, b0 + (size_t)128 * 2048, 32, acc);
#pragma unroll
    for (int m = 0; m < 4; ++m) {
      const size_t row = m0 + wr * 64 + m * 16 + fr;
#pragma unroll
      for (int n = 0; n < 8; ++n) {
        const size_t o = row * 1024 + n0 + wc * 128 + n * 16 + 4 * fq;
        const f32x4 r = *(const f32x4*)(resid + o);
        *(f32x4*)(p.out + o) = r * ALPHA + acc[m][n];
      }
      asm volatile("" ::: "memory");
    }
  }
}

DI float gelu_tanh_(float v) {
  const float u = 0.7978845608028654f * (v + 0.044715f * v * v * v);
  const float e = __expf(2.0f * u);
  const float th = 1.0f - 2.0f / (e + 1.0f);
  return 0.5f * v * (1.0f + th);
}

DI void cmp1_unit(const Params& p, LAS char* lds, int u) {
  GEMM_IDS();
  const int tensor = u >> 4, bg = u & 15;
  const bf16_t* src = (tensor == 0 ? p.kc0 : p.vc0) + (size_t)bg * 4096 * 64;
  const bf16_t* w1 = tensor == 0 ? p.cw1k : p.cw1v;
  const float* bias = tensor == 0 ? p.cb1k : p.cb1v;
  bf16_t* hout = (tensor == 0 ? p.h1k : p.h1v) + (size_t)bg * 256 * 128;
  const int r1 = r0 + 128;
  const char* a0 = (const char*)(src + (size_t)16 * (r0 < 254 ? r0 : 254) * 64) + ck;
  const char* a1 = (const char*)(src + (size_t)16 * (r1 < 254 ? r1 : 254) * 64) + ck;
  const char* b0 = (const char*)(w1 + (size_t)r0 * 2048) + ck;
  f32x4 acc[4][8]; zero_acc(acc);
  gemm_kloop(lds, a0, a1, b0, b0 + (size_t)128 * 4096, 64, acc);
  if (wc == 0) {
#pragma unroll
    for (int m = 0; m < 4; ++m) {
      const int row = wr * 64 + m * 16 + fr;
#pragma unroll
      for (int n = 0; n < 8; ++n) {
        const int cc = n * 16 + 4 * fq;
        const f32x4 bv = *(const f32x4*)(bias + cc);
        u32x2 w; w.x = cvt_pk(gelu_tanh_(acc[m][n][0] + bv[0]), gelu_tanh_(acc[m][n][1] + bv[1]));
        w.y = cvt_pk(gelu_tanh_(acc[m][n][2] + bv[2]), gelu_tanh_(acc[m][n][3] + bv[3]));
        *(u32x2*)(hout + (size_t)row * 128 + cc) = w;
      }
    }
  }
}
DI void phase_cmp2(const Params& p, LAS char* lds) {
  GEMM_IDS();
  for (int u = bid(); u < 32; u += gridDim.x) {
    const int tensor = u >> 4, bg = u & 15;
    const bf16_t* hin = (tensor == 0 ? p.h1k : p.h1v) + (size_t)bg * 256 * 128;
    const bf16_t* w2 = tensor == 0 ? p.cw2k : p.cw2v;
    const char* a0 = (const char*)(hin + (size_t)r0 * 128) + ck;
    const char* b0 = (const char*)(w2 + (size_t)r0 * 128) + ck;
    f32x4 acc[4][8]; zero_acc(acc);
    gemm_kloop(lds, a0, a0 + 128 * 256, b0, b0 + 128 * 256, 4, acc);
    if (wc == 0) {
#pragma unroll
      for (int m = 0; m < 4; ++m) {
        const int n_row = wr * 64 + m * 16 + fr;
        const bool valid = n_row < 255;
        if (!valid) {
#pragma unroll
          for (int n = 0; n < 4; ++n) acc[m][n] = (f32x4){0.f, 0.f, 0.f, 0.f};
        }
        if (tensor == 0) {
          const int pos = valid ? 16 * n_row + 31 : 0;
          rope64_store(&acc[m][0], p.cs64 + pos * 32, p.kcmp + ((size_t)bg * 256 + n_row) * 64, fq);
        } else {
          vt64_store(&acc[m][0], p.vcmpt + (size_t)bg * 64 * 256, 256, perm16(n_row), fq);
        }
      }
    }
  }
}

DI void load_q4(bf16x8 (&qf)[6], const bf16_t* qrow, int h) {
#pragma unroll
  for (int ks = 0; ks < 4; ++ks) qf[ks] = *(const bf16x8*)(qrow + (2 * ks + h) * 8);
}
DI void zero_o(f32x16 (&o)[2]) {
#pragma unroll
  for (int r = 0; r < 16; ++r) { o[0][r] = 0.f; o[1][r] = 0.f; }
}

DI void swa_unit(const Params& p, LAS char* lds, int u) {
  const int tid = thr(), lane = tid & 63, wid = __builtin_amdgcn_readfirstlane(tid >> 6);
  const int r32 = lane & 31, h = lane >> 5;
  const int b = u >> 7, g = (u >> 6) & 1, qb = u & 63, t0 = qb * 64;
  const int hd = g * 4 + (wid & 3), t = t0 + 32 * (wid >> 2) + r32;
  bf16x8 qf[6];
  load_q4(qf, p.q0 + ((size_t)(b * 16 + hd) * 4096 + t) * 64, h);
  f32x16 o[2]; zero_o(o);
  float m = NEGBIG, l = 0.f;
  const float c = 0.125f * LOG2E;
  const int tlo = (t0 - 127) < 0 ? 0 : ((t0 - 127) >> 6);
  const char* kb = (const char*)(p.ka + (size_t)(b * 2 + g) * 4096 * 64);
  const char* vb = (const char*)(p.vta + (size_t)(b * 2 + g) * 64 * 4096);
  kv_stream<false>(lds, kb, vb, 8192, nullptr, tlo, qb, [&](int tile, const LAS char* st) {
    f32x16 sA, sB;
    qk_tile<false>(st, nullptr, qf, r32, h, sA, sB);
    mask_scores(sA, sB, tile * 64, t - 128, t, h);
    softmax_step(sA, sB, c, m, l, o);
    pv_tile(st + 8192, sA, sB, r32, h, o);
  });
  float lt = l_total(l);
  lt += fast_exp2(p.in[2][hd] * LOG2E - m * c);
  const float inv = 1.0f / lt;
#pragma unroll
  for (int r = 0; r < 16; ++r) { o[0][r] *= inv; o[1][r] *= inv; }
  store_o((char*)(p.obuf + (size_t)(b * 4096 + t) * 1024 + hd * 64), o, h);
}

constexpr int NSA_CMPK = A_RING, NSA_CMPV = NSA_CMPK + 32768, NSA_IMP = NSA_CMPV + 32768, NSA_SELM = NSA_IMP + 64 * 65 * 4, NSA_LDS = NSA_SELM + 512;

DI void nsa_unit(const Params& p, LAS char* lds, int b, int g, int qb) {
  const int tid = thr(), lane = tid & 63, wid = __builtin_amdgcn_readfirstlane(tid >> 6);
  const int r32 = lane & 31, h = lane >> 5;
  const int t0 = qb * 64, qh = wid >> 2, hd = g * 4 + (wid & 3), ql = 32 * qh + r32, t = t0 + ql;
  const int bg = b * 2 + g;
  bf16x8 qf[6];
  load_q4(qf, p.q0 + ((size_t)(b * 16 + 8 + hd) * 4096 + t) * 64, h);
  const float* gp = p.gates + (size_t)(b * 4096 + t) * 24 + hd;
  const float g_cmp = gp[0], g_sel = gp[8], g_win = gp[16];
  const float c = 0.125f * LOG2E;
  f32x16 ot[2]; zero_o(ot);
  LAS int* imp = (LAS int*)(lds + NSA_IMP);
  LAS unsigned long long* selm = (LAS unsigned long long*)(lds + NSA_SELM);
  {
    const char* ksrc = (const char*)(p.kcmp + (size_t)bg * 256 * 64);
    const char* vsrc = (const char*)(p.vcmpt + (size_t)bg * 64 * 256);
    asm volatile("s_waitcnt vmcnt(0)" ::: "memory");
#pragma unroll
    for (int i = 0; i < 4; ++i) {
      const int pc = tid + 512 * i, row = pc >> 3, cs = ((pc & 7) ^ ((row >> 1) & 7)) << 4;
      glds16(ksrc + (size_t)row * 128 + cs, lds + NSA_CMPK + pc * 16);
      const int d = tid >> 3, cv = ((tid & 7) ^ ((d >> 1) & 7)) << 4;
      glds16(vsrc + (size_t)d * 512 + i * 128 + cv, lds + NSA_CMPV + i * 8192 + tid * 16);
    }
    for (int i = tid; i < 64 * 65; i += NTHR) imp[i] = 0;
    WAIT_VM_BAR(0);
  }
  {
    const int hi_c = (t - 31) >> 4;
    const int nmax = (t0 + 63 - 31) >> 4;
    const int ntile = (nmax >> 6) + 1;
    float m = NEGBIG, l = 0.f;
    for (int j = 0; j < ntile; ++j) {
      f32x16 sA, sB;
      qk_tile<false>(lds + NSA_CMPK + j * 8192, nullptr, qf, r32, h, sA, sB);
      mask_scores(sA, sB, j * 64, -1000000, hi_c, h);
      const float mnew = fmaxf(m, row_max32(sA, sB));
      const float mc = (mnew < -1e29f) ? 0.f : mnew * c;
      float sum = 0.f;
#pragma unroll
      for (int r = 0; r < 16; ++r) sum += fast_exp2(__builtin_fmaf(sA[r], c, -mc)) + fast_exp2(__builtin_fmaf(sB[r], c, -mc));
      l = l * fast_exp2(m * c - mc) + sum;
      m = mnew;
    }
    const float lt = l_total(l);
    const float inv = lt > 0.f ? 1.0f / lt : 0.f;
    const float mc = (m < -1e29f) ? 0.f : m * c;
    f32x16 oc[2]; zero_o(oc);
    for (int j = 0; j < ntile; ++j) {
      f32x16 sA, sB;
      qk_tile<false>(lds + NSA_CMPK + j * 8192, nullptr, qf, r32, h, sA, sB);
      mask_scores(sA, sB, j * 64, -1000000, hi_c, h);
#pragma unroll
      for (int r = 0; r < 16; ++r) { sA[r] = fast_exp2(__builtin_fmaf(sA[r], c, -mc)) * inv; sB[r] = fast_exp2(__builtin_fmaf(sB[r], c, -mc)) * inv; }
#pragma unroll
      for (int q4 = 0; q4 < 4; ++q4) {
        const int mb = 16 * j + 2 * q4 + h;
        const float a0 = sA[4 * q4] + sA[4 * q4 + 1] + sA[4 * q4 + 2] + 0.5f * sA[4 * q4 + 3];
        const float a1 = sB[4 * q4] + sB[4 * q4 + 1] + sB[4 * q4 + 2] + 0.5f * sB[4 * q4 + 3];
        const float FX = 16777216.0f;
        atomicAdd((int*)(imp + ql * 65 + mb), __float2int_rn(a0 * FX));
        atomicAdd((int*)(imp + ql * 65 + mb + 1), __float2int_rn(0.5f * sA[4 * q4 + 3] * FX));
        atomicAdd((int*)(imp + ql * 65 + mb + 8), __float2int_rn(a1 * FX));
        if (mb + 9 < 64) atomicAdd((int*)(imp + ql * 65 + mb + 9), __float2int_rn(0.5f * sB[4 * q4 + 3] * FX));
      }
      pv_tile(lds + NSA_CMPV + j * 8192, sA, sB, r32, h, oc);
    }
#pragma unroll
    for (int r = 0; r < 16; ++r) { ot[0][r] = g_cmp * oc[0][r]; ot[1][r] = g_cmp * oc[1][r]; }
  }
  LDS_BAR();
  for (int i = 0; i < 8; ++i) {
    const int q = wid * 8 + i, tq = t0 + q;
    const int iv = imp[q * 65 + lane];
    const bool forced = (lane == 0) || (lane == qb) || (lane == qb - 1);
    const bool future = lane * 64 > tq;
    unsigned key = forced ? 0x80000001u : (future ? 1u : (unsigned)iv + 2u);
    unsigned long long picked = 0ull;
#pragma unroll 4
    for (int k = 0; k < 16; ++k) {
      const unsigned mx = wave_max_u32(key);
      const int idx = __builtin_ctzll(__ballot(key == mx));
      picked |= 1ull << idx;
      key = (lane == idx) ? 0u : key;
    }
    if (lane == 0) selm[q] = picked;
  }
  LDS_BAR();
  const unsigned long long mysel = selm[ql];
  {
    f32x16 o[2]; zero_o(o);
    float m = NEGBIG, l = 0.f;
    const char* kb = (const char*)(p.ks + (size_t)bg * 4096 * 64);
    const char* vb = (const char*)(p.vts + (size_t)bg * 64 * 4096);
    kv_stream<false>(lds, kb, vb, 8192, nullptr, 0, qb, [&](int tile, const LAS char* st) {
      f32x16 sA, sB;
      qk_tile<false>(st, nullptr, qf, r32, h, sA, sB);
      const int hi = ((mysel >> tile) & 1ull) ? t : -1;
      mask_scores(sA, sB, tile * 64, -1000000, hi, h);
      softmax_step(sA, sB, c, m, l, o);
      pv_tile(st + 8192, sA, sB, r32, h, o);
    });
    const float lt = l_total(l);
    const float sc = lt > 0.f ? g_sel / lt : 0.f;
#pragma unroll
    for (int r = 0; r < 16; ++r) { ot[0][r] += sc * o[0][r]; ot[1][r] += sc * o[1][r]; }
  }
  {
    f32x16 o[2]; zero_o(o);
    float m = NEGBIG, l = 0.f;
    const char* kb = (const char*)(p.kw + (size_t)bg * 4096 * 64);
    const char* vb = (const char*)(p.vtw + (size_t)bg * 64 * 4096);
    const int tlo = (t0 - 511) < 0 ? 0 : ((t0 - 511) >> 6);
    kv_stream<false>(lds, kb, vb, 8192, nullptr, tlo, qb, [&](int tile, const LAS char* st) {
      f32x16 sA, sB;
      qk_tile<false>(st, nullptr, qf, r32, h, sA, sB);
      mask_scores(sA, sB, tile * 64, t - 512, t, h);
      softmax_step(sA, sB, c, m, l, o);
      pv_tile(st + 8192, sA, sB, r32, h, o);
    });
    const float lt = l_total(l);
    const float sc = lt > 0.f ? g_win / lt : 0.f;
#pragma unroll
    for (int r = 0; r < 16; ++r) { ot[0][r] += sc * o[0][r]; ot[1][r] += sc * o[1][r]; }
  }
  store_o((char*)(p.obuf + (size_t)(b * 4096 + t) * 1024 + 512 + hd * 64), ot, h);
}

DI void phase_swa_cmp1(const Params& p, LAS char* lds) {
  for (int u = bid(); u < 32 + 1024; u += gridDim.x) {
    if (u < 32) cmp1_unit(p, lds, u); else swa_unit(p, lds, u - 32);
  }
}
DI void phase_nsa(const Params& p, LAS char* lds) {
  const int G = gridDim.x;
  for (int j = 0;; ++j) {
    const int pos = (j & 1) ? j * G + (G - 1 - (int)bid()) : j * G + (int)bid();
    if (j * G >= 1024) break;
    if (pos < 1024) nsa_unit(p, lds, (pos & 15) >> 1, pos & 1, 63 - (pos >> 4));
  }
}

DI void mla_unit(const Params& p, LAS char* lds, int b, int hd, int qb4) {
  const int tid = thr(), lane = tid & 63, wid = __builtin_amdgcn_readfirstlane(tid >> 6);
  const int r32 = lane & 31, h = lane >> 5;
  const int tw0 = qb4 * 256 + 32 * wid, t = tw0 + r32;
  const bf16_t* qrow = p.q1 + ((size_t)(b * 16 + hd) * 4096 + t) * 96;
  bf16x8 qf[6];
#pragma unroll
  for (int ks = 0; ks < 6; ++ks) qf[ks] = *(const bf16x8*)(qrow + (2 * ks + h) * 8);
  f32x16 o[2]; zero_o(o);
  float m = NEGBIG, l = 0.f;
  const float c = 0.10206207261596577f * LOG2E;
  const char* kb = (const char*)(p.kn + (size_t)(b * 16 + hd) * 4096 * 64);
  const char* vb = (const char*)(p.vt1 + (size_t)(b * 16 + hd) * 64 * 4096);
  const char* rb = (const char*)(p.krb + (size_t)b * 4096 * 32);
  kv_stream<true>(lds, kb, vb, 8192, rb, 0, qb4 * 4 + 3, [&](int tile, const LAS char* st) {
    if (tile * 64 <= tw0 + 31) {
      f32x16 sA, sB;
      qk_tile<true>(st, st + 16384, qf, r32, h, sA, sB);
      if (tile * 64 + 63 > tw0) mask_scores(sA, sB, tile * 64, -1000000, t, h);
      softmax_step(sA, sB, c, m, l, o);
      pv_tile(st + 8192, sA, sB, r32, h, o);
    }
  });
  const float inv = 1.0f / l_total(l);
#pragma unroll
  for (int r = 0; r < 16; ++r) { o[0][r] *= inv; o[1][r] *= inv; }
  store_o((char*)(p.xb + (size_t)(b * 4096 + t) * 1024 + hd * 64), o, h);
}
DI void phase_mla(const Params& p, LAS char* lds) {
  const int G = gridDim.x;
  for (int j = 0;; ++j) {
    const int pos = (j & 1) ? j * G + (G - 1 - (int)bid()) : j * G + (int)bid();
    if (j * G >= 2048) break;
    if (pos < 2048) mla_unit(p, lds, (pos & 127) >> 4, pos & 15, 15 - (pos >> 7));
  }
}
DI void ln_row(const f32x4 (&v)[4], const float* gam, const float* bet, int lane, f32x4 (&y)[4]) {
  float s = 0.f;
#pragma unroll
  for (int j = 0; j < 4; ++j) s += (v[j][0] + v[j][1]) + (v[j][2] + v[j][3]);
  const float mu = wave_sum(s) * (1.0f / 1024.0f);
  float q = 0.f;
  f32x4 d[4];
#pragma unroll
  for (int j = 0; j < 4; ++j) { d[j] = v[j] - mu; q += (d[j][0] * d[j][0] + d[j][1] * d[j][1]) + (d[j][2] * d[j][2] + d[j][3] * d[j][3]); }
  const float rs = rsqrtf(wave_sum(q) * (1.0f / 1024.0f) + 1e-5f);
#pragma unroll
  for (int j = 0; j < 4; ++j) {
    const f32x4 gv = *(const f32x4*)(gam + 4 * lane + 256 * j), bv = *(const f32x4*)(bet + 4 * lane + 256 * j);
    y[j] = d[j] * rs * gv + bv;
  }
}
DI void phase_lnsplit(const Params& p, int layer) {
  const int lane = thr() & 63, gw = bid() * 8 + (thr() >> 6), nw = gridDim.x * 8;
  const float* gam = p.in[16] + layer * 1024;
  const float* bet = p.in[17] + layer * 1024;
  for (int row = gw; row < NTOK; row += nw) {
    float* xr = p.out + (size_t)row * 1024;
    f32x4 v[4], y[4];
#pragma unroll
    for (int j = 0; j < 4; ++j) v[j] = *(const f32x4*)(xr + 4 * lane + 256 * j);
    ln_row(v, gam, bet, lane, y);
#pragma unroll
    for (int j = 0; j < 4; ++j) {
      *(f32x4*)(xr + 4 * lane + 256 * j) = y[j];
      u32x2 hi; hi.x = cvt_pk(y[j][0], y[j][1]); hi.y = cvt_pk(y[j][2], y[j][3]);
      const float r0 = y[j][0] - __uint_as_float(hi.x << 16), r1 = y[j][1] - __uint_as_float(hi.x & 0xffff0000u);
      const float r2 = y[j][2] - __uint_as_float(hi.y << 16), r3 = y[j][3] - __uint_as_float(hi.y & 0xffff0000u);
      u32x2 lo; lo.x = cvt_pk(r0, r1); lo.y = cvt_pk(r2, r3);
      *(u32x2*)(p.xb + (size_t)row * 1024 + 4 * lane + 256 * j) = hi;
      *(u32x2*)(p.x1lo + (size_t)row * 1024 + 4 * lane + 256 * j) = lo;
    }
  }
}

constexpr int LIST_CAP = 32768;
DI void phase_router(const Params& p, LAS char* lds, int layer) {
  GEMM_IDS();
  LAS float* lg = (LAS float*)lds;
  LAS int* hist = (LAS int*)(lds + 256 * 65 * 4);
  LAS int* se = hist + 128;
  LAS float* sw = (LAS float*)(se + 256 * 6);
  const int half_tokens = NTOK / p.nsplit, cap = LIST_CAP / p.nsplit;
  const float* bias = p.in[21] + layer * 64;
  for (int u = bid(); u < 128; u += gridDim.x) {
    const int m0 = u * 256;
    const size_t aro = (size_t)(m0 + r0) * 2048 + ck, bro = (size_t)r0 * 2048 + ck, h128 = (size_t)128 * 2048;
    f32x4 acc[4][8]; zero_acc(acc);
    SUB_BEGIN(1);
    gemm_kloop(lds, (const char*)p.xb + aro, (const char*)p.xb + aro + h128, (const char*)p.rwh[layer] + bro, (const char*)p.rwh[layer] + bro + h128, 32, acc);
    gemm_kloop(lds, (const char*)p.x1lo + aro, (const char*)p.x1lo + aro + h128, (const char*)p.rwh[layer] + bro, (const char*)p.rwh[layer] + bro + h128, 32, acc);
    gemm_kloop(lds, (const char*)p.xb + aro, (const char*)p.xb + aro + h128, (const char*)p.rwl[layer] + bro, (const char*)p.rwl[layer] + bro + h128, 32, acc);
    SUB_END(1);
    if (wc == 0) {
#pragma unroll
      for (int m = 0; m < 4; ++m)
#pragma unroll
        for (int n = 0; n < 4; ++n)
#pragma unroll
          for (int j = 0; j < 4; ++j) lg[(wr * 64 + m * 16 + fr) * 65 + n * 16 + 4 * fq + j] = acc[m][n][j];
    }
    if (tid < 64) hist[tid] = 0;
    LDS_BAR();
    const float be = bias[lane];
    SUB_BEGIN(2);
    for (int i = 0; i < 32; ++i) {
      const int r = wid * 32 + i;
      const float s = sigmoidf_(lg[r * 65 + lane]);
      const float sb = s + be;
      float m1 = sb, m2 = -INFINITY;
#define TOP2_STEP(ctrl) do { const float o1 = __int_as_float(__builtin_amdgcn_update_dpp(0, __float_as_int(m1), (ctrl), 0xF, 0xF, true)); \
        const float o2 = __int_as_float(__builtin_amdgcn_update_dpp(0, __float_as_int(m2), (ctrl), 0xF, 0xF, true)); \
        const float n1 = fmaxf(m1, o1); m2 = fmaxf(fminf(m1, o1), fmaxf(m2, o2)); m1 = n1; } while (0)
      TOP2_STEP(0xB1); TOP2_STEP(0x4E); TOP2_STEP(0x141);
#undef TOP2_STEP
      const float gs = m1 + m2;
      unsigned gk = ((lane & 7) == 0) ? fkey(gs) : 0u;
      unsigned gmask = 0u;
#pragma unroll
      for (int k = 0; k < 4; ++k) {
        const unsigned mx = wave_max_u32(gk);
        const int idx = __builtin_ctzll(__ballot(gk == mx));
        gmask |= 1u << (idx >> 3);
        gk = (lane == idx) ? 0u : gk;
      }
      const bool allowed = (gmask >> (lane >> 3)) & 1u;
      unsigned ek = allowed ? fkey(sb) : 0u;
      int myslot = -1;
      float sum = 0.f;
#pragma unroll
      for (int k = 0; k < 6; ++k) {
        const unsigned mx = wave_max_u32(ek);
        const int idx = __builtin_ctzll(__ballot(ek == mx));
        sum += __int_as_float(__builtin_amdgcn_readlane(__float_as_int(s), idx));
        if (lane == idx) { myslot = k; ek = 0u; }
      }
      if (myslot >= 0) {
        const int lp = atomicAdd((int*)(hist + lane), 1);
        se[r * 6 + myslot] = lane | (lp << 8);
        sw[r * 6 + myslot] = s / sum * 2.5f;
      }
    }
    LDS_BAR();
    SUB_END(2);
    SUB_BEGIN(3);
    const int half = m0 / half_tokens;
    if (tid < 64) hist[64 + tid] = atomicAdd(p.cnt + (layer * 2 + half) * 64 + tid, hist[tid]);
    LDS_BAR();
    for (int i = tid; i < 256 * 6; i += NTHR) {
      const int v = se[i], e = v & 255, lp = v >> 8, r = i / 6, slot = i - r * 6;
      const int tok = m0 + r;
      p.lists[((size_t)half * 64 + e) * cap + hist[64 + e] + lp] = make_int2(tok * 8 + slot, __float_as_int(sw[i]));
    }
    LDS_BAR();
    SUB_END(3);
  }
}

DI void expert_map(const Params& p, LAS int* tb, int layer, int half) {
  if (thr() < 64) {
    const int c = p.cnt[(layer * 2 + half) * 64 + thr()];
    int t = (c + 255) >> 8, incl = t;
#pragma unroll
    for (int o = 1; o < 64; o <<= 1) { const int v = __shfl_up(incl, o); if ((int)thr() >= o) incl += v; }
    tb[thr()] = incl - t;
    if (thr() == 63) tb[64] = incl;
    tb[65 + thr()] = c;
  }
  LDS_BAR();
}
DI int find_expert(const LAS int* tb, int mt) {
  int e = 0;
#pragma unroll 8
  for (int i = 1; i < 64; ++i) e = (tb[i] <= mt) ? i : e;
  return e;
}
DI void phase_exp1(const Params& p, LAS char* lds, int layer, int half) {
  GEMM_IDS();
  LAS int* tb = (LAS int*)(lds + MISC_OFF);
  expert_map(p, tb, layer, half);
  const int half_tokens = NTOK / p.nsplit, cap = LIST_CAP / p.nsplit;
  const int TR = tb[64], TS = half_tokens / 256;
  for (int u = bid(); u < (TR + TS) * 2; u += gridDim.x) {
    const int mt = u >> 1, nt = u & 1;
    const bf16_t* W;
    int tok0, tok1;
    if (mt < TR) {
      const int e = find_expert(tb, mt), cnt = tb[65 + e];
      const int2* lst = p.lists + ((size_t)half * 64 + e) * cap;
      const int i0 = (mt - tb[e]) * 256 + r0, i1 = i0 + 128;
      tok0 = lst[i0 < cnt ? i0 : 0].x >> 3;
      tok1 = lst[i1 < cnt ? i1 : 0].x >> 3;
      W = p.egu + (size_t)e * 524288;
    } else {
      tok0 = half * half_tokens + (mt - TR) * 256 + r0; tok1 = tok0 + 128;
      W = p.shgu[layer];
    }
    const char* a0 = (const char*)(p.xb + (size_t)tok0 * 1024) + ck;
    const char* a1 = (const char*)(p.xb + (size_t)tok1 * 1024) + ck;
    const char* b0 = (const char*)(W + (size_t)(nt * 256 + r0) * 1024) + ck;
    f32x4 acc[4][8]; zero_acc(acc);
    gemm_kloop(lds, a0, a1, b0, b0 + (size_t)128 * 2048, 32, acc);
    {
#pragma unroll
      for (int m = 0; m < 4; ++m) {
        LAS char* hr = lds + (wr * 64 + m * 16 + fr) * 272 + (wc * 64 + 4 * fq) * 2;
#pragma unroll
        for (int g2 = 0; g2 < 2; ++g2)
#pragma unroll
          for (int n = 0; n < 2; ++n) {
            float hv[4];
#pragma unroll
            for (int j = 0; j < 4; ++j) { const float gt = acc[m][4 * g2 + n][j]; hv[j] = gt / (1.0f + __expf(-gt)) * acc[m][4 * g2 + n + 2][j]; }
            u32x2 w; w.x = cvt_pk(hv[0], hv[1]); w.y = cvt_pk(hv[2], hv[3]);
            *(LAS u32x2*)(hr + g2 * 64 + n * 32) = w;
          }
      }
      LDS_BAR();
#pragma unroll 2
      for (int i = 0; i < 8; ++i) {
        const int c = tid + 512 * i, row = c >> 4, ch = c & 15;
        *(u32x4*)((char*)(p.hbuf + (size_t)(mt * 256 + row) * 256 + nt * 128) + ch * 16) = *(const LAS u32x4*)(lds + row * 272 + ch * 16);
      }
      LDS_BAR();
    }
  }
}
DI void phase_exp2(const Params& p, LAS char* lds, int layer, int half) {
  GEMM_IDS();
  LAS int* tb = (LAS int*)(lds + MISC_OFF);
  expert_map(p, tb, layer, half);
  const int half_tokens = NTOK / p.nsplit, cap = LIST_CAP / p.nsplit;
  const int TR = tb[64], TS = half_tokens / 256;
  for (int u = bid(); u < (TR + TS) * 4; u += gridDim.x) {
    const int mt = u >> 2, nt = u & 3;
    int e = 0, cnt = 0, ib = 0;
    const bf16_t* W;
    if (mt < TR) { e = find_expert(tb, mt); cnt = tb[65 + e]; ib = (mt - tb[e]) * 256; W = p.ed + (size_t)e * 262144; }
    else W = p.shd[layer];
    const char* a0 = (const char*)(p.hbuf + (size_t)(mt * 256 + r0) * 256) + ck;
    const char* b0 = (const char*)(W + (size_t)(nt * 256 + r0) * 256) + ck;
    f32x4 acc[4][8]; zero_acc(acc);
    gemm_kloop(lds, a0, a0 + 128 * 512, b0, b0 + 128 * 512, 8, acc);
    if (mt < TR) {
      const int2* lst = p.lists + ((size_t)half * 64 + e) * cap;
      LAS int* ri = (LAS int*)(lds + MISC_OFF + 1024);
      if (tid < 256) { const int idx = ib + tid; int2 en = make_int2(-1, 0); if (idx < cnt) en = lst[idx]; ri[2 * tid] = en.x; ri[2 * tid + 1] = en.y; }
      LDS_BAR();
#pragma unroll
      for (int m = 0; m < 4; ++m) {
        const int r = wr * 64 + m * 16 + fr;
        const float w = __int_as_float(ri[2 * r + 1]);
        LAS char* cr = lds + r * 528 + (wc * 128 + 4 * fq) * 2;
#pragma unroll
        for (int n = 0; n < 8; ++n) { u32x2 v; v.x = cvt_pk(acc[m][n][0] * w, acc[m][n][1] * w); v.y = cvt_pk(acc[m][n][2] * w, acc[m][n][3] * w); *(LAS u32x2*)(cr + n * 32) = v; }
      asm volatile("" ::: "memory");
      }
      LDS_BAR();
#pragma unroll 2
      for (int i = 0; i < 16; ++i) {
        const int c = tid + 512 * i, row = c >> 5, ch = c & 31;
        const int ex = ri[2 * row];
        if (ex >= 0) {
          const int tok = ex >> 3, slot = ex & 7;
          *(u32x4*)((char*)(p.slab + ((size_t)(tok - half * half_tokens) * 6 + slot) * 1024 + nt * 256) + ch * 16) = *(const LAS u32x4*)(lds + row * 528 + ch * 16);
        }
      }
      LDS_BAR();
    } else {
#pragma unroll
      for (int m = 0; m < 4; ++m) {
        const size_t tok = (size_t)half * half_tokens + (mt - TR) * 256 + wr * 64 + m * 16 + fr;
        float* orow = p.out + tok * 1024 + nt * 256 + wc * 128 + 4 * fq;
#pragma unroll
        for (int n = 0; n < 8; ++n) { const f32x4 r = *(const f32x4*)(orow + n * 16); *(f32x4*)(orow + n * 16) = r * ALPHA + acc[m][n]; if (n & 1) asm volatile("" ::: "memory"); }
      asm volatile("" ::: "memory");
      }
    }
  }
}
DI void phase_combine(const Params& p, int layer, int half) {
  const int lane = thr() & 63, gw = bid() * 8 + (thr() >> 6), nw = gridDim.x * 8;
  const int half_tokens = NTOK / p.nsplit;
  const float* gam = p.in[18] + layer * 1024;
  const float* bet = p.in[19] + layer * 1024;
  for (int r = gw; r < half_tokens; r += nw) {
    const size_t row = (size_t)half * half_tokens + r;
    float* xr = p.out + row * 1024;
    f32x4 v[4], y[4];
#pragma unroll
    for (int j = 0; j < 4; ++j) v[j] = *(const f32x4*)(xr + 4 * lane + 256 * j);
#pragma unroll
    for (int s = 0; s < 6; ++s) {
      const bf16_t* sr = p.slab + ((size_t)r * 6 + s) * 1024;
#pragma unroll
      for (int j = 0; j < 4; ++j) {
        const u32x2 w = *(const u32x2*)(sr + 4 * lane + 256 * j);
        v[j][0] += __uint_as_float(w.x << 16); v[j][1] += __uint_as_float(w.x & 0xffff0000u);
        v[j][2] += __uint_as_float(w.y << 16); v[j][3] += __uint_as_float(w.y & 0xffff0000u);
      }
    }
    ln_row(v, gam, bet, lane, y);
#pragma unroll
    for (int j = 0; j < 4; ++j) {
      *(f32x4*)(xr + 4 * lane + 256 * j) = y[j];
      if (layer == 0) { u32x2 hi; hi.x = cvt_pk(y[j][0], y[j][1]); hi.y = cvt_pk(y[j][2], y[j][3]); *(u32x2*)(p.xb + row * 1024 + 4 * lane + 256 * j) = hi; }
    }
  }
}

DI void phase_inproj1(const Params& p, LAS char* lds) {
  GEMM_IDS();
  for (int u = bid(); u < 128 * 3; u += gridDim.x) {
    const int mt = u / 3, nt = u % 3, m0 = mt * 256, n0 = nt * 256;
    const char* a0 = (const char*)(p.xb + (size_t)(m0 + r0) * 1024) + ck;
    const char* b0 = (const char*)(p.win1t + (size_t)(n0 + r0) * 1024) + ck;
    f32x4 acc[4][8]; zero_acc(acc);
    gemm_kloop(lds, a0, a0 + (size_t)128 * 2048, b0, b0 + (size_t)128 * 2048, 32, acc);
#pragma unroll
    for (int m = 0; m < 4; ++m) {
      float* crow_ = p.cbuf + (size_t)(m0 + wr * 64 + m * 16 + fr) * 768 + n0 + wc * 128 + 4 * fq;
#pragma unroll
      for (int n = 0; n < 8; ++n) *(f32x4*)(crow_ + n * 16) = acc[m][n];
      asm volatile("" ::: "memory");
    }
  }
  int it = 0;
  expert_weights(p, (LAS float*)lds, 1, it);
}
DI void phase_mlanorm(const Params& p) {
  const int lane = thr() & 63, gw = bid() * 8 + (thr() >> 6), nw = gridDim.x * 8;
  for (int row = gw; row < NTOK; row += nw) {
    const float* cr = p.cbuf + (size_t)row * 768;
    float q[6], kv[4];
    float ss = 0.f;
#pragma unroll
    for (int j = 0; j < 6; ++j) { q[j] = cr[lane + 64 * j]; ss += q[j] * q[j]; }
    const float rq = rsqrtf(wave_sum(ss) * (1.0f / 384.0f) + 1e-6f);
#pragma unroll
    for (int j = 0; j < 6; ++j) p.cqb[(size_t)row * 384 + lane + 64 * j] = f2bf(q[j] * rq * p.in[11][lane + 64 * j]);
    ss = 0.f;
#pragma unroll
    for (int j = 0; j < 4; ++j) { kv[j] = cr[384 + lane + 64 * j]; ss += kv[j] * kv[j]; }
    const float rk = rsqrtf(wave_sum(ss) * (1.0f / 256.0f) + 1e-6f);
#pragma unroll
    for (int j = 0; j < 4; ++j) p.ckvb[(size_t)row * 256 + lane + 64 * j] = f2bf(kv[j] * rk * p.in[12][lane + 64 * j]);
    if (lane < 16) {
      const float x1 = cr[640 + lane], x2 = cr[656 + lane];
      const float2 cs = p.cs32[(row & 4095) * 16 + lane];
      p.krb[(size_t)row * 32 + lane] = f2bf(x1 * cs.x - x2 * cs.y);
      p.krb[(size_t)row * 32 + 16 + lane] = f2bf(x1 * cs.y + x2 * cs.x);
    }
  }
}
DI void phase_mlaup(const Params& p, LAS char* lds) {
  GEMM_IDS();
  for (int u = bid(); u < 128 * 6 + 128 * 8; u += gridDim.x) {
    if (u < 128 * 6) {
      const int mt = u / 6, nt = u % 6, m0 = mt * 256, n0 = nt * 256;
      const char* a0 = (const char*)(p.cqb + (size_t)(m0 + r0) * 384) + ck;
      const char* b0 = (const char*)(p.wuqt + (size_t)(n0 + r0) * 384) + ck;
      f32x4 acc[4][8]; zero_acc(acc);
      gemm_kloop(lds, a0, a0 + (size_t)128 * 768, b0, b0 + (size_t)128 * 768, 12, acc);
#pragma unroll
      for (int m = 0; m < 4; ++m) {
        const int row = m0 + wr * 64 + m * 16 + fr, b = row >> 12, t = row & 4095;
#pragma unroll
        for (int pr = 0; pr < 4; ++pr) {
          const int gi = ((n0 + wc * 128) >> 5) + pr, head = gi / 3, part = gi - head * 3;
          bf16_t* dst = p.q1 + ((size_t)(b * 16 + head) * 4096 + t) * 96 + part * 32 + 4 * fq;
          if (part < 2) {
#pragma unroll
            for (int n = 0; n < 2; ++n) { u32x2 w; w.x = cvt_pk(acc[m][2 * pr + n][0], acc[m][2 * pr + n][1]); w.y = cvt_pk(acc[m][2 * pr + n][2], acc[m][2 * pr + n][3]); *(u32x2*)(dst + n * 16) = w; }
          } else {
            const f32x4 c0 = *(const f32x4*)(p.cs32 + t * 16 + 4 * fq), c1 = *(const f32x4*)(p.cs32 + t * 16 + 4 * fq + 2);
            const float co[4] = {c0[0], c0[2], c1[0], c1[2]}, si[4] = {c0[1], c0[3], c1[1], c1[3]};
            float y1[4], y2[4];
#pragma unroll
            for (int j = 0; j < 4; ++j) { const float x1 = acc[m][2 * pr][j], x2 = acc[m][2 * pr + 1][j]; y1[j] = x1 * co[j] - x2 * si[j]; y2[j] = x1 * si[j] + x2 * co[j]; }
            u32x2 w1, w2; w1.x = cvt_pk(y1[0], y1[1]); w1.y = cvt_pk(y1[2], y1[3]); w2.x = cvt_pk(y2[0], y2[1]); w2.y = cvt_pk(y2[2], y2[3]);
            *(u32x2*)(dst) = w1; *(u32x2*)(dst + 16) = w2;
          }
        }
        asm volatile("" ::: "memory");
      }
    } else {
      const int uu = u - 128 * 6, mt = uu >> 3, nt = uu & 7, m0 = mt * 256, n0 = nt * 256;
      const char* a0 = (const char*)(p.ckvb + (size_t)(m0 + r0) * 256) + ck;
      const char* b0 = (const char*)(p.wukvt + (size_t)(n0 + r0) * 256) + ck;
      f32x4 acc[4][8]; zero_acc(acc);
      gemm_kloop(lds, a0, a0 + (size_t)128 * 512, b0, b0 + (size_t)128 * 512, 8, acc);
      const int head = nt * 2 + wc;
#pragma unroll
      for (int m = 0; m < 4; ++m) {
        const int row = m0 + wr * 64 + m * 16 + fr, b = row >> 12, t = row & 4095;
        plain64_store(&acc[m][0], p.kn + ((size_t)(b * 16 + head) * 4096 + t) * 64, fq);
        vt64_store(&acc[m][4], p.vt1 + (size_t)(b * 16 + head) * 64 * 4096, 4096, perm16(t), fq);
      asm volatile("" ::: "memory");
      }
    }
  }
}

constexpr int LDS_BYTES = NSA_LDS > (MISC_OFF + 4096) ? NSA_LDS : (MISC_OFF + 4096);
#ifdef PROBE
constexpr int LDS_TOTAL = 163840;
#else
constexpr int LDS_TOTAL = LDS_BYTES + 64;
#endif
#ifndef ALLCG
#define ALLCG 0
#endif

DI void get_phase(int i, int nsplit, int& ph, int& layer, int& half) {
  const int moe_len = 2 + 3 * nsplit;
  layer = 0; half = 0;
  if (i < 6) { ph = i; return; }
  i -= 6;
  if (i >= moe_len) {
    i -= moe_len; layer = 1;
    if (i < 5) { ph = (i < 4) ? PH_INPROJ1 + i : PH_OUTPROJ; return; }
    i -= 5;
  }
  if (i < 2) { ph = PH_LNSPLIT + i; return; }
  i -= 2; half = i / 3; ph = PH_EXP1 + (i - half * 3);
}
DI int num_phases(int nsplit) { return 6 + 5 + 2 * (2 + 3 * nsplit); }

__global__ void __launch_bounds__(NTHR) fwd_kernel(Params p, int ph_lo, int ph_hi, int use_sync) {
  extern __shared__ __attribute__((aligned(16))) char smem_raw[];
  LAS char* lds = (LAS char*)smem_raw;
  volatile LAS unsigned* bst = (volatile LAS unsigned*)(lds + LDS_BYTES);
  cg::grid_group grid = cg::this_grid();
  XcdBarrier xb;
  if (use_sync) {
    if (threadIdx.x == 0) { bst[0] = 0u; bst[1] = 0u; bst[2] = 0u; bst[3] = 0u; }
    __syncthreads();
    xb = xcd_barrier_post(p.bar, bst);
  }
#ifdef PROBE
  volatile LAS unsigned long long* pacc = (volatile LAS unsigned long long*)(lds + PROBE_LDS_OFF);
  if (blockIdx.x == 0 && threadIdx.x == 0) { pacc[0] = 0ull; pacc[1] = __builtin_amdgcn_s_memrealtime(); pacc[2] = 0ull; }
#endif
  for (int i = ph_lo; i < ph_hi; ++i) {
    int ph, layer, half;
    get_phase(i, p.nsplit, ph, layer, half);
    switch (ph) {
      case PH_PREP: phase_prep(p, lds); break;
      case PH_INPROJ0: phase_inproj0(p, lds); break;
      case PH_SWA_CMP1: phase_swa_cmp1(p, lds); break;
      case PH_CMP2: phase_cmp2(p, lds); break;
      case PH_NSA: phase_nsa(p, lds); break;
      case PH_OUTPROJ: phase_outproj(p, lds, layer); break;
      case PH_LNSPLIT: phase_lnsplit(p, layer); break;
      case PH_ROUTER: phase_router(p, lds, layer); break;
      case PH_EXP1: phase_exp1(p, lds, layer, half); break;
      case PH_EXP2: phase_exp2(p, lds, layer, half); break;
      case PH_COMBINE: phase_combine(p, layer, half); break;
      case PH_INPROJ1: phase_inproj1(p, lds); break;
      case PH_MLANORM: phase_mlanorm(p); break;
      case PH_MLAUP: phase_mlaup(p, lds); break;
      case PH_MLAATT: phase_mla(p, lds); break;
      default: break;
    }
    if (use_sync && i + 1 < ph_hi) { if (i == ph_lo || ALLCG) grid.sync(); else xcd_barrier(xb); }
#ifdef PROBE
    if (blockIdx.x == 0 && threadIdx.x == 0) { const unsigned long long t_ = __builtin_amdgcn_s_memrealtime(); if ((PROBE_DUR >> i) & 1ull) pacc[0] = pacc[0] + (t_ - pacc[1]); pacc[1] = t_; }
#endif
  }
#ifdef PROBE
  {
    __syncthreads();
    const unsigned lane_ = __builtin_amdgcn_mbcnt_hi(~0u, __builtin_amdgcn_mbcnt_lo(~0u, 0u));
    if (blockIdx.x == 0 && lane_ == 0u && atomicAdd((unsigned*)&bst[2], 1u) == 0u) {
      const unsigned long long td = pacc[0], t0 = __builtin_amdgcn_s_memrealtime();
      while (__builtin_amdgcn_s_memrealtime() - t0 < 9ull * td) __builtin_amdgcn_s_sleep(8);
    }
  }
#endif
}

extern "C" void kernel_launch(void* const* d_in, const int* in_sizes, int n_in, void* d_out, int out_size, void* d_ws, size_t ws_size, hipStream_t stream) {
  static int grid_blocks = 0;
  if (grid_blocks == 0) {
    int dev = 0, cus = 0, per_cu = 0;
    hipGetDevice(&dev);
    hipDeviceGetAttribute(&cus, hipDeviceAttributeMultiprocessorCount, dev);
    hipFuncSetAttribute((const void*)fwd_kernel, hipFuncAttributeMaxDynamicSharedMemorySize, LDS_TOTAL);
    hipOccupancyMaxActiveBlocksPerMultiprocessor(&per_cu, (const void*)fwd_kernel, NTHR, LDS_TOTAL);
    if (per_cu < 1) { fprintf(stderr, "kernel_launch: occupancy query says %d blocks per CU\n", per_cu); per_cu = 1; }
    grid_blocks = cus;
    (void)hipGetLastError();
  }
  Params p;
  memset(&p, 0, sizeof(p));
  for (int i = 0; i < 28; ++i) p.in[i] = (const float*)d_in[i];
  p.out = (float*)d_out;
  char* ws = (char*)d_ws;
  size_t off = 0;
  auto take = [&](size_t bytes) { char* r = ws + off; off += (bytes + 255) & ~(size_t)255; return r; };
  p.bar = (unsigned*)take(XCD_BAR_WORDS * 4);
  p.cnt = (int*)take(256 * 4 + 64 * 8);
  p.win0t = (bf16_t*)take((size_t)2304 * 1024 * 2); p.wout0t = (bf16_t*)take((size_t)1024 * 1024 * 2);
  p.cw1k = (bf16_t*)take(256 * 2048 * 2); p.cw1v = (bf16_t*)take(256 * 2048 * 2);
  p.cw2k = (bf16_t*)take(256 * 128 * 2); p.cw2v = (bf16_t*)take(256 * 128 * 2);
  p.win1t = (bf16_t*)take((size_t)768 * 1024 * 2); p.wuqt = (bf16_t*)take((size_t)1536 * 384 * 2);
  p.wukvt = (bf16_t*)take((size_t)2048 * 256 * 2); p.wout1t = (bf16_t*)take((size_t)1024 * 1024 * 2);
  for (int l = 0; l < 2; ++l) {
    p.rwh[l] = (bf16_t*)take(256 * 1024 * 2); p.rwl[l] = (bf16_t*)take(256 * 1024 * 2);
    p.shgu[l] = (bf16_t*)take(512 * 1024 * 2); p.shd[l] = (bf16_t*)take(1024 * 256 * 2);
  }
  p.cb1k = (float*)take(128 * 4); p.cb1v = (float*)take(128 * 4);
  p.cs64 = (float2*)take(4096 * 32 * 8); p.cs32 = (float2*)take(4096 * 16 * 8);
  p.egu = (bf16_t*)take((size_t)64 * 524288 * 2); p.ed = (bf16_t*)take((size_t)64 * 262144 * 2);
  p.xb = (bf16_t*)take((size_t)NTOK * 1024 * 2);
  const size_t act0 = off;
  p.q0 = (bf16_t*)take((size_t)NBATCH * 16 * 4096 * 64 * 2);
  const size_t kvb = (size_t)NBATCH * 2 * 4096 * 64 * 2;
  p.ka = (bf16_t*)take(kvb); p.ks = (bf16_t*)take(kvb); p.kw = (bf16_t*)take(kvb); p.kc0 = (bf16_t*)take(kvb); p.vc0 = (bf16_t*)take(kvb);
  p.vta = (bf16_t*)take(kvb); p.vts = (bf16_t*)take(kvb); p.vtw = (bf16_t*)take(kvb);
  p.h1k = (bf16_t*)take(4096 * 128 * 2); p.h1v = (bf16_t*)take(4096 * 128 * 2);
  p.kcmp = (bf16_t*)take(16 * 256 * 64 * 2); p.vcmpt = (bf16_t*)take(16 * 64 * 256 * 2);
  p.gates = (float*)take((size_t)NTOK * 24 * 4);
  p.obuf = (bf16_t*)take((size_t)NTOK * 1024 * 2);
  const size_t end_l0 = off;
  const size_t need1 = act0 + (size_t)NTOK * 1024 * 2 + (size_t)64 * LIST_CAP * 8 + ((size_t)NTOK * 7 + 64 * 256) * 512 + (size_t)NTOK * 6 * 2048 + 4096;
  p.nsplit = ws_size >= need1 ? 1 : 2;
  off = act0;
  p.x1lo = (bf16_t*)take((size_t)NTOK * 1024 * 2);
  p.lists = (int2*)take((size_t)64 * LIST_CAP * 8);
  p.hbuf = (bf16_t*)take(((size_t)(NTOK / p.nsplit) * 7 + 64 * 256) * 512);
  p.slab = (bf16_t*)take((size_t)(NTOK / p.nsplit) * 6 * 2048);
  const size_t end_moe = off;
  off = act0;
  p.cqb = (bf16_t*)take((size_t)NTOK * 384 * 2); p.ckvb = (bf16_t*)take((size_t)NTOK * 256 * 2); p.krb = (bf16_t*)take((size_t)NTOK * 32 * 2);
  p.q1 = (bf16_t*)take((size_t)NTOK * 16 * 96 * 2);
  p.kn = (bf16_t*)take((size_t)NTOK * 16 * 64 * 2);
  p.cbuf = (float*)p.kn;
  p.vt1 = (bf16_t*)take((size_t)NTOK * 16 * 64 * 2);
  const size_t end_l1 = off;
  size_t need = end_l0 > end_moe ? end_l0 : end_moe; if (end_l1 > need) need = end_l1;
  if (need > ws_size) { fprintf(stderr, "kernel_launch: workspace too small: need %zu, have %zu\n", need, ws_size); return; }
  const int n = 6 + 5 + 2 * (2 + 3 * p.nsplit);
  hipMemsetAsync(p.bar, 0, XCD_BAR_WORDS * 4, stream);
#ifdef MULTI_LAUNCH
  for (int i = 0; i < n; ++i) hipLaunchKernelGGL(fwd_kernel, dim3(grid_blocks), dim3(NTHR), LDS_TOTAL, stream, p, i, i + 1, 0);
#else
  int lo = 0, hi = n, us = 1;
  void* args[] = {&p, &lo, &hi, &us};
  hipError_t e = hipLaunchCooperativeKernel((const void*)fwd_kernel, dim3(grid_blocks), dim3(NTHR), args, LDS_TOTAL, stream);
  if (e != hipSuccess) fprintf(stderr, "cooperative launch failed: %s (grid %d)\n", hipGetErrorString(e), grid_blocks);
#endif
}
```

```cpp
#include <hip/hip_runtime.h>
#include <hip/hip_cooperative_groups.h>
#include <stdint.h>
#include <math.h>
#include <cstdio>
#include <cstring>
namespace cg = cooperative_groups;

#define LAS __attribute__((address_space(3)))
#define DI __device__ __forceinline__
typedef unsigned short bf16_t;
typedef short bf16x8 __attribute__((ext_vector_type(8)));
typedef float f32x4 __attribute__((ext_vector_type(4)));
typedef float f32x16 __attribute__((ext_vector_type(16)));
typedef unsigned u32x4 __attribute__((ext_vector_type(4)));
typedef unsigned u32x2 __attribute__((ext_vector_type(2)));

constexpr int NTOK = 32768, SEQ = 4096, NBATCH = 8, DM = 1024;
constexpr int NTHR = 512;
constexpr int PROBE_LDS_OFF = 163840 - 32;
constexpr float ALPHA = 1.4142135623730951f;
constexpr float LOG2E = 1.4426950408889634f;

typedef __bf16 bf16x2_t __attribute__((ext_vector_type(2)));
typedef float f32x2_t __attribute__((ext_vector_type(2)));
DI unsigned cvt_pk(float lo, float hi) { const f32x2_t f = {lo, hi}; return __builtin_bit_cast(unsigned, __builtin_convertvector(f, bf16x2_t)); }
DI bf16_t f2bf(float x) { return (bf16_t)(cvt_pk(x, 0.f) & 0xffffu); }
DI float bf2f(bf16_t b) { return __uint_as_float(((unsigned)b) << 16); }
DI float fast_exp2(float x) { return __builtin_amdgcn_exp2f(x); }
DI float sigmoidf_(float x) { return 1.0f / (1.0f + __expf(-x)); }
DI int crow(int r, int h) { return (r & 3) + 8 * (r >> 2) + 4 * h; }
DI int perm16(int t) { return (t & ~15) | (((t >> 2) & 1) << 3) | (((t >> 3) & 1) << 2) | (t & 3); }
DI void glds16(const void* g, LAS char* l) { __builtin_amdgcn_global_load_lds((const unsigned*)g, (LAS unsigned*)l, 16, 0, 0); }
#define WAIT_VM_BAR(N) asm volatile("s_waitcnt vmcnt(" #N ") lgkmcnt(0)\n\ts_barrier" ::: "memory")
#define LDS_BAR() asm volatile("s_waitcnt lgkmcnt(0)\n\ts_barrier" ::: "memory")
DI int thr() { int t = threadIdx.x; asm volatile("" : "+v"(t)); return t; }
DI int bid() { int b = blockIdx.x; asm volatile("" : "+s"(b)); return b; }
DI bool xcd_unit(int i, int total, int& u) {
  const int g = (int)gridDim.x, b = bid();
  if (g & 7) { u = b + i * g; return u < total; }
  const int per = g >> 3, x = b & 7, j = b >> 3;
  const int base = (int)(((long)total * x) >> 3), end = (int)(((long)total * (x + 1)) >> 3);
  u = base + j + i * per;
  return u < end;
}
DI void mn_order(int u, int nN, int& mt, int& nt) { const int g4 = 4 * nN, g = u / g4, r = u - g * g4; nt = r >> 2; mt = 4 * g + (r & 3); }
#define DPP_MAX_STEP(k, ctrl) do { const unsigned o_ = (unsigned)__builtin_amdgcn_update_dpp(0, (int)(k), (ctrl), 0xF, 0xF, true); (k) = (k) > o_ ? (k) : o_; } while (0)
DI unsigned wave_max_u32(unsigned k) {
  DPP_MAX_STEP(k, 0xB1);
  DPP_MAX_STEP(k, 0x4E);
  DPP_MAX_STEP(k, 0x141);
  DPP_MAX_STEP(k, 0x140);
  const unsigned m0 = (unsigned)__builtin_amdgcn_readlane((int)k, 0), m1 = (unsigned)__builtin_amdgcn_readlane((int)k, 16);
  const unsigned m2 = (unsigned)__builtin_amdgcn_readlane((int)k, 32), m3 = (unsigned)__builtin_amdgcn_readlane((int)k, 48);
  const unsigned a = m0 > m1 ? m0 : m1, b = m2 > m3 ? m2 : m3;
  return a > b ? a : b;
}
DI unsigned fkey(float x) { const unsigned u = __float_as_uint(x); return (u & 0x80000000u) ? ~u : (u | 0x80000000u); }
DI float wave_sum(float v) {
#pragma unroll
  for (int o = 32; o > 0; o >>= 1) v += __shfl_xor(v, o);
  return v;
}

#ifndef PROBE_BLK
#define PROBE_BLK 0
#endif
#if defined(PROBE) && defined(PROBE_SUBID)
#define SUB_BEGIN(id) do { if ((id) == PROBE_SUBID && blockIdx.x == PROBE_BLK && threadIdx.x == 0) { volatile LAS unsigned long long* q_ = (volatile LAS unsigned long long*)(uintptr_t)PROBE_LDS_OFF; q_[2] = __builtin_amdgcn_s_memrealtime(); } } while (0)
#define SUB_END(id) do { if ((id) == PROBE_SUBID && blockIdx.x == PROBE_BLK && threadIdx.x == 0) { volatile LAS unsigned long long* q_ = (volatile LAS unsigned long long*)(uintptr_t)PROBE_LDS_OFF; q_[0] = q_[0] + (__builtin_amdgcn_s_memrealtime() - q_[2]); } } while (0)
#else
#define SUB_BEGIN(id) do { } while (0)
#define SUB_END(id) do { } while (0)
#endif
#define XB_TMO 0
#define XB_XCNT(j) (16 + 16 * (j))
#define XB_XSUB(j) (272 + 16 * (j))
#define XB_XGEN(j) (528 + 16 * (j))
#define XB_TOP 784
#define XB_TOPGEN 800
#define XCD_BAR_WORDS 1024
#define XB_SPIN_CAP (1u << 22)
typedef __attribute__((address_space(1))) unsigned gu32;
DI unsigned xb_ld(gu32* p) { return __hip_atomic_load(p, __ATOMIC_RELAXED, __HIP_MEMORY_SCOPE_AGENT); }
DI unsigned xb_add(gu32* p, unsigned v) { return __hip_atomic_fetch_add(p, v, __ATOMIC_RELAXED, __HIP_MEMORY_SCOPE_AGENT); }
DI unsigned xb_xcc_id() { return (unsigned)__builtin_amdgcn_s_getreg((3 << 11) | 20) & 0xFu; }
#define XB_SPIN(cond, bar) do { unsigned _sp = 0; while (cond) { __builtin_amdgcn_s_sleep(1); \
    if ((++_sp & 255u) == 0u) { if (xb_ld(&(bar)[XB_TMO])) break; if (_sp > XB_SPIN_CAP) { xb_add(&(bar)[XB_TMO], 1u); break; } } } } while (0)
struct XcdBarrier { gu32* bar; unsigned x; volatile LAS unsigned* st; };
DI XcdBarrier xcd_barrier_post(unsigned* bar_, volatile LAS unsigned* st) {
  gu32* bar = (gu32*)bar_;
  XcdBarrier b; b.bar = bar; b.x = xb_xcc_id(); b.st = st;
  if (threadIdx.x == 0) (void)xb_add(&bar[XB_XCNT(b.x)], 1u);
  return b;
}
DI void xcd_barrier_complete(gu32* bar, unsigned x, unsigned& nloc, unsigned& nx) {
  const unsigned G = gridDim.x;
  unsigned sum, cnt, mine, sp = 0u;
  for (;;) {
    sum = 0u; cnt = 0u; mine = 0u;
#pragma unroll
    for (unsigned j = 0; j < 16; ++j) { const unsigned c = xb_ld(&bar[XB_XCNT(j)]); sum += c; cnt += (c > 0u) ? 1u : 0u; mine = (j == x) ? c : mine; }
    if (sum == G) break;
    __builtin_amdgcn_s_sleep(1);
    if ((++sp & 255u) == 0u) { if (xb_ld(&bar[XB_TMO])) break; if (sp > XB_SPIN_CAP) { xb_add(&bar[XB_TMO], 1u); break; } }
  }
  nloc = mine > 0u ? mine : 1u; nx = cnt > 0u ? cnt : 1u;
}
DI void xcd_barrier(const XcdBarrier& b) {
  asm volatile("s_waitcnt vmcnt(0)" ::: "memory");
  __syncthreads();
  if (threadIdx.x == 0) {
    unsigned long long bar_i = (unsigned long long)b.bar;
    asm volatile("" : "+s"(bar_i));
    gu32* bar = (gu32*)bar_i;
    __builtin_amdgcn_s_waitcnt(0);
    unsigned nloc = b.st[0], nx = b.st[1];
    if (nloc == 0u) { xcd_barrier_complete(bar, b.x, nloc, nx); b.st[0] = nloc; b.st[1] = nx; }
    const unsigned old = xb_add(&bar[XB_XSUB(b.x)], 1u);
    const unsigned gen = old / nloc;
    if (old + 1u == (gen + 1u) * nloc) {
      __builtin_amdgcn_fence(__ATOMIC_RELEASE, "agent");
      asm volatile("s_waitcnt vmcnt(0)" ::: "memory");
      const unsigned og = xb_add(&bar[XB_TOP], 1u);
      const unsigned tg = og / nx;
      if (og + 1u == (tg + 1u) * nx) xb_add(&bar[XB_TOPGEN], 1u);
      else XB_SPIN(xb_ld(&bar[XB_TOPGEN]) == tg, bar);
      __builtin_amdgcn_fence(__ATOMIC_ACQUIRE, "agent");
      xb_add(&bar[XB_XGEN(b.x)], 1u);
      asm volatile("s_waitcnt vmcnt(0)" ::: "memory");
    } else {
      XB_SPIN(xb_ld(&bar[XB_XGEN(b.x)]) == gen, bar);
      __builtin_amdgcn_fence(__ATOMIC_ACQUIRE, "agent");
      asm volatile("s_waitcnt vmcnt(0)" ::: "memory");
    }
  }
  __syncthreads();
}

constexpr int G_STAGE = 32768;
constexpr int G_LDS = 4 * G_STAGE;
constexpr int MISC_OFF = 135168;

DI void gemm_kloop(LAS char* lds, const char* a0, const char* a1, const char* b0, const char* b1, int nk  , f32x4 (&acc)[4][8]) {
  const int tid = thr(), lane = tid & 63, wid = __builtin_amdgcn_readfirstlane(tid >> 6);
  const int wr = wid >> 1, wc = wid & 1, fr = lane & 15, fq = lane >> 4;
  LAS char* dA0 = lds + tid * 16;
  const int aoff = (wr * 64 + fr) * 64 + fq * 16;
  const int boff = 16384 + (wc * 128 + fr) * 64 + fq * 16;
#define G_ISSUE(slot, kt) do { LAS char* _d = dA0 + (slot) * G_STAGE; const size_t _ko = (size_t)(kt) * 64; \
    glds16(a0 + _ko, _d); glds16(a1 + _ko, _d + 8192); glds16(b0 + _ko, _d + 16384); glds16(b1 + _ko, _d + 24576); } while (0)
  G_ISSUE(0, 0);
  if (nk > 1) G_ISSUE(1, 1);
  if (nk > 2) G_ISSUE(2, 2);
  int slot = 0;
  for (int t = 0; t < nk; ++t) {
    SUB_BEGIN(4);
    if (t + 2 < nk) { WAIT_VM_BAR(8); } else if (t + 1 < nk) { WAIT_VM_BAR(4); } else { WAIT_VM_BAR(0); }
    SUB_END(4);
    SUB_BEGIN(5);
    if (t + 3 < nk) { G_ISSUE((slot + 3) & 3, t + 3); }
    const LAS char* base = lds + slot * G_STAGE;
    bf16x8 af[4];
#pragma unroll
    for (int m = 0; m < 4; ++m) af[m] = *(const LAS bf16x8*)(base + aoff + m * 1024);
#pragma unroll
    for (int nh = 0; nh < 2; ++nh) {
      bf16x8 bfr[4];
#pragma unroll
      for (int n = 0; n < 4; ++n) bfr[n] = *(const LAS bf16x8*)(base + boff + (4 * nh + n) * 1024);
#pragma unroll
      for (int m = 0; m < 4; ++m)
#pragma unroll
        for (int n = 0; n < 4; ++n) acc[m][4 * nh + n] = __builtin_amdgcn_mfma_f32_16x16x32_bf16(bfr[n], af[m], acc[m][4 * nh + n], 0, 0, 0);
    }
    slot = (slot + 1) & 3;
    SUB_END(5);
  }
#undef G_ISSUE
  LDS_BAR();
}
DI void zero_acc(f32x4 (&acc)[4][8]) {
#pragma unroll
  for (int m = 0; m < 4; ++m)
#pragma unroll
    for (int n = 0; n < 8; ++n) acc[m][n] = (f32x4){0.f, 0.f, 0.f, 0.f};
}
constexpr int A_STAGE = 20480, A_NST = 3, A_RING = A_NST * A_STAGE;
constexpr float NEGBIG = -1e30f;
#define MFMA32(a, b, c) __builtin_amdgcn_mfma_f32_32x32x16_bf16((a), (b), (c), 0, 0, 0)

template <bool HAS_ROPE>
DI void qk_tile(const LAS char* kt, const LAS char* krt, const bf16x8* qf, int r32, int h, f32x16& sA, f32x16& sB) {
  const int sw = (r32 >> 1) & 7;
  const LAS char* ra = kt + r32 * 128;
  const LAS char* rb = ra + 32 * 128;
  f32x16 z;
#pragma unroll
  for (int i = 0; i < 16; ++i) z[i] = 0.f;
  sA = z; sB = z;
#pragma unroll
  for (int ks = 0; ks < 4; ++ks) {
    const int c = ((2 * ks + h) ^ sw) << 4;
    const bf16x8 ka = *(const LAS bf16x8*)(ra + c);
    const bf16x8 kb = *(const LAS bf16x8*)(rb + c);
    sA = MFMA32(ka, qf[ks], sA);
    sB = MFMA32(kb, qf[ks], sB);
  }
  if (HAS_ROPE) {
    const int sw2 = (r32 >> 2) & 3;
    const LAS char* pa = krt + r32 * 64;
    const LAS char* pb = pa + 32 * 64;
#pragma unroll
    for (int ks = 0; ks < 2; ++ks) {
      const int c = ((2 * ks + h) ^ sw2) << 4;
      const bf16x8 ka = *(const LAS bf16x8*)(pa + c);
      const bf16x8 kb = *(const LAS bf16x8*)(pb + c);
      sA = MFMA32(ka, qf[4 + ks], sA);
      sB = MFMA32(kb, qf[4 + ks], sB);
    }
  }
}

DI bf16x8 pack8(const f32x16& p, int s) {
  u32x4 w;
  w.x = cvt_pk(p[8 * s + 0], p[8 * s + 1]); w.y = cvt_pk(p[8 * s + 2], p[8 * s + 3]);
  w.z = cvt_pk(p[8 * s + 4], p[8 * s + 5]); w.w = cvt_pk(p[8 * s + 6], p[8 * s + 7]);
  return __builtin_bit_cast(bf16x8, w);
}

DI void pv_tile(const LAS char* vt, const f32x16& pA, const f32x16& pB, int r32, int h, f32x16 (&o)[2]) {
  const int sw = (r32 >> 1) & 7;
  const LAS char* r0 = vt + r32 * 128;
  const LAS char* r1 = r0 + 32 * 128;
#pragma unroll
  for (int kk = 0; kk < 4; ++kk) {
    const bf16x8 pt = (kk < 2) ? pack8(pA, kk & 1) : pack8(pB, kk & 1);
    const int c = ((2 * kk + h) ^ sw) << 4;
    const bf16x8 v0 = *(const LAS bf16x8*)(r0 + c);
    const bf16x8 v1 = *(const LAS bf16x8*)(r1 + c);
    o[0] = MFMA32(v0, pt, o[0]);
    o[1] = MFMA32(v1, pt, o[1]);
  }
}

DI void mask_scores(f32x16& sA, f32x16& sB, int key0, int lo, int hi, int h) {
#pragma unroll
  for (int r = 0; r < 16; ++r) {
    const int ka = key0 + crow(r, h), kb = ka + 32;
    sA[r] = (ka > lo && ka <= hi) ? sA[r] : NEGBIG;
    sB[r] = (kb > lo && kb <= hi) ? sB[r] : NEGBIG;
  }
}
DI void mask_lane(f32x16& sA, f32x16& sB, bool keep) {
#pragma unroll
  for (int r = 0; r < 16; ++r) { sA[r] = keep ? sA[r] : NEGBIG; sB[r] = keep ? sB[r] : NEGBIG; }
}
DI float row_max32(const f32x16& sA, const f32x16& sB) {
  float mx = fmaxf(sA[0], sB[0]);
#pragma unroll
  for (int r = 1; r < 16; ++r) mx = fmaxf(mx, fmaxf(sA[r], sB[r]));
  return fmaxf(mx, __shfl_xor(mx, 32));
}
DI void softmax_step(f32x16& sA, f32x16& sB, float c, float& m, float& l, f32x16 (&o)[2]) {
  const float mx = row_max32(sA, sB);
  const float mnew = fmaxf(m, mx);
  const float mc = (mnew < -1e29f) ? 0.f : mnew * c;
  const float alpha = fast_exp2(m * c - mc);
  m = mnew;
  float sum = 0.f;
#pragma unroll
  for (int r = 0; r < 16; ++r) {
    sA[r] = fast_exp2(__builtin_fmaf(sA[r], c, -mc));
    sB[r] = fast_exp2(__builtin_fmaf(sB[r], c, -mc));
    sum += sA[r] + sB[r];
  }
  l = l * alpha + sum;
  if (!__all(alpha == 1.0f)) {
#pragma unroll
    for (int r = 0; r < 16; ++r) { o[0][r] *= alpha; o[1][r] *= alpha; }
  }
}

template <bool HAS_ROPE, class F>
DI void kv_stream(LAS char* ring, const char* kb, const char* vb, size_t vstride, const char* krb, int tile_lo, int tile_hi, F&& per_tile) {
  const int tid = thr();
  const int row = tid >> 3, cs = ((tid & 7) ^ ((row >> 1) & 7)) << 4;
  const char* ksrc = kb + (size_t)row * 128 + cs;
  const char* vsrc = vb + (size_t)row * vstride + cs;
  const int t2 = tid & 255, row2 = t2 >> 2;
  const char* rsrc = krb + (size_t)row2 * 64 + (((t2 & 3) ^ ((row2 >> 2) & 3)) << 4);
  LAS char* dst = ring + tid * 16;
  LAS char* dst2 = ring + 16384 + t2 * 16;
#define A_ISSUE(slot, tl) do { glds16(ksrc + (size_t)(tl) * 8192, dst + (slot) * A_STAGE); glds16(vsrc + (size_t)(tl) * 128, dst + (slot) * A_STAGE + 8192); \
    if (HAS_ROPE) glds16(rsrc + (size_t)(tl) * 4096, dst2 + (slot) * A_STAGE); } while (0)
  if (tile_lo <= tile_hi) A_ISSUE(0, tile_lo);
  if (tile_lo + 1 <= tile_hi) A_ISSUE(1, tile_lo + 1);
  int slot = 0;
  for (int t = tile_lo; t <= tile_hi; ++t) {
    if (HAS_ROPE) SUB_BEGIN(6);
    if (t + 1 <= tile_hi) { if (HAS_ROPE) { WAIT_VM_BAR(3); } else { WAIT_VM_BAR(2); } } else { WAIT_VM_BAR(0); }
    if (HAS_ROPE) SUB_END(6);
    if (HAS_ROPE) SUB_BEGIN(7);
    if (t + 2 <= tile_hi) { int s2 = slot + 2; if (s2 >= 3) s2 -= 3; A_ISSUE(s2, t + 2); }
    per_tile(t, (const LAS char*)(ring + slot * A_STAGE));
    if (HAS_ROPE) SUB_END(7);
    slot = (slot == 2) ? 0 : slot + 1;
  }
#undef A_ISSUE
  LDS_BAR();
}

DI float l_total(float l) { return l + __shfl_xor(l, 32); }

DI void store_o(char* rowp, const f32x16 (&o)[2], int h) {
#pragma unroll
  for (int dd = 0; dd < 2; ++dd)
#pragma unroll
    for (int g = 0; g < 4; ++g) {
      u32x2 w; w.x = cvt_pk(o[dd][4 * g + 0], o[dd][4 * g + 1]); w.y = cvt_pk(o[dd][4 * g + 2], o[dd][4 * g + 3]);
      *(u32x2*)(rowp + (32 * dd + 8 * g + 4 * h) * 2) = w;
    }
}
struct Params {
  const float* in[28];
  float* out;
  unsigned* bar;
  int* cnt;
  bf16_t *win0t, *wout0t, *cw1k, *cw1v, *cw2k, *cw2v, *win1t, *wuqt, *wukvt, *wout1t;
  bf16_t *rwh[2], *rwl[2], *shgu[2], *shd[2];
  bf16_t *egu, *ed;
  float *cb1k, *cb1v;
  float2 *cs64, *cs32;
  bf16_t *xb;
  bf16_t *q0, *ka, *ks, *kw, *kc0, *vc0, *vta, *vts, *vtw, *h1k, *h1v, *kcmp, *vcmpt, *obuf;
  float* gates;
  bf16_t *x1lo, *hbuf, *slab;
  int2* lists;
  float* cbuf;
  bf16_t *cqb, *ckvb, *krb, *q1, *kn, *vt1;
  int nsplit;
  int pad_;
};
enum { PH_PREP = 0, PH_INPROJ0, PH_SWA_CMP1, PH_CMP2, PH_NSA, PH_OUTPROJ, PH_LNSPLIT, PH_ROUTER, PH_EXP1, PH_EXP2, PH_COMBINE, PH_INPROJ1, PH_MLANORM, PH_MLAUP, PH_MLAATT };

DI void xpose_item(LAS float* tile, const float* src, int N, int k0, int n0, bf16_t* dst, int ldd, int mode, bf16_t* dst_lo) {
  const int tid = thr();
  {
    const int n = tid & 63, kk = tid >> 6;
    const bool ok = (n0 + n) < N;
#pragma unroll
    for (int i = 0; i < 8; ++i) { const int k = kk + 8 * i; tile[k * 65 + n] = ok ? src[(size_t)(k0 + k) * N + n0 + n] : 0.f; }
  }
  __syncthreads();
  {
    const int n = tid >> 3, kc = (tid & 7) * 8, gn = n0 + n;
    if (gn < N) {
      float v[8];
#pragma unroll
      for (int j = 0; j < 8; ++j) v[j] = tile[(kc + j) * 65 + n];
      int row = gn;
      if (mode == 1) row = 64 * (gn >> 5) + (gn & 31);
      if (mode == 2) row = 64 * (gn >> 5) + 32 + (gn & 31);
      u32x4 w; w.x = cvt_pk(v[0], v[1]); w.y = cvt_pk(v[2], v[3]); w.z = cvt_pk(v[4], v[5]); w.w = cvt_pk(v[6], v[7]);
      *(u32x4*)(dst + (size_t)row * ldd + k0 + kc) = w;
      if (dst_lo) {
        float r[8];
#pragma unroll
        for (int j = 0; j < 8; ++j) { const unsigned pk = (j & 1) ? (w[j >> 1] >> 16) : (w[j >> 1] & 0xffffu); r[j] = v[j] - __uint_as_float(pk << 16); }
        u32x4 w2; w2.x = cvt_pk(r[0], r[1]); w2.y = cvt_pk(r[2], r[3]); w2.z = cvt_pk(r[4], r[5]); w2.w = cvt_pk(r[6], r[7]);
        *(u32x4*)(dst_lo + (size_t)row * ldd + k0 + kc) = w2;
      }
    }
  }
  __syncthreads();
}
DI void xpose256_load(f32x4 (&v)[8], const float* src, int N, int k0, int n0, int tid) {
  const int n4 = (tid & 63) * 4, kk = tid >> 6;
#pragma unroll
  for (int i = 0; i < 8; ++i) v[i] = *(const f32x4*)(src + (size_t)(k0 + kk + 8 * i) * N + n0 + n4);
}
DI void xpose256_stream(LAS float* tile, const float* src, int K, int N, bf16_t* dst, int mode, int first, int total) {
  const int tid = thr(), nkt = K / 64, G = gridDim.x;
  if (first >= total) return;
  f32x4 v[8];
  xpose256_load(v, src, N, (first % nkt) * 64, (first / nkt) * 256, tid);
  for (int it = first; it < total; it += G) {
    const int k0 = (it % nkt) * 64, n0 = (it / nkt) * 256;
    {
      const int n4 = (tid & 63) * 4, kk = tid >> 6;
#pragma unroll
      for (int i = 0; i < 8; ++i) { LAS float* tp = tile + (kk + 8 * i) * 257 + n4; tp[0] = v[i][0]; tp[1] = v[i][1]; tp[2] = v[i][2]; tp[3] = v[i][3]; }
    }
    __syncthreads();
    if (it + G < total) xpose256_load(v, src, N, ((it + G) % nkt) * 64, ((it + G) / nkt) * 256, tid);
#pragma unroll
    for (int j = 0; j < 4; ++j) {
      const int cix = tid + 512 * j, n = cix >> 3, kc = (cix & 7) * 8, gn = n0 + n;
      float w8[8];
#pragma unroll
      for (int e = 0; e < 8; ++e) w8[e] = tile[(kc + e) * 257 + n];
      int row = gn;
      if (mode == 1) row = 64 * (gn >> 5) + (gn & 31);
      if (mode == 2) row = 64 * (gn >> 5) + 32 + (gn & 31);
      u32x4 w; w.x = cvt_pk(w8[0], w8[1]); w.y = cvt_pk(w8[2], w8[3]); w.z = cvt_pk(w8[4], w8[5]); w.w = cvt_pk(w8[6], w8[7]);
      *(u32x4*)(dst + (size_t)row * K + k0 + kc) = w;
    }
    __syncthreads();
  }
}
DI void xpose_matrix(LAS float* tile, const float* src, int K, int N, bf16_t* dst, int mode, bf16_t* dst_lo, int& itbase) {
  const bool wide = (N % 256 == 0) && dst_lo == nullptr;
  const int nkt = K / 64, nnt = wide ? N / 256 : (N + 63) / 64, total = nkt * nnt;
  int first = (int)((bid() + gridDim.x - (itbase % gridDim.x)) % gridDim.x);
  if (wide) xpose256_stream(tile, src, K, N, dst, mode, first, total);
  else for (int i = first; i < total; i += gridDim.x) xpose_item(tile, src, N, (i % nkt) * 64, (i / nkt) * 64, dst, K, mode, dst_lo);
  itbase += total;
}
DI void zero_rows(bf16_t* dst, size_t nelem) {
  u32x4 z = (u32x4){0u, 0u, 0u, 0u};
  for (size_t i = ((size_t)bid() * NTHR + thr()) * 8; i < nelem; i += (size_t)gridDim.x * NTHR * 8) *(u32x4*)(dst + i) = z;
}
DI void expert_weights(const Params& p, LAS float* tile, int layer, int& it) {
  const size_t eo = (size_t)layer * 64 * 262144;
  for (int e = 0; e < 64; ++e) {
    xpose_matrix(tile, p.in[22] + eo + (size_t)e * 262144, 1024, 256, p.egu + (size_t)e * 524288, 1, nullptr, it);
    xpose_matrix(tile, p.in[23] + eo + (size_t)e * 262144, 1024, 256, p.egu + (size_t)e * 524288, 2, nullptr, it);
    xpose_matrix(tile, p.in[24] + eo + (size_t)e * 262144, 256, 1024, p.ed + (size_t)e * 262144, 0, nullptr, it);
  }
}
DI void phase_prep(const Params& p, LAS char* lds) {
  LAS float* tile = (LAS float*)lds;
  const int tid = thr();
  SUB_BEGIN(8);
  {
    const size_t stride = (size_t)gridDim.x * NTHR * 8;
    for (size_t i = ((size_t)bid() * NTHR + tid) * 8; i < (size_t)NTOK * DM; i += 4 * stride) {
      f32x4 a[4], b[4];
#pragma unroll
      for (int q = 0; q < 4; ++q) { const size_t o = i + q * stride; if (o < (size_t)NTOK * DM) { a[q] = *(const f32x4*)(p.in[0] + o); b[q] = *(const f32x4*)(p.in[0] + o + 4); } }
#pragma unroll
      for (int q = 0; q < 4; ++q) { const size_t o = i + q * stride; if (o < (size_t)NTOK * DM) {
        u32x4 w; w.x = cvt_pk(a[q][0], a[q][1]); w.y = cvt_pk(a[q][2], a[q][3]); w.z = cvt_pk(b[q][0], b[q][1]); w.w = cvt_pk(b[q][2], b[q][3]);
        *(u32x4*)(p.xb + o) = w; } }
    }
  }
  SUB_END(8);
  zero_rows(p.win0t + (size_t)2072 * 1024, (size_t)232 * 1024);
  zero_rows(p.cw2k + 64 * 128, 192 * 128);
  zero_rows(p.cw2v + 64 * 128, 192 * 128);
  zero_rows(p.cw1k + (size_t)128 * 2048, (size_t)128 * 2048);
  zero_rows(p.cw1v + (size_t)128 * 2048, (size_t)128 * 2048);
  zero_rows(p.win1t + (size_t)672 * 1024, (size_t)96 * 1024);
  for (int l = 0; l < 2; ++l) { zero_rows(p.rwh[l] + 64 * 1024, 192 * 1024); zero_rows(p.rwl[l] + 64 * 1024, 192 * 1024); }
  if (bid() == 0 && tid < 256) p.cnt[tid] = 0;
  for (int i = bid() * NTHR + tid; i < 4096 * 32; i += gridDim.x * NTHR) {
    const int t = i >> 5, f = i & 31;
    const float ang = (float)t * powf(10000.0f, -2.0f * (float)f / 64.0f);
    p.cs64[i] = make_float2(cosf(ang), sinf(ang));
  }
  for (int i = bid() * NTHR + tid; i < 4096 * 16; i += gridDim.x * NTHR) {
    const int t = i >> 4, f = i & 15;
    const float ang = (float)t * powf(10000.0f, -2.0f * (float)f / 32.0f);
    p.cs32[i] = make_float2(cosf(ang), sinf(ang));
  }
  SUB_BEGIN(10);
  if (bid() == 1 || bid() == 2) {
    const float* pe = bid() == 1 ? p.in[3] : p.in[6];
    const float* w1 = bid() == 1 ? p.in[4] : p.in[7];
    float* dst = bid() == 1 ? p.cb1k : p.cb1v;
    const int j = tid & 127, part = tid >> 7;
    float s = 0.f;
    for (int k0 = part * 512; k0 < part * 512 + 512; k0 += 32) {
      float wv[32], pv[32];
#pragma unroll
      for (int q = 0; q < 32; ++q) { wv[q] = w1[(size_t)(k0 + q) * 128 + j]; pv[q] = pe[k0 + q]; }
#pragma unroll
      for (int q = 0; q < 32; ++q) s = fmaf(pv[q], wv[q], s);
    }
    tile[tid] = s;
    __syncthreads();
    if (tid < 128) dst[tid] = tile[tid] + tile[tid + 128] + tile[tid + 256] + tile[tid + 384];
    __syncthreads();
  }
  SUB_END(10);
  SUB_BEGIN(9);
  int it = 0;
  xpose_matrix(tile, p.in[1], 1024, 2072, p.win0t, 0, nullptr, it);
  xpose_matrix(tile, p.in[9], 1024, 1024, p.wout0t, 0, nullptr, it);
  xpose_matrix(tile, p.in[4], 2048, 128, p.cw1k, 0, nullptr, it);
  xpose_matrix(tile, p.in[7], 2048, 128, p.cw1v, 0, nullptr, it);
  xpose_matrix(tile, p.in[5], 128, 64, p.cw2k, 0, nullptr, it);
  xpose_matrix(tile, p.in[8], 128, 64, p.cw2v, 0, nullptr, it);
  xpose_matrix(tile, p.in[10], 1024, 672, p.win1t, 0, nullptr, it);
  xpose_matrix(tile, p.in[13], 384, 1536, p.wuqt, 0, nullptr, it);
  xpose_matrix(tile, p.in[14], 256, 2048, p.wukvt, 0, nullptr, it);
  xpose_matrix(tile, p.in[15], 1024, 1024, p.wout1t, 0, nullptr, it);
  for (int l = 0; l < 2; ++l) {
    xpose_matrix(tile, p.in[20] + (size_t)l * 65536, 1024, 64, p.rwh[l], 0, p.rwl[l], it);
    xpose_matrix(tile, p.in[25] + (size_t)l * 262144, 1024, 256, p.shgu[l], 1, nullptr, it);
    xpose_matrix(tile, p.in[26] + (size_t)l * 262144, 1024, 256, p.shgu[l], 2, nullptr, it);
    xpose_matrix(tile, p.in[27] + (size_t)l * 262144, 256, 1024, p.shd[l], 0, nullptr, it);
  }
  expert_weights(p, tile, 0, it);
  SUB_END(9);
}

DI void rope64_store(const f32x4* a, const float2* cs, bf16_t* rowp, int fq) {
#pragma unroll
  for (int n = 0; n < 2; ++n) {
    const f32x4 c0 = *(const f32x4*)(cs + n * 16 + 4 * fq), c1 = *(const f32x4*)(cs + n * 16 + 4 * fq + 2);
    const float co[4] = {c0[0], c0[2], c1[0], c1[2]}, si[4] = {c0[1], c0[3], c1[1], c1[3]};
    float y1[4], y2[4];
#pragma unroll
    for (int j = 0; j < 4; ++j) { const float x1 = a[n][j], x2 = a[n + 2][j]; y1[j] = x1 * co[j] - x2 * si[j]; y2[j] = x1 * si[j] + x2 * co[j]; }
    u32x2 w1, w2; w1.x = cvt_pk(y1[0], y1[1]); w1.y = cvt_pk(y1[2], y1[3]); w2.x = cvt_pk(y2[0], y2[1]); w2.y = cvt_pk(y2[2], y2[3]);
    *(u32x2*)(rowp + n * 16 + 4 * fq) = w1;
    *(u32x2*)(rowp + 32 + n * 16 + 4 * fq) = w2;
  }
}
DI void plain64_store(const f32x4* a, bf16_t* rowp, int fq) {
#pragma unroll
  for (int n = 0; n < 4; ++n) {
    u32x2 w; w.x = cvt_pk(a[n][0], a[n][1]); w.y = cvt_pk(a[n][2], a[n][3]);
    *(u32x2*)(rowp + n * 16 + 4 * fq) = w;
  }
}
DI void vt64_store(const f32x4* a, bf16_t* vt_base  , int ld, int tperm, int fq) {
#pragma unroll
  for (int n = 0; n < 4; ++n)
#pragma unroll
    for (int j = 0; j < 4; ++j) vt_base[(size_t)(n * 16 + 4 * fq + j) * ld + tperm] = f2bf(a[n][j]);
}
#define GEMM_IDS() const int tid = thr(), lane = tid & 63, wid = __builtin_amdgcn_readfirstlane(tid >> 6); \
  const int wr = wid >> 1, wc = wid & 1, fr = lane & 15, fq = lane >> 4; const int r0 = tid >> 2, ck = (tid & 3) * 16; (void)lane; (void)wr; (void)wc; (void)fr; (void)fq

DI void phase_inproj0(const Params& p, LAS char* lds) {
  GEMM_IDS();
  for (int i = 0, u; xcd_unit(i, 128 * 9, u); ++i) {
    int mt, nt; mn_order(u, 9, mt, nt);
    const int m0 = mt * 256, n0 = nt * 256;
    const char* a0 = (const char*)(p.xb + (size_t)(m0 + r0) * 1024) + ck;
    const char* b0 = (const char*)(p.win0t + (size_t)(n0 + r0) * 1024) + ck;
    f32x4 acc[4][8]; zero_acc(acc);
    gemm_kloop(lds, a0, a0 + (size_t)128 * 2048, b0, b0 + (size_t)128 * 2048, 32, acc);
#pragma unroll
    for (int g2 = 0; g2 < 2; ++g2) {
      const int G = ((n0 + wc * 128) >> 6) + g2;
#pragma unroll
      for (int m = 0; m < 4; ++m) {
        const int row = m0 + wr * 64 + m * 16 + fr, b = row >> 12, t = row & 4095;
        const float2* cs = p.cs64 + t * 32;
        const f32x4* a = &acc[m][4 * g2];
        if (G < 8) rope64_store(a, cs, p.q0 + ((size_t)(b * 16 + G) * 4096 + t) * 64, fq);
        else if (G < 10) rope64_store(a, cs, p.ka + ((size_t)(b * 2 + (G - 8)) * 4096 + t) * 64, fq);
        else if (G < 12) vt64_store(a, p.vta + (size_t)(b * 2 + (G - 10)) * 64 * 4096, 4096, perm16(t), fq);
        else if (G < 20) rope64_store(a, cs, p.q0 + ((size_t)(b * 16 + 8 + (G - 12)) * 4096 + t) * 64, fq);
        else if (G < 22) plain64_store(a, p.kc0 + ((size_t)(b * 2 + (G - 20)) * 4096 + t) * 64, fq);
        else if (G < 24) plain64_store(a, p.vc0 + ((size_t)(b * 2 + (G - 22)) * 4096 + t) * 64, fq);
        else if (G < 26) rope64_store(a, cs, p.ks + ((size_t)(b * 2 + (G - 24)) * 4096 + t) * 64, fq);
        else if (G < 28) vt64_store(a, p.vts + (size_t)(b * 2 + (G - 26)) * 64 * 4096, 4096, perm16(t), fq);
        else if (G < 30) rope64_store(a, cs, p.kw + ((size_t)(b * 2 + (G - 28)) * 4096 + t) * 64, fq);
        else if (G < 32) vt64_store(a, p.vtw + (size_t)(b * 2 + (G - 30)) * 64 * 4096, 4096, perm16(t), fq);
        else if (G == 32) {
#pragma unroll
          for (int n = 0; n < 2; ++n)
#pragma unroll
            for (int j = 0; j < 4; ++j) { const int cc = n * 16 + 4 * fq + j; if (cc < 24) p.gates[(size_t)row * 24 + cc] = sigmoidf_(a[n][j]); }
        }
        asm volatile("" ::: "memory");
      }
    }
  }
}

DI void phase_outproj(const Params& p, LAS char* lds, int layer) {
  GEMM_IDS();
  const bf16_t* A = layer == 0 ? p.obuf : p.xb;
  const bf16_t* Bt = layer == 0 ? p.wout0t : p.wout1t;
  const float* resid = layer == 0 ? p.in[0] : p.out;
  for (int i = 0, u; xcd_unit(i, 128 * 4, u); ++i) {
    int mt, nt; mn_order(u, 4, mt, nt);
    const int m0 = mt * 256, n0 = nt * 256;
    const char* a0 = (const char*)(A + (size_t)(m0 + r0) * 1024) + ck;
    const char* b0 = (const char*)(Bt + (size_t)(n0 + r0) * 1024) + ck;
    f32x4 acc[4][8]; zero_acc(acc);
    gemm_kloop(lds, a0, a0 + (size_t)128 * 2048, b0, b0 + (size_t)128 * 2048, 32, acc);
#pragma unroll
    for (int m = 0; m < 4; ++m) {
      const size_t row = m0 + wr * 64 + m * 16 + fr;
#pragma unroll
      for (int n = 0; n < 8; ++n) {
        const size_t o = row * 1024 + n0 + wc * 128 + n * 16 + 4 * fq;
        const f32x4 r = *(const f32x4*)(resid + o);
        *(f32x4*)(p.out + o) = r * ALPHA + acc[m][n];
      }
      asm volatile("" ::: "memory");
    }
  }
}

DI float gelu_tanh_(float v) {
  const float u = 0.7978845608028654f * (v + 0.044715f * v * v * v);
  const float e = __expf(2.0f * u);
  const float th = 1.0f - 2.0f / (e + 1.0f);
  return 0.5f * v * (1.0f + th);
}

DI void cmp1_unit(const Params& p, LAS char* lds, int u) {
  GEMM_IDS();
  const int tensor = u >> 4, bg = u & 15;
  const bf16_t* src = (tensor == 0 ? p.kc0 : p.vc0) + (size_t)bg * 4096 * 64;
  const bf16_t* w1 = tensor == 0 ? p.cw1k : p.cw1v;
  const float* bias = tensor == 0 ? p.cb1k : p.cb1v;
  bf16_t* hout = (tensor == 0 ? p.h1k : p.h1v) + (size_t)bg * 256 * 128;
  const int r1 = r0 + 128;
  const char* a0 = (const char*)(src + (size_t)16 * (r0 < 254 ? r0 : 254) * 64) + ck;
  const char* a1 = (const char*)(src + (size_t)16 * (r1 < 254 ? r1 : 254) * 64) + ck;
  const char* b0 = (const char*)(w1 + (size_t)r0 * 2048) + ck;
  f32x4 acc[4][8]; zero_acc(acc);
  gemm_kloop(lds, a0, a1, b0, b0 + (size_t)128 * 4096, 64, acc);
  if (wc == 0) {
#pragma unroll
    for (int m = 0; m < 4; ++m) {
      const int row = wr * 64 + m * 16 + fr;
#pragma unroll
      for (int n = 0; n < 8; ++n) {
        const int cc = n * 16 + 4 * fq;
        const f32x4 bv = *(const f32x4*)(bias + cc);
        u32x2 w; w.x = cvt_pk(gelu_tanh_(acc[m][n][0] + bv[0]), gelu_tanh_(acc[m][n][1] + bv[1]));
        w.y = cvt_pk(gelu_tanh_(acc[m][n][2] + bv[2]), gelu_tanh_(acc[m][n][3] + bv[3]));
        *(u32x2*)(hout + (size_t)row * 128 + cc) = w;
      }
    }
  }
}
DI void phase_cmp2(const Params& p, LAS char* lds) {
  GEMM_IDS();
  for (int u = bid(); u < 32; u += gridDim.x) {
    const int tensor = u >> 4, bg = u & 15;
    const bf16_t* hin = (tensor == 0 ? p.h1k : p.h1v) + (size_t)bg * 256 * 128;
    const bf16_t* w2 = tensor == 0 ? p.cw2k : p.cw2v;
    const char* a0 = (const char*)(hin + (size_t)r0 * 128) + ck;
    const char* b0 = (const char*)(w2 + (size_t)r0 * 128) + ck;
    f32x4 acc[4][8]; zero_acc(acc);
    gemm_kloop(lds, a0, a0 + 128 * 256, b0, b0 + 128 * 256, 4, acc);
    if (wc == 0) {
#pragma unroll
      for (int m = 0; m < 4; ++m) {
        const int n_row = wr * 64 + m * 16 + fr;
        const bool valid = n_row < 255;
        if (!valid) {
#pragma unroll
          for (int n = 0; n < 4; ++n) acc[m][n] = (f32x4){0.f, 0.f, 0.f, 0.f};
        }
        if (tensor == 0) {
          const int pos = valid ? 16 * n_row + 31 : 0;
          rope64_store(&acc[m][0], p.cs64 + pos * 32, p.kcmp + ((size_t)bg * 256 + n_row) * 64, fq);
        } else {
          vt64_store(&acc[m][0], p.vcmpt + (size_t)bg * 64 * 256, 256, perm16(n_row), fq);
        }
      }
    }
  }
}

DI void load_q4(bf16x8 (&qf)[6], const bf16_t* qrow, int h) {
#pragma unroll
  for (int ks = 0; ks < 4; ++ks) qf[ks] = *(const bf16x8*)(qrow + (2 * ks + h) * 8);
}
DI void zero_o(f32x16 (&o)[2]) {
#pragma unroll
  for (int r = 0; r < 16; ++r) { o[0][r] = 0.f; o[1][r] = 0.f; }
}

DI void swa_unit(const Params& p, LAS char* lds, int u) {
  const int tid = thr(), lane = tid & 63, wid = __builtin_amdgcn_readfirstlane(tid >> 6);
  const int r32 = lane & 31, h = lane >> 5;
  const int b = u >> 7, g = (u >> 6) & 1, qb = u & 63, t0 = qb * 64;
  const int hd = g * 4 + (wid & 3), tw0 = t0 + 32 * (wid >> 2), t = tw0 + r32;
  bf16x8 qf[6];
  load_q4(qf, p.q0 + ((size_t)(b * 16 + hd) * 4096 + t) * 64, h);
  f32x16 o[2]; zero_o(o);
  float m = NEGBIG, l = 0.f;
  const float c = 0.125f * LOG2E;
  const int tlo = (t0 - 127) < 0 ? 0 : ((t0 - 127) >> 6);
  const char* kb = (const char*)(p.ka + (size_t)(b * 2 + g) * 4096 * 64);
  const char* vb = (const char*)(p.vta + (size_t)(b * 2 + g) * 64 * 4096);
  kv_stream<false>(lds, kb, vb, 8192, nullptr, tlo, qb, [&](int tile, const LAS char* st) {
    f32x16 sA, sB;
    qk_tile<false>(st, nullptr, qf, r32, h, sA, sB);
    if (!(tile * 64 > tw0 + 31 - 128 && tile * 64 + 63 <= tw0)) mask_scores(sA, sB, tile * 64, t - 128, t, h);
    softmax_step(sA, sB, c, m, l, o);
    pv_tile(st + 8192, sA, sB, r32, h, o);
  });
  float lt = l_total(l);
  lt += fast_exp2(p.in[2][hd] * LOG2E - m * c);
  const float inv = 1.0f / lt;
#pragma unroll
  for (int r = 0; r < 16; ++r) { o[0][r] *= inv; o[1][r] *= inv; }
  store_o((char*)(p.obuf + (size_t)(b * 4096 + t) * 1024 + hd * 64), o, h);
}

constexpr int NSA_CMPK = 0, NSA_CMPV = 32768, NSA_IMP = A_RING > 65536 ? A_RING : 65536, NSA_SELM = NSA_IMP + 64 * 65 * 4, NSA_LDS = NSA_SELM + 512;

DI void nsa_unit(const Params& p, LAS char* lds, int b, int g, int qb) {
  const int tid = thr(), lane = tid & 63, wid = __builtin_amdgcn_readfirstlane(tid >> 6);
  const int r32 = lane & 31, h = lane >> 5;
  const int t0 = qb * 64, qh = wid >> 2, hd = g * 4 + (wid & 3), ql = 32 * qh + r32, t = t0 + ql, tw0 = t0 + 32 * qh;
  const int bg = b * 2 + g;
  bf16x8 qf[6];
  load_q4(qf, p.q0 + ((size_t)(b * 16 + 8 + hd) * 4096 + t) * 64, h);
  const float* gp = p.gates + (size_t)(b * 4096 + t) * 24 + hd;
  const float g_cmp = gp[0], g_sel = gp[8], g_win = gp[16];
  const float c = 0.125f * LOG2E;
  f32x16 ot[2]; zero_o(ot);
  LAS int* imp = (LAS int*)(lds + NSA_IMP);
  LAS unsigned long long* selm = (LAS unsigned long long*)(lds + NSA_SELM);
  {
    const char* ksrc = (const char*)(p.kcmp + (size_t)bg * 256 * 64);
    const char* vsrc = (const char*)(p.vcmpt + (size_t)bg * 64 * 256);
    asm volatile("s_waitcnt vmcnt(0)" ::: "memory");
#pragma unroll
    for (int i = 0; i < 4; ++i) {
      const int pc = tid + 512 * i, row = pc >> 3, cs = ((pc & 7) ^ ((row >> 1) & 7)) << 4;
      glds16(ksrc + (size_t)row * 128 + cs, lds + NSA_CMPK + pc * 16);
      const int d = tid >> 3, cv = ((tid & 7) ^ ((d >> 1) & 7)) << 4;
      glds16(vsrc + (size_t)d * 512 + i * 128 + cv, lds + NSA_CMPV + i * 8192 + tid * 16);
    }
    for (int i = tid; i < 64 * 65; i += NTHR) imp[i] = 0;
    WAIT_VM_BAR(0);
  }
  {
    const int hi_c = (t - 31) >> 4;
    const int nmax = (t0 + 63 - 31) >> 4;
    const int ntile = (nmax >> 6) + 1;
    float m = NEGBIG, l = 0.f;
    for (int j = 0; j < ntile; ++j) {
      f32x16 sA, sB;
      qk_tile<false>(lds + NSA_CMPK + j * 8192, nullptr, qf, r32, h, sA, sB);
      mask_scores(sA, sB, j * 64, -1000000, hi_c, h);
      const float mnew = fmaxf(m, row_max32(sA, sB));
      const float mc = (mnew < -1e29f) ? 0.f : mnew * c;
      float sum = 0.f;
#pragma unroll
      for (int r = 0; r < 16; ++r) sum += fast_exp2(__builtin_fmaf(sA[r], c, -mc)) + fast_exp2(__builtin_fmaf(sB[r], c, -mc));
      l = l * fast_exp2(m * c - mc) + sum;
      m = mnew;
    }
    const float lt = l_total(l);
    const float inv = lt > 0.f ? 1.0f / lt : 0.f;
    const float mc = (m < -1e29f) ? 0.f : m * c;
    f32x16 oc[2]; zero_o(oc);
    for (int j = 0; j < ntile; ++j) {
      f32x16 sA, sB;
      qk_tile<false>(lds + NSA_CMPK + j * 8192, nullptr, qf, r32, h, sA, sB);
      mask_scores(sA, sB, j * 64, -1000000, hi_c, h);
#pragma unroll
      for (int r = 0; r < 16; ++r) { sA[r] = fast_exp2(__builtin_fmaf(sA[r], c, -mc)) * inv; sB[r] = fast_exp2(__builtin_fmaf(sB[r], c, -mc)) * inv; }
#pragma unroll
      for (int q4 = 0; q4 < 4; ++q4) {
        const int mb = 16 * j + 2 * q4 + h;
        const float a0 = sA[4 * q4] + sA[4 * q4 + 1] + sA[4 * q4 + 2] + 0.5f * sA[4 * q4 + 3];
        const float a1 = sB[4 * q4] + sB[4 * q4 + 1] + sB[4 * q4 + 2] + 0.5f * sB[4 * q4 + 3];
        const float FX = 16777216.0f;
        atomicAdd((int*)(imp + ql * 65 + mb), __float2int_rn(a0 * FX));
        atomicAdd((int*)(imp + ql * 65 + mb + 1), __float2int_rn(0.5f * sA[4 * q4 + 3] * FX));
        atomicAdd((int*)(imp + ql * 65 + mb + 8), __float2int_rn(a1 * FX));
        if (mb + 9 < 64) atomicAdd((int*)(imp + ql * 65 + mb + 9), __float2int_rn(0.5f * sB[4 * q4 + 3] * FX));
      }
      pv_tile(lds + NSA_CMPV + j * 8192, sA, sB, r32, h, oc);
    }
#pragma unroll
    for (int r = 0; r < 16; ++r) { ot[0][r] = g_cmp * oc[0][r]; ot[1][r] = g_cmp * oc[1][r]; }
  }
  LDS_BAR();
  for (int i = 0; i < 8; ++i) {
    const int q = wid * 8 + i, tq = t0 + q;
    const int iv = imp[q * 65 + lane];
    const bool forced = (lane == 0) || (lane == qb) || (lane == qb - 1);
    const bool future = lane * 64 > tq;
    unsigned key = forced ? 0x80000001u : (future ? 1u : (unsigned)iv + 2u);
    unsigned long long picked = 0ull;
#pragma unroll 4
    for (int k = 0; k < 16; ++k) {
      const unsigned mx = wave_max_u32(key);
      const int idx = __builtin_ctzll(__ballot(key == mx));
      picked |= 1ull << idx;
      key = (lane == idx) ? 0u : key;
    }
    if (lane == 0) selm[q] = picked;
  }
  LDS_BAR();
  const unsigned long long mysel = selm[ql];
  {
    f32x16 o[2]; zero_o(o);
    float m = NEGBIG, l = 0.f;
    const char* kb = (const char*)(p.ks + (size_t)bg * 4096 * 64);
    const char* vb = (const char*)(p.vts + (size_t)bg * 64 * 4096);
    kv_stream<false>(lds, kb, vb, 8192, nullptr, 0, qb, [&](int tile, const LAS char* st) {
      f32x16 sA, sB;
      qk_tile<false>(st, nullptr, qf, r32, h, sA, sB);
      const bool keep = (mysel >> tile) & 1ull;
      if (tile < qb) mask_lane(sA, sB, keep); else mask_scores(sA, sB, tile * 64, -1000000, keep ? t : -1, h);
      softmax_step(sA, sB, c, m, l, o);
      pv_tile(st + 8192, sA, sB, r32, h, o);
    });
    const float lt = l_total(l);
    const float sc = lt > 0.f ? g_sel / lt : 0.f;
#pragma unroll
    for (int r = 0; r < 16; ++r) { ot[0][r] += sc * o[0][r]; ot[1][r] += sc * o[1][r]; }
  }
  {
    f32x16 o[2]; zero_o(o);
    float m = NEGBIG, l = 0.f;
    const char* kb = (const char*)(p.kw + (size_t)bg * 4096 * 64);
    const char* vb = (const char*)(p.vtw + (size_t)bg * 64 * 4096);
    const int tlo = (t0 - 511) < 0 ? 0 : ((t0 - 511) >> 6);
    kv_stream<false>(lds, kb, vb, 8192, nullptr, tlo, qb, [&](int tile, const LAS char* st) {
      f32x16 sA, sB;
      qk_tile<false>(st, nullptr, qf, r32, h, sA, sB);
      if (!(tile * 64 > tw0 + 31 - 512 && tile * 64 + 63 <= tw0)) mask_scores(sA, sB, tile * 64, t - 512, t, h);
      softmax_step(sA, sB, c, m, l, o);
      pv_tile(st + 8192, sA, sB, r32, h, o);
    });
    const float lt = l_total(l);
    const float sc = lt > 0.f ? g_win / lt : 0.f;
#pragma unroll
    for (int r = 0; r < 16; ++r) { ot[0][r] += sc * o[0][r]; ot[1][r] += sc * o[1][r]; }
  }
  store_o((char*)(p.obuf + (size_t)(b * 4096 + t) * 1024 + 512 + hd * 64), ot, h);
}

DI void phase_swa_cmp1(const Params& p, LAS char* lds) {
  if (bid() < 32) cmp1_unit(p, lds, bid());
  for (int i = 0, u; xcd_unit(i, 1024, u); ++i) swa_unit(p, lds, u);
}
DI void phase_nsa(const Params& p, LAS char* lds) {
  const int G = gridDim.x;
  if ((G & 7) == 0 && G >= 16) {
    const int per = G >> 3, x = bid() & 7, jb = bid() >> 3;
    for (int j = 0; j * per < 128; ++j) {
      const int pos = (j & 1) ? j * per + (per - 1 - jb) : j * per + jb;
      if (pos < 128) { const int bg = 2 * x + (pos & 1); nsa_unit(p, lds, bg >> 1, bg & 1, 63 - (pos >> 1)); }
    }
  } else {
    for (int j = 0;; ++j) {
      const int pos = (j & 1) ? j * G + (G - 1 - (int)bid()) : j * G + (int)bid();
      if (j * G >= 1024) break;
      if (pos < 1024) nsa_unit(p, lds, (pos & 15) >> 1, pos & 1, 63 - (pos >> 4));
    }
  }
}

DI void mla_unit(const Params& p, LAS char* lds, int b, int hd, int qb4) {
  const int tid = thr(), lane = tid & 63, wid = __builtin_amdgcn_readfirstlane(tid >> 6);
  const int r32 = lane & 31, h = lane >> 5;
  const int tw0 = qb4 * 256 + 32 * wid, t = tw0 + r32;
  const bf16_t* qrow = p.q1 + ((size_t)(b * 16 + hd) * 4096 + t) * 96;
  bf16x8 qf[6];
#pragma unroll
  for (int ks = 0; ks < 6; ++ks) qf[ks] = *(const bf16x8*)(qrow + (2 * ks + h) * 8);
  f32x16 o[2]; zero_o(o);
  float m = NEGBIG, l = 0.f;
  const float c = 0.10206207261596577f * LOG2E;
  const char* kb = (const char*)(p.kn + (size_t)(b * 16 + hd) * 4096 * 64);
  const char* vb = (const char*)(p.vt1 + (size_t)(b * 16 + hd) * 64 * 4096);
  const char* rb = (const char*)(p.krb + (size_t)b * 4096 * 32);
  kv_stream<true>(lds, kb, vb, 8192, rb, 0, qb4 * 4 + 3, [&](int tile, const LAS char* st) {
    if (tile * 64 <= tw0 + 31) {
      f32x16 sA, sB;
      qk_tile<true>(st, st + 16384, qf, r32, h, sA, sB);
      if (tile * 64 + 63 > tw0) mask_scores(sA, sB, tile * 64, -1000000, t, h);
      softmax_step(sA, sB, c, m, l, o);
      pv_tile(st + 8192, sA, sB, r32, h, o);
    }
  });
  const float inv = 1.0f / l_total(l);
#pragma unroll
  for (int r = 0; r < 16; ++r) { o[0][r] *= inv; o[1][r] *= inv; }
  store_o((char*)(p.xb + (size_t)(b * 4096 + t) * 1024 + hd * 64), o, h);
}
DI void phase_mla(const Params& p, LAS char* lds) {
  const int G = gridDim.x;
  if ((G & 7) == 0 && G >= 16) {
    const int per = G >> 3, x = bid() & 7, jb = bid() >> 3;
    for (int j = 0; j * per < 256; ++j) {
      const int pos = (j & 1) ? j * per + (per - 1 - jb) : j * per + jb;
      if (pos < 256) { const int bh = 16 * x + (pos & 15); mla_unit(p, lds, bh >> 4, bh & 15, 15 - (pos >> 4)); }
    }
  } else {
    for (int j = 0;; ++j) {
      const int pos = (j & 1) ? j * G + (G - 1 - (int)bid()) : j * G + (int)bid();
      if (j * G >= 2048) break;
      if (pos < 2048) mla_unit(p, lds, (pos & 127) >> 4, pos & 15, 15 - (pos >> 7));
    }
  }
}
DI void ln_row(const f32x4 (&v)[4], const float* gam, const float* bet, int lane, f32x4 (&y)[4]) {
  float s = 0.f;
#pragma unroll
  for (int j = 0; j < 4; ++j) s += (v[j][0] + v[j][1]) + (v[j][2] + v[j][3]);
  const float mu = wave_sum(s) * (1.0f / 1024.0f);
  float q = 0.f;
  f32x4 d[4];
#pragma unroll
  for (int j = 0; j < 4; ++j) { d[j] = v[j] - mu; q += (d[j][0] * d[j][0] + d[j][1] * d[j][1]) + (d[j][2] * d[j][2] + d[j][3] * d[j][3]); }
  const float rs = rsqrtf(wave_sum(q) * (1.0f / 1024.0f) + 1e-5f);
#pragma unroll
  for (int j = 0; j < 4; ++j) {
    const f32x4 gv = *(const f32x4*)(gam + 4 * lane + 256 * j), bv = *(const f32x4*)(bet + 4 * lane + 256 * j);
    y[j] = d[j] * rs * gv + bv;
  }
}
DI void phase_lnsplit(const Params& p, int layer) {
  const int lane = thr() & 63, gw = bid() * 8 + (thr() >> 6), nw = gridDim.x * 8;
  const float* gam = p.in[16] + layer * 1024;
  const float* bet = p.in[17] + layer * 1024;
  for (int row = gw; row < NTOK; row += nw) {
    float* xr = p.out + (size_t)row * 1024;
    f32x4 v[4], y[4];
#pragma unroll
    for (int j = 0; j < 4; ++j) v[j] = *(const f32x4*)(xr + 4 * lane + 256 * j);
    ln_row(v, gam, bet, lane, y);
#pragma unroll
    for (int j = 0; j < 4; ++j) {
      *(f32x4*)(xr + 4 * lane + 256 * j) = y[j];
      u32x2 hi; hi.x = cvt_pk(y[j][0], y[j][1]); hi.y = cvt_pk(y[j][2], y[j][3]);
      const float r0 = y[j][0] - __uint_as_float(hi.x << 16), r1 = y[j][1] - __uint_as_float(hi.x & 0xffff0000u);
      const float r2 = y[j][2] - __uint_as_float(hi.y << 16), r3 = y[j][3] - __uint_as_float(hi.y & 0xffff0000u);
      u32x2 lo; lo.x = cvt_pk(r0, r1); lo.y = cvt_pk(r2, r3);
      *(u32x2*)(p.xb + (size_t)row * 1024 + 4 * lane + 256 * j) = hi;
      *(u32x2*)(p.x1lo + (size_t)row * 1024 + 4 * lane + 256 * j) = lo;
    }
  }
}

constexpr int LIST_CAP = 32768;
DI void phase_router(const Params& p, LAS char* lds, int layer) {
  GEMM_IDS();
  LAS float* lg = (LAS float*)lds;
  LAS int* hist = (LAS int*)(lds + 256 * 65 * 4);
  LAS int* se = hist + 128;
  LAS float* sw = (LAS float*)(se + 256 * 6);
  const int half_tokens = NTOK / p.nsplit, cap = LIST_CAP / p.nsplit;
  const float* bias = p.in[21] + layer * 64;
  for (int u = bid(); u < 128; u += gridDim.x) {
    const int m0 = u * 256;
    const size_t aro = (size_t)(m0 + r0) * 2048 + ck, bro = (size_t)r0 * 2048 + ck, h128 = (size_t)128 * 2048;
    f32x4 acc[4][8]; zero_acc(acc);
    SUB_BEGIN(1);
    gemm_kloop(lds, (const char*)p.xb + aro, (const char*)p.xb + aro + h128, (const char*)p.rwh[layer] + bro, (const char*)p.rwh[layer] + bro + h128, 32, acc);
    gemm_kloop(lds, (const char*)p.x1lo + aro, (const char*)p.x1lo + aro + h128, (const char*)p.rwh[layer] + bro, (const char*)p.rwh[layer] + bro + h128, 32, acc);
    gemm_kloop(lds, (const char*)p.xb + aro, (const char*)p.xb + aro + h128, (const char*)p.rwl[layer] + bro, (const char*)p.rwl[layer] + bro + h128, 32, acc);
    SUB_END(1);
    if (wc == 0) {
#pragma unroll
      for (int m = 0; m < 4; ++m)
#pragma unroll
        for (int n = 0; n < 4; ++n)
#pragma unroll
          for (int j = 0; j < 4; ++j) lg[(wr * 64 + m * 16 + fr) * 65 + n * 16 + 4 * fq + j] = acc[m][n][j];
    }
    if (tid < 64) hist[tid] = 0;
    LDS_BAR();
    const float be = bias[lane];
    SUB_BEGIN(2);
    for (int i = 0; i < 32; ++i) {
      const int r = wid * 32 + i;
      const float s = sigmoidf_(lg[r * 65 + lane]);
      const float sb = s + be;
      float m1 = sb, m2 = -INFINITY;
#define TOP2_STEP(ctrl) do { const float o1 = __int_as_float(__builtin_amdgcn_update_dpp(0, __float_as_int(m1), (ctrl), 0xF, 0xF, true)); \
        const float o2 = __int_as_float(__builtin_amdgcn_update_dpp(0, __float_as_int(m2), (ctrl), 0xF, 0xF, true)); \
        const float n1 = fmaxf(m1, o1); m2 = fmaxf(fminf(m1, o1), fmaxf(m2, o2)); m1 = n1; } while (0)
      TOP2_STEP(0xB1); TOP2_STEP(0x4E); TOP2_STEP(0x141);
#undef TOP2_STEP
      const float gs = m1 + m2;
      unsigned gk = ((lane & 7) == 0) ? fkey(gs) : 0u;
      unsigned gmask = 0u;
#pragma unroll
      for (int k = 0; k < 4; ++k) {
        const unsigned mx = wave_max_u32(gk);
        const int idx = __builtin_ctzll(__ballot(gk == mx));
        gmask |= 1u << (idx >> 3);
        gk = (lane == idx) ? 0u : gk;
      }
      const bool allowed = (gmask >> (lane >> 3)) & 1u;
      unsigned ek = allowed ? fkey(sb) : 0u;
      int myslot = -1;
      float sum = 0.f;
#pragma unroll
      for (int k = 0; k < 6; ++k) {
        const unsigned mx = wave_max_u32(ek);
        const int idx = __builtin_ctzll(__ballot(ek == mx));
        sum += __int_as_float(__builtin_amdgcn_readlane(__float_as_int(s), idx));
        if (lane == idx) { myslot = k; ek = 0u; }
      }
      if (myslot >= 0) {
        const int lp = atomicAdd((int*)(hist + lane), 1);
        se[r * 6 + myslot] = lane | (lp << 8);
        sw[r * 6 + myslot] = s / sum * 2.5f;
      }
    }
    LDS_BAR();
    SUB_END(2);
    SUB_BEGIN(3);
    const int half = m0 / half_tokens;
    if (tid < 64) hist[64 + tid] = atomicAdd(p.cnt + (layer * 2 + half) * 64 + tid, hist[tid]);
    LDS_BAR();
    for (int i = tid; i < 256 * 6; i += NTHR) {
      const int v = se[i], e = v & 255, lp = v >> 8, r = i / 6, slot = i - r * 6;
      const int tok = m0 + r;
      p.lists[((size_t)half * 64 + e) * cap + hist[64 + e] + lp] = make_int2(tok * 8 + slot, __float_as_int(sw[i]));
    }
    LDS_BAR();
    SUB_END(3);
  }
}

DI void expert_map(const Params& p, LAS int* tb, int layer, int half) {
  if (thr() < 64) {
    const int c = p.cnt[(layer * 2 + half) * 64 + thr()];
    int t = (c + 255) >> 8, incl = t;
#pragma unroll
    for (int o = 1; o < 64; o <<= 1) { const int v = __shfl_up(incl, o); if ((int)thr() >= o) incl += v; }
    tb[thr()] = incl - t;
    if (thr() == 63) tb[64] = incl;
    tb[65 + thr()] = c;
  }
  LDS_BAR();
}
DI int find_expert(const LAS int* tb, int mt) {
  int e = 0;
#pragma unroll 8
  for (int i = 1; i < 64; ++i) e = (tb[i] <= mt) ? i : e;
  return e;
}
DI void phase_exp1(const Params& p, LAS char* lds, int layer, int half) {
  GEMM_IDS();
  LAS int* tb = (LAS int*)(lds + MISC_OFF);
  expert_map(p, tb, layer, half);
  const int half_tokens = NTOK / p.nsplit, cap = LIST_CAP / p.nsplit;
  const int TR = tb[64], TS = half_tokens / 256;
  for (int pass = 0; pass < 2; ++pass)
  for (int i = 0, u; xcd_unit(i, (pass == 0 ? TR : TS) * 2, u); ++i) {
    const int mt = (u >> 1) + (pass == 0 ? 0 : TR), nt = u & 1;
    const bf16_t* W;
    int tok0, tok1;
    if (mt < TR) {
      const int e = find_expert(tb, mt), cnt = tb[65 + e];
      const int2* lst = p.lists + ((size_t)half * 64 + e) * cap;
      const int i0 = (mt - tb[e]) * 256 + r0, i1 = i0 + 128;
      tok0 = lst[i0 < cnt ? i0 : 0].x >> 3;
      tok1 = lst[i1 < cnt ? i1 : 0].x >> 3;
      W = p.egu + (size_t)e * 524288;
    } else {
      tok0 = half * half_tokens + (mt - TR) * 256 + r0; tok1 = tok0 + 128;
      W = p.shgu[layer];
    }
    const char* a0 = (const char*)(p.xb + (size_t)tok0 * 1024) + ck;
    const char* a1 = (const char*)(p.xb + (size_t)tok1 * 1024) + ck;
    const char* b0 = (const char*)(W + (size_t)(nt * 256 + r0) * 1024) + ck;
    f32x4 acc[4][8]; zero_acc(acc);
    gemm_kloop(lds, a0, a1, b0, b0 + (size_t)128 * 2048, 32, acc);
    {
#pragma unroll
      for (int m = 0; m < 4; ++m) {
        LAS char* hr = lds + (wr * 64 + m * 16 + fr) * 272 + (wc * 64 + 4 * fq) * 2;
#pragma unroll
        for (int g2 = 0; g2 < 2; ++g2)
#pragma unroll
          for (int n = 0; n < 2; ++n) {
            float hv[4];
#pragma unroll
            for (int j = 0; j < 4; ++j) { const float gt = acc[m][4 * g2 + n][j]; hv[j] = gt / (1.0f + __expf(-gt)) * acc[m][4 * g2 + n + 2][j]; }
            u32x2 w; w.x = cvt_pk(hv[0], hv[1]); w.y = cvt_pk(hv[2], hv[3]);
            *(LAS u32x2*)(hr + g2 * 64 + n * 32) = w;
          }
      }
      LDS_BAR();
#pragma unroll 2
      for (int i = 0; i < 8; ++i) {
        const int c = tid + 512 * i, row = c >> 4, ch = c & 15;
        *(u32x4*)((char*)(p.hbuf + (size_t)(mt * 256 + row) * 256 + nt * 128) + ch * 16) = *(const LAS u32x4*)(lds + row * 272 + ch * 16);
      }
      LDS_BAR();
    }
  }
}
DI void phase_exp2(const Params& p, LAS char* lds, int layer, int half) {
  GEMM_IDS();
  LAS int* tb = (LAS int*)(lds + MISC_OFF);
  expert_map(p, tb, layer, half);
  const int half_tokens = NTOK / p.nsplit, cap = LIST_CAP / p.nsplit;
  const int TR = tb[64], TS = half_tokens / 256;
  for (int pass = 0; pass < 2; ++pass)
  for (int i = 0, u; xcd_unit(i, (pass == 0 ? TR : TS) * 4, u); ++i) {
    const int mt = (u >> 2) + (pass == 0 ? 0 : TR), nt = u & 3;
    int e = 0, cnt = 0, ib = 0;
    const bf16_t* W;
    if (mt < TR) { e = find_expert(tb, mt); cnt = tb[65 + e]; ib = (mt - tb[e]) * 256; W = p.ed + (size_t)e * 262144; }
    else W = p.shd[layer];
    const char* a0 = (const char*)(p.hbuf + (size_t)(mt * 256 + r0) * 256) + ck;
    const char* b0 = (const char*)(W + (size_t)(nt * 256 + r0) * 256) + ck;
    f32x4 acc[4][8]; zero_acc(acc);
    gemm_kloop(lds, a0, a0 + 128 * 512, b0, b0 + 128 * 512, 8, acc);
    if (mt < TR) {
      const int2* lst = p.lists + ((size_t)half * 64 + e) * cap;
      LAS int* ri = (LAS int*)(lds + MISC_OFF + 1024);
      if (tid < 256) { const int idx = ib + tid; int2 en = make_int2(-1, 0); if (idx < cnt) en = lst[idx]; ri[2 * tid] = en.x; ri[2 * tid + 1] = en.y; }
      LDS_BAR();
#pragma unroll
      for (int m = 0; m < 4; ++m) {
        const int r = wr * 64 + m * 16 + fr;
        const float w = __int_as_float(ri[2 * r + 1]);
        LAS char* cr = lds + r * 528 + (wc * 128 + 4 * fq) * 2;
#pragma unroll
        for (int n = 0; n < 8; ++n) { u32x2 v; v.x = cvt_pk(acc[m][n][0] * w, acc[m][n][1] * w); v.y = cvt_pk(acc[m][n][2] * w, acc[m][n][3] * w); *(LAS u32x2*)(cr + n * 32) = v; }
      asm volatile("" ::: "memory");
      }
      LDS_BAR();
#pragma unroll 2
      for (int i = 0; i < 16; ++i) {
        const int c = tid + 512 * i, row = c >> 5, ch = c & 31;
        const int ex = ri[2 * row];
        if (ex >= 0) {
          const int tok = ex >> 3, slot = ex & 7;
          *(u32x4*)((char*)(p.slab + ((size_t)(tok - half * half_tokens) * 6 + slot) * 1024 + nt * 256) + ch * 16) = *(const LAS u32x4*)(lds + row * 528 + ch * 16);
        }
      }
      LDS_BAR();
    } else {
#pragma unroll
      for (int m = 0; m < 4; ++m) {
        const size_t tok = (size_t)half * half_tokens + (mt - TR) * 256 + wr * 64 + m * 16 + fr;
        float* orow = p.out + tok * 1024 + nt * 256 + wc * 128 + 4 * fq;
#pragma unroll
        for (int n = 0; n < 8; ++n) { const f32x4 r = *(const f32x4*)(orow + n * 16); *(f32x4*)(orow + n * 16) = r * ALPHA + acc[m][n]; if (n & 1) asm volatile("" ::: "memory"); }
      asm volatile("" ::: "memory");
      }
    }
  }
}
DI void phase_combine(const Params& p, int layer, int half) {
  const int lane = thr() & 63, gw = bid() * 8 + (thr() >> 6), nw = gridDim.x * 8;
  const int half_tokens = NTOK / p.nsplit;
  const float* gam = p.in[18] + layer * 1024;
  const float* bet = p.in[19] + layer * 1024;
  for (int r = gw; r < half_tokens; r += nw) {
    const size_t row = (size_t)half * half_tokens + r;
    float* xr = p.out + row * 1024;
    f32x4 v[4], y[4];
#pragma unroll
    for (int j = 0; j < 4; ++j) v[j] = *(const f32x4*)(xr + 4 * lane + 256 * j);
#pragma unroll
    for (int s = 0; s < 6; ++s) {
      const bf16_t* sr = p.slab + ((size_t)r * 6 + s) * 1024;
#pragma unroll
      for (int j = 0; j < 4; ++j) {
        const u32x2 w = *(const u32x2*)(sr + 4 * lane + 256 * j);
        v[j][0] += __uint_as_float(w.x << 16); v[j][1] += __uint_as_float(w.x & 0xffff0000u);
        v[j][2] += __uint_as_float(w.y << 16); v[j][3] += __uint_as_float(w.y & 0xffff0000u);
      }
    }
    ln_row(v, gam, bet, lane, y);
#pragma unroll
    for (int j = 0; j < 4; ++j) {
      *(f32x4*)(xr + 4 * lane + 256 * j) = y[j];
      if (layer == 0) { u32x2 hi; hi.x = cvt_pk(y[j][0], y[j][1]); hi.y = cvt_pk(y[j][2], y[j][3]); *(u32x2*)(p.xb + row * 1024 + 4 * lane + 256 * j) = hi; }
    }
  }
}

DI void phase_inproj1(const Params& p, LAS char* lds) {
  GEMM_IDS();
  for (int i = 0, u; xcd_unit(i, 128 * 3, u); ++i) {
    int mt, nt; mn_order(u, 3, mt, nt);
    const int m0 = mt * 256, n0 = nt * 256;
    const char* a0 = (const char*)(p.xb + (size_t)(m0 + r0) * 1024) + ck;
    const char* b0 = (const char*)(p.win1t + (size_t)(n0 + r0) * 1024) + ck;
    f32x4 acc[4][8]; zero_acc(acc);
    gemm_kloop(lds, a0, a0 + (size_t)128 * 2048, b0, b0 + (size_t)128 * 2048, 32, acc);
#pragma unroll
    for (int m = 0; m < 4; ++m) {
      float* crow_ = p.cbuf + (size_t)(m0 + wr * 64 + m * 16 + fr) * 768 + n0 + wc * 128 + 4 * fq;
#pragma unroll
      for (int n = 0; n < 8; ++n) *(f32x4*)(crow_ + n * 16) = acc[m][n];
      asm volatile("" ::: "memory");
    }
  }
  int it = 0;
  expert_weights(p, (LAS float*)lds, 1, it);
}
DI void phase_mlanorm(const Params& p) {
  const int lane = thr() & 63, gw = bid() * 8 + (thr() >> 6), nw = gridDim.x * 8;
  for (int row = gw; row < NTOK; row += nw) {
    const float* cr = p.cbuf + (size_t)row * 768;
    float q[6], kv[4];
    float ss = 0.f;
#pragma unroll
    for (int j = 0; j < 6; ++j) { q[j] = cr[lane + 64 * j]; ss += q[j] * q[j]; }
    const float rq = rsqrtf(wave_sum(ss) * (1.0f / 384.0f) + 1e-6f);
#pragma unroll
    for (int j = 0; j < 6; ++j) p.cqb[(size_t)row * 384 + lane + 64 * j] = f2bf(q[j] * rq * p.in[11][lane + 64 * j]);
    ss = 0.f;
#pragma unroll
    for (int j = 0; j < 4; ++j) { kv[j] = cr[384 + lane + 64 * j]; ss += kv[j] * kv[j]; }
    const float rk = rsqrtf(wave_sum(ss) * (1.0f / 256.0f) + 1e-6f);
#pragma unroll
    for (int j = 0; j < 4; ++j) p.ckvb[(size_t)row * 256 + lane + 64 * j] = f2bf(kv[j] * rk * p.in[12][lane + 64 * j]);
    if (lane < 16) {
      const float x1 = cr[640 + lane], x2 = cr[656 + lane];
      const float2 cs = p.cs32[(row & 4095) * 16 + lane];
      p.krb[(size_t)row * 32 + lane] = f2bf(x1 * cs.x - x2 * cs.y);
      p.krb[(size_t)row * 32 + 16 + lane] = f2bf(x1 * cs.y + x2 * cs.x);
    }
  }
}
DI void phase_mlaup(const Params& p, LAS char* lds) {
  GEMM_IDS();
  for (int i = 0, u; xcd_unit(i, 128 * 14, u); ++i) {
    const int x8 = u / 224, ul = u - x8 * 224;
    if (ul < 96) {
      int mtl, nt; mn_order(ul, 6, mtl, nt);
      const int mt = x8 * 16 + mtl, m0 = mt * 256, n0 = nt * 256;
      const char* a0 = (const char*)(p.cqb + (size_t)(m0 + r0) * 384) + ck;
      const char* b0 = (const char*)(p.wuqt + (size_t)(n0 + r0) * 384) + ck;
      f32x4 acc[4][8]; zero_acc(acc);
      gemm_kloop(lds, a0, a0 + (size_t)128 * 768, b0, b0 + (size_t)128 * 768, 12, acc);
#pragma unroll
      for (int m = 0; m < 4; ++m) {
        const int row = m0 + wr * 64 + m * 16 + fr, b = row >> 12, t = row & 4095;
#pragma unroll
        for (int pr = 0; pr < 4; ++pr) {
          const int gi = ((n0 + wc * 128) >> 5) + pr, head = gi / 3, part = gi - head * 3;
          bf16_t* dst = p.q1 + ((size_t)(b * 16 + head) * 4096 + t) * 96 + part * 32 + 4 * fq;
          if (part < 2) {
#pragma unroll
            for (int n = 0; n < 2; ++n) { u32x2 w; w.x = cvt_pk(acc[m][2 * pr + n][0], acc[m][2 * pr + n][1]); w.y = cvt_pk(acc[m][2 * pr + n][2], acc[m][2 * pr + n][3]); *(u32x2*)(dst + n * 16) = w; }
          } else {
            const f32x4 c0 = *(const f32x4*)(p.cs32 + t * 16 + 4 * fq), c1 = *(const f32x4*)(p.cs32 + t * 16 + 4 * fq + 2);
            const float co[4] = {c0[0], c0[2], c1[0], c1[2]}, si[4] = {c0[1], c0[3], c1[1], c1[3]};
            float y1[4], y2[4];
#pragma unroll
            for (int j = 0; j < 4; ++j) { const float x1 = acc[m][2 * pr][j], x2 = acc[m][2 * pr + 1][j]; y1[j] = x1 * co[j] - x2 * si[j]; y2[j] = x1 * si[j] + x2 * co[j]; }
            u32x2 w1, w2; w1.x = cvt_pk(y1[0], y1[1]); w1.y = cvt_pk(y1[2], y1[3]); w2.x = cvt_pk(y2[0], y2[1]); w2.y = cvt_pk(y2[2], y2[3]);
            *(u32x2*)(dst) = w1; *(u32x2*)(dst + 16) = w2;
          }
        }
        asm volatile("" ::: "memory");
      }
    } else {
      int mtl, nt; mn_order(ul - 96, 8, mtl, nt);
      const int mt = x8 * 16 + mtl, m0 = mt * 256, n0 = nt * 256;
      const char* a0 = (const char*)(p.ckvb + (size_t)(m0 + r0) * 256) + ck;
      const char* b0 = (const char*)(p.wukvt + (size_t)(n0 + r0) * 256) + ck;
      f32x4 acc[4][8]; zero_acc(acc);
      gemm_kloop(lds, a0, a0 + (size_t)128 * 512, b0, b0 + (size_t)128 * 512, 8, acc);
      const int head = nt * 2 + wc;
#pragma unroll
      for (int m = 0; m < 4; ++m) {
        const int row = m0 + wr * 64 + m * 16 + fr, b = row >> 12, t = row & 4095;
        plain64_store(&acc[m][0], p.kn + ((size_t)(b * 16 + head) * 4096 + t) * 64, fq);
        vt64_store(&acc[m][4], p.vt1 + (size_t)(b * 16 + head) * 64 * 4096, 4096, perm16(t), fq);
      asm volatile("" ::: "memory");
      }
    }
  }
}

constexpr int LDS_BYTES = NSA_LDS > (MISC_OFF + 4096) ? NSA_LDS : (MISC_OFF + 4096);
#ifdef PROBE
constexpr int LDS_TOTAL = 163840;
#else
constexpr int LDS_TOTAL = LDS_BYTES + 64;
#endif
#ifndef ALLCG
#define ALLCG 0
#endif

DI void get_phase(int i, int nsplit, int& ph, int& layer, int& half) {
  const int moe_len = 2 + 3 * nsplit;
  layer = 0; half = 0;
  if (i < 6) { ph = i; return; }
  i -= 6;
  if (i >= moe_len) {
    i -= moe_len; layer = 1;
    if (i < 5) { ph = (i < 4) ? PH_INPROJ1 + i : PH_OUTPROJ; return; }
    i -= 5;
  }
  if (i < 2) { ph = PH_LNSPLIT + i; return; }
  i -= 2; half = i / 3; ph = PH_EXP1 + (i - half * 3);
}
DI int num_phases(int nsplit) { return 6 + 5 + 2 * (2 + 3 * nsplit); }

__global__ void __launch_bounds__(NTHR) fwd_kernel(Params p, int ph_lo, int ph_hi, int use_sync) {
  extern __shared__ __attribute__((aligned(16))) char smem_raw[];
  LAS char* lds = (LAS char*)smem_raw;
  volatile LAS unsigned* bst = (volatile LAS unsigned*)(lds + LDS_BYTES);
  cg::grid_group grid = cg::this_grid();
  XcdBarrier xb;
  if (use_sync) {
    if (threadIdx.x == 0) { bst[0] = 0u; bst[1] = 0u; bst[2] = 0u; bst[3] = 0u; }
    __syncthreads();
    xb = xcd_barrier_post(p.bar, bst);
  }
#ifdef PROBE
  volatile LAS unsigned long long* pacc = (volatile LAS unsigned long long*)(lds + PROBE_LDS_OFF);
  if (blockIdx.x == PROBE_BLK && threadIdx.x == 0) { pacc[0] = 0ull; pacc[1] = __builtin_amdgcn_s_memrealtime(); pacc[2] = 0ull; }
#endif
  for (int i = ph_lo; i < ph_hi; ++i) {
    int ph, layer, half;
    get_phase(i, p.nsplit, ph, layer, half);
    switch (ph) {
      case PH_PREP: phase_prep(p, lds); break;
      case PH_INPROJ0: phase_inproj0(p, lds); break;
      case PH_SWA_CMP1: phase_swa_cmp1(p, lds); break;
      case PH_CMP2: phase_cmp2(p, lds); break;
      case PH_NSA: phase_nsa(p, lds); break;
      case PH_OUTPROJ: phase_outproj(p, lds, layer); break;
      case PH_LNSPLIT: phase_lnsplit(p, layer); break;
      case PH_ROUTER: phase_router(p, lds, layer); break;
      case PH_EXP1: phase_exp1(p, lds, layer, half); break;
      case PH_EXP2: phase_exp2(p, lds, layer, half); break;
      case PH_COMBINE: phase_combine(p, layer, half); break;
      case PH_INPROJ1: phase_inproj1(p, lds); break;
      case PH_MLANORM: phase_mlanorm(p); break;
      case PH_MLAUP: phase_mlaup(p, lds); break;
      case PH_MLAATT: phase_mla(p, lds); break;
      default: break;
    }
    if (use_sync && i + 1 < ph_hi) { if (i == ph_lo || ALLCG) grid.sync(); else xcd_barrier(xb); }
#ifdef PROBE
    if (blockIdx.x == PROBE_BLK && threadIdx.x == 0) { const unsigned long long t_ = __builtin_amdgcn_s_memrealtime(); if ((PROBE_DUR >> i) & 1ull) pacc[0] = pacc[0] + (t_ - pacc[1]); pacc[1] = t_; }
#endif
  }
#ifdef PROBE
#ifdef PROBE_XCC
  {
    if (threadIdx.x == 0) __hip_atomic_store(p.cnt + 512 + blockIdx.x, (int)xb_xcc_id() + 1, __ATOMIC_RELAXED, __HIP_MEMORY_SCOPE_AGENT);
    xcd_barrier(xb);
    if (blockIdx.x == 0 && threadIdx.x == 0) {
      int bad = 0;
      for (int b = 0; b < (int)gridDim.x; ++b) bad += (__hip_atomic_load(p.cnt + 512 + b, __ATOMIC_RELAXED, __HIP_MEMORY_SCOPE_AGENT) != __hip_atomic_load(p.cnt + 512 + (b & 7), __ATOMIC_RELAXED, __HIP_MEMORY_SCOPE_AGENT)) ? 1 : 0;
      pacc[0] = (unsigned long long)bad * 10000ull / 9ull;
    }
  }
#endif
  {
    __syncthreads();
    const unsigned lane_ = __builtin_amdgcn_mbcnt_hi(~0u, __builtin_amdgcn_mbcnt_lo(~0u, 0u));
    if (blockIdx.x == PROBE_BLK && lane_ == 0u && atomicAdd((unsigned*)&bst[2], 1u) == 0u) {
      const unsigned long long td = pacc[0], t0 = __builtin_amdgcn_s_memrealtime();
      while (__builtin_amdgcn_s_memrealtime() - t0 < 9ull * td) __builtin_amdgcn_s_sleep(8);
    }
  }
#endif
}

extern "C" void kernel_launch(void* const* d_in, const int* in_sizes, int n_in, void* d_out, int out_size, void* d_ws, size_t ws_size, hipStream_t stream) {
  static int grid_blocks = 0;
  if (grid_blocks == 0) {
    int dev = 0, cus = 0, per_cu = 0;
    hipGetDevice(&dev);
    hipDeviceGetAttribute(&cus, hipDeviceAttributeMultiprocessorCount, dev);
    hipFuncSetAttribute((const void*)fwd_kernel, hipFuncAttributeMaxDynamicSharedMemorySize, LDS_TOTAL);
    hipOccupancyMaxActiveBlocksPerMultiprocessor(&per_cu, (const void*)fwd_kernel, NTHR, LDS_TOTAL);
    if (per_cu < 1) { fprintf(stderr, "kernel_launch: occupancy query says %d blocks per CU\n", per_cu); per_cu = 1; }
    grid_blocks = cus;
    (void)hipGetLastError();
  }
  Params p;
  memset(&p, 0, sizeof(p));
  for (int i = 0; i < 28; ++i) p.in[i] = (const float*)d_in[i];
  p.out = (float*)d_out;
  char* ws = (char*)d_ws;
  size_t off = 0;
  auto take = [&](size_t bytes) { char* r = ws + off; off += (bytes + 255) & ~(size_t)255; return r; };
  p.bar = (unsigned*)take(XCD_BAR_WORDS * 4);
  p.cnt = (int*)take(4096);
  p.win0t = (bf16_t*)take((size_t)2304 * 1024 * 2); p.wout0t = (bf16_t*)take((size_t)1024 * 1024 * 2);
  p.cw1k = (bf16_t*)take(256 * 2048 * 2); p.cw1v = (bf16_t*)take(256 * 2048 * 2);
  p.cw2k = (bf16_t*)take(256 * 128 * 2); p.cw2v = (bf16_t*)take(256 * 128 * 2);
  p.win1t = (bf16_t*)take((size_t)768 * 1024 * 2); p.wuqt = (bf16_t*)take((size_t)1536 * 384 * 2);
  p.wukvt = (bf16_t*)take((size_t)2048 * 256 * 2); p.wout1t = (bf16_t*)take((size_t)1024 * 1024 * 2);
  for (int l = 0; l < 2; ++l) {
    p.rwh[l] = (bf16_t*)take(256 * 1024 * 2); p.rwl[l] = (bf16_t*)take(256 * 1024 * 2);
    p.shgu[l] = (bf16_t*)take(512 * 1024 * 2); p.shd[l] = (bf16_t*)take(1024 * 256 * 2);
  }
  p.cb1k = (float*)take(128 * 4); p.cb1v = (float*)take(128 * 4);
  p.cs64 = (float2*)take(4096 * 32 * 8); p.cs32 = (float2*)take(4096 * 16 * 8);
  p.egu = (bf16_t*)take((size_t)64 * 524288 * 2); p.ed = (bf16_t*)take((size_t)64 * 262144 * 2);
  p.xb = (bf16_t*)take((size_t)NTOK * 1024 * 2);
  const size_t act0 = off;
  p.q0 = (bf16_t*)take((size_t)NBATCH * 16 * 4096 * 64 * 2);
  const size_t kvb = (size_t)NBATCH * 2 * 4096 * 64 * 2;
  p.ka = (bf16_t*)take(kvb); p.ks = (bf16_t*)take(kvb); p.kw = (bf16_t*)take(kvb); p.kc0 = (bf16_t*)take(kvb); p.vc0 = (bf16_t*)take(kvb);
  p.vta = (bf16_t*)take(kvb); p.vts = (bf16_t*)take(kvb); p.vtw = (bf16_t*)take(kvb);
  p.h1k = (bf16_t*)take(4096 * 128 * 2); p.h1v = (bf16_t*)take(4096 * 128 * 2);
  p.kcmp = (bf16_t*)take(16 * 256 * 64 * 2); p.vcmpt = (bf16_t*)take(16 * 64 * 256 * 2);
  p.gates = (float*)take((size_t)NTOK * 24 * 4);
  p.obuf = (bf16_t*)take((size_t)NTOK * 1024 * 2);
  const size_t end_l0 = off;
  const size_t need1 = act0 + (size_t)NTOK * 1024 * 2 + (size_t)64 * LIST_CAP * 8 + ((size_t)NTOK * 7 + 64 * 256) * 512 + (size_t)NTOK * 6 * 2048 + 4096;
  p.nsplit = ws_size >= need1 ? 1 : 2;
  off = act0;
  p.x1lo = (bf16_t*)take((size_t)NTOK * 1024 * 2);
  p.lists = (int2*)take((size_t)64 * LIST_CAP * 8);
  p.hbuf = (bf16_t*)take(((size_t)(NTOK / p.nsplit) * 7 + 64 * 256) * 512);
  p.slab = (bf16_t*)take((size_t)(NTOK / p.nsplit) * 6 * 2048);
  const size_t end_moe = off;
  off = act0;
  p.cqb = (bf16_t*)take((size_t)NTOK * 384 * 2); p.ckvb = (bf16_t*)take((size_t)NTOK * 256 * 2); p.krb = (bf16_t*)take((size_t)NTOK * 32 * 2);
  p.q1 = (bf16_t*)take((size_t)NTOK * 16 * 96 * 2);
  p.kn = (bf16_t*)take((size_t)NTOK * 16 * 64 * 2);
  p.cbuf = (float*)p.kn;
  p.vt1 = (bf16_t*)take((size_t)NTOK * 16 * 64 * 2);
  const size_t end_l1 = off;
  size_t need = end_l0 > end_moe ? end_l0 : end_moe; if (end_l1 > need) need = end_l1;
  if (need > ws_size) { fprintf(stderr, "kernel_launch: workspace too small: need %zu, have %zu\n", need, ws_size); return; }
  const int n = 6 + 5 + 2 * (2 + 3 * p.nsplit);
  hipMemsetAsync(p.bar, 0, XCD_BAR_WORDS * 4, stream);
#ifdef MULTI_LAUNCH
  for (int i = 0; i < n; ++i) hipLaunchKernelGGL(fwd_kernel, dim3(grid_blocks), dim3(NTHR), LDS_TOTAL, stream, p, i, i + 1, 0);
#else
  int lo = 0, hi = n, us = 1;
  void* args[] = {&p, &lo, &hi, &us};
  hipError_t e = hipLaunchCooperativeKernel((const void*)fwd_kernel, dim3(grid_blocks), dim3(NTHR), args, LDS_TOTAL, stream);
  if (e != hipSuccess) fprintf(stderr, "cooperative launch failed: %s (grid %d)\n", hipGetErrorString(e), grid_blocks);
#endif
}
```

```cpp
#include <hip/hip_runtime.h>
#include <hip/hip_cooperative_groups.h>
#include <stdint.h>
#include <math.h>
#include <cstdio>
#include <cstring>
namespace cg = cooperative_groups;

#define LAS __attribute__((address_space(3)))
#define DI __device__ __forceinline__
typedef unsigned short bf16_t;
typedef short bf16x8 __attribute__((ext_vector_type(8)));
typedef float f32x4 __attribute__((ext_vector_type(4)));
typedef float f32x16 __attribute__((ext_vector_type(16)));
typedef unsigned u32x4 __attribute__((ext_vector_type(4)));
typedef unsigned u32x2 __attribute__((ext_vector_type(2)));

constexpr int NTOK = 32768, SEQ = 4096, NBATCH = 8, DM = 1024;
constexpr int NTHR = 512;
constexpr int PROBE_LDS_OFF = 163840 - 32;
constexpr float ALPHA = 1.4142135623730951f;
constexpr float LOG2E = 1.4426950408889634f;

typedef __bf16 bf16x2_t __attribute__((ext_vector_type(2)));
typedef float f32x2_t __attribute__((ext_vector_type(2)));
DI unsigned cvt_pk(float lo, float hi) { const f32x2_t f = {lo, hi}; return __builtin_bit_cast(unsigned, __builtin_convertvector(f, bf16x2_t)); }
DI bf16_t f2bf(float x) { return (bf16_t)(cvt_pk(x, 0.f) & 0xffffu); }
DI float bf2f(bf16_t b) { return __uint_as_float(((unsigned)b) << 16); }
DI float fast_exp2(float x) { return __builtin_amdgcn_exp2f(x); }
DI float sigmoidf_(float x) { return 1.0f / (1.0f + __expf(-x)); }
DI int crow(int r, int h) { return (r & 3) + 8 * (r >> 2) + 4 * h; }
DI int perm16(int t) { return (t & ~15) | (((t >> 2) & 1) << 3) | (((t >> 3) & 1) << 2) | (t & 3); }
DI void glds16(const void* g, LAS char* l) { __builtin_amdgcn_global_load_lds((const unsigned*)g, (LAS unsigned*)l, 16, 0, 0); }
#define WAIT_VM_BAR(N) asm volatile("s_waitcnt vmcnt(" #N ") lgkmcnt(0)\n\ts_barrier" ::: "memory")
#define LDS_BAR() asm volatile("s_waitcnt lgkmcnt(0)\n\ts_barrier" ::: "memory")
DI int thr() { int t = threadIdx.x; asm volatile("" : "+v"(t)); return t; }
DI int bid() { int b = blockIdx.x; asm volatile("" : "+s"(b)); return b; }
DI bool xcd_unit(int i, int total, int& u) {
  const int g = (int)gridDim.x, b = bid();
  if (g & 7) { u = b + i * g; return u < total; }
  const int per = g >> 3, x = b & 7, j = b >> 3;
  const int base = (int)(((long)total * x) >> 3), end = (int)(((long)total * (x + 1)) >> 3);
  u = base + j + i * per;
  return u < end;
}
DI bool xcd_unit2(int i, int totA, int totB, int& u, bool& isB) {
  const int g = (int)gridDim.x, b = bid();
  if (g & 7) { const int v = b + i * g; isB = v >= totA; u = isB ? v - totA : v; return v < totA + totB; }
  const int per = g >> 3, x = b & 7, j = b >> 3;
  const int a0 = (int)(((long)totA * x) >> 3), a1 = (int)(((long)totA * (x + 1)) >> 3);
  const int b0 = (int)(((long)totB * x) >> 3), b1 = (int)(((long)totB * (x + 1)) >> 3);
  const int li = j + i * per, nA = a1 - a0;
  isB = li >= nA;
  u = isB ? b0 + (li - nA) : a0 + li;
  return li < nA + (b1 - b0);
}
DI void mn_order(int u, int nN, int& mt, int& nt) { const int g4 = 4 * nN, g = u / g4, r = u - g * g4; nt = r >> 2; mt = 4 * g + (r & 3); }
#define DPP_MAX_STEP(k, ctrl) do { const unsigned o_ = (unsigned)__builtin_amdgcn_update_dpp(0, (int)(k), (ctrl), 0xF, 0xF, true); (k) = (k) > o_ ? (k) : o_; } while (0)
DI unsigned wave_max_u32(unsigned k) {
  DPP_MAX_STEP(k, 0xB1);
  DPP_MAX_STEP(k, 0x4E);
  DPP_MAX_STEP(k, 0x141);
  DPP_MAX_STEP(k, 0x140);
  const unsigned m0 = (unsigned)__builtin_amdgcn_readlane((int)k, 0), m1 = (unsigned)__builtin_amdgcn_readlane((int)k, 16);
  const unsigned m2 = (unsigned)__builtin_amdgcn_readlane((int)k, 32), m3 = (unsigned)__builtin_amdgcn_readlane((int)k, 48);
  const unsigned a = m0 > m1 ? m0 : m1, b = m2 > m3 ? m2 : m3;
  return a > b ? a : b;
}
DI unsigned fkey(float x) { const unsigned u = __float_as_uint(x); return (u & 0x80000000u) ? ~u : (u | 0x80000000u); }
DI float wave_sum(float v) {
#pragma unroll
  for (int o = 32; o > 0; o >>= 1) v += __shfl_xor(v, o);
  return v;
}

#ifndef PROBE_BLK
#define PROBE_BLK 0
#endif
#if defined(PROBE) && defined(PROBE_SUBID)
#define SUB_BEGIN(id) do { if ((id) == PROBE_SUBID && blockIdx.x == PROBE_BLK && threadIdx.x == 0) { volatile LAS unsigned long long* q_ = (volatile LAS unsigned long long*)(uintptr_t)PROBE_LDS_OFF; q_[2] = __builtin_amdgcn_s_memrealtime(); } } while (0)
#define SUB_END(id) do { if ((id) == PROBE_SUBID && blockIdx.x == PROBE_BLK && threadIdx.x == 0) { volatile LAS unsigned long long* q_ = (volatile LAS unsigned long long*)(uintptr_t)PROBE_LDS_OFF; q_[0] = q_[0] + (__builtin_amdgcn_s_memrealtime() - q_[2]); } } while (0)
#else
#define SUB_BEGIN(id) do { } while (0)
#define SUB_END(id) do { } while (0)
#endif
#define XB_TMO 0
#define XB_XCNT(j) (16 + 16 * (j))
#define XB_XSUB(j) (272 + 16 * (j))
#define XB_XGEN(j) (528 + 16 * (j))
#define XB_TOP 784
#define XB_TOPGEN 800
#define XCD_BAR_WORDS 1024
#define XB_SPIN_CAP (1u << 22)
typedef __attribute__((address_space(1))) unsigned gu32;
DI unsigned xb_ld(gu32* p) { return __hip_atomic_load(p, __ATOMIC_RELAXED, __HIP_MEMORY_SCOPE_AGENT); }
DI unsigned xb_add(gu32* p, unsigned v) { return __hip_atomic_fetch_add(p, v, __ATOMIC_RELAXED, __HIP_MEMORY_SCOPE_AGENT); }
DI unsigned xb_xcc_id() { return (unsigned)__builtin_amdgcn_s_getreg((3 << 11) | 20) & 0xFu; }
#define XB_SPIN(cond, bar) do { unsigned _sp = 0; while (cond) { __builtin_amdgcn_s_sleep(1); \
    if ((++_sp & 255u) == 0u) { if (xb_ld(&(bar)[XB_TMO])) break; if (_sp > XB_SPIN_CAP) { xb_add(&(bar)[XB_TMO], 1u); break; } } } } while (0)
struct XcdBarrier { gu32* bar; unsigned x; volatile LAS unsigned* st; };
DI XcdBarrier xcd_barrier_post(unsigned* bar_, volatile LAS unsigned* st) {
  gu32* bar = (gu32*)bar_;
  XcdBarrier b; b.bar = bar; b.x = xb_xcc_id(); b.st = st;
  if (threadIdx.x == 0) (void)xb_add(&bar[XB_XCNT(b.x)], 1u);
  return b;
}
DI void xcd_barrier_complete(gu32* bar, unsigned x, unsigned& nloc, unsigned& nx) {
  const unsigned G = gridDim.x;
  unsigned sum, cnt, mine, sp = 0u;
  for (;;) {
    sum = 0u; cnt = 0u; mine = 0u;
#pragma unroll
    for (unsigned j = 0; j < 16; ++j) { const unsigned c = xb_ld(&bar[XB_XCNT(j)]); sum += c; cnt += (c > 0u) ? 1u : 0u; mine = (j == x) ? c : mine; }
    if (sum == G) break;
    __builtin_amdgcn_s_sleep(1);
    if ((++sp & 255u) == 0u) { if (xb_ld(&bar[XB_TMO])) break; if (sp > XB_SPIN_CAP) { xb_add(&bar[XB_TMO], 1u); break; } }
  }
  nloc = mine > 0u ? mine : 1u; nx = cnt > 0u ? cnt : 1u;
}
DI void xcd_barrier(const XcdBarrier& b) {
  asm volatile("s_waitcnt vmcnt(0)" ::: "memory");
  __syncthreads();
  if (threadIdx.x == 0) {
    unsigned long long bar_i = (unsigned long long)b.bar;
    asm volatile("" : "+s"(bar_i));
    gu32* bar = (gu32*)bar_i;
    __builtin_amdgcn_s_waitcnt(0);
    unsigned nloc = b.st[0], nx = b.st[1];
    if (nloc == 0u) { xcd_barrier_complete(bar, b.x, nloc, nx); b.st[0] = nloc; b.st[1] = nx; }
    const unsigned old = xb_add(&bar[XB_XSUB(b.x)], 1u);
    const unsigned gen = old / nloc;
    if (old + 1u == (gen + 1u) * nloc) {
      __builtin_amdgcn_fence(__ATOMIC_RELEASE, "agent");
      asm volatile("s_waitcnt vmcnt(0)" ::: "memory");
      const unsigned og = xb_add(&bar[XB_TOP], 1u);
      const unsigned tg = og / nx;
      if (og + 1u == (tg + 1u) * nx) xb_add(&bar[XB_TOPGEN], 1u);
      else XB_SPIN(xb_ld(&bar[XB_TOPGEN]) == tg, bar);
      __builtin_amdgcn_fence(__ATOMIC_ACQUIRE, "agent");
      xb_add(&bar[XB_XGEN(b.x)], 1u);
      asm volatile("s_waitcnt vmcnt(0)" ::: "memory");
    } else {
      XB_SPIN(xb_ld(&bar[XB_XGEN(b.x)]) == gen, bar);
      __builtin_amdgcn_fence(__ATOMIC_ACQUIRE, "agent");
      asm volatile("s_waitcnt vmcnt(0)" ::: "memory");
    }
  }
  __syncthreads();
}

constexpr int G_STAGE = 32768;
constexpr int G_LDS = 4 * G_STAGE;
constexpr int MISC_OFF = 135168;

DI void gemm_kloop(LAS char* lds, const char* a0, const char* a1, const char* b0, const char* b1, int nk  , f32x4 (&acc)[4][8]) {
  const int tid = thr(), lane = tid & 63, wid = __builtin_amdgcn_readfirstlane(tid >> 6);
  const int wr = wid >> 1, wc = wid & 1, fr = lane & 15, fq = lane >> 4;
  LAS char* dA0 = lds + tid * 16;
  const int aoff = (wr * 64 + fr) * 64 + fq * 16;
  const int boff = 16384 + (wc * 128 + fr) * 64 + fq * 16;
#define G_ISSUE(slot, kt) do { LAS char* _d = dA0 + (slot) * G_STAGE; const size_t _ko = (size_t)(kt) * 64; \
    glds16(a0 + _ko, _d); glds16(a1 + _ko, _d + 8192); glds16(b0 + _ko, _d + 16384); glds16(b1 + _ko, _d + 24576); } while (0)
  G_ISSUE(0, 0);
  if (nk > 1) G_ISSUE(1, 1);
  if (nk > 2) G_ISSUE(2, 2);
  int slot = 0;
  for (int t = 0; t < nk; ++t) {
    SUB_BEGIN(4);
    if (t + 2 < nk) { WAIT_VM_BAR(8); } else if (t + 1 < nk) { WAIT_VM_BAR(4); } else { WAIT_VM_BAR(0); }
    SUB_END(4);
    SUB_BEGIN(5);
    if (t + 3 < nk) { G_ISSUE((slot + 3) & 3, t + 3); }
    const LAS char* base = lds + slot * G_STAGE;
    bf16x8 af[4];
#pragma unroll
    for (int m = 0; m < 4; ++m) af[m] = *(const LAS bf16x8*)(base + aoff + m * 1024);
#pragma unroll
    for (int nh = 0; nh < 2; ++nh) {
      bf16x8 bfr[4];
#pragma unroll
      for (int n = 0; n < 4; ++n) bfr[n] = *(const LAS bf16x8*)(base + boff + (4 * nh + n) * 1024);
#pragma unroll
      for (int m = 0; m < 4; ++m)
#pragma unroll
        for (int n = 0; n < 4; ++n) acc[m][4 * nh + n] = __builtin_amdgcn_mfma_f32_16x16x32_bf16(bfr[n], af[m], acc[m][4 * nh + n], 0, 0, 0);
    }
    slot = (slot + 1) & 3;
    SUB_END(5);
  }
#undef G_ISSUE
  LDS_BAR();
}
DI void zero_acc(f32x4 (&acc)[4][8]) {
#pragma unroll
  for (int m = 0; m < 4; ++m)
#pragma unroll
    for (int n = 0; n < 8; ++n) acc[m][n] = (f32x4){0.f, 0.f, 0.f, 0.f};
}
constexpr int A_STAGE = 20480, A_NST = 3, A_RING = A_NST * A_STAGE;
constexpr float NEGBIG = -1e30f;
#define MFMA32(a, b, c) __builtin_amdgcn_mfma_f32_32x32x16_bf16((a), (b), (c), 0, 0, 0)

template <bool HAS_ROPE>
DI void qk_tile(const LAS char* kt, const LAS char* krt, const bf16x8* qf, int r32, int h, f32x16& sA, f32x16& sB) {
  const int sw = (r32 >> 1) & 7;
  const LAS char* ra = kt + r32 * 128;
  const LAS char* rb = ra + 32 * 128;
  f32x16 z;
#pragma unroll
  for (int i = 0; i < 16; ++i) z[i] = 0.f;
  sA = z; sB = z;
#pragma unroll
  for (int ks = 0; ks < 4; ++ks) {
    const int c = ((2 * ks + h) ^ sw) << 4;
    const bf16x8 ka = *(const LAS bf16x8*)(ra + c);
    const bf16x8 kb = *(const LAS bf16x8*)(rb + c);
    sA = MFMA32(ka, qf[ks], sA);
    sB = MFMA32(kb, qf[ks], sB);
  }
  if (HAS_ROPE) {
    const int sw2 = (r32 >> 2) & 3;
    const LAS char* pa = krt + r32 * 64;
    const LAS char* pb = pa + 32 * 64;
#pragma unroll
    for (int ks = 0; ks < 2; ++ks) {
      const int c = ((2 * ks + h) ^ sw2) << 4;
      const bf16x8 ka = *(const LAS bf16x8*)(pa + c);
      const bf16x8 kb = *(const LAS bf16x8*)(pb + c);
      sA = MFMA32(ka, qf[4 + ks], sA);
      sB = MFMA32(kb, qf[4 + ks], sB);
    }
  }
}

DI bf16x8 pack8(const f32x16& p, int s) {
  u32x4 w;
  w.x = cvt_pk(p[8 * s + 0], p[8 * s + 1]); w.y = cvt_pk(p[8 * s + 2], p[8 * s + 3]);
  w.z = cvt_pk(p[8 * s + 4], p[8 * s + 5]); w.w = cvt_pk(p[8 * s + 6], p[8 * s + 7]);
  return __builtin_bit_cast(bf16x8, w);
}

DI void pv_tile(const LAS char* vt, const f32x16& pA, const f32x16& pB, int r32, int h, f32x16 (&o)[2]) {
  const int sw = (r32 >> 1) & 7;
  const LAS char* r0 = vt + r32 * 128;
  const LAS char* r1 = r0 + 32 * 128;
#pragma unroll
  for (int kk = 0; kk < 4; ++kk) {
    const bf16x8 pt = (kk < 2) ? pack8(pA, kk & 1) : pack8(pB, kk & 1);
    const int c = ((2 * kk + h) ^ sw) << 4;
    const bf16x8 v0 = *(const LAS bf16x8*)(r0 + c);
    const bf16x8 v1 = *(const LAS bf16x8*)(r1 + c);
    o[0] = MFMA32(v0, pt, o[0]);
    o[1] = MFMA32(v1, pt, o[1]);
  }
}

DI void mask_scores(f32x16& sA, f32x16& sB, int key0, int lo, int hi, int h) {
#pragma unroll
  for (int r = 0; r < 16; ++r) {
    const int ka = key0 + crow(r, h), kb = ka + 32;
    sA[r] = (ka > lo && ka <= hi) ? sA[r] : NEGBIG;
    sB[r] = (kb > lo && kb <= hi) ? sB[r] : NEGBIG;
  }
}
DI void mask_lane(f32x16& sA, f32x16& sB, bool keep) {
#pragma unroll
  for (int r = 0; r < 16; ++r) { sA[r] = keep ? sA[r] : NEGBIG; sB[r] = keep ? sB[r] : NEGBIG; }
}
DI float row_max32(const f32x16& sA, const f32x16& sB) {
  float mx = fmaxf(sA[0], sB[0]);
#pragma unroll
  for (int r = 1; r < 16; ++r) mx = fmaxf(mx, fmaxf(sA[r], sB[r]));
  return fmaxf(mx, __shfl_xor(mx, 32));
}
DI void softmax_step(f32x16& sA, f32x16& sB, float c, float& m, float& l, f32x16 (&o)[2]) {
  const float mx = row_max32(sA, sB);
  const float mnew = fmaxf(m, mx);
  const float mc = (mnew < -1e29f) ? 0.f : mnew * c;
  const float alpha = fast_exp2(m * c - mc);
  m = mnew;
  float sum = 0.f;
#pragma unroll
  for (int r = 0; r < 16; ++r) {
    sA[r] = fast_exp2(__builtin_fmaf(sA[r], c, -mc));
    sB[r] = fast_exp2(__builtin_fmaf(sB[r], c, -mc));
    sum += sA[r] + sB[r];
  }
  l = l * alpha + sum;
  if (!__all(alpha == 1.0f)) {
#pragma unroll
    for (int r = 0; r < 16; ++r) { o[0][r] *= alpha; o[1][r] *= alpha; }
  }
}

template <bool HAS_ROPE, class F>
DI void kv_stream(LAS char* ring, const char* kb, const char* vb, size_t vstride, const char* krb, int tile_lo, int tile_hi, F&& per_tile) {
  const int tid = thr();
  const int row = tid >> 3, cs = ((tid & 7) ^ ((row >> 1) & 7)) << 4;
  const char* ksrc = kb + (size_t)row * 128 + cs;
  const char* vsrc = vb + (size_t)row * vstride + cs;
  const int t2 = tid & 255, row2 = t2 >> 2;
  const char* rsrc = krb + (size_t)row2 * 64 + (((t2 & 3) ^ ((row2 >> 2) & 3)) << 4);
  LAS char* dst = ring + tid * 16;
  LAS char* dst2 = ring + 16384 + t2 * 16;
#define A_ISSUE(slot, tl) do { glds16(ksrc + (size_t)(tl) * 8192, dst + (slot) * A_STAGE); glds16(vsrc + (size_t)(tl) * 128, dst + (slot) * A_STAGE + 8192); \
    if (HAS_ROPE) glds16(rsrc + (size_t)(tl) * 4096, dst2 + (slot) * A_STAGE); } while (0)
  if (tile_lo <= tile_hi) A_ISSUE(0, tile_lo);
  if (tile_lo + 1 <= tile_hi) A_ISSUE(1, tile_lo + 1);
  int slot = 0;
  for (int t = tile_lo; t <= tile_hi; ++t) {
    if (HAS_ROPE) SUB_BEGIN(6);
    if (t + 1 <= tile_hi) { if (HAS_ROPE) { WAIT_VM_BAR(3); } else { WAIT_VM_BAR(2); } } else { WAIT_VM_BAR(0); }
    if (HAS_ROPE) SUB_END(6);
    if (HAS_ROPE) SUB_BEGIN(7);
    if (t + 2 <= tile_hi) { int s2 = slot + 2; if (s2 >= 3) s2 -= 3; A_ISSUE(s2, t + 2); }
    per_tile(t, (const LAS char*)(ring + slot * A_STAGE));
    if (HAS_ROPE) SUB_END(7);
    slot = (slot == 2) ? 0 : slot + 1;
  }
#undef A_ISSUE
  LDS_BAR();
}

DI float l_total(float l) { return l + __shfl_xor(l, 32); }

DI void store_o(char* rowp, const f32x16 (&o)[2], int h) {
#pragma unroll
  for (int dd = 0; dd < 2; ++dd)
#pragma unroll
    for (int g = 0; g < 4; ++g) {
      u32x2 w; w.x = cvt_pk(o[dd][4 * g + 0], o[dd][4 * g + 1]); w.y = cvt_pk(o[dd][4 * g + 2], o[dd][4 * g + 3]);
      *(u32x2*)(rowp + (32 * dd + 8 * g + 4 * h) * 2) = w;
    }
}
struct Params {
  const float* in[28];
  float* out;
  unsigned* bar;
  int* cnt;
  bf16_t *win0t, *wout0t, *cw1k, *cw1v, *cw2k, *cw2v, *win1t, *wuqt, *wukvt, *wout1t;
  bf16_t *rwh[2], *rwl[2], *shgu[2], *shd[2];
  bf16_t *egu, *ed;
  float *cb1k, *cb1v;
  float2 *cs64, *cs32;
  bf16_t *xb;
  bf16_t *q0, *ka, *ks, *kw, *kc0, *vc0, *vta, *vts, *vtw, *h1k, *h1v, *kcmp, *vcmpt, *obuf;
  float* gates;
  bf16_t *x1lo, *hbuf, *slab;
  int2* lists;
  float* cbuf;
  bf16_t *cqb, *ckvb, *krb, *q1, *kn, *vt1;
  int nsplit;
  int pad_;
};
enum { PH_PREP = 0, PH_INPROJ0, PH_SWA_CMP1, PH_CMP2, PH_NSA, PH_OUTPROJ, PH_LNSPLIT, PH_ROUTER, PH_EXP1, PH_EXP2, PH_COMBINE, PH_INPROJ1, PH_MLANORM, PH_MLAUP, PH_MLAATT };

DI void xpose_item(LAS float* tile, const float* src, int N, int k0, int n0, bf16_t* dst, int ldd, int mode, bf16_t* dst_lo) {
  const int tid = thr();
  {
    const int n = tid & 63, kk = tid >> 6;
    const bool ok = (n0 + n) < N;
#pragma unroll
    for (int i = 0; i < 8; ++i) { const int k = kk + 8 * i; tile[k * 65 + n] = ok ? src[(size_t)(k0 + k) * N + n0 + n] : 0.f; }
  }
  __syncthreads();
  {
    const int n = tid >> 3, kc = (tid & 7) * 8, gn = n0 + n;
    if (gn < N) {
      float v[8];
#pragma unroll
      for (int j = 0; j < 8; ++j) v[j] = tile[(kc + j) * 65 + n];
      int row = gn;
      if (mode == 1) row = 64 * (gn >> 5) + (gn & 31);
      if (mode == 2) row = 64 * (gn >> 5) + 32 + (gn & 31);
      u32x4 w; w.x = cvt_pk(v[0], v[1]); w.y = cvt_pk(v[2], v[3]); w.z = cvt_pk(v[4], v[5]); w.w = cvt_pk(v[6], v[7]);
      *(u32x4*)(dst + (size_t)row * ldd + k0 + kc) = w;
      if (dst_lo) {
        float r[8];
#pragma unroll
        for (int j = 0; j < 8; ++j) { const unsigned pk = (j & 1) ? (w[j >> 1] >> 16) : (w[j >> 1] & 0xffffu); r[j] = v[j] - __uint_as_float(pk << 16); }
        u32x4 w2; w2.x = cvt_pk(r[0], r[1]); w2.y = cvt_pk(r[2], r[3]); w2.z = cvt_pk(r[4], r[5]); w2.w = cvt_pk(r[6], r[7]);
        *(u32x4*)(dst_lo + (size_t)row * ldd + k0 + kc) = w2;
      }
    }
  }
  __syncthreads();
}
DI void xpose256_load(f32x4 (&v)[8], const float* src, int N, int k0, int n0, int tid) {
  const int n4 = (tid & 63) * 4, kk = tid >> 6;
#pragma unroll
  for (int i = 0; i < 8; ++i) v[i] = *(const f32x4*)(src + (size_t)(k0 + kk + 8 * i) * N + n0 + n4);
}
DI void xpose256_stream(LAS float* tile, const float* src, int K, int N, bf16_t* dst, int mode, int first, int total) {
  const int tid = thr(), nkt = K / 64, G = gridDim.x;
  if (first >= total) return;
  f32x4 v[8];
  xpose256_load(v, src, N, (first % nkt) * 64, (first / nkt) * 256, tid);
  for (int it = first; it < total; it += G) {
    const int k0 = (it % nkt) * 64, n0 = (it / nkt) * 256;
    {
      const int n4 = (tid & 63) * 4, kk = tid >> 6;
#pragma unroll
      for (int i = 0; i < 8; ++i) { LAS float* tp = tile + (kk + 8 * i) * 257 + n4; tp[0] = v[i][0]; tp[1] = v[i][1]; tp[2] = v[i][2]; tp[3] = v[i][3]; }
    }
    __syncthreads();
    if (it + G < total) xpose256_load(v, src, N, ((it + G) % nkt) * 64, ((it + G) / nkt) * 256, tid);
#pragma unroll
    for (int j = 0; j < 4; ++j) {
      const int cix = tid + 512 * j, n = cix >> 3, kc = (cix & 7) * 8, gn = n0 + n;
      float w8[8];
#pragma unroll
      for (int e = 0; e < 8; ++e) w8[e] = tile[(kc + e) * 257 + n];
      int row = gn;
      if (mode == 1) row = 64 * (gn >> 5) + (gn & 31);
      if (mode == 2) row = 64 * (gn >> 5) + 32 + (gn & 31);
      u32x4 w; w.x = cvt_pk(w8[0], w8[1]); w.y = cvt_pk(w8[2], w8[3]); w.z = cvt_pk(w8[4], w8[5]); w.w = cvt_pk(w8[6], w8[7]);
      *(u32x4*)(dst + (size_t)row * K + k0 + kc) = w;
    }
    __syncthreads();
  }
}
DI void xpose_matrix(LAS float* tile, const float* src, int K, int N, bf16_t* dst, int mode, bf16_t* dst_lo, int& itbase) {
  const bool wide = (N % 256 == 0) && dst_lo == nullptr;
  const int nkt = K / 64, nnt = wide ? N / 256 : (N + 63) / 64, total = nkt * nnt;
  int first = (int)((bid() + gridDim.x - (itbase % gridDim.x)) % gridDim.x);
  if (wide) xpose256_stream(tile, src, K, N, dst, mode, first, total);
  else for (int i = first; i < total; i += gridDim.x) xpose_item(tile, src, N, (i % nkt) * 64, (i / nkt) * 64, dst, K, mode, dst_lo);
  itbase += total;
}
DI void zero_rows(bf16_t* dst, size_t nelem) {
  u32x4 z = (u32x4){0u, 0u, 0u, 0u};
  for (size_t i = ((size_t)bid() * NTHR + thr()) * 8; i < nelem; i += (size_t)gridDim.x * NTHR * 8) *(u32x4*)(dst + i) = z;
}
DI void expert_weights(const Params& p, LAS float* tile, int layer, int& it) {
  const size_t eo = (size_t)layer * 64 * 262144;
  for (int e = 0; e < 64; ++e) {
    xpose_matrix(tile, p.in[22] + eo + (size_t)e * 262144, 1024, 256, p.egu + (size_t)e * 524288, 1, nullptr, it);
    xpose_matrix(tile, p.in[23] + eo + (size_t)e * 262144, 1024, 256, p.egu + (size_t)e * 524288, 2, nullptr, it);
    xpose_matrix(tile, p.in[24] + eo + (size_t)e * 262144, 256, 1024, p.ed + (size_t)e * 262144, 0, nullptr, it);
  }
}
DI void phase_prep(const Params& p, LAS char* lds) {
  LAS float* tile = (LAS float*)lds;
  const int tid = thr();
  SUB_BEGIN(8);
  {
    const size_t stride = (size_t)gridDim.x * NTHR * 8;
    for (size_t i = ((size_t)bid() * NTHR + tid) * 8; i < (size_t)NTOK * DM; i += 4 * stride) {
      f32x4 a[4], b[4];
#pragma unroll
      for (int q = 0; q < 4; ++q) { const size_t o = i + q * stride; if (o < (size_t)NTOK * DM) { a[q] = *(const f32x4*)(p.in[0] + o); b[q] = *(const f32x4*)(p.in[0] + o + 4); } }
#pragma unroll
      for (int q = 0; q < 4; ++q) { const size_t o = i + q * stride; if (o < (size_t)NTOK * DM) {
        u32x4 w; w.x = cvt_pk(a[q][0], a[q][1]); w.y = cvt_pk(a[q][2], a[q][3]); w.z = cvt_pk(b[q][0], b[q][1]); w.w = cvt_pk(b[q][2], b[q][3]);
        *(u32x4*)(p.xb + o) = w; } }
    }
  }
  SUB_END(8);
  zero_rows(p.win0t + (size_t)2072 * 1024, (size_t)232 * 1024);
  zero_rows(p.cw2k + 64 * 128, 192 * 128);
  zero_rows(p.cw2v + 64 * 128, 192 * 128);
  zero_rows(p.win1t + (size_t)672 * 1024, (size_t)96 * 1024);
  for (int l = 0; l < 2; ++l) { zero_rows(p.rwh[l] + 64 * 1024, 192 * 1024); zero_rows(p.rwl[l] + 64 * 1024, 192 * 1024); }
  if (bid() == 0 && tid < 256) p.cnt[tid] = 0;
  for (int i = bid() * NTHR + tid; i < 4096 * 32; i += gridDim.x * NTHR) {
    const int t = i >> 5, f = i & 31;
    const float ang = (float)t * powf(10000.0f, -2.0f * (float)f / 64.0f);
    p.cs64[i] = make_float2(cosf(ang), sinf(ang));
  }
  for (int i = bid() * NTHR + tid; i < 4096 * 16; i += gridDim.x * NTHR) {
    const int t = i >> 4, f = i & 15;
    const float ang = (float)t * powf(10000.0f, -2.0f * (float)f / 32.0f);
    p.cs32[i] = make_float2(cosf(ang), sinf(ang));
  }
  SUB_BEGIN(10);
  if (bid() == 1 || bid() == 2) {
    const float* pe = bid() == 1 ? p.in[3] : p.in[6];
    const float* w1 = bid() == 1 ? p.in[4] : p.in[7];
    float* dst = bid() == 1 ? p.cb1k : p.cb1v;
    const int j = tid & 127, part = tid >> 7;
    float s = 0.f;
    for (int k0 = part * 512; k0 < part * 512 + 512; k0 += 32) {
      float wv[32], pv[32];
#pragma unroll
      for (int q = 0; q < 32; ++q) { wv[q] = w1[(size_t)(k0 + q) * 128 + j]; pv[q] = pe[k0 + q]; }
#pragma unroll
      for (int q = 0; q < 32; ++q) s = fmaf(pv[q], wv[q], s);
    }
    tile[tid] = s;
    __syncthreads();
    if (tid < 128) dst[tid] = tile[tid] + tile[tid + 128] + tile[tid + 256] + tile[tid + 384];
    __syncthreads();
  }
  SUB_END(10);
  SUB_BEGIN(9);
  int it = 0;
  xpose_matrix(tile, p.in[1], 1024, 2072, p.win0t, 0, nullptr, it);
  xpose_matrix(tile, p.in[9], 1024, 1024, p.wout0t, 0, nullptr, it);
  xpose_matrix(tile, p.in[4], 1024, 128, p.cw1k, 0, nullptr, it);
  xpose_matrix(tile, p.in[4] + (size_t)1024 * 128, 1024, 128, p.cw1k + (size_t)128 * 1024, 0, nullptr, it);
  xpose_matrix(tile, p.in[7], 1024, 128, p.cw1v, 0, nullptr, it);
  xpose_matrix(tile, p.in[7] + (size_t)1024 * 128, 1024, 128, p.cw1v + (size_t)128 * 1024, 0, nullptr, it);
  xpose_matrix(tile, p.in[5], 128, 64, p.cw2k, 0, nullptr, it);
  xpose_matrix(tile, p.in[8], 128, 64, p.cw2v, 0, nullptr, it);
  xpose_matrix(tile, p.in[10], 1024, 672, p.win1t, 0, nullptr, it);
  xpose_matrix(tile, p.in[13], 384, 1536, p.wuqt, 0, nullptr, it);
  xpose_matrix(tile, p.in[14], 256, 2048, p.wukvt, 0, nullptr, it);
  xpose_matrix(tile, p.in[15], 1024, 1024, p.wout1t, 0, nullptr, it);
  for (int l = 0; l < 2; ++l) {
    xpose_matrix(tile, p.in[20] + (size_t)l * 65536, 1024, 64, p.rwh[l], 0, p.rwl[l], it);
    xpose_matrix(tile, p.in[25] + (size_t)l * 262144, 1024, 256, p.shgu[l], 1, nullptr, it);
    xpose_matrix(tile, p.in[26] + (size_t)l * 262144, 1024, 256, p.shgu[l], 2, nullptr, it);
    xpose_matrix(tile, p.in[27] + (size_t)l * 262144, 256, 1024, p.shd[l], 0, nullptr, it);
  }
  expert_weights(p, tile, 0, it);
  SUB_END(9);
}

DI void rope64_store(const f32x4* a, const float2* cs, bf16_t* rowp, int fq) {
#pragma unroll
  for (int n = 0; n < 2; ++n) {
    const f32x4 c0 = *(const f32x4*)(cs + n * 16 + 4 * fq), c1 = *(const f32x4*)(cs + n * 16 + 4 * fq + 2);
    const float co[4] = {c0[0], c0[2], c1[0], c1[2]}, si[4] = {c0[1], c0[3], c1[1], c1[3]};
    float y1[4], y2[4];
#pragma unroll
    for (int j = 0; j < 4; ++j) { const float x1 = a[n][j], x2 = a[n + 2][j]; y1[j] = x1 * co[j] - x2 * si[j]; y2[j] = x1 * si[j] + x2 * co[j]; }
    u32x2 w1, w2; w1.x = cvt_pk(y1[0], y1[1]); w1.y = cvt_pk(y1[2], y1[3]); w2.x = cvt_pk(y2[0], y2[1]); w2.y = cvt_pk(y2[2], y2[3]);
    *(u32x2*)(rowp + n * 16 + 4 * fq) = w1;
    *(u32x2*)(rowp + 32 + n * 16 + 4 * fq) = w2;
  }
}
DI void plain64_store(const f32x4* a, bf16_t* rowp, int fq) {
#pragma unroll
  for (int n = 0; n < 4; ++n) {
    u32x2 w; w.x = cvt_pk(a[n][0], a[n][1]); w.y = cvt_pk(a[n][2], a[n][3]);
    *(u32x2*)(rowp + n * 16 + 4 * fq) = w;
  }
}
DI void vt64_store(const f32x4* a, bf16_t* vt_base  , int ld, int tperm, int fq) {
#pragma unroll
  for (int n = 0; n < 4; ++n)
#pragma unroll
    for (int j = 0; j < 4; ++j) vt_base[(size_t)(n * 16 + 4 * fq + j) * ld + tperm] = f2bf(a[n][j]);
}
#define GEMM_IDS() const int tid = thr(), lane = tid & 63, wid = __builtin_amdgcn_readfirstlane(tid >> 6); \
  const int wr = wid >> 1, wc = wid & 1, fr = lane & 15, fq = lane >> 4; const int r0 = tid >> 2, ck = (tid & 3) * 16; (void)lane; (void)wr; (void)wc; (void)fr; (void)fq

DI void phase_inproj0(const Params& p, LAS char* lds) {
  GEMM_IDS();
  for (int i = 0, u; xcd_unit(i, 128 * 9, u); ++i) {
    int mt, nt; mn_order(u, 9, mt, nt);
    const int m0 = mt * 256, n0 = nt * 256;
    const char* a0 = (const char*)(p.xb + (size_t)(m0 + r0) * 1024) + ck;
    const char* b0 = (const char*)(p.win0t + (size_t)(n0 + r0) * 1024) + ck;
    f32x4 acc[4][8]; zero_acc(acc);
    gemm_kloop(lds, a0, a0 + (size_t)128 * 2048, b0, b0 + (size_t)128 * 2048, 32, acc);
#pragma unroll
    for (int g2 = 0; g2 < 2; ++g2) {
      const int G = ((n0 + wc * 128) >> 6) + g2;
#pragma unroll
      for (int m = 0; m < 4; ++m) {
        const int row = m0 + wr * 64 + m * 16 + fr, b = row >> 12, t = row & 4095;
        const float2* cs = p.cs64 + t * 32;
        const f32x4* a = &acc[m][4 * g2];
        if (G < 8) rope64_store(a, cs, p.q0 + ((size_t)(b * 16 + G) * 4096 + t) * 64, fq);
        else if (G < 10) rope64_store(a, cs, p.ka + ((size_t)(b * 2 + (G - 8)) * 4096 + t) * 64, fq);
        else if (G < 12) vt64_store(a, p.vta + (size_t)(b * 2 + (G - 10)) * 64 * 4096, 4096, perm16(t), fq);
        else if (G < 20) rope64_store(a, cs, p.q0 + ((size_t)(b * 16 + 8 + (G - 12)) * 4096 + t) * 64, fq);
        else if (G < 22) plain64_store(a, p.kc0 + ((size_t)(b * 2 + (G - 20)) * 4096 + t) * 64, fq);
        else if (G < 24) plain64_store(a, p.vc0 + ((size_t)(b * 2 + (G - 22)) * 4096 + t) * 64, fq);
        else if (G < 26) rope64_store(a, cs, p.ks + ((size_t)(b * 2 + (G - 24)) * 4096 + t) * 64, fq);
        else if (G < 28) vt64_store(a, p.vts + (size_t)(b * 2 + (G - 26)) * 64 * 4096, 4096, perm16(t), fq);
        else if (G < 30) rope64_store(a, cs, p.kw + ((size_t)(b * 2 + (G - 28)) * 4096 + t) * 64, fq);
        else if (G < 32) vt64_store(a, p.vtw + (size_t)(b * 2 + (G - 30)) * 64 * 4096, 4096, perm16(t), fq);
        else if (G == 32) {
#pragma unroll
          for (int n = 0; n < 2; ++n)
#pragma unroll
            for (int j = 0; j < 4; ++j) { const int cc = n * 16 + 4 * fq + j; if (cc < 24) p.gates[(size_t)row * 24 + cc] = sigmoidf_(a[n][j]); }
        }
        asm volatile("" ::: "memory");
      }
    }
  }
}

DI void phase_outproj(const Params& p, LAS char* lds, int layer) {
  GEMM_IDS();
  const bf16_t* A = layer == 0 ? p.obuf : p.xb;
  const bf16_t* Bt = layer == 0 ? p.wout0t : p.wout1t;
  const float* resid = layer == 0 ? p.in[0] : p.out;
  for (int i = 0, u; xcd_unit(i, 128 * 4, u); ++i) {
    int mt, nt; mn_order(u, 4, mt, nt);
    const int m0 = mt * 256, n0 = nt * 256;
    const char* a0 = (const char*)(A + (size_t)(m0 + r0) * 1024) + ck;
    const char* b0 = (const char*)(Bt + (size_t)(n0 + r0) * 1024) + ck;
    f32x4 acc[4][8]; zero_acc(acc);
    gemm_kloop(lds, a0, a0 + (size_t)128 * 2048, b0, b0 + (size_t)128 * 2048, 32, acc);
#pragma unroll
    for (int m = 0; m < 4; ++m) {
      const size_t row = m0 + wr * 64 + m * 16 + fr;
#pragma unroll
      for (int n = 0; n < 8; ++n) {
        const size_t o = row * 1024 + n0 + wc * 128 + n * 16 + 4 * fq;
        const f32x4 r = *(const f32x4*)(resid + o);
        *(f32x4*)(p.out + o) = r * ALPHA + acc[m][n];
      }
      asm volatile("" ::: "memory");
    }
  }
}

DI float gelu_tanh_(float v) {
  const float u = 0.7978845608028654f * (v + 0.044715f * v * v * v);
  const float e = __expf(2.0f * u);
  const float th = 1.0f - 2.0f / (e + 1.0f);
  return 0.5f * v * (1.0f + th);
}

DI void cmp1_unit(const Params& p, LAS char* lds, int u) {
  GEMM_IDS();
  const int tensor = u >> 4, bg = u & 15;
  const bf16_t* src = (tensor == 0 ? p.kc0 : p.vc0) + (size_t)bg * 4096 * 64;
  const bf16_t* w1 = tensor == 0 ? p.cw1k : p.cw1v;
  const float* bias = tensor == 0 ? p.cb1k : p.cb1v;
  bf16_t* hout = (tensor == 0 ? p.h1k : p.h1v) + (size_t)bg * 256 * 128;
  const char* a0 = (const char*)(src + (size_t)r0 * 1024) + ck;
  const char* b0 = (const char*)(w1 + (size_t)r0 * 1024) + ck;
  f32x4 acc[4][8]; zero_acc(acc);
  gemm_kloop(lds, a0, a0 + (size_t)128 * 2048, b0, b0 + (size_t)128 * 2048, 32, acc);
  if (wc == 1) {
#pragma unroll
    for (int m = 0; m < 4; ++m)
#pragma unroll
      for (int n = 0; n < 8; ++n) *(LAS f32x4*)(lds + (wr * 64 + m * 16 + fr) * 528 + (n * 16 + 4 * fq) * 4) = acc[m][n];
  }
  LDS_BAR();
  if (wc == 0) {
#pragma unroll
    for (int m = 0; m < 4; ++m) {
      const int row = wr * 64 + m * 16 + fr;
#pragma unroll
      for (int n = 0; n < 8; ++n) {
        const int cc = n * 16 + 4 * fq;
        const f32x4 bv = *(const f32x4*)(bias + cc);
        f32x4 bot = (f32x4){0.f, 0.f, 0.f, 0.f};
        if (row < 255) bot = *(const LAS f32x4*)(lds + (row + 1) * 528 + cc * 4);
        const f32x4 v = acc[m][n] + bot + bv;
        u32x2 w; w.x = cvt_pk(gelu_tanh_(v[0]), gelu_tanh_(v[1])); w.y = cvt_pk(gelu_tanh_(v[2]), gelu_tanh_(v[3]));
        if (row == 255) { w.x = 0u; w.y = 0u; }
        *(u32x2*)(hout + (size_t)row * 128 + cc) = w;
      }
    }
  }
  LDS_BAR();
}
DI void phase_cmp2(const Params& p, LAS char* lds) {
  GEMM_IDS();
  for (int u = bid(); u < 32; u += gridDim.x) {
    const int tensor = u >> 4, bg = u & 15;
    const bf16_t* hin = (tensor == 0 ? p.h1k : p.h1v) + (size_t)bg * 256 * 128;
    const bf16_t* w2 = tensor == 0 ? p.cw2k : p.cw2v;
    const char* a0 = (const char*)(hin + (size_t)r0 * 128) + ck;
    const char* b0 = (const char*)(w2 + (size_t)r0 * 128) + ck;
    f32x4 acc[4][8]; zero_acc(acc);
    gemm_kloop(lds, a0, a0 + 128 * 256, b0, b0 + 128 * 256, 4, acc);
    if (wc == 0) {
#pragma unroll
      for (int m = 0; m < 4; ++m) {
        const int n_row = wr * 64 + m * 16 + fr;
        const bool valid = n_row < 255;
        if (!valid) {
#pragma unroll
          for (int n = 0; n < 4; ++n) acc[m][n] = (f32x4){0.f, 0.f, 0.f, 0.f};
        }
        if (tensor == 0) {
          const int pos = valid ? 16 * n_row + 31 : 0;
          rope64_store(&acc[m][0], p.cs64 + pos * 32, p.kcmp + ((size_t)bg * 256 + n_row) * 64, fq);
        } else {
          vt64_store(&acc[m][0], p.vcmpt + (size_t)bg * 64 * 256, 256, perm16(n_row), fq);
        }
      }
    }
  }
}

DI void load_q4(bf16x8 (&qf)[6], const bf16_t* qrow, int h) {
#pragma unroll
  for (int ks = 0; ks < 4; ++ks) qf[ks] = *(const bf16x8*)(qrow + (2 * ks + h) * 8);
}
DI void zero_o(f32x16 (&o)[2]) {
#pragma unroll
  for (int r = 0; r < 16; ++r) { o[0][r] = 0.f; o[1][r] = 0.f; }
}

DI void swa_unit(const Params& p, LAS char* lds, int u) {
  const int tid = thr(), lane = tid & 63, wid = __builtin_amdgcn_readfirstlane(tid >> 6);
  const int r32 = lane & 31, h = lane >> 5;
  const int b = u >> 7, g = (u >> 6) & 1, qb = u & 63, t0 = qb * 64;
  const int hd = g * 4 + (wid & 3), tw0 = t0 + 32 * (wid >> 2), t = tw0 + r32;
  bf16x8 qf[6];
  load_q4(qf, p.q0 + ((size_t)(b * 16 + hd) * 4096 + t) * 64, h);
  f32x16 o[2]; zero_o(o);
  float m = NEGBIG, l = 0.f;
  const float c = 0.125f * LOG2E;
  const int tlo = (t0 - 127) < 0 ? 0 : ((t0 - 127) >> 6);
  const char* kb = (const char*)(p.ka + (size_t)(b * 2 + g) * 4096 * 64);
  const char* vb = (const char*)(p.vta + (size_t)(b * 2 + g) * 64 * 4096);
  kv_stream<false>(lds, kb, vb, 8192, nullptr, tlo, qb, [&](int tile, const LAS char* st) {
    f32x16 sA, sB;
    qk_tile<false>(st, nullptr, qf, r32, h, sA, sB);
    if (!(tile * 64 > tw0 + 31 - 128 && tile * 64 + 63 <= tw0)) mask_scores(sA, sB, tile * 64, t - 128, t, h);
    softmax_step(sA, sB, c, m, l, o);
    pv_tile(st + 8192, sA, sB, r32, h, o);
  });
  float lt = l_total(l);
  lt += fast_exp2(p.in[2][hd] * LOG2E - m * c);
  const float inv = 1.0f / lt;
#pragma unroll
  for (int r = 0; r < 16; ++r) { o[0][r] *= inv; o[1][r] *= inv; }
  store_o((char*)(p.obuf + (size_t)(b * 4096 + t) * 1024 + hd * 64), o, h);
}

constexpr int NSA_CMPK = 0, NSA_CMPV = 32768, NSA_IMP = A_RING > 65536 ? A_RING : 65536, NSA_SELM = NSA_IMP + 64 * 65 * 4, NSA_LDS = NSA_SELM + 512;

DI void nsa_unit(const Params& p, LAS char* lds, int b, int g, int qb) {
  const int tid = thr(), lane = tid & 63, wid = __builtin_amdgcn_readfirstlane(tid >> 6);
  const int r32 = lane & 31, h = lane >> 5;
  const int t0 = qb * 64, qh = wid >> 2, hd = g * 4 + (wid & 3), ql = 32 * qh + r32, t = t0 + ql, tw0 = t0 + 32 * qh;
  const int bg = b * 2 + g;
  bf16x8 qf[6];
  load_q4(qf, p.q0 + ((size_t)(b * 16 + 8 + hd) * 4096 + t) * 64, h);
  const float* gp = p.gates + (size_t)(b * 4096 + t) * 24 + hd;
  const float g_cmp = gp[0], g_sel = gp[8], g_win = gp[16];
  const float c = 0.125f * LOG2E;
  f32x16 ot[2]; zero_o(ot);
  LAS int* imp = (LAS int*)(lds + NSA_IMP);
  LAS unsigned long long* selm = (LAS unsigned long long*)(lds + NSA_SELM);
  {
    const char* ksrc = (const char*)(p.kcmp + (size_t)bg * 256 * 64);
    const char* vsrc = (const char*)(p.vcmpt + (size_t)bg * 64 * 256);
    asm volatile("s_waitcnt vmcnt(0)" ::: "memory");
#pragma unroll
    for (int i = 0; i < 4; ++i) {
      const int pc = tid + 512 * i, row = pc >> 3, cs = ((pc & 7) ^ ((row >> 1) & 7)) << 4;
      glds16(ksrc + (size_t)row * 128 + cs, lds + NSA_CMPK + pc * 16);
      const int d = tid >> 3, cv = ((tid & 7) ^ ((d >> 1) & 7)) << 4;
      glds16(vsrc + (size_t)d * 512 + i * 128 + cv, lds + NSA_CMPV + i * 8192 + tid * 16);
    }
    for (int i = tid; i < 64 * 65; i += NTHR) imp[i] = 0;
    WAIT_VM_BAR(0);
  }
  {
    const int hi_c = (t - 31) >> 4;
    const int nmax = (t0 + 63 - 31) >> 4;
    const int ntile = (nmax >> 6) + 1;
    float m = NEGBIG, l = 0.f;
    for (int j = 0; j < ntile; ++j) {
      f32x16 sA, sB;
      qk_tile<false>(lds + NSA_CMPK + j * 8192, nullptr, qf, r32, h, sA, sB);
      mask_scores(sA, sB, j * 64, -1000000, hi_c, h);
      const float mnew = fmaxf(m, row_max32(sA, sB));
      const float mc = (mnew < -1e29f) ? 0.f : mnew * c;
      float sum = 0.f;
#pragma unroll
      for (int r = 0; r < 16; ++r) sum += fast_exp2(__builtin_fmaf(sA[r], c, -mc)) + fast_exp2(__builtin_fmaf(sB[r], c, -mc));
      l = l * fast_exp2(m * c - mc) + sum;
      m = mnew;
    }
    const float lt = l_total(l);
    const float inv = lt > 0.f ? 1.0f / lt : 0.f;
    const float mc = (m < -1e29f) ? 0.f : m * c;
    f32x16 oc[2]; zero_o(oc);
    for (int j = 0; j < ntile; ++j) {
      f32x16 sA, sB;
      qk_tile<false>(lds + NSA_CMPK + j * 8192, nullptr, qf, r32, h, sA, sB);
      mask_scores(sA, sB, j * 64, -1000000, hi_c, h);
#pragma unroll
      for (int r = 0; r < 16; ++r) { sA[r] = fast_exp2(__builtin_fmaf(sA[r], c, -mc)) * inv; sB[r] = fast_exp2(__builtin_fmaf(sB[r], c, -mc)) * inv; }
#pragma unroll
      for (int q4 = 0; q4 < 4; ++q4) {
        const int mb = 16 * j + 2 * q4 + h;
        const float a0 = sA[4 * q4] + sA[4 * q4 + 1] + sA[4 * q4 + 2] + 0.5f * sA[4 * q4 + 3];
        const float a1 = sB[4 * q4] + sB[4 * q4 + 1] + sB[4 * q4 + 2] + 0.5f * sB[4 * q4 + 3];
        const float FX = 16777216.0f;
        atomicAdd((int*)(imp + ql * 65 + mb), __float2int_rn(a0 * FX));
        atomicAdd((int*)(imp + ql * 65 + mb + 1), __float2int_rn(0.5f * sA[4 * q4 + 3] * FX));
        atomicAdd((int*)(imp + ql * 65 + mb + 8), __float2int_rn(a1 * FX));
        if (mb + 9 < 64) atomicAdd((int*)(imp + ql * 65 + mb + 9), __float2int_rn(0.5f * sB[4 * q4 + 3] * FX));
      }
      pv_tile(lds + NSA_CMPV + j * 8192, sA, sB, r32, h, oc);
    }
#pragma unroll
    for (int r = 0; r < 16; ++r) { ot[0][r] = g_cmp * oc[0][r]; ot[1][r] = g_cmp * oc[1][r]; }
  }
  LDS_BAR();
  for (int i = 0; i < 8; ++i) {
    const int q = wid * 8 + i, tq = t0 + q;
    const int iv = imp[q * 65 + lane];
    const bool forced = (lane == 0) || (lane == qb) || (lane == qb - 1);
    const bool future = lane * 64 > tq;
    unsigned key = forced ? 0x80000001u : (future ? 1u : (unsigned)iv + 2u);
    unsigned long long picked = 0ull;
#pragma unroll 4
    for (int k = 0; k < 16; ++k) {
      const unsigned mx = wave_max_u32(key);
      const int idx = __builtin_ctzll(__ballot(key == mx));
      picked |= 1ull << idx;
      key = (lane == idx) ? 0u : key;
    }
    if (lane == 0) selm[q] = picked;
  }
  LDS_BAR();
  const unsigned long long mysel = selm[ql];
  {
    f32x16 o[2]; zero_o(o);
    float m = NEGBIG, l = 0.f;
    const char* kb = (const char*)(p.ks + (size_t)bg * 4096 * 64);
    const char* vb = (const char*)(p.vts + (size_t)bg * 64 * 4096);
    kv_stream<false>(lds, kb, vb, 8192, nullptr, 0, qb, [&](int tile, const LAS char* st) {
      f32x16 sA, sB;
      qk_tile<false>(st, nullptr, qf, r32, h, sA, sB);
      const bool keep = (mysel >> tile) & 1ull;
      if (tile < qb) mask_lane(sA, sB, keep); else mask_scores(sA, sB, tile * 64, -1000000, keep ? t : -1, h);
      softmax_step(sA, sB, c, m, l, o);
      pv_tile(st + 8192, sA, sB, r32, h, o);
    });
    const float lt = l_total(l);
    const float sc = lt > 0.f ? g_sel / lt : 0.f;
#pragma unroll
    for (int r = 0; r < 16; ++r) { ot[0][r] += sc * o[0][r]; ot[1][r] += sc * o[1][r]; }
  }
  {
    f32x16 o[2]; zero_o(o);
    float m = NEGBIG, l = 0.f;
    const char* kb = (const char*)(p.kw + (size_t)bg * 4096 * 64);
    const char* vb = (const char*)(p.vtw + (size_t)bg * 64 * 4096);
    const int tlo = (t0 - 511) < 0 ? 0 : ((t0 - 511) >> 6);
    kv_stream<false>(lds, kb, vb, 8192, nullptr, tlo, qb, [&](int tile, const LAS char* st) {
      f32x16 sA, sB;
      qk_tile<false>(st, nullptr, qf, r32, h, sA, sB);
      if (!(tile * 64 > tw0 + 31 - 512 && tile * 64 + 63 <= tw0)) mask_scores(sA, sB, tile * 64, t - 512, t, h);
      softmax_step(sA, sB, c, m, l, o);
      pv_tile(st + 8192, sA, sB, r32, h, o);
    });
    const float lt = l_total(l);
    const float sc = lt > 0.f ? g_win / lt : 0.f;
#pragma unroll
    for (int r = 0; r < 16; ++r) { ot[0][r] += sc * o[0][r]; ot[1][r] += sc * o[1][r]; }
  }
  store_o((char*)(p.obuf + (size_t)(b * 4096 + t) * 1024 + 512 + hd * 64), ot, h);
}

DI void phase_swa_cmp1(const Params& p, LAS char* lds) {
  if (bid() < 32) cmp1_unit(p, lds, bid());
  for (int i = 0, u; xcd_unit(i, 1024, u); ++i) swa_unit(p, lds, u);
}
DI void phase_nsa(const Params& p, LAS char* lds) {
  const int G = gridDim.x;
  if ((G & 7) == 0 && G >= 16) {
    const int per = G >> 3, x = bid() & 7, jb = bid() >> 3;
    for (int j = 0; j * per < 128; ++j) {
      const int pos = (j & 1) ? j * per + (per - 1 - jb) : j * per + jb;
      if (pos < 128) { const int bg = 2 * x + (pos & 1); nsa_unit(p, lds, bg >> 1, bg & 1, 63 - (pos >> 1)); }
    }
  } else {
    for (int j = 0;; ++j) {
      const int pos = (j & 1) ? j * G + (G - 1 - (int)bid()) : j * G + (int)bid();
      if (j * G >= 1024) break;
      if (pos < 1024) nsa_unit(p, lds, (pos & 15) >> 1, pos & 1, 63 - (pos >> 4));
    }
  }
}

DI void mla_unit(const Params& p, LAS char* lds, int b, int hd, int qb4) {
  const int tid = thr(), lane = tid & 63, wid = __builtin_amdgcn_readfirstlane(tid >> 6);
  const int r32 = lane & 31, h = lane >> 5;
  const int tw0 = qb4 * 256 + 32 * wid, t = tw0 + r32;
  const bf16_t* qrow = p.q1 + ((size_t)(b * 16 + hd) * 4096 + t) * 96;
  bf16x8 qf[6];
#pragma unroll
  for (int ks = 0; ks < 6; ++ks) qf[ks] = *(const bf16x8*)(qrow + (2 * ks + h) * 8);
  f32x16 o[2]; zero_o(o);
  float m = NEGBIG, l = 0.f;
  const float c = 0.10206207261596577f * LOG2E;
  const char* kb = (const char*)(p.kn + (size_t)(b * 16 + hd) * 4096 * 64);
  const char* vb = (const char*)(p.vt1 + (size_t)(b * 16 + hd) * 64 * 4096);
  const char* rb = (const char*)(p.krb + (size_t)b * 4096 * 32);
  kv_stream<true>(lds, kb, vb, 8192, rb, 0, qb4 * 4 + 3, [&](int tile, const LAS char* st) {
    if (tile * 64 <= tw0 + 31) {
      f32x16 sA, sB;
      qk_tile<true>(st, st + 16384, qf, r32, h, sA, sB);
      if (tile * 64 + 63 > tw0) mask_scores(sA, sB, tile * 64, -1000000, t, h);
      softmax_step(sA, sB, c, m, l, o);
      pv_tile(st + 8192, sA, sB, r32, h, o);
    }
  });
  const float inv = 1.0f / l_total(l);
#pragma unroll
  for (int r = 0; r < 16; ++r) { o[0][r] *= inv; o[1][r] *= inv; }
  store_o((char*)(p.xb + (size_t)(b * 4096 + t) * 1024 + hd * 64), o, h);
}
DI void phase_mla(const Params& p, LAS char* lds) {
  const int G = gridDim.x;
  if ((G & 7) == 0 && G >= 16) {
    const int per = G >> 3, x = bid() & 7, jb = bid() >> 3;
    for (int j = 0; j * per < 256; ++j) {
      const int pos = (j & 1) ? j * per + (per - 1 - jb) : j * per + jb;
      if (pos < 256) { const int bh = 16 * x + (pos & 15); mla_unit(p, lds, bh >> 4, bh & 15, 15 - (pos >> 4)); }
    }
  } else {
    for (int j = 0;; ++j) {
      const int pos = (j & 1) ? j * G + (G - 1 - (int)bid()) : j * G + (int)bid();
      if (j * G >= 2048) break;
      if (pos < 2048) mla_unit(p, lds, (pos & 127) >> 4, pos & 15, 15 - (pos >> 7));
    }
  }
}
DI void ln_row(const f32x4 (&v)[4], const float* gam, const float* bet, int lane, f32x4 (&y)[4]) {
  float s = 0.f;
#pragma unroll
  for (int j = 0; j < 4; ++j) s += (v[j][0] + v[j][1]) + (v[j][2] + v[j][3]);
  const float mu = wave_sum(s) * (1.0f / 1024.0f);
  float q = 0.f;
  f32x4 d[4];
#pragma unroll
  for (int j = 0; j < 4; ++j) { d[j] = v[j] - mu; q += (d[j][0] * d[j][0] + d[j][1] * d[j][1]) + (d[j][2] * d[j][2] + d[j][3] * d[j][3]); }
  const float rs = rsqrtf(wave_sum(q) * (1.0f / 1024.0f) + 1e-5f);
#pragma unroll
  for (int j = 0; j < 4; ++j) {
    const f32x4 gv = *(const f32x4*)(gam + 4 * lane + 256 * j), bv = *(const f32x4*)(bet + 4 * lane + 256 * j);
    y[j] = d[j] * rs * gv + bv;
  }
}
DI void phase_lnsplit(const Params& p, int layer) {
  const int lane = thr() & 63, gw = bid() * 8 + (thr() >> 6), nw = gridDim.x * 8;
  const float* gam = p.in[16] + layer * 1024;
  const float* bet = p.in[17] + layer * 1024;
  for (int row = gw; row < NTOK; row += nw) {
    float* xr = p.out + (size_t)row * 1024;
    f32x4 v[4], y[4];
#pragma unroll
    for (int j = 0; j < 4; ++j) v[j] = *(const f32x4*)(xr + 4 * lane + 256 * j);
    ln_row(v, gam, bet, lane, y);
#pragma unroll
    for (int j = 0; j < 4; ++j) {
      *(f32x4*)(xr + 4 * lane + 256 * j) = y[j];
      u32x2 hi; hi.x = cvt_pk(y[j][0], y[j][1]); hi.y = cvt_pk(y[j][2], y[j][3]);
      const float r0 = y[j][0] - __uint_as_float(hi.x << 16), r1 = y[j][1] - __uint_as_float(hi.x & 0xffff0000u);
      const float r2 = y[j][2] - __uint_as_float(hi.y << 16), r3 = y[j][3] - __uint_as_float(hi.y & 0xffff0000u);
      u32x2 lo; lo.x = cvt_pk(r0, r1); lo.y = cvt_pk(r2, r3);
      *(u32x2*)(p.xb + (size_t)row * 1024 + 4 * lane + 256 * j) = hi;
      *(u32x2*)(p.x1lo + (size_t)row * 1024 + 4 * lane + 256 * j) = lo;
    }
  }
}

constexpr int LIST_CAP = 32768;
constexpr int R_STAGE = 12288;
DI void router_kloop(LAS char* lds, const char* a0, const char* b0, int nk, f32x4 (&acc)[4]) {
  const int tid = thr(), lane = tid & 63, wid = __builtin_amdgcn_readfirstlane(tid >> 6), fr = lane & 15, fq = lane >> 4;
  LAS char* dA = lds + tid * 16;
  LAS char* dB = lds + 8192 + (tid & 255) * 16;
  const int aoff = (wid * 16 + fr) * 64 + fq * 16, boff = 8192 + fr * 64 + fq * 16;
#define R_ISSUE(slot, kt) do { glds16(a0 + (size_t)(kt) * 64, dA + (slot) * R_STAGE); glds16(b0 + (size_t)(kt) * 64, dB + (slot) * R_STAGE); } while (0)
  R_ISSUE(0, 0);
  if (nk > 1) R_ISSUE(1, 1);
  if (nk > 2) R_ISSUE(2, 2);
  int slot = 0;
  for (int t = 0; t < nk; ++t) {
    if (t + 2 < nk) { WAIT_VM_BAR(4); } else if (t + 1 < nk) { WAIT_VM_BAR(2); } else { WAIT_VM_BAR(0); }
    if (t + 3 < nk) R_ISSUE((slot + 3) & 3, t + 3);
    const LAS char* base = lds + slot * R_STAGE;
    const bf16x8 af = *(const LAS bf16x8*)(base + aoff);
#pragma unroll
    for (int n = 0; n < 4; ++n) { const bf16x8 bf_ = *(const LAS bf16x8*)(base + boff + n * 1024); acc[n] = __builtin_amdgcn_mfma_f32_16x16x32_bf16(bf_, af, acc[n], 0, 0, 0); }
    slot = (slot + 1) & 3;
  }
#undef R_ISSUE
  LDS_BAR();
}
DI void phase_router(const Params& p, LAS char* lds, int layer) {
  const int tid = thr(), lane = tid & 63, wid = __builtin_amdgcn_readfirstlane(tid >> 6), fr = lane & 15, fq = lane >> 4;
  LAS float* lg = (LAS float*)(lds + 4 * R_STAGE) + wid * (16 * 65);
  LAS int* hist = (LAS int*)(lds + 4 * R_STAGE + 8 * 16 * 65 * 4);
  LAS int* se = hist + 128;
  LAS float* sw = (LAS float*)(se + 128 * 6);
  const int half_tokens = NTOK / p.nsplit, cap = LIST_CAP / p.nsplit;
  const float* bias = p.in[21] + layer * 64;
  for (int u = bid(); u < 256; u += gridDim.x) {
    const int m0 = u * 128;
    const size_t aro = (size_t)(m0 + (tid >> 2)) * 2048 + (tid & 3) * 16, bro = (size_t)((tid & 255) >> 2) * 2048 + (tid & 3) * 16;
    f32x4 acc[4];
#pragma unroll
    for (int n = 0; n < 4; ++n) acc[n] = (f32x4){0.f, 0.f, 0.f, 0.f};
    SUB_BEGIN(1);
    router_kloop(lds, (const char*)p.xb + aro, (const char*)p.rwh[layer] + bro, 32, acc);
    router_kloop(lds, (const char*)p.x1lo + aro, (const char*)p.rwh[layer] + bro, 32, acc);
    router_kloop(lds, (const char*)p.xb + aro, (const char*)p.rwl[layer] + bro, 32, acc);
    SUB_END(1);
#pragma unroll
    for (int n = 0; n < 4; ++n)
#pragma unroll
      for (int j = 0; j < 4; ++j) lg[fr * 65 + n * 16 + 4 * fq + j] = acc[n][j];
    if (tid < 64) hist[tid] = 0;
    LDS_BAR();
    const float be = bias[lane];
    SUB_BEGIN(2);
    for (int i = 0; i < 16; ++i) {
      const int r = wid * 16 + i;
      const float s = sigmoidf_(lg[i * 65 + lane]);
      const float sb = s + be;
      float m1 = sb, m2 = -INFINITY;
#define TOP2_STEP(ctrl) do { const float o1 = __int_as_float(__builtin_amdgcn_update_dpp(0, __float_as_int(m1), (ctrl), 0xF, 0xF, true)); \
        const float o2 = __int_as_float(__builtin_amdgcn_update_dpp(0, __float_as_int(m2), (ctrl), 0xF, 0xF, true)); \
        const float n1 = fmaxf(m1, o1); m2 = fmaxf(fminf(m1, o1), fmaxf(m2, o2)); m1 = n1; } while (0)
      TOP2_STEP(0xB1); TOP2_STEP(0x4E); TOP2_STEP(0x141);
#undef TOP2_STEP
      const float gs = m1 + m2;
      unsigned gk = ((lane & 7) == 0) ? fkey(gs) : 0u;
      unsigned gmask = 0u;
#pragma unroll
      for (int k = 0; k < 4; ++k) {
        const unsigned mx = wave_max_u32(gk);
        const int idx = __builtin_ctzll(__ballot(gk == mx));
        gmask |= 1u << (idx >> 3);
        gk = (lane == idx) ? 0u : gk;
      }
      const bool allowed = (gmask >> (lane >> 3)) & 1u;
      unsigned ek = allowed ? fkey(sb) : 0u;
      int myslot = -1;
      float sum = 0.f;
#pragma unroll
      for (int k = 0; k < 6; ++k) {
        const unsigned mx = wave_max_u32(ek);
        const int idx = __builtin_ctzll(__ballot(ek == mx));
        sum += __int_as_float(__builtin_amdgcn_readlane(__float_as_int(s), idx));
        if (lane == idx) { myslot = k; ek = 0u; }
      }
      if (myslot >= 0) {
        const int lp = atomicAdd((int*)(hist + lane), 1);
        se[r * 6 + myslot] = lane | (lp << 8);
        sw[r * 6 + myslot] = s / sum * 2.5f;
      }
    }
    LDS_BAR();
    SUB_END(2);
    const int half = m0 / half_tokens;
    if (tid < 64) hist[64 + tid] = atomicAdd(p.cnt + (layer * 2 + half) * 64 + tid, hist[tid]);
    LDS_BAR();
    for (int i = tid; i < 128 * 6; i += NTHR) {
      const int v = se[i], e = v & 255, lp = v >> 8, r = i / 6, slot = i - r * 6;
      const int tok = m0 + r;
      p.lists[((size_t)half * 64 + e) * cap + hist[64 + e] + lp] = make_int2(tok * 8 + slot, __float_as_int(sw[i]));
    }
    LDS_BAR();
  }
}

DI void expert_map(const Params& p, LAS int* tb, int layer, int half) {
  if (thr() < 64) {
    const int c = p.cnt[(layer * 2 + half) * 64 + thr()];
    int t = (c + 255) >> 8, incl = t;
#pragma unroll
    for (int o = 1; o < 64; o <<= 1) { const int v = __shfl_up(incl, o); if ((int)thr() >= o) incl += v; }
    tb[thr()] = incl - t;
    if (thr() == 63) tb[64] = incl;
    tb[65 + thr()] = c;
  }
  LDS_BAR();
}
DI int find_expert(const LAS int* tb, int mt) {
  int e = 0;
#pragma unroll 8
  for (int i = 1; i < 64; ++i) e = (tb[i] <= mt) ? i : e;
  return e;
}
DI void phase_exp1(const Params& p, LAS char* lds, int layer, int half) {
  GEMM_IDS();
  LAS int* tb = (LAS int*)(lds + MISC_OFF);
  expert_map(p, tb, layer, half);
  const int half_tokens = NTOK / p.nsplit, cap = LIST_CAP / p.nsplit;
  const int TR = tb[64], TS = half_tokens / 256;
  bool isS;
  for (int i = 0, u; xcd_unit2(i, TR * 2, TS * 2, u, isS); ++i) {
    const int mt = (u >> 1) + (isS ? TR : 0), nt = u & 1;
    const bf16_t* W;
    int tok0, tok1;
    if (mt < TR) {
      const int e = find_expert(tb, mt), cnt = tb[65 + e];
      const int2* lst = p.lists + ((size_t)half * 64 + e) * cap;
      const int i0 = (mt - tb[e]) * 256 + r0, i1 = i0 + 128;
      tok0 = lst[i0 < cnt ? i0 : 0].x >> 3;
      tok1 = lst[i1 < cnt ? i1 : 0].x >> 3;
      W = p.egu + (size_t)e * 524288;
    } else {
      tok0 = half * half_tokens + (mt - TR) * 256 + r0; tok1 = tok0 + 128;
      W = p.shgu[layer];
    }
    const char* a0 = (const char*)(p.xb + (size_t)tok0 * 1024) + ck;
    const char* a1 = (const char*)(p.xb + (size_t)tok1 * 1024) + ck;
    const char* b0 = (const char*)(W + (size_t)(nt * 256 + r0) * 1024) + ck;
    f32x4 acc[4][8]; zero_acc(acc);
    gemm_kloop(lds, a0, a1, b0, b0 + (size_t)128 * 2048, 32, acc);
    {
#pragma unroll
      for (int m = 0; m < 4; ++m) {
        LAS char* hr = lds + (wr * 64 + m * 16 + fr) * 272 + (wc * 64 + 4 * fq) * 2;
#pragma unroll
        for (int g2 = 0; g2 < 2; ++g2)
#pragma unroll
          for (int n = 0; n < 2; ++n) {
            float hv[4];
#pragma unroll
            for (int j = 0; j < 4; ++j) { const float gt = acc[m][4 * g2 + n][j]; hv[j] = gt / (1.0f + __expf(-gt)) * acc[m][4 * g2 + n + 2][j]; }
            u32x2 w; w.x = cvt_pk(hv[0], hv[1]); w.y = cvt_pk(hv[2], hv[3]);
            *(LAS u32x2*)(hr + g2 * 64 + n * 32) = w;
          }
      }
      LDS_BAR();
#pragma unroll 2
      for (int i = 0; i < 8; ++i) {
        const int c = tid + 512 * i, row = c >> 4, ch = c & 15;
        *(u32x4*)((char*)(p.hbuf + (size_t)(mt * 256 + row) * 256 + nt * 128) + ch * 16) = *(const LAS u32x4*)(lds + row * 272 + ch * 16);
      }
      LDS_BAR();
    }
  }
}
DI void phase_exp2(const Params& p, LAS char* lds, int layer, int half) {
  GEMM_IDS();
  LAS int* tb = (LAS int*)(lds + MISC_OFF);
  expert_map(p, tb, layer, half);
  const int half_tokens = NTOK / p.nsplit, cap = LIST_CAP / p.nsplit;
  const int TR = tb[64], TS = half_tokens / 256;
  bool isS;
  for (int i = 0, u; xcd_unit2(i, TR * 4, TS * 4, u, isS); ++i) {
    const int mt = (u >> 2) + (isS ? TR : 0), nt = u & 3;
    int e = 0, cnt = 0, ib = 0;
    const bf16_t* W;
    if (mt < TR) { e = find_expert(tb, mt); cnt = tb[65 + e]; ib = (mt - tb[e]) * 256; W = p.ed + (size_t)e * 262144; }
    else W = p.shd[layer];
    const char* a0 = (const char*)(p.hbuf + (size_t)(mt * 256 + r0) * 256) + ck;
    const char* b0 = (const char*)(W + (size_t)(nt * 256 + r0) * 256) + ck;
    f32x4 acc[4][8]; zero_acc(acc);
    gemm_kloop(lds, a0, a0 + 128 * 512, b0, b0 + 128 * 512, 8, acc);
    if (mt < TR) {
      const int2* lst = p.lists + ((size_t)half * 64 + e) * cap;
      LAS int* ri = (LAS int*)(lds + MISC_OFF + 1024);
      if (tid < 256) { const int idx = ib + tid; int2 en = make_int2(-1, 0); if (idx < cnt) en = lst[idx]; ri[2 * tid] = en.x; ri[2 * tid + 1] = en.y; }
      LDS_BAR();
#pragma unroll
      for (int m = 0; m < 4; ++m) {
        const int r = wr * 64 + m * 16 + fr;
        const float w = __int_as_float(ri[2 * r + 1]);
        LAS char* cr = lds + r * 528 + (wc * 128 + 4 * fq) * 2;
#pragma unroll
        for (int n = 0; n < 8; ++n) { u32x2 v; v.x = cvt_pk(acc[m][n][0] * w, acc[m][n][1] * w); v.y = cvt_pk(acc[m][n][2] * w, acc[m][n][3] * w); *(LAS u32x2*)(cr + n * 32) = v; }
      asm volatile("" ::: "memory");
      }
      LDS_BAR();
#pragma unroll 2
      for (int i = 0; i < 16; ++i) {
        const int c = tid + 512 * i, row = c >> 5, ch = c & 31;
        const int ex = ri[2 * row];
        if (ex >= 0) {
          const int tok = ex >> 3, slot = ex & 7;
          *(u32x4*)((char*)(p.slab + ((size_t)(tok - half * half_tokens) * 6 + slot) * 1024 + nt * 256) + ch * 16) = *(const LAS u32x4*)(lds + row * 528 + ch * 16);
        }
      }
      LDS_BAR();
    } else {
#pragma unroll
      for (int m = 0; m < 4; ++m) {
        const size_t tok = (size_t)half * half_tokens + (mt - TR) * 256 + wr * 64 + m * 16 + fr;
        float* orow = p.out + tok * 1024 + nt * 256 + wc * 128 + 4 * fq;
#pragma unroll
        for (int n = 0; n < 8; ++n) { const f32x4 r = *(const f32x4*)(orow + n * 16); *(f32x4*)(orow + n * 16) = r * ALPHA + acc[m][n]; if (n & 1) asm volatile("" ::: "memory"); }
      asm volatile("" ::: "memory");
      }
    }
  }
}
DI void phase_combine(const Params& p, int layer, int half) {
  const int lane = thr() & 63, gw = bid() * 8 + (thr() >> 6), nw = gridDim.x * 8;
  const int half_tokens = NTOK / p.nsplit;
  const float* gam = p.in[18] + layer * 1024;
  const float* bet = p.in[19] + layer * 1024;
  for (int r = gw; r < half_tokens; r += nw) {
    const size_t row = (size_t)half * half_tokens + r;
    float* xr = p.out + row * 1024;
    f32x4 v[4], y[4];
#pragma unroll
    for (int j = 0; j < 4; ++j) v[j] = *(const f32x4*)(xr + 4 * lane + 256 * j);
#pragma unroll
    for (int s = 0; s < 6; ++s) {
      const bf16_t* sr = p.slab + ((size_t)r * 6 + s) * 1024;
#pragma unroll
      for (int j = 0; j < 4; ++j) {
        const u32x2 w = *(const u32x2*)(sr + 4 * lane + 256 * j);
        v[j][0] += __uint_as_float(w.x << 16); v[j][1] += __uint_as_float(w.x & 0xffff0000u);
        v[j][2] += __uint_as_float(w.y << 16); v[j][3] += __uint_as_float(w.y & 0xffff0000u);
      }
    }
    ln_row(v, gam, bet, lane, y);
#pragma unroll
    for (int j = 0; j < 4; ++j) {
      *(f32x4*)(xr + 4 * lane + 256 * j) = y[j];
      if (layer == 0) { u32x2 hi; hi.x = cvt_pk(y[j][0], y[j][1]); hi.y = cvt_pk(y[j][2], y[j][3]); *(u32x2*)(p.xb + row * 1024 + 4 * lane + 256 * j) = hi; }
    }
  }
}

DI void phase_inproj1(const Params& p, LAS char* lds) {
  GEMM_IDS();
  for (int i = 0, u; xcd_unit(i, 128 * 3, u); ++i) {
    int mt, nt; mn_order(u, 3, mt, nt);
    const int m0 = mt * 256, n0 = nt * 256;
    const char* a0 = (const char*)(p.xb + (size_t)(m0 + r0) * 1024) + ck;
    const char* b0 = (const char*)(p.win1t + (size_t)(n0 + r0) * 1024) + ck;
    f32x4 acc[4][8]; zero_acc(acc);
    gemm_kloop(lds, a0, a0 + (size_t)128 * 2048, b0, b0 + (size_t)128 * 2048, 32, acc);
#pragma unroll
    for (int m = 0; m < 4; ++m) {
      float* crow_ = p.cbuf + (size_t)(m0 + wr * 64 + m * 16 + fr) * 768 + n0 + wc * 128 + 4 * fq;
#pragma unroll
      for (int n = 0; n < 8; ++n) *(f32x4*)(crow_ + n * 16) = acc[m][n];
      asm volatile("" ::: "memory");
    }
  }
  int it = 0;
  expert_weights(p, (LAS float*)lds, 1, it);
}
DI void phase_mlanorm(const Params& p) {
  const int lane = thr() & 63, gw = bid() * 8 + (thr() >> 6), nw = gridDim.x * 8;
  for (int row = gw; row < NTOK; row += nw) {
    const float* cr = p.cbuf + (size_t)row * 768;
    float q[6], kv[4];
    float ss = 0.f;
#pragma unroll
    for (int j = 0; j < 6; ++j) { q[j] = cr[lane + 64 * j]; ss += q[j] * q[j]; }
    const float rq = rsqrtf(wave_sum(ss) * (1.0f / 384.0f) + 1e-6f);
#pragma unroll
    for (int j = 0; j < 6; ++j) p.cqb[(size_t)row * 384 + lane + 64 * j] = f2bf(q[j] * rq * p.in[11][lane + 64 * j]);
    ss = 0.f;
#pragma unroll
    for (int j = 0; j < 4; ++j) { kv[j] = cr[384 + lane + 64 * j]; ss += kv[j] * kv[j]; }
    const float rk = rsqrtf(wave_sum(ss) * (1.0f / 256.0f) + 1e-6f);
#pragma unroll
    for (int j = 0; j < 4; ++j) p.ckvb[(size_t)row * 256 + lane + 64 * j] = f2bf(kv[j] * rk * p.in[12][lane + 64 * j]);
    if (lane < 16) {
      const float x1 = cr[640 + lane], x2 = cr[656 + lane];
      const float2 cs = p.cs32[(row & 4095) * 16 + lane];
      p.krb[(size_t)row * 32 + lane] = f2bf(x1 * cs.x - x2 * cs.y);
      p.krb[(size_t)row * 32 + 16 + lane] = f2bf(x1 * cs.y + x2 * cs.x);
    }
  }
}
DI void phase_mlaup(const Params& p, LAS char* lds) {
  GEMM_IDS();
  for (int i = 0, u; xcd_unit(i, 128 * 14, u); ++i) {
    const int x8 = u / 224, ul = u - x8 * 224;
    if (ul < 96) {
      int mtl, nt; mn_order(ul, 6, mtl, nt);
      const int mt = x8 * 16 + mtl, m0 = mt * 256, n0 = nt * 256;
      const char* a0 = (const char*)(p.cqb + (size_t)(m0 + r0) * 384) + ck;
      const char* b0 = (const char*)(p.wuqt + (size_t)(n0 + r0) * 384) + ck;
      f32x4 acc[4][8]; zero_acc(acc);
      gemm_kloop(lds, a0, a0 + (size_t)128 * 768, b0, b0 + (size_t)128 * 768, 12, acc);
#pragma unroll
      for (int m = 0; m < 4; ++m) {
        const int row = m0 + wr * 64 + m * 16 + fr, b = row >> 12, t = row & 4095;
#pragma unroll
        for (int pr = 0; pr < 4; ++pr) {
          const int gi = ((n0 + wc * 128) >> 5) + pr, head = gi / 3, part = gi - head * 3;
          bf16_t* dst = p.q1 + ((size_t)(b * 16 + head) * 4096 + t) * 96 + part * 32 + 4 * fq;
          if (part < 2) {
#pragma unroll
            for (int n = 0; n < 2; ++n) { u32x2 w; w.x = cvt_pk(acc[m][2 * pr + n][0], acc[m][2 * pr + n][1]); w.y = cvt_pk(acc[m][2 * pr + n][2], acc[m][2 * pr + n][3]); *(u32x2*)(dst + n * 16) = w; }
          } else {
            const f32x4 c0 = *(const f32x4*)(p.cs32 + t * 16 + 4 * fq), c1 = *(const f32x4*)(p.cs32 + t * 16 + 4 * fq + 2);
            const float co[4] = {c0[0], c0[2], c1[0], c1[2]}, si[4] = {c0[1], c0[3], c1[1], c1[3]};
            float y1[4], y2[4];
#pragma unroll
            for (int j = 0; j < 4; ++j) { const float x1 = acc[m][2 * pr][j], x2 = acc[m][2 * pr + 1][j]; y1[j] = x1 * co[j] - x2 * si[j]; y2[j] = x1 * si[j] + x2 * co[j]; }
            u32x2 w1, w2; w1.x = cvt_pk(y1[0], y1[1]); w1.y = cvt_pk(y1[2], y1[3]); w2.x = cvt_pk(y2[0], y2[1]); w2.y = cvt_pk(y2[2], y2[3]);
            *(u32x2*)(dst) = w1; *(u32x2*)(dst + 16) = w2;
          }
        }
        asm volatile("" ::: "memory");
      }
    } else {
      int mtl, nt; mn_order(ul - 96, 8, mtl, nt);
      const int mt = x8 * 16 + mtl, m0 = mt * 256, n0 = nt * 256;
      const char* a0 = (const char*)(p.ckvb + (size_t)(m0 + r0) * 256) + ck;
      const char* b0 = (const char*)(p.wukvt + (size_t)(n0 + r0) * 256) + ck;
      f32x4 acc[4][8]; zero_acc(acc);
      gemm_kloop(lds, a0, a0 + (size_t)128 * 512, b0, b0 + (size_t)128 * 512, 8, acc);
      const int head = nt * 2 + wc;
#pragma unroll
      for (int m = 0; m < 4; ++m) {
        const int row = m0 + wr * 64 + m * 16 + fr, b = row >> 12, t = row & 4095;
        plain64_store(&acc[m][0], p.kn + ((size_t)(b * 16 + head) * 4096 + t) * 64, fq);
        vt64_store(&acc[m][4], p.vt1 + (size_t)(b * 16 + head) * 64 * 4096, 4096, perm16(t), fq);
      asm volatile("" ::: "memory");
      }
    }
  }
}

constexpr int LDS_BYTES = NSA_LDS > (MISC_OFF + 4096) ? NSA_LDS : (MISC_OFF + 4096);
#ifdef PROBE
constexpr int LDS_TOTAL = 163840;
#else
constexpr int LDS_TOTAL = LDS_BYTES + 64;
#endif
#ifndef ALLCG
#define ALLCG 0
#endif

DI void get_phase(int i, int nsplit, int& ph, int& layer, int& half) {
  const int moe_len = 2 + 3 * nsplit;
  layer = 0; half = 0;
  if (i < 6) { ph = i; return; }
  i -= 6;
  if (i >= moe_len) {
    i -= moe_len; layer = 1;
    if (i < 5) { ph = (i < 4) ? PH_INPROJ1 + i : PH_OUTPROJ; return; }
    i -= 5;
  }
  if (i < 2) { ph = PH_LNSPLIT + i; return; }
  i -= 2; half = i / 3; ph = PH_EXP1 + (i - half * 3);
}
DI int num_phases(int nsplit) { return 6 + 5 + 2 * (2 + 3 * nsplit); }

__global__ void __launch_bounds__(NTHR) fwd_kernel(Params p, int ph_lo, int ph_hi, int use_sync) {
  extern __shared__ __attribute__((aligned(16))) char smem_raw[];
  LAS char* lds = (LAS char*)smem_raw;
  volatile LAS unsigned* bst = (volatile LAS unsigned*)(lds + LDS_BYTES);
  cg::grid_group grid = cg::this_grid();
  XcdBarrier xb;
  if (use_sync) {
    if (threadIdx.x == 0) { bst[0] = 0u; bst[1] = 0u; bst[2] = 0u; bst[3] = 0u; }
    __syncthreads();
    xb = xcd_barrier_post(p.bar, bst);
  }
#ifndef PROBE_RVR
#define PROBE_RVR 0ull
#endif
#ifdef PROBE
  volatile LAS unsigned long long* pacc = (volatile LAS unsigned long long*)(lds + PROBE_LDS_OFF);
  if (blockIdx.x == PROBE_BLK && threadIdx.x == 0) { pacc[0] = 0ull; pacc[1] = __builtin_amdgcn_s_memrealtime(); pacc[2] = 0ull; }
#endif
  for (int i = ph_lo; i < ph_hi; ++i) {
    int ph, layer, half;
    get_phase(i, p.nsplit, ph, layer, half);
    switch (ph) {
      case PH_PREP: phase_prep(p, lds); break;
      case PH_INPROJ0: phase_inproj0(p, lds); break;
      case PH_SWA_CMP1: phase_swa_cmp1(p, lds); break;
      case PH_CMP2: phase_cmp2(p, lds); break;
      case PH_NSA: phase_nsa(p, lds); break;
      case PH_OUTPROJ: phase_outproj(p, lds, layer); break;
      case PH_LNSPLIT: phase_lnsplit(p, layer); break;
      case PH_ROUTER: phase_router(p, lds, layer); break;
      case PH_EXP1: phase_exp1(p, lds, layer, half); break;
      case PH_EXP2: phase_exp2(p, lds, layer, half); break;
      case PH_COMBINE: phase_combine(p, layer, half); break;
      case PH_INPROJ1: phase_inproj1(p, lds); break;
      case PH_MLANORM: phase_mlanorm(p); break;
      case PH_MLAUP: phase_mlaup(p, lds); break;
      case PH_MLAATT: phase_mla(p, lds); break;
      default: break;
    }
    if ((PROBE_RVR >> i) & 1ull) SUB_BEGIN(11);
    if (use_sync && i + 1 < ph_hi) { if (i == ph_lo || ALLCG) grid.sync(); else xcd_barrier(xb); }
    if ((PROBE_RVR >> i) & 1ull) SUB_END(11);
#ifdef PROBE
    if (blockIdx.x == PROBE_BLK && threadIdx.x == 0) { const unsigned long long t_ = __builtin_amdgcn_s_memrealtime(); if ((PROBE_DUR >> i) & 1ull) pacc[0] = pacc[0] + (t_ - pacc[1]); pacc[1] = t_; }
#endif
  }
#ifdef PROBE
#ifdef PROBE_XCC
  {
    if (threadIdx.x == 0) __hip_atomic_store(p.cnt + 512 + blockIdx.x, (int)xb_xcc_id() + 1, __ATOMIC_RELAXED, __HIP_MEMORY_SCOPE_AGENT);
    xcd_barrier(xb);
    if (blockIdx.x == 0 && threadIdx.x == 0) {
      int bad = 0;
      for (int b = 0; b < (int)gridDim.x; ++b) bad += (__hip_atomic_load(p.cnt + 512 + b, __ATOMIC_RELAXED, __HIP_MEMORY_SCOPE_AGENT) != __hip_atomic_load(p.cnt + 512 + (b & 7), __ATOMIC_RELAXED, __HIP_MEMORY_SCOPE_AGENT)) ? 1 : 0;
      pacc[0] = (unsigned long long)bad * 10000ull / 9ull;
    }
  }
#endif
  {
    __syncthreads();
    const unsigned lane_ = __builtin_amdgcn_mbcnt_hi(~0u, __builtin_amdgcn_mbcnt_lo(~0u, 0u));
    if (blockIdx.x == PROBE_BLK && lane_ == 0u && atomicAdd((unsigned*)&bst[2], 1u) == 0u) {
      const unsigned long long td = pacc[0], t0 = __builtin_amdgcn_s_memrealtime();
      while (__builtin_amdgcn_s_memrealtime() - t0 < 9ull * td) __builtin_amdgcn_s_sleep(8);
    }
  }
#endif
}

extern "C" void kernel_launch(void* const* d_in, const int* in_sizes, int n_in, void* d_out, int out_size, void* d_ws, size_t ws_size, hipStream_t stream) {
  static int grid_blocks = 0;
  if (grid_blocks == 0) {
    int dev = 0, cus = 0, per_cu = 0;
    hipGetDevice(&dev);
    hipDeviceGetAttribute(&cus, hipDeviceAttributeMultiprocessorCount, dev);
    hipFuncSetAttribute((const void*)fwd_kernel, hipFuncAttributeMaxDynamicSharedMemorySize, LDS_TOTAL);
    hipOccupancyMaxActiveBlocksPerMultiprocessor(&per_cu, (const void*)fwd_kernel, NTHR, LDS_TOTAL);
    if (per_cu < 1) { fprintf(stderr, "kernel_launch: occupancy query says %d blocks per CU\n", per_cu); per_cu = 1; }
    grid_blocks = cus;
    (void)hipGetLastError();
  }
  Params p;
  memset(&p, 0, sizeof(p));
  for (int i = 0; i < 28; ++i) p.in[i] = (const float*)d_in[i];
  p.out = (float*)d_out;
  char* ws = (char*)d_ws;
  size_t off = 0;
  auto take = [&](size_t bytes) { char* r = ws + off; off += (bytes + 255) & ~(size_t)255; return r; };
  p.bar = (unsigned*)take(XCD_BAR_WORDS * 4);
  p.cnt = (int*)take(4096);
  p.win0t = (bf16_t*)take((size_t)2304 * 1024 * 2); p.wout0t = (bf16_t*)take((size_t)1024 * 1024 * 2);
  p.cw1k = (bf16_t*)take(256 * 2048 * 2); p.cw1v = (bf16_t*)take(256 * 2048 * 2);
  p.cw2k = (bf16_t*)take(256 * 128 * 2); p.cw2v = (bf16_t*)take(256 * 128 * 2);
  p.win1t = (bf16_t*)take((size_t)768 * 1024 * 2); p.wuqt = (bf16_t*)take((size_t)1536 * 384 * 2);
  p.wukvt = (bf16_t*)take((size_t)2048 * 256 * 2); p.wout1t = (bf16_t*)take((size_t)1024 * 1024 * 2);
  for (int l = 0; l < 2; ++l) {
    p.rwh[l] = (bf16_t*)take(256 * 1024 * 2); p.rwl[l] = (bf16_t*)take(256 * 1024 * 2);
    p.shgu[l] = (bf16_t*)take(512 * 1024 * 2); p.shd[l] = (bf16_t*)take(1024 * 256 * 2);
  }
  p.cb1k = (float*)take(128 * 4); p.cb1v = (float*)take(128 * 4);
  p.cs64 = (float2*)take(4096 * 32 * 8); p.cs32 = (float2*)take(4096 * 16 * 8);
  p.egu = (bf16_t*)take((size_t)64 * 524288 * 2); p.ed = (bf16_t*)take((size_t)64 * 262144 * 2);
  p.xb = (bf16_t*)take((size_t)NTOK * 1024 * 2);
  const size_t act0 = off;
  p.q0 = (bf16_t*)take((size_t)NBATCH * 16 * 4096 * 64 * 2);
  const size_t kvb = (size_t)NBATCH * 2 * 4096 * 64 * 2;
  p.ka = (bf16_t*)take(kvb); p.ks = (bf16_t*)take(kvb); p.kw = (bf16_t*)take(kvb); p.kc0 = (bf16_t*)take(kvb); p.vc0 = (bf16_t*)take(kvb);
  p.vta = (bf16_t*)take(kvb); p.vts = (bf16_t*)take(kvb); p.vtw = (bf16_t*)take(kvb);
  p.h1k = (bf16_t*)take(4096 * 128 * 2); p.h1v = (bf16_t*)take(4096 * 128 * 2);
  p.kcmp = (bf16_t*)take(16 * 256 * 64 * 2); p.vcmpt = (bf16_t*)take(16 * 64 * 256 * 2);
  p.gates = (float*)take((size_t)NTOK * 24 * 4);
  p.obuf = (bf16_t*)take((size_t)NTOK * 1024 * 2);
  const size_t end_l0 = off;
  const size_t need1 = act0 + (size_t)NTOK * 1024 * 2 + (size_t)64 * LIST_CAP * 8 + ((size_t)NTOK * 7 + 64 * 256) * 512 + (size_t)NTOK * 6 * 2048 + 4096;
  p.nsplit = ws_size >= need1 ? 1 : 2;
  off = act0;
  p.x1lo = (bf16_t*)take((size_t)NTOK * 1024 * 2);
  p.lists = (int2*)take((size_t)64 * LIST_CAP * 8);
  p.hbuf = (bf16_t*)take(((size_t)(NTOK / p.nsplit) * 7 + 64 * 256) * 512);
  p.slab = (bf16_t*)take((size_t)(NTOK / p.nsplit) * 6 * 2048);
  const size_t end_moe = off;
  off = act0;
  p.cqb = (bf16_t*)take((size_t)NTOK * 384 * 2); p.ckvb = (bf16_t*)take((size_t)NTOK * 256 * 2); p.krb = (bf16_t*)take((size_t)NTOK * 32 * 2);
  p.q1 = (bf16_t*)take((size_t)NTOK * 16 * 96 * 2);
  p.kn = (bf16_t*)take((size_t)NTOK * 16 * 64 * 2);
  p.cbuf = (float*)p.kn;
  p.vt1 = (bf16_t*)take((size_t)NTOK * 16 * 64 * 2);
  const size_t end_l1 = off;
  size_t need = end_l0 > end_moe ? end_l0 : end_moe; if (end_l1 > need) need = end_l1;
  if (need > ws_size) { fprintf(stderr, "kernel_launch: workspace too small: need %zu, have %zu\n", need, ws_size); return; }
  const int n = 6 + 5 + 2 * (2 + 3 * p.nsplit);
  hipMemsetAsync(p.bar, 0, XCD_BAR_WORDS * 4, stream);
#ifdef MULTI_LAUNCH
  for (int i = 0; i < n; ++i) hipLaunchKernelGGL(fwd_kernel, dim3(grid_blocks), dim3(NTHR), LDS_TOTAL, stream, p, i, i + 1, 0);
#else
  int lo = 0, hi = n, us = 1;
  void* args[] = {&p, &lo, &hi, &us};
  hipError_t e = hipLaunchCooperativeKernel((const void*)fwd_kernel, dim3(grid_blocks), dim3(NTHR), args, LDS_TOTAL, stream);
  if (e != hipSuccess) fprintf(stderr, "cooperative launch failed: %s (grid %d)\n", hipGetErrorString(e), grid_blocks);
#endif
}
```

```cpp
#include <hip/hip_runtime.h>
#include <hip/hip_cooperative_groups.h>
#include <stdint.h>
#include <math.h>
#include <cstdio>
#include <cstring>
namespace cg = cooperative_groups;

#define LAS __attribute__((address_space(3)))
#define DI __device__ __forceinline__
typedef unsigned short bf16_t;
typedef short bf16x8 __attribute__((ext_vector_type(8)));
typedef float f32x4 __attribute__((ext_vector_type(4)));
typedef float f32x16 __attribute__((ext_vector_type(16)));
typedef unsigned u32x4 __attribute__((ext_vector_type(4)));
typedef unsigned u32x2 __attribute__((ext_vector_type(2)));

constexpr int NTOK = 32768, SEQ = 4096, NBATCH = 8, DM = 1024;
constexpr int NTHR = 512;
constexpr int PROBE_LDS_OFF = 163840 - 32;
constexpr float ALPHA = 1.4142135623730951f;
constexpr float LOG2E = 1.4426950408889634f;

typedef __bf16 bf16x2_t __attribute__((ext_vector_type(2)));
typedef float f32x2_t __attribute__((ext_vector_type(2)));
DI unsigned cvt_pk(float lo, float hi) { const f32x2_t f = {lo, hi}; return __builtin_bit_cast(unsigned, __builtin_convertvector(f, bf16x2_t)); }
DI bf16_t f2bf(float x) { return (bf16_t)(cvt_pk(x, 0.f) & 0xffffu); }
DI float bf2f(bf16_t b) { return __uint_as_float(((unsigned)b) << 16); }
DI float fast_exp2(float x) { return __builtin_amdgcn_exp2f(x); }
DI float sigmoidf_(float x) { return 1.0f / (1.0f + __expf(-x)); }
DI int crow(int r, int h) { return (r & 3) + 8 * (r >> 2) + 4 * h; }
DI int perm16(int t) { return (t & ~15) | (((t >> 2) & 1) << 3) | (((t >> 3) & 1) << 2) | (t & 3); }
DI void glds16(const void* g, LAS char* l) { __builtin_amdgcn_global_load_lds((const unsigned*)g, (LAS unsigned*)l, 16, 0, 0); }
#define WAIT_VM_BAR(N) asm volatile("s_waitcnt vmcnt(" #N ") lgkmcnt(0)\n\ts_barrier" ::: "memory")
#define LDS_BAR() asm volatile("s_waitcnt lgkmcnt(0)\n\ts_barrier" ::: "memory")
DI int thr() { int t = threadIdx.x; asm volatile("" : "+v"(t)); return t; }
DI int gdim() { int g = gridDim.x; asm volatile("" : "+s"(g)); return g; }
DI int bid() { int b = blockIdx.x; asm volatile("" : "+s"(b)); return b; }
DI bool xcd_unit(int i, int total, int& u) {
  const int g = gdim(), b = bid();
  if (g & 7) { u = b + i * g; return u < total; }
  const int per = g >> 3, x = b & 7, j = b >> 3;
  const int base = (int)(((long)total * x) >> 3), end = (int)(((long)total * (x + 1)) >> 3);
  u = base + j + i * per;
  return u < end;
}
DI bool xcd_unit2(int i, int totA, int totB, int& u, bool& isB) {
  const int g = gdim(), b = bid();
  if (g & 7) { const int v = b + i * g; isB = v >= totA; u = isB ? v - totA : v; return v < totA + totB; }
  const int per = g >> 3, x = b & 7, j = b >> 3;
  const int a0 = (int)(((long)totA * x) >> 3), a1 = (int)(((long)totA * (x + 1)) >> 3);
  const int b0 = (int)(((long)totB * x) >> 3), b1 = (int)(((long)totB * (x + 1)) >> 3);
  const int li = j + i * per, nA = a1 - a0;
  isB = li >= nA;
  u = isB ? b0 + (li - nA) : a0 + li;
  return li < nA + (b1 - b0);
}
DI void mn_order(int u, int nN, int& mt, int& nt) { const int g4 = 4 * nN, g = u / g4, r = u - g * g4; nt = r >> 2; mt = 4 * g + (r & 3); }
#define DPP_MAX_STEP(k, ctrl) do { const unsigned o_ = (unsigned)__builtin_amdgcn_update_dpp(0, (int)(k), (ctrl), 0xF, 0xF, true); (k) = (k) > o_ ? (k) : o_; } while (0)
DI unsigned wave_max_u32(unsigned k) {
  DPP_MAX_STEP(k, 0xB1);
  DPP_MAX_STEP(k, 0x4E);
  DPP_MAX_STEP(k, 0x141);
  DPP_MAX_STEP(k, 0x140);
  const unsigned m0 = (unsigned)__builtin_amdgcn_readlane((int)k, 0), m1 = (unsigned)__builtin_amdgcn_readlane((int)k, 16);
  const unsigned m2 = (unsigned)__builtin_amdgcn_readlane((int)k, 32), m3 = (unsigned)__builtin_amdgcn_readlane((int)k, 48);
  const unsigned a = m0 > m1 ? m0 : m1, b = m2 > m3 ? m2 : m3;
  return a > b ? a : b;
}
DI unsigned fkey(float x) { const unsigned u = __float_as_uint(x); return (u & 0x80000000u) ? ~u : (u | 0x80000000u); }
DI int shx_i(int v, int o) { return __builtin_amdgcn_ds_bpermute((((int)thr() & 63) ^ o) << 2, v); }
DI float shx(float v, int o) { return __int_as_float(shx_i(__float_as_int(v), o)); }
DI float wave_sum(float v) {
#pragma unroll
  for (int o = 32; o > 0; o >>= 1) v += shx(v, o);
  return v;
}

#ifndef PROBE_BLK
#define PROBE_BLK 0
#endif
#if defined(PROBE) && defined(PROBE_SUBID)
#define SUB_BEGIN(id) do { if ((id) == PROBE_SUBID && blockIdx.x == PROBE_BLK && threadIdx.x == 0) { volatile LAS unsigned long long* q_ = (volatile LAS unsigned long long*)(uintptr_t)PROBE_LDS_OFF; q_[2] = __builtin_amdgcn_s_memrealtime(); } } while (0)
#define SUB_END(id) do { if ((id) == PROBE_SUBID && blockIdx.x == PROBE_BLK && threadIdx.x == 0) { volatile LAS unsigned long long* q_ = (volatile LAS unsigned long long*)(uintptr_t)PROBE_LDS_OFF; q_[0] = q_[0] + (__builtin_amdgcn_s_memrealtime() - q_[2]); } } while (0)
#else
#define SUB_BEGIN(id) do { } while (0)
#define SUB_END(id) do { } while (0)
#endif
#define XB_TMO 0
#define XB_XCNT(j) (16 + 16 * (j))
#define XB_XSUB(j) (272 + 16 * (j))
#define XB_XGEN(j) (528 + 16 * (j))
#define XB_TOP 784
#define XB_TOPGEN 800
#define XCD_BAR_WORDS 1024
#define XB_SPIN_CAP (1u << 22)
typedef __attribute__((address_space(1))) unsigned gu32;
DI unsigned xb_ld(gu32* p) { return __hip_atomic_load(p, __ATOMIC_RELAXED, __HIP_MEMORY_SCOPE_AGENT); }
DI unsigned xb_add(gu32* p, unsigned v) { return __hip_atomic_fetch_add(p, v, __ATOMIC_RELAXED, __HIP_MEMORY_SCOPE_AGENT); }
DI unsigned xb_xcc_id() { return (unsigned)__builtin_amdgcn_s_getreg((3 << 11) | 20) & 0xFu; }
#define XB_SPIN(cond, bar) do { unsigned _sp = 0; while (cond) { __builtin_amdgcn_s_sleep(1); \
    if ((++_sp & 255u) == 0u) { if (xb_ld(&(bar)[XB_TMO])) break; if (_sp > XB_SPIN_CAP) { xb_add(&(bar)[XB_TMO], 1u); break; } } } } while (0)
struct XcdBarrier { gu32* bar; unsigned x; volatile LAS unsigned* st; };
DI XcdBarrier xcd_barrier_post(unsigned* bar_, volatile LAS unsigned* st) {
  gu32* bar = (gu32*)bar_;
  XcdBarrier b; b.bar = bar; b.x = xb_xcc_id(); b.st = st;
  if (threadIdx.x == 0) (void)xb_add(&bar[XB_XCNT(b.x)], 1u);
  return b;
}
DI void xcd_barrier_complete(gu32* bar, unsigned x, unsigned& nloc, unsigned& nx) {
  const unsigned G = gridDim.x;
  unsigned sum, cnt, mine, sp = 0u;
  for (;;) {
    sum = 0u; cnt = 0u; mine = 0u;
#pragma unroll
    for (unsigned j = 0; j < 16; ++j) { const unsigned c = xb_ld(&bar[XB_XCNT(j)]); sum += c; cnt += (c > 0u) ? 1u : 0u; mine = (j == x) ? c : mine; }
    if (sum == G) break;
    __builtin_amdgcn_s_sleep(1);
    if ((++sp & 255u) == 0u) { if (xb_ld(&bar[XB_TMO])) break; if (sp > XB_SPIN_CAP) { xb_add(&bar[XB_TMO], 1u); break; } }
  }
  nloc = mine > 0u ? mine : 1u; nx = cnt > 0u ? cnt : 1u;
}
DI void xcd_barrier(const XcdBarrier& b) {
  asm volatile("s_waitcnt vmcnt(0)" ::: "memory");
  __syncthreads();
  if (threadIdx.x == 0) {
    unsigned long long bar_i = (unsigned long long)b.bar;
    asm volatile("" : "+s"(bar_i));
    gu32* bar = (gu32*)bar_i;
    __builtin_amdgcn_s_waitcnt(0);
    unsigned nloc = b.st[0], nx = b.st[1];
    if (nloc == 0u) { xcd_barrier_complete(bar, b.x, nloc, nx); b.st[0] = nloc; b.st[1] = nx; }
    const unsigned g = b.st[3];
    const unsigned old = xb_add(&bar[XB_XSUB(b.x)], 1u);
    const unsigned gen = old / nloc;
    if (old + 1u == (gen + 1u) * nloc) {
      __builtin_amdgcn_fence(__ATOMIC_RELEASE, "agent");
      asm volatile("s_waitcnt vmcnt(0)" ::: "memory");
      const unsigned og = xb_add(&bar[XB_TOP], 1u);
      const unsigned tg = og / nx;
      if (og + 1u == (tg + 1u) * nx) xb_add(&bar[XB_TOPGEN], 1u);
      else XB_SPIN(xb_ld(&bar[XB_TOPGEN]) == g, bar);
    } else {
      XB_SPIN(xb_ld(&bar[XB_TOPGEN]) == g, bar);
    }
    __builtin_amdgcn_fence(__ATOMIC_ACQUIRE, "agent");
    asm volatile("s_waitcnt vmcnt(0)" ::: "memory");
    b.st[3] = g + 1u;
  }
  __syncthreads();
}

constexpr int G_STAGE = 32768;
constexpr int G_LDS = 4 * G_STAGE;
constexpr int MISC_OFF = 135168;

template <bool PREFETCHED = false, int VAR = 0>
DI void gemm_kloop(LAS char* lds, const char* a0, const char* a1, const char* b0, const char* b1, int nk  , f32x4 (&acc)[4][8]) {
  const int tid = thr(), lane = tid & 63, wid = __builtin_amdgcn_readfirstlane(tid >> 6);
  const int wr = wid >> 1, wc = wid & 1, fr = lane & 15, fq = lane >> 4;
  LAS char* dA0 = lds + tid * 16;
  const int aoff = (wr * 64 + fr) * 64 + fq * 16;
  const int boff = 16384 + (wc * 128 + fr) * 64 + fq * 16;
#define G_ISSUE(slot, kt) do { LAS char* _d = dA0 + (slot) * G_STAGE; const size_t _ko = (size_t)(kt) * 64; \
    glds16(a0 + _ko, _d); glds16(a1 + _ko, _d + 8192); glds16(b0 + _ko, _d + 16384); glds16(b1 + _ko, _d + 24576); } while (0)
  if (!PREFETCHED) {
    G_ISSUE(0, 0);
    if (nk > 1) G_ISSUE(1, 1);
    if (nk > 2) G_ISSUE(2, 2);
  }
  if (nk > 2) { WAIT_VM_BAR(8); } else if (nk > 1) { WAIT_VM_BAR(4); } else { WAIT_VM_BAR(0); }
  bf16x8 af[4], blo[4];
#pragma unroll
  for (int m = 0; m < 4; ++m) af[m] = *(const LAS bf16x8*)(lds + aoff + m * 1024);
#pragma unroll
  for (int n = 0; n < 4; ++n) blo[n] = *(const LAS bf16x8*)(lds + boff + n * 1024);
  int slot = 0;
#pragma unroll 2
  for (int t = 0; t < nk; ++t) {
    const bool more = t + 1 < nk, pf = (VAR == 1) ? false : (t + 3 < nk);
    if (VAR == 2) { asm volatile("s_waitcnt vmcnt(4) lgkmcnt(0)" ::: "memory"); } else
    if (more) { if (t + 2 < nk) { WAIT_VM_BAR(4); } else { WAIT_VM_BAR(0); } }
#define PD_() (dA0 + ((slot + 3) & 3) * G_STAGE)
#define PKO_() ((size_t)(t + 3) * 64)
    const LAS char* base = lds + slot * G_STAGE;
    const LAS char* nbase = lds + ((slot + 1) & 3) * G_STAGE;
    bf16x8 bhi[4], a3n = af[3];
#pragma unroll
    for (int m = 0; m < 4; ++m) {
#pragma unroll
      for (int n = 0; n < 4; ++n) acc[m][n] = __builtin_amdgcn_mfma_f32_16x16x32_bf16(blo[n], af[m], acc[m][n], 0, 0, 0);
      if (m == 0) { __builtin_amdgcn_sched_barrier(0);
#pragma unroll
        for (int n = 0; n < 4; ++n) bhi[n] = (VAR == 3) ? blo[n] : *(const LAS bf16x8*)(base + boff + (4 + n) * 1024);
        __builtin_amdgcn_sched_barrier(0); }
      if (m == 1) { __builtin_amdgcn_sched_barrier(0); if (pf) glds16(a0 + PKO_(), PD_()); __builtin_amdgcn_sched_barrier(0); }
      if (m == 2) { __builtin_amdgcn_sched_barrier(0); if (pf) glds16(a1 + PKO_(), PD_() + 8192); __builtin_amdgcn_sched_barrier(0); }
    }
    __builtin_amdgcn_sched_barrier(0);
#pragma unroll
    for (int m = 0; m < 4; ++m) {
#pragma unroll
      for (int n = 0; n < 4; ++n) acc[m][4 + n] = __builtin_amdgcn_mfma_f32_16x16x32_bf16(bhi[n], af[m], acc[m][4 + n], 0, 0, 0);
      __builtin_amdgcn_sched_barrier(0);
      if (more && VAR != 3) {
        if (m < 3) af[m] = *(const LAS bf16x8*)(nbase + aoff + m * 1024);
        if (m == 2) a3n = *(const LAS bf16x8*)(nbase + aoff + 3 * 1024);
        if (m < 2) { blo[2 * m] = *(const LAS bf16x8*)(nbase + boff + (2 * m) * 1024); blo[2 * m + 1] = *(const LAS bf16x8*)(nbase + boff + (2 * m + 1) * 1024); }
      }
      if (m == 1) { if (pf) glds16(b0 + PKO_(), PD_() + 16384); }
      if (m == 2) { if (pf) glds16(b1 + PKO_(), PD_() + 24576); }
      __builtin_amdgcn_sched_barrier(0);
    }
    af[3] = a3n;
#undef PD_
#undef PKO_
    slot = (slot + 1) & 3;
  }
#undef G_ISSUE
  LDS_BAR();
}
DI void gemm_prefetch(LAS char* lds, const char* a0, const char* a1, const char* b0, const char* b1, int nk) {
  LAS char* dA0 = lds + thr() * 16;
#pragma unroll
  for (int s = 0; s < 3; ++s) if (s < nk) { LAS char* d_ = dA0 + s * G_STAGE; const size_t ko = (size_t)s * 64;
    glds16(a0 + ko, d_); glds16(a1 + ko, d_ + 8192); glds16(b0 + ko, d_ + 16384); glds16(b1 + ko, d_ + 24576); }
}
DI void zero_acc(f32x4 (&acc)[4][8]) {
  float z = 0.f; asm volatile("" : "+v"(z));
#pragma unroll
  for (int m = 0; m < 4; ++m)
#pragma unroll
    for (int n = 0; n < 8; ++n) acc[m][n] = (f32x4){z, z, z, z};
}
struct GemmPtrs { const char *a0, *a1, *b0, *b1; int nk; };
template <int NK, int RB  , class Keep, class Setup, class Epi>
DI void gemm_units_sel(LAS char* lds, int total, Keep&& keep, Setup&& setup, Epi&& epi) {
  int i = 0, u = 0, u2 = 0;
  auto next = [&](int& u_) { while (xcd_unit(i, total, u_)) { ++i; if (keep(u_)) return true; } return false; };
  bool has = next(u);
  const char *a0 = nullptr, *b0 = nullptr;
  if (has) { setup(u, a0, b0); gemm_prefetch(lds, a0, a0 + RB, b0, b0 + RB, NK); }
  while (has) {
    const bool has2 = next(u2);
    f32x4 acc[4][8]; zero_acc(acc);
    gemm_kloop<true>(lds, a0, a0 + RB, b0, b0 + RB, NK, acc);
    if (has2) { setup(u2, a0, b0); gemm_prefetch(lds, a0, a0 + RB, b0, b0 + RB, NK); }
    epi(u, acc);
    u = u2; has = has2;
  }
}
template <class Setup, class Epi>
DI void gemm_units(LAS char* lds, int total, Setup&& setup, Epi&& epi) {
  int u;
  bool has = xcd_unit(0, total, u);
  GemmPtrs P{};
  if (has) { P = setup(u); gemm_prefetch(lds, P.a0, P.a1, P.b0, P.b1, P.nk); }
  for (int i = 0; has; ++i) {
    int u2;
    const bool has2 = xcd_unit(i + 1, total, u2);
    f32x4 acc[4][8]; zero_acc(acc);
    gemm_kloop<true>(lds, P.a0, P.a1, P.b0, P.b1, P.nk, acc);
    GemmPtrs P2{};
    if (has2) { P2 = setup(u2); gemm_prefetch(lds, P2.a0, P2.a1, P2.b0, P2.b1, P2.nk); }
    epi(u, acc);
    u = u2; P = P2; has = has2;
  }
}
constexpr int A_STAGE = 20480, A_NST = 3, A_RING = A_NST * A_STAGE;
constexpr float NEGBIG = -1e30f;
#define MFMA32(a, b, c) __builtin_amdgcn_mfma_f32_32x32x16_bf16((a), (b), (c), 0, 0, 0)

template <bool HAS_ROPE>
DI void qk_tile(const LAS char* kt, const LAS char* krt, const bf16x8* qf, int r32, int h, const f32x16& cinit, f32x16& sA, f32x16& sB) {
  const int sw = (r32 >> 1) & 7;
  const LAS char* ra = kt + r32 * 128;
  const LAS char* rb = ra + 32 * 128;
#pragma unroll
  for (int ks = 0; ks < 4; ++ks) {
    const int c = ((2 * ks + h) ^ sw) << 4;
    const bf16x8 ka = *(const LAS bf16x8*)(ra + c);
    const bf16x8 kb = *(const LAS bf16x8*)(rb + c);
    if (ks == 0) { sA = MFMA32(ka, qf[0], cinit); sB = MFMA32(kb, qf[0], cinit); }
    else { sA = MFMA32(ka, qf[ks], sA); sB = MFMA32(kb, qf[ks], sB); }
  }
  if (HAS_ROPE) {
    const int sw2 = (r32 >> 2) & 3;
    const LAS char* pa = krt + r32 * 64;
    const LAS char* pb = pa + 32 * 64;
#pragma unroll
    for (int ks = 0; ks < 2; ++ks) {
      const int c = ((2 * ks + h) ^ sw2) << 4;
      const bf16x8 ka = *(const LAS bf16x8*)(pa + c);
      const bf16x8 kb = *(const LAS bf16x8*)(pb + c);
      sA = MFMA32(ka, qf[4 + ks], sA);
      sB = MFMA32(kb, qf[4 + ks], sB);
    }
  }
}

DI bf16x8 pack8(const f32x16& p, int s) {
  u32x4 w;
  w.x = cvt_pk(p[8 * s + 0], p[8 * s + 1]); w.y = cvt_pk(p[8 * s + 2], p[8 * s + 3]);
  w.z = cvt_pk(p[8 * s + 4], p[8 * s + 5]); w.w = cvt_pk(p[8 * s + 6], p[8 * s + 7]);
  return __builtin_bit_cast(bf16x8, w);
}

DI void pv_tile(const LAS char* vt, const f32x16& pA, const f32x16& pB, int r32, int h, f32x16 (&o)[2]) {
  const int sw = (r32 >> 1) & 7;
  const LAS char* r0 = vt + r32 * 128;
  const LAS char* r1 = r0 + 32 * 128;
#pragma unroll
  for (int kk = 0; kk < 4; ++kk) {
    const bf16x8 pt = (kk < 2) ? pack8(pA, kk & 1) : pack8(pB, kk & 1);
    const int c = ((2 * kk + h) ^ sw) << 4;
    const bf16x8 v0 = *(const LAS bf16x8*)(r0 + c);
    const bf16x8 v1 = *(const LAS bf16x8*)(r1 + c);
    o[0] = MFMA32(v0, pt, o[0]);
    o[1] = MFMA32(v1, pt, o[1]);
  }
}

DI void mask_scores(f32x16& sA, f32x16& sB, int key0, int lo, int hi, int h) {
#pragma unroll
  for (int r = 0; r < 16; ++r) {
    const int ka = key0 + crow(r, h), kb = ka + 32;
    sA[r] = (ka > lo && ka <= hi) ? sA[r] : NEGBIG;
    sB[r] = (kb > lo && kb <= hi) ? sB[r] : NEGBIG;
  }
}
DI void mask_lane(f32x16& sA, f32x16& sB, bool keep) {
#pragma unroll
  for (int r = 0; r < 16; ++r) { sA[r] = keep ? sA[r] : NEGBIG; sB[r] = keep ? sB[r] : NEGBIG; }
}
DI float row_max32(const f32x16& sA, const f32x16& sB) {
  float mx = fmaxf(sA[0], sB[0]);
#pragma unroll
  for (int r = 1; r < 16; ++r) mx = fmaxf(mx, fmaxf(sA[r], sB[r]));
  return fmaxf(mx, shx(mx, 32));
}
DI void softmax_step(f32x16& sA, f32x16& sB, float c, float& m, float& l, f32x16 (&o)[2]) {
  const float mx = row_max32(sA, sB);
  const float mnew = fmaxf(m, mx);
  const float mc = (mnew < -1e29f) ? 0.f : mnew * c;
  const float alpha = fast_exp2(m * c - mc);
  m = mnew;
  float sum = 0.f;
#pragma unroll
  for (int r = 0; r < 16; ++r) {
    sA[r] = fast_exp2(__builtin_fmaf(sA[r], c, -mc));
    sB[r] = fast_exp2(__builtin_fmaf(sB[r], c, -mc));
    sum += sA[r] + sB[r];
  }
  l = l * alpha + sum;
  if (!__all(alpha == 1.0f)) {
#pragma unroll
    for (int r = 0; r < 16; ++r) { o[0][r] *= alpha; o[1][r] *= alpha; }
  }
}

constexpr float SM_THR = 8.0f;
struct SmState { float ref, l; bool started; };
DI void sm_init(SmState& s, f32x16& negr) { s.ref = 0.f; s.l = 0.f; s.started = false;
#pragma unroll
  for (int r = 0; r < 16; ++r) negr[r] = 0.f; }
DI void softmax_ref(f32x16& sA, f32x16& sB, SmState& st, f32x16& negr, f32x16 (&o)[2]) {
  float mh = fmaxf(sA[0], sB[0]);
#pragma unroll
  for (int r = 1; r < 16; ++r) mh = fmaxf(mh, fmaxf(sA[r], sB[r]));
  if (__any((mh > SM_THR) || (!st.started && mh > -1e29f))) {
    const float tmax = fmaxf(mh, shx(mh, 32));
    const bool need = (tmax > SM_THR) || (!st.started && tmax > -1e29f);
    const float d = need ? tmax : 0.f;
    const float alpha = need ? (st.started ? fast_exp2(-d) : 0.f) : 1.f;
    st.ref += d; st.l *= alpha; st.started = st.started || need;
    const float nr = -st.ref;
#pragma unroll
    for (int r = 0; r < 16; ++r) { o[0][r] *= alpha; o[1][r] *= alpha; sA[r] -= d; sB[r] -= d; negr[r] = nr; }
  }
  float sum = 0.f;
#pragma unroll
  for (int r = 0; r < 16; ++r) { sA[r] = fast_exp2(sA[r]); sB[r] = fast_exp2(sB[r]); sum += sA[r] + sB[r]; }
  st.l += sum;
}

template <bool HAS_ROPE, class F>
DI void kv_stream(LAS char* ring, const char* kb, const char* vb, size_t vstride, const char* krb, int tile_lo, int tile_hi, F&& per_tile) {
  const int tid = thr();
  const int row = tid >> 3, cs = ((tid & 7) ^ ((row >> 1) & 7)) << 4;
  const char* ksrc = kb + (size_t)row * 128 + cs;
  const char* vsrc = vb + (size_t)row * vstride + cs;
  const int t2 = tid & 255, row2 = t2 >> 2;
  const char* rsrc = krb + (size_t)row2 * 64 + (((t2 & 3) ^ ((row2 >> 2) & 3)) << 4);
  LAS char* dst = ring + tid * 16;
  LAS char* dst2 = ring + 16384 + t2 * 16;
#define A_ISSUE(slot, tl) do { glds16(ksrc + (size_t)(tl) * 8192, dst + (slot) * A_STAGE); glds16(vsrc + (size_t)(tl) * 128, dst + (slot) * A_STAGE + 8192); \
    if (HAS_ROPE) glds16(rsrc + (size_t)(tl) * 4096, dst2 + (slot) * A_STAGE); } while (0)
  if (tile_lo <= tile_hi) A_ISSUE(0, tile_lo);
  if (tile_lo + 1 <= tile_hi) A_ISSUE(1, tile_lo + 1);
  int slot = 0;
  for (int t = tile_lo; t <= tile_hi; ++t) {
    if (HAS_ROPE) SUB_BEGIN(6);
    if (t + 1 <= tile_hi) { if (HAS_ROPE) { WAIT_VM_BAR(3); } else { WAIT_VM_BAR(2); } } else { WAIT_VM_BAR(0); }
    if (HAS_ROPE) SUB_END(6);
    if (HAS_ROPE) SUB_BEGIN(7);
    if (t + 2 <= tile_hi) { int s2 = slot + 2; if (s2 >= 3) s2 -= 3; A_ISSUE(s2, t + 2); }
    per_tile(t, (const LAS char*)(ring + slot * A_STAGE));
    if (HAS_ROPE) SUB_END(7);
    slot = (slot == 2) ? 0 : slot + 1;
  }
#undef A_ISSUE
  LDS_BAR();
}

DI float l_total(float l) { return l + shx(l, 32); }

DI void store_o(char* rowp, const f32x16 (&o)[2], int h) {
#pragma unroll
  for (int dd = 0; dd < 2; ++dd)
#pragma unroll
    for (int g = 0; g < 4; ++g) {
      u32x2 w; w.x = cvt_pk(o[dd][4 * g + 0], o[dd][4 * g + 1]); w.y = cvt_pk(o[dd][4 * g + 2], o[dd][4 * g + 3]);
      *(u32x2*)(rowp + (32 * dd + 8 * g + 4 * h) * 2) = w;
    }
}
DI void store_o_rows(LAS char* lds, bf16_t* rows0, const f32x16 (&o)[2], int wid, int lane) {
  const int r32 = lane & 31, h = lane >> 5;
  LAS char* stg = lds + wid * 4608;
#pragma unroll
  for (int dd = 0; dd < 2; ++dd)
#pragma unroll
    for (int g = 0; g < 4; ++g) {
      u32x2 w; w.x = cvt_pk(o[dd][4 * g + 0], o[dd][4 * g + 1]); w.y = cvt_pk(o[dd][4 * g + 2], o[dd][4 * g + 3]);
      *(LAS u32x2*)(stg + r32 * 144 + (32 * dd + 8 * g + 4 * h) * 2) = w;
    }
#pragma unroll
  for (int q = 0; q < 4; ++q) {
    const int rl = (lane >> 3) + 8 * q;
    *(u32x4*)(rows0 + (size_t)rl * 1024 + (lane & 7) * 8) = *(const LAS u32x4*)(stg + rl * 144 + (lane & 7) * 16);
  }
  LDS_BAR();
}
struct Params {
  const float* in[28];
  float* out;
  unsigned* bar;
  int* cnt;
  bf16_t *win0t, *wout0t, *cw1k, *cw1v, *cw2k, *cw2v, *win1t, *wuqt, *wukvt, *wout1t;
  bf16_t *rwh[2], *rwl[2], *shgu[2], *shd[2];
  bf16_t *egu, *ed;
  float *cb1k, *cb1v;
  float2 *cs64, *cs32;
  bf16_t *xb;
  bf16_t *q0, *ka, *ks, *kw, *kc0, *vc0, *vta, *vts, *vtw, *h1k, *h1v, *kcmp, *vcmpt, *obuf;
  float* gates;
  bf16_t *x1lo, *hbuf, *slab;
  int2* lists;
  float* cbuf;
  bf16_t *cqb, *ckvb, *krb, *q1, *kn, *vt1;
  int nsplit;
  int pad_;
};
enum { PH_PREP = 0, PH_INPROJ0, PH_SWA_CMP1, PH_CMP2, PH_NSA, PH_OUTPROJ, PH_LNSPLIT, PH_ROUTER, PH_EXP1, PH_EXP2, PH_COMBINE, PH_INPROJ1, PH_MLANORM, PH_MLAUP, PH_MLAATT };

DI void xpose_item(LAS float* tile, const float* src, int N, int k0, int n0, bf16_t* dst, int ldd, int mode, bf16_t* dst_lo) {
  const int tid = thr();
  {
    const int n = tid & 63, kk = tid >> 6;
    const bool ok = (n0 + n) < N;
#pragma unroll
    for (int i = 0; i < 8; ++i) { const int k = kk + 8 * i; tile[k * 65 + n] = ok ? src[(size_t)(k0 + k) * N + n0 + n] : 0.f; }
  }
  __syncthreads();
  {
    const int n = tid >> 3, kc = (tid & 7) * 8, gn = n0 + n;
    if (gn < N) {
      float v[8];
#pragma unroll
      for (int j = 0; j < 8; ++j) v[j] = tile[(kc + j) * 65 + n];
      int row = gn;
      if (mode == 1) row = 64 * (gn >> 5) + (gn & 31);
      if (mode == 2) row = 64 * (gn >> 5) + 32 + (gn & 31);
      u32x4 w; w.x = cvt_pk(v[0], v[1]); w.y = cvt_pk(v[2], v[3]); w.z = cvt_pk(v[4], v[5]); w.w = cvt_pk(v[6], v[7]);
      *(u32x4*)(dst + (size_t)row * ldd + k0 + kc) = w;
      if (dst_lo) {
        float r[8];
#pragma unroll
        for (int j = 0; j < 8; ++j) { const unsigned pk = (j & 1) ? (w[j >> 1] >> 16) : (w[j >> 1] & 0xffffu); r[j] = v[j] - __uint_as_float(pk << 16); }
        u32x4 w2; w2.x = cvt_pk(r[0], r[1]); w2.y = cvt_pk(r[2], r[3]); w2.z = cvt_pk(r[4], r[5]); w2.w = cvt_pk(r[6], r[7]);
        *(u32x4*)(dst_lo + (size_t)row * ldd + k0 + kc) = w2;
      }
    }
  }
  __syncthreads();
}
DI void xpose256_load(f32x4 (&v)[8], const float* src, int N, int k0, int n0, int tid) {
  const int n4 = (tid & 63) * 4, kk = tid >> 6;
#pragma unroll
  for (int i = 0; i < 8; ++i) v[i] = *(const f32x4*)(src + (size_t)(k0 + kk + 8 * i) * N + n0 + n4);
}
DI void xpose256_stream(LAS float* tile, const float* src, int K, int N, bf16_t* dst, int mode, int first, int total, int G) {
  const int tid = thr(), nkt = K / 64;
  if (first >= total) return;
  f32x4 v[8];
  xpose256_load(v, src, N, (first % nkt) * 64, (first / nkt) * 256, tid);
  for (int it = first; it < total; it += G) {
    const int k0 = (it % nkt) * 64, n0 = (it / nkt) * 256;
    {
      const int n4 = (tid & 63) * 4, kk = tid >> 6;
#pragma unroll
      for (int i = 0; i < 8; ++i) { LAS float* tp = tile + (kk + 8 * i) * 257 + n4; tp[0] = v[i][0]; tp[1] = v[i][1]; tp[2] = v[i][2]; tp[3] = v[i][3]; }
    }
    __syncthreads();
    if (it + G < total) xpose256_load(v, src, N, ((it + G) % nkt) * 64, ((it + G) / nkt) * 256, tid);
#pragma unroll
    for (int j = 0; j < 4; ++j) {
      const int cix = tid + 512 * j, n = cix >> 3, kc = (cix & 7) * 8, gn = n0 + n;
      float w8[8];
#pragma unroll
      for (int e = 0; e < 8; ++e) w8[e] = tile[(kc + e) * 257 + n];
      int row = gn;
      if (mode == 1) row = 64 * (gn >> 5) + (gn & 31);
      if (mode == 2) row = 64 * (gn >> 5) + 32 + (gn & 31);
      u32x4 w; w.x = cvt_pk(w8[0], w8[1]); w.y = cvt_pk(w8[2], w8[3]); w.z = cvt_pk(w8[4], w8[5]); w.w = cvt_pk(w8[6], w8[7]);
      *(u32x4*)(dst + (size_t)row * K + k0 + kc) = w;
    }
    __syncthreads();
  }
}
DI void xpose_matrix(LAS float* tile, const float* src, int K, int N, bf16_t* dst, int mode, bf16_t* dst_lo, int& itbase, int vb = -2, int vG = 0) {
  const bool wide = (N % 256 == 0) && dst_lo == nullptr;
  const int nkt = K / 64, nnt = wide ? N / 256 : (N + 63) / 64, total = nkt * nnt;
  if (vb == -2) { vb = bid(); vG = gdim(); }
  if (vb >= 0) {
    const int first = (int)((vb + vG - (itbase % vG)) % vG);
    if (wide) xpose256_stream(tile, src, K, N, dst, mode, first, total, vG);
    else for (int i = first; i < total; i += vG) xpose_item(tile, src, N, (i % nkt) * 64, (i / nkt) * 64, dst, K, mode, dst_lo);
  }
  itbase += total;
}
DI void zero_rows(bf16_t* dst, size_t nelem) {
  unsigned z0 = 0u; asm volatile("" : "+v"(z0));
  const u32x4 z = (u32x4){z0, z0, z0, z0};
  for (size_t i = ((size_t)bid() * NTHR + thr()) * 8; i < nelem; i += (size_t)gdim() * NTHR * 8) *(u32x4*)(dst + i) = z;
}
DI void expert_weights(const Params& p, LAS float* tile, int layer, int& it, int e_lo = 0, int e_hi = 64, int vb = -2, int vG = 0) {
  const size_t eo = (size_t)layer * 64 * 262144;
  for (int e = e_lo; e < e_hi; ++e) {
    xpose_matrix(tile, p.in[22] + eo + (size_t)e * 262144, 1024, 256, p.egu + (size_t)e * 524288, 1, nullptr, it, vb, vG);
    xpose_matrix(tile, p.in[23] + eo + (size_t)e * 262144, 1024, 256, p.egu + (size_t)e * 524288, 2, nullptr, it, vb, vG);
    xpose_matrix(tile, p.in[24] + eo + (size_t)e * 262144, 256, 1024, p.ed + (size_t)e * 262144, 0, nullptr, it, vb, vG);
  }
}
struct XItem { const float* src; bf16_t* dst; int K, N, k0, n0, mode; };
DI XItem expert_item(const Params& p, int layer, int idx) {
  const int e = idx / 48, r = idx - e * 48, m = r >> 4, q = r & 15;
  const size_t eo = ((size_t)layer * 64 + e) * 262144;
  XItem it;
  it.src = (m == 0 ? p.in[22] : (m == 1 ? p.in[23] : p.in[24])) + eo;
  it.dst = m < 2 ? p.egu + (size_t)e * 524288 : p.ed + (size_t)e * 262144;
  it.K = m < 2 ? 1024 : 256; it.N = m < 2 ? 256 : 1024;
  it.k0 = m < 2 ? q * 64 : (q & 3) * 64; it.n0 = m < 2 ? 0 : (q >> 2) * 256; it.mode = m < 2 ? m + 1 : 0;
  return it;
}
DI void xitem_to_lds(LAS float* tile, const f32x4 (&v)[8], int tid) {
  const int n4 = (tid & 63) * 4, kk = tid >> 6;
#pragma unroll
  for (int i = 0; i < 8; ++i) { LAS float* tp = tile + (kk + 8 * i) * 257 + n4; tp[0] = v[i][0]; tp[1] = v[i][1]; tp[2] = v[i][2]; tp[3] = v[i][3]; }
}
DI void xitem_store(const LAS float* tile, const XItem& X, int tid) {
#pragma unroll
  for (int j = 0; j < 4; ++j) {
    const int cix = tid + 512 * j, n = cix >> 3, kc = (cix & 7) * 8, gn = X.n0 + n;
    float w8[8];
#pragma unroll
    for (int e = 0; e < 8; ++e) w8[e] = tile[(kc + e) * 257 + n];
    int row = gn;
    if (X.mode == 1) row = 64 * (gn >> 5) + (gn & 31);
    if (X.mode == 2) row = 64 * (gn >> 5) + 32 + (gn & 31);
    u32x4 w; w.x = cvt_pk(w8[0], w8[1]); w.y = cvt_pk(w8[2], w8[3]); w.z = cvt_pk(w8[4], w8[5]); w.w = cvt_pk(w8[6], w8[7]);
    *(u32x4*)(X.dst + (size_t)row * X.K + X.k0 + kc) = w;
  }
}
DI void expert_stream(const Params& p, LAS float* tile, int layer, int e_lo, int e_hi, int vb, int vG) {
  if (vb < 0) return;
  const int tid = thr(), base = e_lo * 48, total = (e_hi - e_lo) * 48;
  f32x4 va[8], vc[8];
  if (vb < total) { const XItem X = expert_item(p, layer, base + vb); xpose256_load(va, X.src, X.N, X.k0, X.n0, tid); }
  if (vb + vG < total) { const XItem X = expert_item(p, layer, base + vb + vG); xpose256_load(vc, X.src, X.N, X.k0, X.n0, tid); }
  for (int i = vb; i < total; i += 2 * vG) {
    {
      const XItem X = expert_item(p, layer, base + i);
      xitem_to_lds(tile, va, tid);
      __syncthreads();
      if (i + 2 * vG < total) { const XItem Y = expert_item(p, layer, base + i + 2 * vG); xpose256_load(va, Y.src, Y.N, Y.k0, Y.n0, tid); }
      xitem_store(tile, X, tid);
      __syncthreads();
    }
    if (i + vG < total) {
      const XItem X = expert_item(p, layer, base + i + vG);
      xitem_to_lds(tile, vc, tid);
      __syncthreads();
      if (i + 3 * vG < total) { const XItem Y = expert_item(p, layer, base + i + 3 * vG); xpose256_load(vc, Y.src, Y.N, Y.k0, Y.n0, tid); }
      xitem_store(tile, X, tid);
      __syncthreads();
    }
  }
}
DI void phase_prep(const Params& p, LAS char* lds) {
  LAS float* tile = (LAS float*)lds;
  const int tid = thr();
  SUB_BEGIN(8);
  {
    const size_t stride = (size_t)gdim() * NTHR * 8;
    for (size_t i = ((size_t)bid() * NTHR + tid) * 8; i < (size_t)NTOK * DM; i += 4 * stride) {
      f32x4 a[4], b[4];
#pragma unroll
      for (int q = 0; q < 4; ++q) { const size_t o = i + q * stride; if (o < (size_t)NTOK * DM) { a[q] = *(const f32x4*)(p.in[0] + o); b[q] = *(const f32x4*)(p.in[0] + o + 4); } }
#pragma unroll
      for (int q = 0; q < 4; ++q) { const size_t o = i + q * stride; if (o < (size_t)NTOK * DM) {
        u32x4 w; w.x = cvt_pk(a[q][0], a[q][1]); w.y = cvt_pk(a[q][2], a[q][3]); w.z = cvt_pk(b[q][0], b[q][1]); w.w = cvt_pk(b[q][2], b[q][3]);
        *(u32x4*)(p.xb + o) = w; } }
    }
  }
  SUB_END(8);
  zero_rows(p.win0t + (size_t)2072 * 1024, (size_t)232 * 1024);
  zero_rows(p.cw2k + 64 * 128, 192 * 128);
  zero_rows(p.cw2v + 64 * 128, 192 * 128);
  zero_rows(p.win1t + (size_t)672 * 1024, (size_t)96 * 1024);
  for (int l = 0; l < 2; ++l) { zero_rows(p.rwh[l] + 64 * 1024, 192 * 1024); zero_rows(p.rwl[l] + 64 * 1024, 192 * 1024); }
  if (bid() == 0 && tid < 256) p.cnt[tid] = 0;
  for (int i = bid() * NTHR + tid; i < 4096 * 32; i += gdim() * NTHR) {
    const int t = i >> 5, f = i & 31;
    const float ang = (float)t * powf(10000.0f, -2.0f * (float)f / 64.0f);
    p.cs64[i] = make_float2(cosf(ang), sinf(ang));
  }
  for (int i = bid() * NTHR + tid; i < 4096 * 16; i += gdim() * NTHR) {
    const int t = i >> 4, f = i & 15;
    const float ang = (float)t * powf(10000.0f, -2.0f * (float)f / 32.0f);
    p.cs32[i] = make_float2(cosf(ang), sinf(ang));
  }
  SUB_BEGIN(10);
  {
    const int gw = bid() * 8 + (tid >> 6), lane = tid & 63;
    if (gw < 256) {
      const int mtx = gw >> 7, j = gw & 127;
      const float* pe = mtx == 0 ? p.in[3] : p.in[6];
      const float* w1 = mtx == 0 ? p.in[4] : p.in[7];
      float* dst = mtx == 0 ? p.cb1k : p.cb1v;
      float wv[32], pv[32];
#pragma unroll
      for (int q = 0; q < 32; ++q) { const int k = lane + 64 * q; wv[q] = w1[(size_t)k * 128 + j]; pv[q] = pe[k]; }
      float s = 0.f;
#pragma unroll
      for (int q = 0; q < 32; ++q) s = fmaf(pv[q], wv[q], s);
      s = wave_sum(s);
      if (lane == 0) dst[j] = s;
    }
  }
  SUB_END(10);
  SUB_BEGIN(9);
  int it = 0;
  xpose_matrix(tile, p.in[1], 1024, 2072, p.win0t, 0, nullptr, it);
  xpose_matrix(tile, p.in[9], 1024, 1024, p.wout0t, 0, nullptr, it);
  xpose_matrix(tile, p.in[4], 1024, 128, p.cw1k, 0, nullptr, it);
  xpose_matrix(tile, p.in[4] + (size_t)1024 * 128, 1024, 128, p.cw1k + (size_t)128 * 1024, 0, nullptr, it);
  xpose_matrix(tile, p.in[7], 1024, 128, p.cw1v, 0, nullptr, it);
  xpose_matrix(tile, p.in[7] + (size_t)1024 * 128, 1024, 128, p.cw1v + (size_t)128 * 1024, 0, nullptr, it);
  xpose_matrix(tile, p.in[5], 128, 64, p.cw2k, 0, nullptr, it);
  xpose_matrix(tile, p.in[8], 128, 64, p.cw2v, 0, nullptr, it);
  xpose_matrix(tile, p.in[10], 1024, 672, p.win1t, 0, nullptr, it);
  xpose_matrix(tile, p.in[13], 384, 1536, p.wuqt, 0, nullptr, it);
  xpose_matrix(tile, p.in[14], 256, 2048, p.wukvt, 0, nullptr, it);
  xpose_matrix(tile, p.in[15], 1024, 1024, p.wout1t, 0, nullptr, it);
  for (int l = 0; l < 2; ++l) {
    xpose_matrix(tile, p.in[20] + (size_t)l * 65536, 1024, 64, p.rwh[l], 0, p.rwl[l], it);
    xpose_matrix(tile, p.in[25] + (size_t)l * 262144, 1024, 256, p.shgu[l], 1, nullptr, it);
    xpose_matrix(tile, p.in[26] + (size_t)l * 262144, 1024, 256, p.shgu[l], 2, nullptr, it);
    xpose_matrix(tile, p.in[27] + (size_t)l * 262144, 256, 1024, p.shd[l], 0, nullptr, it);
  }
  expert_stream(p, tile, 0, 0, 64, bid(), gdim());
  SUB_END(9);
}

constexpr float QS64 = 0.125f * LOG2E;
constexpr float QS96 = 0.10206207261596577f * LOG2E;
DI void rope64_store(const f32x4* a, const float2* cs, bf16_t* rowp, int fq, float sc = 1.0f) {
#pragma unroll
  for (int n = 0; n < 2; ++n) {
    const f32x4 c0 = *(const f32x4*)(cs + n * 16 + 4 * fq), c1 = *(const f32x4*)(cs + n * 16 + 4 * fq + 2);
    const float co[4] = {c0[0], c0[2], c1[0], c1[2]}, si[4] = {c0[1], c0[3], c1[1], c1[3]};
    float y1[4], y2[4];
#pragma unroll
    for (int j = 0; j < 4; ++j) { const float x1 = a[n][j] * sc, x2 = a[n + 2][j] * sc; y1[j] = x1 * co[j] - x2 * si[j]; y2[j] = x1 * si[j] + x2 * co[j]; }
    u32x2 w1, w2; w1.x = cvt_pk(y1[0], y1[1]); w1.y = cvt_pk(y1[2], y1[3]); w2.x = cvt_pk(y2[0], y2[1]); w2.y = cvt_pk(y2[2], y2[3]);
    *(u32x2*)(rowp + n * 16 + 4 * fq) = w1;
    *(u32x2*)(rowp + 32 + n * 16 + 4 * fq) = w2;
  }
}
DI void rope64_lds(const f32x4* a, const float2* cs, LAS bf16_t* rowp, int fq, float sc) {
#pragma unroll
  for (int n = 0; n < 2; ++n) {
    const f32x4 c0 = *(const f32x4*)(cs + n * 16 + 4 * fq), c1 = *(const f32x4*)(cs + n * 16 + 4 * fq + 2);
    const float co[4] = {c0[0], c0[2], c1[0], c1[2]}, si[4] = {c0[1], c0[3], c1[1], c1[3]};
    float y1[4], y2[4];
#pragma unroll
    for (int j = 0; j < 4; ++j) { const float x1 = a[n][j] * sc, x2 = a[n + 2][j] * sc; y1[j] = x1 * co[j] - x2 * si[j]; y2[j] = x1 * si[j] + x2 * co[j]; }
    u32x2 w1, w2; w1.x = cvt_pk(y1[0], y1[1]); w1.y = cvt_pk(y1[2], y1[3]); w2.x = cvt_pk(y2[0], y2[1]); w2.y = cvt_pk(y2[2], y2[3]);
    *(LAS u32x2*)(rowp + n * 16 + 4 * fq) = w1;
    *(LAS u32x2*)(rowp + 32 + n * 16 + 4 * fq) = w2;
  }
}
DI void plain64_lds(const f32x4* a, LAS bf16_t* rowp, int fq) {
#pragma unroll
  for (int n = 0; n < 4; ++n) {
    u32x2 w; w.x = cvt_pk(a[n][0], a[n][1]); w.y = cvt_pk(a[n][2], a[n][3]);
    *(LAS u32x2*)(rowp + n * 16 + 4 * fq) = w;
  }
}
DI void plain64_store(const f32x4* a, bf16_t* rowp, int fq, float sc = 1.0f) {
#pragma unroll
  for (int n = 0; n < 4; ++n) {
    u32x2 w; w.x = cvt_pk(a[n][0] * sc, a[n][1] * sc); w.y = cvt_pk(a[n][2] * sc, a[n][3] * sc);
    *(u32x2*)(rowp + n * 16 + 4 * fq) = w;
  }
}
DI void vt64_store(const f32x4* a, bf16_t* vt_base  , int ld, int tperm, int fq, float sc = 1.0f) {
#pragma unroll
  for (int n = 0; n < 4; ++n)
#pragma unroll
    for (int j = 0; j < 4; ++j) vt_base[(size_t)(n * 16 + 4 * fq + j) * ld + tperm] = f2bf(a[n][j] * sc);
}
#define GEMM_IDS() const int tid = thr(), lane = tid & 63, wid = __builtin_amdgcn_readfirstlane(tid >> 6); \
  const int wr = wid >> 1, wc = wid & 1; int fr = lane & 15, fq = lane >> 4, r0 = tid >> 2, ck = (tid & 3) * 16; (void)lane; (void)wr; (void)wc; (void)fr; (void)fq
#define EPI_OPAQUE() asm volatile("" : "+v"(fr), "+v"(fq), "+v"(r0), "+v"(ck))

DI void phase_inproj0(const Params& p, LAS char* lds) {
  GEMM_IDS();
  for (int i = 0, u; xcd_unit(i, 128 * 8, u); ++i) {
    int mt, nt; mn_order(u, 8, mt, nt);
    const int m0 = mt * 256, n0 = nt * 256;
    const char* a0 = (const char*)(p.xb + (size_t)(m0 + r0) * 1024) + ck;
    const char* b0 = (const char*)(p.win0t + (size_t)(n0 + r0) * 1024) + ck;
    f32x4 acc[4][8]; zero_acc(acc);
    gemm_kloop(lds, a0, a0 + (size_t)128 * 2048, b0, b0 + (size_t)128 * 2048, 32, acc);
    EPI_OPAQUE();
    const int l_ = thr() & 63, rowb = m0 + wr * 64, bb = rowb >> 12, tb0 = rowb & 4095;
    LAS char* stg = lds + wid * 9216;
#pragma unroll
    for (int g2 = 0; g2 < 2; ++g2) {
      const int G = ((n0 + wc * 128) >> 6) + g2;
      int kind; bf16_t* hb = nullptr;
      if (G < 8) { kind = 0; hb = p.q0 + (size_t)(bb * 16 + G) * 4096 * 64; }
      else if (G < 10) { kind = 1; hb = p.ka + (size_t)(bb * 2 + (G - 8)) * 4096 * 64; }
      else if (G < 12) { kind = 3; hb = p.vta + (size_t)(bb * 2 + (G - 10)) * 64 * 4096; }
      else if (G < 20) { kind = 0; hb = p.q0 + (size_t)(bb * 16 + 8 + (G - 12)) * 4096 * 64; }
      else if (G < 22) { kind = 2; hb = p.kc0 + (size_t)(bb * 2 + (G - 20)) * 4096 * 64; }
      else if (G < 24) { kind = 2; hb = p.vc0 + (size_t)(bb * 2 + (G - 22)) * 4096 * 64; }
      else if (G < 26) { kind = 1; hb = p.ks + (size_t)(bb * 2 + (G - 24)) * 4096 * 64; }
      else if (G < 28) { kind = 3; hb = p.vts + (size_t)(bb * 2 + (G - 26)) * 64 * 4096; }
      else if (G < 30) { kind = 1; hb = p.kw + (size_t)(bb * 2 + (G - 28)) * 4096 * 64; }
      else { kind = 3; hb = p.vtw + (size_t)(bb * 2 + (G - 30)) * 64 * 4096; }
      if (kind == 3) {
        asm volatile("" ::: "memory");
#pragma unroll
        for (int m = 0; m < 4; ++m) {
          const int tp = m * 16 + (perm16(fr) & 15);
#pragma unroll
          for (int n = 0; n < 4; ++n)
#pragma unroll
            for (int j = 0; j < 4; ++j) *(LAS bf16_t*)(stg + (n * 16 + 4 * fq + j) * 144 + tp * 2) = f2bf(acc[m][4 * g2 + n][j]);
        }
        asm volatile("" ::: "memory");
#pragma unroll
        for (int q = 0; q < 8; ++q) {
          const int dl = (l_ >> 3) + 8 * q;
          const u32x4 dv = *(const LAS u32x4*)(stg + dl * 144 + (l_ & 7) * 16);
          *(u32x4*)(hb + (size_t)dl * 4096 + tb0 + (l_ & 7) * 8) = dv;
        }
        asm volatile("" ::: "memory");
      } else {
#pragma unroll
        for (int m = 0; m < 4; ++m) {
          const int t = tb0 + m * 16 + fr;
          LAS bf16_t* sr = (LAS bf16_t*)(stg + (m * 16 + fr) * 144);
          if (kind == 2) plain64_lds(&acc[m][4 * g2], sr, fq);
          else rope64_lds(&acc[m][4 * g2], p.cs64 + t * 32, sr, fq, kind == 0 ? QS64 : 1.0f);
          asm volatile("" ::: "memory");
        }
#pragma unroll
        for (int q = 0; q < 8; ++q) {
          const int rl = (l_ >> 3) + 8 * q;
          const u32x4 dv = *(const LAS u32x4*)(stg + rl * 144 + (l_ & 7) * 16);
          *(u32x4*)(hb + (size_t)(tb0 + rl) * 64 + (l_ & 7) * 8) = dv;
        }
        asm volatile("" ::: "memory");
      }
    }
    LDS_BAR();
  }
}

DI void phase_outproj(const Params& p, LAS char* lds, int layer) {
  GEMM_IDS();
  const bf16_t* A = layer == 0 ? p.obuf : p.xb;
  const bf16_t* Bt = layer == 0 ? p.wout0t : p.wout1t;
  const float* resid = layer == 0 ? p.in[0] : p.out;
  for (int i = 0, u; xcd_unit(i, 128 * 4, u); ++i) {
    int mt, nt; mn_order(u, 4, mt, nt);
    const int m0 = mt * 256, n0 = nt * 256;
    const char* a0 = (const char*)(A + (size_t)(m0 + r0) * 1024) + ck;
    const char* b0 = (const char*)(Bt + (size_t)(n0 + r0) * 1024) + ck;
    f32x4 acc[4][8]; zero_acc(acc);
    gemm_kloop(lds, a0, a0 + (size_t)128 * 2048, b0, b0 + (size_t)128 * 2048, 32, acc);
    EPI_OPAQUE();
#pragma unroll
    for (int m = 0; m < 4; ++m) {
      const size_t row = m0 + wr * 64 + m * 16 + fr;
#pragma unroll
      for (int n = 0; n < 8; ++n) {
        const size_t o = row * 1024 + n0 + wc * 128 + n * 16 + 4 * fq;
        const f32x4 r = *(const f32x4*)(resid + o);
        *(f32x4*)(p.out + o) = r * ALPHA + acc[m][n];
      }
      asm volatile("" ::: "memory");
    }
  }
}

DI float gelu_tanh_(float v) {
  const float u = 0.7978845608028654f * (v + 0.044715f * v * v * v);
  const float e = __expf(2.0f * u);
  const float th = 1.0f - 2.0f / (e + 1.0f);
  return 0.5f * v * (1.0f + th);
}

DI void cmp1_unit(const Params& p, LAS char* lds, int u) {
  GEMM_IDS();
  const int tensor = u >> 4, bg = u & 15;
  const bf16_t* src = (tensor == 0 ? p.kc0 : p.vc0) + (size_t)bg * 4096 * 64;
  const bf16_t* w1 = tensor == 0 ? p.cw1k : p.cw1v;
  const float* bias = tensor == 0 ? p.cb1k : p.cb1v;
  bf16_t* hout = (tensor == 0 ? p.h1k : p.h1v) + (size_t)bg * 256 * 128;
  const char* a0 = (const char*)(src + (size_t)r0 * 1024) + ck;
  const char* b0 = (const char*)(w1 + (size_t)r0 * 1024) + ck;
  f32x4 acc[4][8]; zero_acc(acc);
  gemm_kloop(lds, a0, a0 + (size_t)128 * 2048, b0, b0 + (size_t)128 * 2048, 32, acc);
  EPI_OPAQUE();
  if (wc == 1) {
#pragma unroll
    for (int m = 0; m < 4; ++m)
#pragma unroll
      for (int n = 0; n < 8; ++n) *(LAS f32x4*)(lds + (wr * 64 + m * 16 + fr) * 528 + (n * 16 + 4 * fq) * 4) = acc[m][n];
  }
  LDS_BAR();
  if (wc == 0) {
#pragma unroll
    for (int m = 0; m < 4; ++m) {
      const int row = wr * 64 + m * 16 + fr;
#pragma unroll
      for (int n = 0; n < 8; ++n) {
        const int cc = n * 16 + 4 * fq;
        const f32x4 bv = *(const f32x4*)(bias + cc);
        f32x4 bot = (f32x4){0.f, 0.f, 0.f, 0.f};
        if (row < 255) bot = *(const LAS f32x4*)(lds + (row + 1) * 528 + cc * 4);
        const f32x4 v = acc[m][n] + bot + bv;
        u32x2 w; w.x = cvt_pk(gelu_tanh_(v[0]), gelu_tanh_(v[1])); w.y = cvt_pk(gelu_tanh_(v[2]), gelu_tanh_(v[3]));
        if (row == 255) { w.x = 0u; w.y = 0u; }
        *(u32x2*)(hout + (size_t)row * 128 + cc) = w;
      }
    }
  }
  LDS_BAR();
}
DI void cmp2_unit(const Params& p, LAS char* lds, int u) {
  GEMM_IDS();
  {
    const int tensor = u >> 4, bg = u & 15;
    const bf16_t* hin = (tensor == 0 ? p.h1k : p.h1v) + (size_t)bg * 256 * 128;
    const bf16_t* w2 = tensor == 0 ? p.cw2k : p.cw2v;
    const char* a0 = (const char*)(hin + (size_t)r0 * 128) + ck;
    const char* b0 = (const char*)(w2 + (size_t)r0 * 128) + ck;
    f32x4 acc[4][8]; zero_acc(acc);
    gemm_kloop(lds, a0, a0 + 128 * 256, b0, b0 + 128 * 256, 4, acc);
    EPI_OPAQUE();
    if (wc == 0) {
#pragma unroll
      for (int m = 0; m < 4; ++m) {
        const int n_row = wr * 64 + m * 16 + fr;
        const bool valid = n_row < 255;
        if (!valid) {
#pragma unroll
          for (int n = 0; n < 4; ++n) acc[m][n] = (f32x4){0.f, 0.f, 0.f, 0.f};
        }
        if (tensor == 0) {
          const int pos = valid ? 16 * n_row + 31 : 0;
          rope64_store(&acc[m][0], p.cs64 + pos * 32, p.kcmp + ((size_t)bg * 256 + n_row) * 64, fq);
        } else {
          vt64_store(&acc[m][0], p.vcmpt + (size_t)bg * 64 * 256, 256, perm16(n_row), fq);
        }
      }
    }
  }
}

DI void load_q4(bf16x8 (&qf)[6], const bf16_t* qrow, int h) {
#pragma unroll
  for (int ks = 0; ks < 4; ++ks) qf[ks] = *(const bf16x8*)(qrow + (2 * ks + h) * 8);
}
DI void zero_o(f32x16 (&o)[2]) {
#pragma unroll
  for (int r = 0; r < 16; ++r) { o[0][r] = 0.f; o[1][r] = 0.f; }
}

DI void swa_unit(const Params& p, LAS char* lds, int u) {
  const int tid = thr(), lane = tid & 63, wid = __builtin_amdgcn_readfirstlane(tid >> 6);
  const int r32 = lane & 31, h = lane >> 5;
  const int b = u >> 7, g = (u >> 6) & 1, qb = u & 63, t0 = qb * 64;
  const int hd = g * 4 + (wid & 3), tw0 = t0 + 32 * (wid >> 2), t = tw0 + r32;
  bf16x8 qf[6];
  load_q4(qf, p.q0 + ((size_t)(b * 16 + hd) * 4096 + t) * 64, h);
  f32x16 o[2]; zero_o(o);
  SmState sm; f32x16 negr; sm_init(sm, negr);
  const int tlo = (t0 - 127) < 0 ? 0 : ((t0 - 127) >> 6);
  const char* kb = (const char*)(p.ka + (size_t)(b * 2 + g) * 4096 * 64);
  const char* vb = (const char*)(p.vta + (size_t)(b * 2 + g) * 64 * 4096);
  kv_stream<false>(lds, kb, vb, 8192, nullptr, tlo, qb, [&](int tile, const LAS char* st) {
    f32x16 sA, sB;
    qk_tile<false>(st, nullptr, qf, r32, h, negr, sA, sB);
    if (!(tile * 64 > tw0 + 31 - 128 && tile * 64 + 63 <= tw0)) mask_scores(sA, sB, tile * 64, t - 128, t, h);
    softmax_ref(sA, sB, sm, negr, o);
    pv_tile(st + 8192, sA, sB, r32, h, o);
  });
  float lt = l_total(sm.l);
  lt += fast_exp2(p.in[2][hd] * LOG2E - sm.ref);
  const float inv = 1.0f / lt;
#pragma unroll
  for (int r = 0; r < 16; ++r) { o[0][r] *= inv; o[1][r] *= inv; }
  store_o_rows(lds, p.obuf + (size_t)(b * 4096 + tw0) * 1024 + hd * 64, o, wid, lane);
}

constexpr int NSA_CMPK = 0, NSA_CMPV = 32768, NSA_IMP = A_RING > 65536 ? A_RING : 65536, NSA_SELM = NSA_IMP + 64 * 65 * 4, NSA_LDS = NSA_SELM + 512;

DI void nsa_unit(const Params& p, LAS char* lds, int b, int g, int qb) {
  const int tid = thr(), lane = tid & 63, wid = __builtin_amdgcn_readfirstlane(tid >> 6);
  const int r32 = lane & 31, h = lane >> 5;
  const int t0 = qb * 64, qh = wid >> 2, hd = g * 4 + (wid & 3), ql = 32 * qh + r32, t = t0 + ql, tw0 = t0 + 32 * qh;
  const int bg = b * 2 + g;
  bf16x8 qf[6];
  load_q4(qf, p.q0 + ((size_t)(b * 16 + 8 + hd) * 4096 + t) * 64, h);
  const float* gp = p.gates + (size_t)(b * 4096 + t) * 24 + hd;
  const float g_cmp = gp[0], g_sel = gp[8], g_win = gp[16];
  f32x16 ot[2]; zero_o(ot);
  f32x16 zero16;
#pragma unroll
  for (int r = 0; r < 16; ++r) zero16[r] = 0.f;
  LAS int* imp = (LAS int*)(lds + NSA_IMP);
  LAS unsigned long long* selm = (LAS unsigned long long*)(lds + NSA_SELM);
  {
    const char* ksrc = (const char*)(p.kcmp + (size_t)bg * 256 * 64);
    const char* vsrc = (const char*)(p.vcmpt + (size_t)bg * 64 * 256);
    asm volatile("s_waitcnt vmcnt(0)" ::: "memory");
#pragma unroll
    for (int i = 0; i < 4; ++i) {
      const int pc = tid + 512 * i, row = pc >> 3, cs = ((pc & 7) ^ ((row >> 1) & 7)) << 4;
      glds16(ksrc + (size_t)row * 128 + cs, lds + NSA_CMPK + pc * 16);
      const int d = tid >> 3, cv = ((tid & 7) ^ ((d >> 1) & 7)) << 4;
      glds16(vsrc + (size_t)d * 512 + i * 128 + cv, lds + NSA_CMPV + i * 8192 + tid * 16);
    }
    for (int i = tid; i < 64 * 65; i += NTHR) imp[i] = 0;
    WAIT_VM_BAR(0);
  }
  {
    const int hi_c = (t - 31) >> 4;
    const int nmax = (t0 + 63 - 31) >> 4;
    const int ntile = (nmax >> 6) + 1;
    float m = NEGBIG, l = 0.f;
    for (int j = 0; j < ntile; ++j) {
      f32x16 sA, sB;
      qk_tile<false>(lds + NSA_CMPK + j * 8192, nullptr, qf, r32, h, zero16, sA, sB);
      mask_scores(sA, sB, j * 64, -1000000, hi_c, h);
      const float mnew = fmaxf(m, row_max32(sA, sB));
      const float mc = (mnew < -1e29f) ? 0.f : mnew;
      float sum = 0.f;
#pragma unroll
      for (int r = 0; r < 16; ++r) sum += fast_exp2(sA[r] - mc) + fast_exp2(sB[r] - mc);
      l = l * fast_exp2(m - mc) + sum;
      m = mnew;
    }
    const float lt = l_total(l);
    const float inv = lt > 0.f ? 1.0f / lt : 0.f;
    const float mc = (m < -1e29f) ? 0.f : m;
    f32x16 oc[2]; zero_o(oc);
    for (int j = 0; j < ntile; ++j) {
      f32x16 sA, sB;
      qk_tile<false>(lds + NSA_CMPK + j * 8192, nullptr, qf, r32, h, zero16, sA, sB);
      mask_scores(sA, sB, j * 64, -1000000, hi_c, h);
#pragma unroll
      for (int r = 0; r < 16; ++r) { sA[r] = fast_exp2(sA[r] - mc) * inv; sB[r] = fast_exp2(sB[r] - mc) * inv; }
#pragma unroll
      for (int q4 = 0; q4 < 4; ++q4) {
        const int mb = 16 * j + 2 * q4 + h;
        const float a0 = sA[4 * q4] + sA[4 * q4 + 1] + sA[4 * q4 + 2] + 0.5f * sA[4 * q4 + 3];
        const float a1 = sB[4 * q4] + sB[4 * q4 + 1] + sB[4 * q4 + 2] + 0.5f * sB[4 * q4 + 3];
        const float FX = 16777216.0f;
        atomicAdd((int*)(imp + ql * 65 + mb), __float2int_rn(a0 * FX));
        atomicAdd((int*)(imp + ql * 65 + mb + 1), __float2int_rn(0.5f * sA[4 * q4 + 3] * FX));
        atomicAdd((int*)(imp + ql * 65 + mb + 8), __float2int_rn(a1 * FX));
        if (mb + 9 < 64) atomicAdd((int*)(imp + ql * 65 + mb + 9), __float2int_rn(0.5f * sB[4 * q4 + 3] * FX));
      }
      pv_tile(lds + NSA_CMPV + j * 8192, sA, sB, r32, h, oc);
    }
#pragma unroll
    for (int r = 0; r < 16; ++r) { ot[0][r] = g_cmp * oc[0][r]; ot[1][r] = g_cmp * oc[1][r]; }
  }
  LDS_BAR();
  for (int i0 = 0; i0 < 8; i0 += 4) {
    unsigned key[4]; unsigned long long picked[4];
#pragma unroll
    for (int c = 0; c < 4; ++c) {
      const int q = wid * 8 + i0 + c, tq = t0 + q;
      const int iv = imp[q * 65 + lane];
      const bool forced = (lane == 0) || (lane == qb) || (lane == qb - 1);
      const bool future = lane * 64 > tq;
      key[c] = forced ? 0x80000001u : (future ? 1u : (unsigned)iv + 2u);
      picked[c] = 0ull;
    }
#pragma unroll 4
    for (int k = 0; k < 16; ++k)
#pragma unroll
      for (int c = 0; c < 4; ++c) {
        const unsigned mx = wave_max_u32(key[c]);
        const int idx = __builtin_ctzll(__ballot(key[c] == mx));
        picked[c] |= 1ull << idx;
        key[c] = (lane == idx) ? 0u : key[c];
      }
#pragma unroll
    for (int c = 0; c < 4; ++c) if (lane == 0) selm[wid * 8 + i0 + c] = picked[c];
  }
  LDS_BAR();
  const unsigned long long mysel = selm[ql];
  {
    f32x16 o[2]; zero_o(o);
    SmState sm; f32x16 negr; sm_init(sm, negr);
    const char* kb = (const char*)(p.ks + (size_t)bg * 4096 * 64);
    const char* vb = (const char*)(p.vts + (size_t)bg * 64 * 4096);
    kv_stream<false>(lds, kb, vb, 8192, nullptr, 0, qb, [&](int tile, const LAS char* st) {
      f32x16 sA, sB;
      qk_tile<false>(st, nullptr, qf, r32, h, negr, sA, sB);
      const bool keep = (mysel >> tile) & 1ull;
      if (tile < qb) mask_lane(sA, sB, keep); else mask_scores(sA, sB, tile * 64, -1000000, keep ? t : -1, h);
      softmax_ref(sA, sB, sm, negr, o);
      pv_tile(st + 8192, sA, sB, r32, h, o);
    });
    const float lt = l_total(sm.l);
    const float sc = lt > 0.f ? g_sel / lt : 0.f;
#pragma unroll
    for (int r = 0; r < 16; ++r) { ot[0][r] += sc * o[0][r]; ot[1][r] += sc * o[1][r]; }
  }
  {
    f32x16 o[2]; zero_o(o);
    SmState sm; f32x16 negr; sm_init(sm, negr);
    const char* kb = (const char*)(p.kw + (size_t)bg * 4096 * 64);
    const char* vb = (const char*)(p.vtw + (size_t)bg * 64 * 4096);
    const int tlo = (t0 - 511) < 0 ? 0 : ((t0 - 511) >> 6);
    kv_stream<false>(lds, kb, vb, 8192, nullptr, tlo, qb, [&](int tile, const LAS char* st) {
      f32x16 sA, sB;
      qk_tile<false>(st, nullptr, qf, r32, h, negr, sA, sB);
      if (!(tile * 64 > tw0 + 31 - 512 && tile * 64 + 63 <= tw0)) mask_scores(sA, sB, tile * 64, t - 512, t, h);
      softmax_ref(sA, sB, sm, negr, o);
      pv_tile(st + 8192, sA, sB, r32, h, o);
    });
    const float lt = l_total(sm.l);
    const float sc = lt > 0.f ? g_win / lt : 0.f;
#pragma unroll
    for (int r = 0; r < 16; ++r) { ot[0][r] += sc * o[0][r]; ot[1][r] += sc * o[1][r]; }
  }
  store_o_rows(lds, p.obuf + (size_t)(b * 4096 + tw0) * 1024 + 512 + hd * 64, ot, wid, lane);
}

DI void cmp_block(const Params& p, LAS char* lds, int u) {
  cmp1_unit(p, lds, u);
  asm volatile("s_waitcnt vmcnt(0)" ::: "memory");
  __syncthreads();
  __builtin_amdgcn_fence(__ATOMIC_ACQUIRE, "agent");
  cmp2_unit(p, lds, u);
}
DI void phase_swa_cmp1(const Params& p, LAS char* lds) {
  if (gdim() == 256) {
    const int x = bid() & 7, jb = bid() >> 3;
    int start, cnt;
    if (jb < 4) { cmp_block(p, lds, bid()); start = jb; cnt = 1; }
    else { const int r = jb - 4; if (r < 12) { start = 4 + 5 * r; cnt = 5; } else { start = 64 + 4 * (r - 12); cnt = 4; } }
    for (int i = 0; i < cnt; ++i) swa_unit(p, lds, x * 128 + start + i);
  } else {
    for (int u = bid(); u < 32; u += gdim()) cmp_block(p, lds, u);
    for (int i = 0, u; xcd_unit(i, 1024, u); ++i) swa_unit(p, lds, u);
  }
}
DI void phase_nsa(const Params& p, LAS char* lds) {
  const int G = gdim();
  if ((G & 7) == 0 && G >= 16) {
    const int per = G >> 3, x = bid() & 7, jb = bid() >> 3;
    for (int j = 0; j * per < 128; ++j) {
      const int pos = (j & 1) ? j * per + (per - 1 - jb) : j * per + jb;
      if (pos < 128) { const int bg = 2 * x + (pos & 1); nsa_unit(p, lds, bg >> 1, bg & 1, 63 - (pos >> 1)); }
    }
  } else {
    for (int j = 0;; ++j) {
      const int pos = (j & 1) ? j * G + (G - 1 - (int)bid()) : j * G + (int)bid();
      if (j * G >= 1024) break;
      if (pos < 1024) nsa_unit(p, lds, (pos & 15) >> 1, pos & 1, 63 - (pos >> 4));
    }
  }
}

DI void mla_unit(const Params& p, LAS char* lds, int b, int hd, int qb4) {
  const int tid = thr(), lane = tid & 63, wid = __builtin_amdgcn_readfirstlane(tid >> 6);
  const int r32 = lane & 31, h = lane >> 5;
  const int tw0 = qb4 * 256 + 32 * wid, t = tw0 + r32;
  const bf16_t* qrow = p.q1 + ((size_t)(b * 16 + hd) * 4096 + t) * 96;
  bf16x8 qf[6];
#pragma unroll
  for (int ks = 0; ks < 6; ++ks) qf[ks] = *(const bf16x8*)(qrow + (2 * ks + h) * 8);
  f32x16 o[2]; zero_o(o);
  SmState sm; f32x16 negr; sm_init(sm, negr);
  const char* kb = (const char*)(p.kn + (size_t)(b * 16 + hd) * 4096 * 64);
  const char* vb = (const char*)(p.vt1 + (size_t)(b * 16 + hd) * 64 * 4096);
  const char* rb = (const char*)(p.krb + (size_t)b * 4096 * 32);
  kv_stream<true>(lds, kb, vb, 8192, rb, 0, qb4 * 4 + 3, [&](int tile, const LAS char* st) {
    if (tile * 64 <= tw0 + 31) {
      f32x16 sA, sB;
      qk_tile<true>(st, st + 16384, qf, r32, h, negr, sA, sB);
      if (tile * 64 + 63 > tw0) mask_scores(sA, sB, tile * 64, -1000000, t, h);
      softmax_ref(sA, sB, sm, negr, o);
      pv_tile(st + 8192, sA, sB, r32, h, o);
    }
  });
  const float inv = 1.0f / l_total(sm.l);
#pragma unroll
  for (int r = 0; r < 16; ++r) { o[0][r] *= inv; o[1][r] *= inv; }
  {
    LAS char* stg = lds + wid * 4608;
#pragma unroll
    for (int dd = 0; dd < 2; ++dd)
#pragma unroll
      for (int g = 0; g < 4; ++g) {
        u32x2 w; w.x = cvt_pk(o[dd][4 * g + 0], o[dd][4 * g + 1]); w.y = cvt_pk(o[dd][4 * g + 2], o[dd][4 * g + 3]);
        *(LAS u32x2*)(stg + r32 * 144 + (32 * dd + 8 * g + 4 * h) * 2) = w;
      }
#pragma unroll
    for (int q = 0; q < 4; ++q) {
      const int rl = (lane >> 3) + 8 * q;
      *(u32x4*)(p.xb + (size_t)(b * 4096 + tw0 + rl) * 1024 + hd * 64 + (lane & 7) * 8) = *(const LAS u32x4*)(stg + rl * 144 + (lane & 7) * 16);
    }
    LDS_BAR();
  }
}
DI void phase_mla(const Params& p, LAS char* lds) {
  const int G = gdim();
  if ((G & 7) == 0 && G >= 16) {
    const int per = G >> 3, x = bid() & 7, jb = bid() >> 3;
    for (int j = 0; j * per < 256; ++j) {
      const int pos = (j & 1) ? j * per + (per - 1 - jb) : j * per + jb;
      if (pos < 256) { const int bh = 16 * x + (pos & 15); mla_unit(p, lds, bh >> 4, bh & 15, 15 - (pos >> 4)); }
    }
  } else {
    for (int j = 0;; ++j) {
      const int pos = (j & 1) ? j * G + (G - 1 - (int)bid()) : j * G + (int)bid();
      if (j * G >= 2048) break;
      if (pos < 2048) mla_unit(p, lds, (pos & 127) >> 4, pos & 15, 15 - (pos >> 7));
    }
  }
}
DI void ln_row(const f32x4 (&v)[4], const float* gam, const float* bet, int lane, f32x4 (&y)[4]) {
  float s = 0.f;
#pragma unroll
  for (int j = 0; j < 4; ++j) s += (v[j][0] + v[j][1]) + (v[j][2] + v[j][3]);
  const float mu = wave_sum(s) * (1.0f / 1024.0f);
  float q = 0.f;
  f32x4 d[4];
#pragma unroll
  for (int j = 0; j < 4; ++j) { d[j] = v[j] - mu; q += (d[j][0] * d[j][0] + d[j][1] * d[j][1]) + (d[j][2] * d[j][2] + d[j][3] * d[j][3]); }
  const float rs = rsqrtf(wave_sum(q) * (1.0f / 1024.0f) + 1e-5f);
#pragma unroll
  for (int j = 0; j < 4; ++j) {
    const f32x4 gv = *(const f32x4*)(gam + 4 * lane + 256 * j), bv = *(const f32x4*)(bet + 4 * lane + 256 * j);
    y[j] = d[j] * rs * gv + bv;
  }
}
DI void st_wt8(void* p, u32x2 v) { __hip_atomic_store((unsigned long long*)p, ((unsigned long long)v.y << 32) | v.x, __ATOMIC_RELAXED, __HIP_MEMORY_SCOPE_SYSTEM); }
DI void lnsplit_store(const Params& p, size_t row, int lane, const f32x4 (&y)[4]) {
#pragma unroll
  for (int j = 0; j < 4; ++j) {
    u32x2 hi; hi.x = cvt_pk(y[j][0], y[j][1]); hi.y = cvt_pk(y[j][2], y[j][3]);
    const float r0 = y[j][0] - __uint_as_float(hi.x << 16), r1 = y[j][1] - __uint_as_float(hi.x & 0xffff0000u);
    const float r2 = y[j][2] - __uint_as_float(hi.y << 16), r3 = y[j][3] - __uint_as_float(hi.y & 0xffff0000u);
    u32x2 lo; lo.x = cvt_pk(r0, r1); lo.y = cvt_pk(r2, r3);
    *(u32x2*)(p.xb + row * 1024 + 4 * lane + 256 * j) = hi;
    *(u32x2*)(p.x1lo + row * 1024 + 4 * lane + 256 * j) = lo;
  }
}
constexpr int LIST_CAP = 32768;
constexpr int R_STAGE = 12288;
DI void router_kloop(LAS char* lds, const char* a0, const char* b0, int nk, f32x4 (&acc)[4]) {
  const int tid = thr(), lane = tid & 63, wid = __builtin_amdgcn_readfirstlane(tid >> 6), fr = lane & 15, fq = lane >> 4;
  LAS char* dA = lds + tid * 16;
  LAS char* dB = lds + 8192 + (tid & 255) * 16;
  const int aoff = (wid * 16 + fr) * 64 + fq * 16, boff = 8192 + fr * 64 + fq * 16;
#define R_ISSUE(slot, kt) do { glds16(a0 + (size_t)(kt) * 64, dA + (slot) * R_STAGE); glds16(b0 + (size_t)(kt) * 64, dB + (slot) * R_STAGE); } while (0)
  R_ISSUE(0, 0);
  if (nk > 1) R_ISSUE(1, 1);
  if (nk > 2) R_ISSUE(2, 2);
  int slot = 0;
  for (int t = 0; t < nk; ++t) {
    if (t + 2 < nk) { WAIT_VM_BAR(4); } else if (t + 1 < nk) { WAIT_VM_BAR(2); } else { WAIT_VM_BAR(0); }
    if (t + 3 < nk) R_ISSUE((slot + 3) & 3, t + 3);
    const LAS char* base = lds + slot * R_STAGE;
    const bf16x8 af = *(const LAS bf16x8*)(base + aoff);
#pragma unroll
    for (int n = 0; n < 4; ++n) { const bf16x8 bf_ = *(const LAS bf16x8*)(base + boff + n * 1024); acc[n] = __builtin_amdgcn_mfma_f32_16x16x32_bf16(bf_, af, acc[n], 0, 0, 0); }
    slot = (slot + 1) & 3;
  }
#undef R_ISSUE
  LDS_BAR();
}
constexpr int R3_STAGE = 24576;
DI void router3_kloop(LAS char* lds, const char* ahi, const char* alo, const char* bsel  , int nk, f32x4 (&acc)[4]) {
  const int tid = thr(), lane = tid & 63, wid = __builtin_amdgcn_readfirstlane(tid >> 6), fr = lane & 15, fq = lane >> 4;
  LAS char* dA = lds + tid * 16;
  LAS char* dB = lds + 16384 + tid * 16;
  const int aoff = (wid * 16 + fr) * 64 + fq * 16, boff = 16384 + fr * 64 + fq * 16;
#define R3_ISSUE(slot, kt) do { glds16(ahi + (size_t)(kt) * 64, dA + (slot) * R3_STAGE); glds16(alo + (size_t)(kt) * 64, dA + 8192 + (slot) * R3_STAGE); \
    glds16(bsel + (size_t)(kt) * 64, dB + (slot) * R3_STAGE); } while (0)
  R3_ISSUE(0, 0);
  if (nk > 1) R3_ISSUE(1, 1);
  if (nk > 2) R3_ISSUE(2, 2);
  int slot = 0;
  for (int t = 0; t < nk; ++t) {
    if (t + 2 < nk) { WAIT_VM_BAR(6); } else if (t + 1 < nk) { WAIT_VM_BAR(3); } else { WAIT_VM_BAR(0); }
    if (t + 3 < nk) R3_ISSUE((slot + 3) & 3, t + 3);
    const LAS char* base = lds + slot * R3_STAGE;
    const bf16x8 ah = *(const LAS bf16x8*)(base + aoff), al = *(const LAS bf16x8*)(base + 8192 + aoff);
#pragma unroll
    for (int n = 0; n < 4; ++n) {
      const bf16x8 bh = *(const LAS bf16x8*)(base + boff + n * 1024), bl = *(const LAS bf16x8*)(base + 4096 + boff + n * 1024);
      acc[n] = __builtin_amdgcn_mfma_f32_16x16x32_bf16(bh, ah, acc[n], 0, 0, 0);
      acc[n] = __builtin_amdgcn_mfma_f32_16x16x32_bf16(bh, al, acc[n], 0, 0, 0);
      acc[n] = __builtin_amdgcn_mfma_f32_16x16x32_bf16(bl, ah, acc[n], 0, 0, 0);
    }
    slot = (slot + 1) & 3;
  }
#undef R3_ISSUE
  LDS_BAR();
}
DI void gate_pass(const Params& p, LAS char* lds) {
  const int tid = thr(), lane = tid & 63, wid = __builtin_amdgcn_readfirstlane(tid >> 6), fr = lane & 15, fq = lane >> 4;
  for (int u = bid(); u < 256; u += gdim()) {
    const int m0 = u * 128;
    const size_t aro = (size_t)(m0 + (tid >> 2)) * 2048 + (tid & 3) * 16, bro = (size_t)(2048 + ((tid & 255) >> 2)) * 2048 + (tid & 3) * 16;
    f32x4 acc[4];
#pragma unroll
    for (int n = 0; n < 4; ++n) acc[n] = (f32x4){0.f, 0.f, 0.f, 0.f};
    router_kloop(lds, (const char*)p.xb + aro, (const char*)p.win0t + bro, 32, acc);
    const size_t row = (size_t)m0 + wid * 16 + fr;
#pragma unroll
    for (int n = 0; n < 2; ++n)
#pragma unroll
      for (int j = 0; j < 4; ++j) { const int cc = n * 16 + 4 * fq + j; if (cc < 24) p.gates[row * 24 + cc] = sigmoidf_(acc[n][j]); }
  }
}
DI void phase_router(const Params& p, LAS char* lds, int layer) {
  const int tid = thr(), lane = tid & 63, wid = __builtin_amdgcn_readfirstlane(tid >> 6), fr = lane & 15, fq = lane >> 4;
  LAS float* lg = (LAS float*)(lds + 4 * R3_STAGE) + wid * (16 * 65);
  LAS int* hist = (LAS int*)(lds + 4 * R3_STAGE + 8 * 16 * 65 * 4);
  LAS int* se = hist + 128;
  LAS float* sw = (LAS float*)(se + 128 * 6);
  const int half_tokens = NTOK / p.nsplit, cap = LIST_CAP / p.nsplit;
  const float* bias = p.in[21] + layer * 64;
  for (int u = bid(); u < 256; u += gdim()) {
    const int m0 = u * 128;
    {
      const float* gam = p.in[16] + layer * 1024;
      const float* bet = p.in[17] + layer * 1024;
      for (int i = 0; i < 16; i += 2) {
        const size_t row = (size_t)m0 + wid * 16 + i, row2 = row + 1;
        f32x4 v0[4], v1[4], y[4];
#pragma unroll
        for (int j = 0; j < 4; ++j) v0[j] = *(const f32x4*)(p.out + row * 1024 + 4 * lane + 256 * j);
#pragma unroll
        for (int j = 0; j < 4; ++j) v1[j] = *(const f32x4*)(p.out + row2 * 1024 + 4 * lane + 256 * j);
        ln_row(v0, gam, bet, lane, y); lnsplit_store(p, row, lane, y);
        ln_row(v1, gam, bet, lane, y); lnsplit_store(p, row2, lane, y);
      }
      asm volatile("s_waitcnt vmcnt(0)" ::: "memory");
      __syncthreads();
      __builtin_amdgcn_fence(__ATOMIC_ACQUIRE, "agent");
    }
    const size_t aro = (size_t)(m0 + (tid >> 2)) * 2048 + (tid & 3) * 16, bro = (size_t)((tid & 255) >> 2) * 2048 + (tid & 3) * 16;
    f32x4 acc[4];
#pragma unroll
    for (int n = 0; n < 4; ++n) acc[n] = (f32x4){0.f, 0.f, 0.f, 0.f};
    SUB_BEGIN(1);
    router3_kloop(lds, (const char*)p.xb + aro, (const char*)p.x1lo + aro, (const char*)(tid < 256 ? p.rwh[layer] : p.rwl[layer]) + bro, 32, acc);
    SUB_END(1);
#pragma unroll
    for (int n = 0; n < 4; ++n)
#pragma unroll
      for (int j = 0; j < 4; ++j) lg[fr * 65 + n * 16 + 4 * fq + j] = acc[n][j];
    if (tid < 64) hist[tid] = 0;
    LDS_BAR();
    const float be = bias[lane];
    SUB_BEGIN(2);
    for (int i0 = 0; i0 < 16; i0 += 4) {
      float s[4], sb[4], m1[4], m2[4];
#pragma unroll
      for (int c = 0; c < 4; ++c) { s[c] = sigmoidf_(lg[(i0 + c) * 65 + lane]); sb[c] = s[c] + be; m1[c] = sb[c]; m2[c] = -INFINITY; }
#define TOP2_STEP(c, ctrl) do { const float o1 = __int_as_float(__builtin_amdgcn_update_dpp(0, __float_as_int(m1[c]), (ctrl), 0xF, 0xF, true)); \
        const float o2 = __int_as_float(__builtin_amdgcn_update_dpp(0, __float_as_int(m2[c]), (ctrl), 0xF, 0xF, true)); \
        const float n1 = fmaxf(m1[c], o1); m2[c] = fmaxf(fminf(m1[c], o1), fmaxf(m2[c], o2)); m1[c] = n1; } while (0)
#pragma unroll
      for (int c = 0; c < 4; ++c) TOP2_STEP(c, 0xB1);
#pragma unroll
      for (int c = 0; c < 4; ++c) TOP2_STEP(c, 0x4E);
#pragma unroll
      for (int c = 0; c < 4; ++c) TOP2_STEP(c, 0x141);
#undef TOP2_STEP
      unsigned gk[4], gmask[4];
#pragma unroll
      for (int c = 0; c < 4; ++c) { gk[c] = ((lane & 7) == 0) ? fkey(m1[c] + m2[c]) : 0u; gmask[c] = 0u; }
#pragma unroll
      for (int k = 0; k < 4; ++k)
#pragma unroll
        for (int c = 0; c < 4; ++c) {
          const unsigned mx = wave_max_u32(gk[c]);
          const int idx = __builtin_ctzll(__ballot(gk[c] == mx));
          gmask[c] |= 1u << (idx >> 3);
          gk[c] = (lane == idx) ? 0u : gk[c];
        }
      unsigned ek[4]; int myslot[4]; float sum[4];
#pragma unroll
      for (int c = 0; c < 4; ++c) { const bool allowed = (gmask[c] >> (lane >> 3)) & 1u; ek[c] = allowed ? fkey(sb[c]) : 0u; myslot[c] = -1; sum[c] = 0.f; }
#pragma unroll
      for (int k = 0; k < 6; ++k)
#pragma unroll
        for (int c = 0; c < 4; ++c) {
          const unsigned mx = wave_max_u32(ek[c]);
          const int idx = __builtin_ctzll(__ballot(ek[c] == mx));
          sum[c] += __int_as_float(__builtin_amdgcn_readlane(__float_as_int(s[c]), idx));
          if (lane == idx) { myslot[c] = k; ek[c] = 0u; }
        }
#pragma unroll
      for (int c = 0; c < 4; ++c)
        if (myslot[c] >= 0) {
          const int r = wid * 16 + i0 + c;
          const int lp = atomicAdd((int*)(hist + lane), 1);
          se[r * 6 + myslot[c]] = lane | (lp << 8);
          sw[r * 6 + myslot[c]] = s[c] / sum[c] * 2.5f;
        }
    }
    LDS_BAR();
    SUB_END(2);
    const int half = m0 / half_tokens;
    if (tid < 64) hist[64 + tid] = atomicAdd(p.cnt + (layer * 2 + half) * 64 + tid, hist[tid]);
    LDS_BAR();
    for (int i = tid; i < 128 * 6; i += NTHR) {
      const int v = se[i], e = v & 255, lp = v >> 8, r = i / 6, slot = i - r * 6;
      const int tok = m0 + r;
      p.lists[((size_t)half * 64 + e) * cap + hist[64 + e] + lp] = make_int2(tok * 8 + slot, __float_as_int(sw[i]));
    }
    LDS_BAR();
  }
}

DI void expert_map(const Params& p, LAS int* tb, int layer, int half) {
  if (thr() < 64) {
    const int c = p.cnt[(layer * 2 + half) * 64 + thr()];
    int t = (c + 255) >> 8, incl = t;
#pragma unroll
    for (int o = 1; o < 64; o <<= 1) { const int v = __builtin_amdgcn_ds_bpermute((((int)thr() - o) & 63) << 2, incl); if ((int)thr() >= o) incl += v; }
    tb[thr()] = incl - t;
    if (thr() == 63) { tb[64] = incl; tb[130] = half * (NTOK / p.nsplit); }
    tb[65 + thr()] = c;
  }
  LDS_BAR();
}
DI int find_expert(const LAS int* tb, int mt) {
  int e = 0;
#pragma unroll 8
  for (int i = 1; i < 64; ++i) e = (tb[i] <= mt) ? i : e;
  return e;
}
struct ExpPtrs { const char *a0, *a1, *b0; };
DI void phase_exp1(const Params& p, LAS char* lds, int layer, int half) {
  const int wid = __builtin_amdgcn_readfirstlane(thr() >> 6), wr = wid >> 1, wc = wid & 1;
  LAS int* tb = (LAS int*)(lds + MISC_OFF);
  expert_map(p, tb, layer, half);
  const int half_tokens = NTOK / p.nsplit, cap = LIST_CAP / p.nsplit;
  const int TR = tb[64], TS = half_tokens / 256;
  auto lookup = [&](int u, bool isS, int& mt, int& nt, int& tok0, int& tok1, const bf16_t*& W) {
    mt = (u >> 1) + (isS ? TR : 0); nt = u & 1;
    const int r0 = thr() >> 2;
    if (!isS) {
      const int e = __builtin_amdgcn_readfirstlane(find_expert(tb, mt)), cnt = tb[65 + e];
      const int2* lst = p.lists + ((size_t)half * 64 + e) * cap;
      const int i0 = (mt - tb[e]) * 256 + r0, i1 = i0 + 128;
      tok0 = lst[i0 < cnt ? i0 : 0].x >> 3; tok1 = lst[i1 < cnt ? i1 : 0].x >> 3;
      W = p.egu + (size_t)e * 524288;
    } else { tok0 = tb[130] + (mt - TR) * 256 + r0; tok1 = tok0 + 128; W = p.shgu[layer]; }
  };
  auto mkptrs = [&](int nt, int tok0, int tok1, const bf16_t* W) {
    const int t_ = thr(), r0 = t_ >> 2, ck = (t_ & 3) * 16;
    ExpPtrs q; q.a0 = (const char*)(p.xb + (size_t)tok0 * 1024) + ck; q.a1 = (const char*)(p.xb + (size_t)tok1 * 1024) + ck;
    q.b0 = (const char*)(W + (size_t)(nt * 256 + r0) * 1024) + ck; return q; };
  int u, mt, nt, tok0, tok1; bool isS; const bf16_t* W;
  bool has = xcd_unit2(0, TR * 2, TS * 2, u, isS);
  ExpPtrs cur{};
  if (has) { lookup(u, isS, mt, nt, tok0, tok1, W); cur = mkptrs(nt, tok0, tok1, W); gemm_prefetch(lds, cur.a0, cur.a1, cur.b0, cur.b0 + (size_t)128 * 2048, 32); }
  for (int i = 0; has; ++i) {
    int u2, mt2 = 0, nt2 = 0, tokn0 = 0, tokn1 = 0; bool isS2; const bf16_t* W2 = nullptr;
    const bool has2 = xcd_unit2(i + 1, TR * 2, TS * 2, u2, isS2);
    if (has2) lookup(u2, isS2, mt2, nt2, tokn0, tokn1, W2);
    f32x4 acc[4][8]; zero_acc(acc);
    gemm_kloop<true>(lds, cur.a0, cur.a1, cur.b0, cur.b0 + (size_t)128 * 2048, 32, acc);
    const int l_ = thr() & 63, fr = l_ & 15, fq = l_ >> 4;
    ExpPtrs nxt{};
    if (has2) { nxt = mkptrs(nt2, tokn0, tokn1, W2); gemm_prefetch(lds, nxt.a0, nxt.a1, nxt.b0, nxt.b0 + (size_t)128 * 2048, 32); }
    LAS char* stg = lds + 3 * G_STAGE + wid * 2304;
#pragma unroll
    for (int m = 0; m < 4; ++m) {
#pragma unroll
      for (int g2 = 0; g2 < 2; ++g2)
#pragma unroll
        for (int n = 0; n < 2; ++n) {
          float hv[4];
#pragma unroll
          for (int j = 0; j < 4; ++j) { const float gt = acc[m][4 * g2 + n][j]; hv[j] = gt * __builtin_amdgcn_rcpf(1.0f + __expf(-gt)) * acc[m][4 * g2 + n + 2][j]; }
          u32x2 w; w.x = cvt_pk(hv[0], hv[1]); w.y = cvt_pk(hv[2], hv[3]);
          *(LAS u32x2*)(stg + fr * 144 + (g2 * 32 + n * 16 + 4 * fq) * 2) = w;
        }
#pragma unroll
      for (int q = 0; q < 2; ++q) {
        const int rl = (l_ >> 3) + 8 * q;
        const u32x4 dv = *(const LAS u32x4*)(stg + rl * 144 + (l_ & 7) * 16);
        *(u32x4*)(p.hbuf + (size_t)(mt * 256 + wr * 64 + m * 16 + rl) * 256 + nt * 128 + wc * 64 + (l_ & 7) * 8) = dv;
      }
    }
    cur = nxt; mt = __builtin_amdgcn_readfirstlane(mt2); nt = __builtin_amdgcn_readfirstlane(nt2); has = has2;
  }
}
constexpr int E2_STG = 3 * G_STAGE;
DI void phase_exp2(const Params& p, LAS char* lds, int layer, int half) {
  const int wid = __builtin_amdgcn_readfirstlane(thr() >> 6), wr = wid >> 1, wc = wid & 1;
  LAS int* tb = (LAS int*)(lds + MISC_OFF);
  expert_map(p, tb, layer, half);
  const int half_tokens = NTOK / p.nsplit, cap = LIST_CAP / p.nsplit;
  const int TR = tb[64], TS = half_tokens / 256;
  auto lookup = [&](int u, bool isS, int& mt, int& nt, const bf16_t*& W, int2& en) {
    mt = (u >> 2) + (isS ? TR : 0); nt = u & 3;
    if (!isS) {
      const int e = __builtin_amdgcn_readfirstlane(find_expert(tb, mt)), cnt = tb[65 + e], ib = (mt - tb[e]) * 256;
      const int2* lst = p.lists + ((size_t)half * 64 + e) * cap;
      en = make_int2(-1, 0);
      const int t_ = thr();
      if (t_ < 256) { const int idx = ib + t_; if (idx < cnt) en = lst[idx]; }
      W = p.ed + (size_t)e * 262144;
    } else {
      int one; asm volatile("s_mov_b32 %0, 0x3f800000" : "=s"(one));
      en = make_int2((half * half_tokens + (mt - TR) * 256 + (int)thr()) * 8 + 6, one);
      W = p.shd[layer];
    }
  };
  auto mkptrs = [&](int mt, int nt, const bf16_t* W) {
    const int t_ = thr(), r0 = t_ >> 2, ck = (t_ & 3) * 16;
    ExpPtrs q; q.a0 = (const char*)(p.hbuf + (size_t)(mt * 256 + r0) * 256) + ck; q.a1 = q.a0 + 128 * 512;
    q.b0 = (const char*)(W + (size_t)(nt * 256 + r0) * 256) + ck; return q; };
  int u, mt, nt; bool isS; const bf16_t* W; int2 en;
  bool has = xcd_unit2(0, TR * 4, TS * 4, u, isS);
  ExpPtrs cur{};
  if (has) { lookup(u, isS, mt, nt, W, en); cur = mkptrs(mt, nt, W); gemm_prefetch(lds, cur.a0, cur.a1, cur.b0, cur.b0 + 128 * 512, 8); }
  LAS char* stg = lds + E2_STG + wid * 4352;
  for (int i = 0; has; ++i) {
    LAS int* ri = (LAS int*)(lds + MISC_OFF + 1024 + (i & 1) * 2048);
    { const int t_ = thr(); if (t_ < 256) { ri[2 * t_] = en.x; ri[2 * t_ + 1] = en.y; } }
    const int ntc = nt;
    int u2, mt2 = 0, nt2 = 0; bool isS2; const bf16_t* W2 = nullptr; int2 en2 = make_int2(-1, 0);
    const bool has2 = xcd_unit2(i + 1, TR * 4, TS * 4, u2, isS2);
    if (has2) lookup(u2, isS2, mt2, nt2, W2, en2);
    f32x4 acc[4][8]; zero_acc(acc);
    SUB_BEGIN(20);
    gemm_kloop<true>(lds, cur.a0, cur.a1, cur.b0, cur.b0 + 128 * 512, 8, acc);
    const int l_ = thr() & 63, fr = l_ & 15, fq = l_ >> 4;
    SUB_END(20);
    ExpPtrs nxt{};
    if (has2) { nxt = mkptrs(mt2, nt2, W2); gemm_prefetch(lds, nxt.a0, nxt.a1, nxt.b0, nxt.b0 + 128 * 512, 8); }
    SUB_BEGIN(21);
#pragma unroll
    for (int m = 0; m < 4; ++m) {
      const int rb = wr * 64 + m * 16;
      const float w = __int_as_float(ri[2 * (rb + fr) + 1]);
      LAS char* cr = stg + fr * 272 + fq * 8;
#pragma unroll
      for (int n = 0; n < 8; ++n) { u32x2 v; v.x = cvt_pk(acc[m][n][0] * w, acc[m][n][1] * w); v.y = cvt_pk(acc[m][n][2] * w, acc[m][n][3] * w); *(LAS u32x2*)(cr + n * 32) = v; }
#pragma unroll
      for (int q = 0; q < 4; ++q) {
        const int rl = fq + 4 * q;
        const int ex = ri[2 * (rb + rl)];
        const u32x4 d = *(const LAS u32x4*)(stg + rl * 272 + fr * 16);
        if (ex >= 0) {
          const int tok = ex >> 3, slot = ex & 7;
          char* dst = (slot == 6) ? (char*)(p.out + (size_t)tok * 1024) : (char*)(p.slab + ((size_t)(tok - half * half_tokens) * 6 + slot) * 1024);
          *(u32x4*)(dst + ntc * 512 + wc * 256 + fr * 16) = d;
        }
      }
    }
    SUB_END(21);
    cur = nxt; mt = mt2; nt = nt2; W = W2; en = en2; has = has2;
  }
}
DI void phase_combine(const Params& p, int layer, int half) {
  const int lane = thr() & 63, gw = bid() * 8 + (thr() >> 6), nw = gdim() * 8;
  const int half_tokens = NTOK / p.nsplit;
  const float* gam = p.in[18] + layer * 1024;
  const float* bet = p.in[19] + layer * 1024;
  for (int r = gw; r < half_tokens; r += nw) {
    const size_t row = (size_t)half * half_tokens + r;
    float* xr = p.out + row * 1024;
    f32x4 v[4], y[4];
#pragma unroll
    for (int j = 0; j < 4; ++j) {
      const u32x2 hi = *(const u32x2*)(p.xb + row * 1024 + 4 * lane + 256 * j), lo = *(const u32x2*)(p.x1lo + row * 1024 + 4 * lane + 256 * j);
      const u32x2 sh = *(const u32x2*)((const bf16_t*)xr + 4 * lane + 256 * j);
      v[j][0] = (__uint_as_float(hi.x << 16) + __uint_as_float(lo.x << 16)) * ALPHA + __uint_as_float(sh.x << 16);
      v[j][1] = (__uint_as_float(hi.x & 0xffff0000u) + __uint_as_float(lo.x & 0xffff0000u)) * ALPHA + __uint_as_float(sh.x & 0xffff0000u);
      v[j][2] = (__uint_as_float(hi.y << 16) + __uint_as_float(lo.y << 16)) * ALPHA + __uint_as_float(sh.y << 16);
      v[j][3] = (__uint_as_float(hi.y & 0xffff0000u) + __uint_as_float(lo.y & 0xffff0000u)) * ALPHA + __uint_as_float(sh.y & 0xffff0000u);
    }
#pragma unroll
    for (int s = 0; s < 6; ++s) {
      const bf16_t* sr = p.slab + ((size_t)r * 6 + s) * 1024;
#pragma unroll
      for (int j = 0; j < 4; ++j) {
        const u32x2 w = *(const u32x2*)(sr + 4 * lane + 256 * j);
        v[j][0] += __uint_as_float(w.x << 16); v[j][1] += __uint_as_float(w.x & 0xffff0000u);
        v[j][2] += __uint_as_float(w.y << 16); v[j][3] += __uint_as_float(w.y & 0xffff0000u);
      }
    }
    ln_row(v, gam, bet, lane, y);
#pragma unroll
    for (int j = 0; j < 4; ++j) {
      *(f32x4*)(xr + 4 * lane + 256 * j) = y[j];
      if (layer == 0) { u32x2 hi; hi.x = cvt_pk(y[j][0], y[j][1]); hi.y = cvt_pk(y[j][2], y[j][3]); *(u32x2*)(p.xb + row * 1024 + 4 * lane + 256 * j) = hi; }
    }
  }
}

DI void phase_inproj1(const Params& p, LAS char* lds) {
  GEMM_IDS();
  for (int i = 0, u; xcd_unit(i, 128 * 3, u); ++i) {
    int mt, nt; mn_order(u, 3, mt, nt);
    const int m0 = mt * 256, n0 = nt * 256;
    const char* a0 = (const char*)(p.xb + (size_t)(m0 + r0) * 1024) + ck;
    const char* b0 = (const char*)(p.win1t + (size_t)(n0 + r0) * 1024) + ck;
    f32x4 acc[4][8]; zero_acc(acc);
    gemm_kloop(lds, a0, a0 + (size_t)128 * 2048, b0, b0 + (size_t)128 * 2048, 32, acc);
    EPI_OPAQUE();
    const int g = nt * 2 + wc;
#pragma unroll
    for (int m = 0; m < 4; ++m) {
      const int row = m0 + wr * 64 + m * 16 + fr;
      if (g < 5) {
        const float* gam = g < 3 ? p.in[11] + g * 128 : p.in[12] + (g - 3) * 128;
        bf16_t* dst = g < 3 ? p.cqb + (size_t)row * 384 + g * 128 : p.ckvb + (size_t)row * 256 + (g - 3) * 128;
        float ss = 0.f;
#pragma unroll
        for (int n = 0; n < 8; ++n) {
          const f32x4 gv = *(const f32x4*)(gam + n * 16 + 4 * fq), a = acc[m][n];
          ss += (a[0] * a[0] + a[1] * a[1]) + (a[2] * a[2] + a[3] * a[3]);
          u32x2 w; w.x = cvt_pk(a[0] * gv[0], a[1] * gv[1]); w.y = cvt_pk(a[2] * gv[2], a[3] * gv[3]);
          *(u32x2*)(dst + n * 16 + 4 * fq) = w;
        }
        ss += shx(ss, 16); ss += shx(ss, 32);
        if (fq == 0) p.cbuf[(size_t)row * 8 + g] = ss;
      } else {
        const int t = row & 4095;
        const f32x4 c0 = *(const f32x4*)(p.cs32 + t * 16 + 4 * fq), c1 = *(const f32x4*)(p.cs32 + t * 16 + 4 * fq + 2);
        const float co[4] = {c0[0], c0[2], c1[0], c1[2]}, si[4] = {c0[1], c0[3], c1[1], c1[3]};
        float y1[4], y2[4];
#pragma unroll
        for (int j = 0; j < 4; ++j) { const float x1 = acc[m][0][j], x2 = acc[m][1][j]; y1[j] = x1 * co[j] - x2 * si[j]; y2[j] = x1 * si[j] + x2 * co[j]; }
        u32x2 w1, w2; w1.x = cvt_pk(y1[0], y1[1]); w1.y = cvt_pk(y1[2], y1[3]); w2.x = cvt_pk(y2[0], y2[1]); w2.y = cvt_pk(y2[2], y2[3]);
        *(u32x2*)(p.krb + (size_t)row * 32 + 4 * fq) = w1; *(u32x2*)(p.krb + (size_t)row * 32 + 16 + 4 * fq) = w2;
      }
      asm volatile("" ::: "memory");
    }
  }
  int it = 0;
  if (gdim() == 256) {
    const int jb = bid() >> 3;
    expert_stream(p, (LAS float*)lds, 1, 0, 46, bid(), 256);
    expert_stream(p, (LAS float*)lds, 1, 46, 64, jb >= 16 ? (jb - 16) * 8 + (bid() & 7) : -1, 128);
  } else expert_stream(p, (LAS float*)lds, 1, 0, 64, bid(), gdim());
}
DI void phase_mlaup(const Params& p, LAS char* lds) {
  GEMM_IDS();
  auto decode = [&](int u, bool& isq, int& m0, int& n0, int& nt) {
    const int x8 = u / 224, ul = u - x8 * 224;
    isq = ul < 96;
    int mtl; mn_order(isq ? ul : ul - 96, isq ? 6 : 8, mtl, nt);
    m0 = (x8 * 16 + mtl) * 256; n0 = nt * 256;
  };
  gemm_units_sel<12, 128 * 768>(lds, 128 * 14,
    [&](int u) { return (u % 224) < 96; },
    [&](int u, const char*& a0, const char*& b0) {
      bool isq; int m0, n0, nt; decode(u, isq, m0, n0, nt);
      const int t_ = thr(), r0_ = t_ >> 2, ck_ = (t_ & 3) * 16;
      a0 = (const char*)(p.cqb + (size_t)(m0 + r0_) * 384) + ck_; b0 = (const char*)(p.wuqt + (size_t)(n0 + r0_) * 384) + ck_;
    },
    [&](int u, f32x4 (&acc)[4][8]) {
      bool isq; int m0, n0, nt; decode(u, isq, m0, n0, nt);
      EPI_OPAQUE();
#pragma unroll
      for (int m = 0; m < 4; ++m) {
        const int row = m0 + wr * 64 + m * 16 + fr, b = row >> 12, t = row & 4095;
        const f32x4 sq = *(const f32x4*)(p.cbuf + (size_t)row * 8);
        const float QS = QS96 * rsqrtf((sq[0] + sq[1] + sq[2]) * (1.0f / 384.0f) + 1e-6f);
#pragma unroll
        for (int pr = 0; pr < 4; ++pr) {
          const int gi = ((n0 + wc * 128) >> 5) + pr, head = gi / 3, part = gi - head * 3;
          bf16_t* dst = p.q1 + ((size_t)(b * 16 + head) * 4096 + t) * 96 + part * 32 + 4 * fq;
          if (part < 2) {
#pragma unroll
            for (int n = 0; n < 2; ++n) { const f32x4 v = acc[m][2 * pr + n] * QS; u32x2 w; w.x = cvt_pk(v[0], v[1]); w.y = cvt_pk(v[2], v[3]); *(u32x2*)(dst + n * 16) = w; }
          } else {
            const f32x4 c0 = *(const f32x4*)(p.cs32 + t * 16 + 4 * fq), c1 = *(const f32x4*)(p.cs32 + t * 16 + 4 * fq + 2);
            const float co[4] = {c0[0], c0[2], c1[0], c1[2]}, si[4] = {c0[1], c0[3], c1[1], c1[3]};
            float y1[4], y2[4];
#pragma unroll
            for (int j = 0; j < 4; ++j) { const float x1 = acc[m][2 * pr][j] * QS, x2 = acc[m][2 * pr + 1][j] * QS; y1[j] = x1 * co[j] - x2 * si[j]; y2[j] = x1 * si[j] + x2 * co[j]; }
            u32x2 w1, w2; w1.x = cvt_pk(y1[0], y1[1]); w1.y = cvt_pk(y1[2], y1[3]); w2.x = cvt_pk(y2[0], y2[1]); w2.y = cvt_pk(y2[2], y2[3]);
            *(u32x2*)(dst) = w1; *(u32x2*)(dst + 16) = w2;
          }
        }
        asm volatile("" ::: "memory");
      }
    });
  gemm_units_sel<8, 128 * 512>(lds, 128 * 14,
    [&](int u) { return (u % 224) >= 96; },
    [&](int u, const char*& a0, const char*& b0) {
      bool isq; int m0, n0, nt; decode(u, isq, m0, n0, nt);
      const int t_ = thr(), r0_ = t_ >> 2, ck_ = (t_ & 3) * 16;
      a0 = (const char*)(p.ckvb + (size_t)(m0 + r0_) * 256) + ck_; b0 = (const char*)(p.wukvt + (size_t)(n0 + r0_) * 256) + ck_;
    },
    [&](int u, f32x4 (&acc)[4][8]) {
      bool isq; int m0, n0, nt; decode(u, isq, m0, n0, nt);
      EPI_OPAQUE();
      const int head = nt * 2 + wc, l_ = thr() & 63;
      const int rowb = m0 + wr * 64, b = rowb >> 12, tb0 = rowb & 4095;
      LAS char* stg = lds + 3 * G_STAGE + wid * 3072;
#pragma unroll
      for (int m = 0; m < 4; ++m) {
        const size_t row = (size_t)rowb + m * 16 + fr;
        const float rk = rsqrtf((p.cbuf[row * 8 + 3] + p.cbuf[row * 8 + 4]) * (1.0f / 256.0f) + 1e-6f);
#pragma unroll
        for (int n = 0; n < 4; ++n) {
          const f32x4 v = acc[m][n] * rk;
          u32x2 w; w.x = cvt_pk(v[0], v[1]); w.y = cvt_pk(v[2], v[3]);
          *(LAS u32x2*)(stg + fr * 144 + (n * 16 + 4 * fq) * 2) = w;
        }
#pragma unroll
        for (int q = 0; q < 2; ++q) {
          const int rl = (l_ >> 3) + 8 * q;
          const u32x4 dv = *(const LAS u32x4*)(stg + rl * 144 + (l_ & 7) * 16);
          *(u32x4*)(p.kn + ((size_t)(b * 16 + head) * 4096 + tb0 + m * 16 + rl) * 64 + (l_ & 7) * 8) = dv;
        }
        asm volatile("" ::: "memory");
        const int tp = perm16(fr) & 15;
#pragma unroll
        for (int n = 0; n < 4; ++n)
#pragma unroll
          for (int j = 0; j < 4; ++j) *(LAS bf16_t*)(stg + (n * 16 + 4 * fq + j) * 48 + tp * 2) = f2bf(acc[m][4 + n][j] * rk);
        asm volatile("" ::: "memory");
#pragma unroll
        for (int q = 0; q < 2; ++q) {
          const int dl = (l_ >> 1) + 32 * q;
          const u32x4 dv = *(const LAS u32x4*)(stg + dl * 48 + (l_ & 1) * 16);
          *(u32x4*)(p.vt1 + ((size_t)(b * 16 + head) * 64 + dl) * 4096 + tb0 + m * 16 + (l_ & 1) * 8) = dv;
        }
        asm volatile("" ::: "memory");
      }
    });
}

constexpr int LDS_BYTES = NSA_LDS > (MISC_OFF + 6144) ? NSA_LDS : (MISC_OFF + 6144);
#ifdef PROBE
constexpr int LDS_TOTAL = 163840;
#else
constexpr int LDS_TOTAL = LDS_BYTES + 64;
#endif
#ifndef ALLCG
#define ALLCG 0
#endif

#ifdef PROBE_TEST
DI void phase_test(const Params& p, LAS char* lds) {
  GEMM_IDS();
  for (int i = 0, u; xcd_unit(i, 128 * 9, u); ++i) {
    int mt, nt; mn_order(u, 9, mt, nt);
    if (PROBE_TEST == 2) { mt &= (p.nsplit >> 4); nt &= (p.nsplit >> 4); }
    const char* a0 = (const char*)(p.xb + (size_t)(mt * 256 + r0) * 1024) + ck;
    const char* b0 = (const char*)(p.win0t + (size_t)(nt * 256 + r0) * 1024) + ck;
    f32x4 acc[4][8]; zero_acc(acc);
    if (PROBE_TEST == 3) {
      bf16x8 af[4], bfr[4];
#pragma unroll
      for (int q = 0; q < 4; ++q) { af[q] = *(const bf16x8*)(a0 + q * 64); bfr[q] = *(const bf16x8*)(b0 + q * 64); }
      for (int t = 0; t < 32; ++t) {
        LDS_BAR();
#pragma unroll
        for (int nh = 0; nh < 2; ++nh)
#pragma unroll
          for (int m = 0; m < 4; ++m)
#pragma unroll
            for (int n = 0; n < 4; ++n) acc[m][4 * nh + n] = __builtin_amdgcn_mfma_f32_16x16x32_bf16(bfr[n], af[m], acc[m][4 * nh + n], 0, 0, 0);
      }
    } else if (PROBE_TEST >= 10) gemm_kloop<false, PROBE_TEST - 10>(lds, a0, a0 + (size_t)128 * 2048, b0, b0 + (size_t)128 * 2048, 32, acc);
    else
    gemm_kloop(lds, a0, a0 + (size_t)128 * 2048, b0, b0 + (size_t)128 * 2048, 32, acc);
    EPI_OPAQUE();
#pragma unroll
    for (int m = 0; m < 4; ++m)
#pragma unroll
      for (int n = 0; n < 8; ++n) asm volatile("" :: "v"(acc[m][n]));
  }
}
#endif
DI void get_phase(int i, int nsplit, int& ph, int& layer, int& half) {
  const int moe_len = 1 + 3 * nsplit;
  layer = 0; half = 0;
#ifdef PROBE_TEST
  if (i == 2) { ph = 99; return; }
  if (i > 2) i -= 1;
#endif
  if (i < 5) { ph = (i < 3) ? i : i + 1; return; }
  i -= 5;
  if (i >= moe_len) {
    i -= moe_len; layer = 1;
    if (i < 4) { ph = (i == 0) ? PH_INPROJ1 : ((i < 3) ? PH_MLAUP + (i - 1) : PH_OUTPROJ); return; }
    i -= 4;
  }
  if (i < 1) { ph = PH_ROUTER; return; }
  i -= 1; half = i / 3; ph = PH_EXP1 + (i - half * 3);
}
DI int num_phases(int nsplit) { return 5 + 4 + 2 * (1 + 3 * nsplit); }

__global__ void __launch_bounds__(NTHR) fwd_kernel(Params p_arg, int ph_lo, int ph_hi, int use_sync) {
  const Params& p0 = p_arg;
  extern __shared__ __attribute__((aligned(16))) char smem_raw[];
  LAS char* lds = (LAS char*)smem_raw;
  volatile LAS unsigned* bst = (volatile LAS unsigned*)(lds + LDS_BYTES);
  cg::grid_group grid = cg::this_grid();
  XcdBarrier xb;
  if (use_sync) {
    if (threadIdx.x == 0) { bst[0] = 0u; bst[1] = 0u; bst[2] = 0u; bst[3] = 0u; }
    __syncthreads();
    xb = xcd_barrier_post(p0.bar, bst);
  }
#ifndef PROBE_RVR
#define PROBE_RVR 0ull
#endif
#ifdef PROBE
  volatile LAS unsigned long long* pacc = (volatile LAS unsigned long long*)(lds + PROBE_LDS_OFF);
  if (blockIdx.x == PROBE_BLK && threadIdx.x == 0) { pacc[0] = 0ull; pacc[1] = __builtin_amdgcn_s_memrealtime(); pacc[2] = 0ull; }
#endif
  for (int i = ph_lo; i < ph_hi; ++i) {
    const __attribute__((address_space(4))) char* kp_ = (const __attribute__((address_space(4))) char*)__builtin_amdgcn_kernarg_segment_ptr();
    asm volatile("" : "+s"(kp_));
    const Params& p = *(const Params*)kp_;
    int ph, layer, half;
    get_phase(i, p.nsplit, ph, layer, half);
    switch (ph) {
      case PH_PREP: phase_prep(p, lds); break;
      case PH_INPROJ0: phase_inproj0(p, lds); gate_pass(p, lds); break;
      case PH_SWA_CMP1: phase_swa_cmp1(p, lds); break;
      case PH_NSA: phase_nsa(p, lds); break;
      case PH_OUTPROJ: phase_outproj(p, lds, layer); break;
      case PH_ROUTER: phase_router(p, lds, layer); break;
      case PH_EXP1: phase_exp1(p, lds, layer, half); break;
      case PH_EXP2: phase_exp2(p, lds, layer, half); break;
      case PH_COMBINE: phase_combine(p, layer, half); break;
      case PH_INPROJ1: phase_inproj1(p, lds); break;
      case PH_MLAUP: phase_mlaup(p, lds); break;
      case PH_MLAATT: phase_mla(p, lds); break;
#ifdef PROBE_TEST
      case 99: phase_test(p, lds); break;
#endif
      default: break;
    }
    if ((PROBE_RVR >> i) & 1ull) SUB_BEGIN(11);
    const bool indep = (ph == PH_COMBINE) && (half + 1 < p.nsplit);
    if (use_sync && i + 1 < ph_hi && !indep) { if (i == ph_lo || ALLCG) grid.sync(); else xcd_barrier(xb); }
    if ((PROBE_RVR >> i) & 1ull) SUB_END(11);
#ifdef PROBE
    if (blockIdx.x == PROBE_BLK && threadIdx.x == 0) { const unsigned long long t_ = __builtin_amdgcn_s_memrealtime(); if ((PROBE_DUR >> i) & 1ull) pacc[0] = pacc[0] + (t_ - pacc[1]); pacc[1] = t_; }
#endif
  }
#ifdef PROBE
#ifdef PROBE_XCC
  {
    if (threadIdx.x == 0) __hip_atomic_store(p.cnt + 512 + blockIdx.x, (int)xb_xcc_id() + 1, __ATOMIC_RELAXED, __HIP_MEMORY_SCOPE_AGENT);
    xcd_barrier(xb);
    if (blockIdx.x == 0 && threadIdx.x == 0) {
      int bad = 0;
      for (int b = 0; b < (int)gridDim.x; ++b) bad += (__hip_atomic_load(p.cnt + 512 + b, __ATOMIC_RELAXED, __HIP_MEMORY_SCOPE_AGENT) != __hip_atomic_load(p.cnt + 512 + (b & 7), __ATOMIC_RELAXED, __HIP_MEMORY_SCOPE_AGENT)) ? 1 : 0;
      pacc[0] = (unsigned long long)bad * 10000ull / 9ull;
    }
  }
#endif
  {
    __syncthreads();
    const unsigned lane_ = __builtin_amdgcn_mbcnt_hi(~0u, __builtin_amdgcn_mbcnt_lo(~0u, 0u));
    if (blockIdx.x == PROBE_BLK && lane_ == 0u && atomicAdd((unsigned*)&bst[2], 1u) == 0u) {
      const unsigned long long td = pacc[0], t0 = __builtin_amdgcn_s_memrealtime();
      while (__builtin_amdgcn_s_memrealtime() - t0 < 9ull * td) __builtin_amdgcn_s_sleep(8);
    }
  }
#endif
}

extern "C" void kernel_launch(void* const* d_in, const int* in_sizes, int n_in, void* d_out, int out_size, void* d_ws, size_t ws_size, hipStream_t stream) {
  static int grid_blocks = 0;
  if (grid_blocks == 0) {
    int dev = 0, cus = 0, per_cu = 0;
    hipGetDevice(&dev);
    hipDeviceGetAttribute(&cus, hipDeviceAttributeMultiprocessorCount, dev);
    hipFuncSetAttribute((const void*)fwd_kernel, hipFuncAttributeMaxDynamicSharedMemorySize, LDS_TOTAL);
    hipOccupancyMaxActiveBlocksPerMultiprocessor(&per_cu, (const void*)fwd_kernel, NTHR, LDS_TOTAL);
    if (per_cu < 1) { fprintf(stderr, "kernel_launch: occupancy query says %d blocks per CU\n", per_cu); per_cu = 1; }
    grid_blocks = cus;
    (void)hipGetLastError();
  }
  Params p;
  memset(&p, 0, sizeof(p));
  for (int i = 0; i < 28; ++i) p.in[i] = (const float*)d_in[i];
  p.out = (float*)d_out;
  char* ws = (char*)d_ws;
  size_t off = 0;
  auto take = [&](size_t bytes) { char* r = ws + off; off += (bytes + 255) & ~(size_t)255; return r; };
  p.bar = (unsigned*)take(XCD_BAR_WORDS * 4);
  p.cnt = (int*)take(4096);
  p.win0t = (bf16_t*)take((size_t)2304 * 1024 * 2); p.wout0t = (bf16_t*)take((size_t)1024 * 1024 * 2);
  p.cw1k = (bf16_t*)take(256 * 2048 * 2); p.cw1v = (bf16_t*)take(256 * 2048 * 2);
  p.cw2k = (bf16_t*)take(256 * 128 * 2); p.cw2v = (bf16_t*)take(256 * 128 * 2);
  p.win1t = (bf16_t*)take((size_t)768 * 1024 * 2); p.wuqt = (bf16_t*)take((size_t)1536 * 384 * 2);
  p.wukvt = (bf16_t*)take((size_t)2048 * 256 * 2); p.wout1t = (bf16_t*)take((size_t)1024 * 1024 * 2);
  for (int l = 0; l < 2; ++l) {
    p.rwh[l] = (bf16_t*)take(256 * 1024 * 2); p.rwl[l] = (bf16_t*)take(256 * 1024 * 2);
    p.shgu[l] = (bf16_t*)take(512 * 1024 * 2); p.shd[l] = (bf16_t*)take(1024 * 256 * 2);
  }
  p.cb1k = (float*)take(128 * 4); p.cb1v = (float*)take(128 * 4);
  p.cs64 = (float2*)take(4096 * 32 * 8); p.cs32 = (float2*)take(4096 * 16 * 8);
  p.egu = (bf16_t*)take((size_t)64 * 524288 * 2); p.ed = (bf16_t*)take((size_t)64 * 262144 * 2);
  p.xb = (bf16_t*)take((size_t)NTOK * 1024 * 2);
  const size_t act0 = off;
  p.q0 = (bf16_t*)take((size_t)NBATCH * 16 * 4096 * 64 * 2);
  const size_t kvb = (size_t)NBATCH * 2 * 4096 * 64 * 2;
  p.ka = (bf16_t*)take(kvb); p.ks = (bf16_t*)take(kvb); p.kw = (bf16_t*)take(kvb); p.kc0 = (bf16_t*)take(kvb); p.vc0 = (bf16_t*)take(kvb);
  p.vta = (bf16_t*)take(kvb); p.vts = (bf16_t*)take(kvb); p.vtw = (bf16_t*)take(kvb);
  p.h1k = (bf16_t*)take(4096 * 128 * 2); p.h1v = (bf16_t*)take(4096 * 128 * 2);
  p.kcmp = (bf16_t*)take(16 * 256 * 64 * 2); p.vcmpt = (bf16_t*)take(16 * 64 * 256 * 2);
  p.gates = (float*)take((size_t)NTOK * 24 * 4);
  p.obuf = (bf16_t*)take((size_t)NTOK * 1024 * 2);
  const size_t end_l0 = off;
  const size_t need1 = act0 + (size_t)NTOK * 1024 * 2 + (size_t)64 * LIST_CAP * 8 + ((size_t)NTOK * 7 + 64 * 256) * 512 + (size_t)NTOK * 6 * 2048 + 4096;
  p.nsplit = ws_size >= need1 ? 1 : 2;
  off = act0;
  p.x1lo = (bf16_t*)take((size_t)NTOK * 1024 * 2);
  p.lists = (int2*)take((size_t)64 * LIST_CAP * 8);
  p.hbuf = (bf16_t*)take(((size_t)(NTOK / p.nsplit) * 7 + 64 * 256) * 512);
  p.slab = (bf16_t*)take((size_t)(NTOK / p.nsplit) * 6 * 2048);
  const size_t end_moe = off;
  off = act0;
  p.cqb = (bf16_t*)take((size_t)NTOK * 384 * 2); p.ckvb = (bf16_t*)take((size_t)NTOK * 256 * 2); p.krb = (bf16_t*)take((size_t)NTOK * 32 * 2);
  p.q1 = (bf16_t*)take((size_t)NTOK * 16 * 96 * 2);
  p.kn = (bf16_t*)take((size_t)NTOK * 16 * 64 * 2);
  p.cbuf = nullptr;
  p.vt1 = (bf16_t*)take((size_t)NTOK * 16 * 64 * 2);
  p.cbuf = (float*)take((size_t)NTOK * 8 * 4);
  const size_t end_l1 = off;
  size_t need = end_l0 > end_moe ? end_l0 : end_moe; if (end_l1 > need) need = end_l1;
  if (need > ws_size) { fprintf(stderr, "kernel_launch: workspace too small: need %zu, have %zu\n", need, ws_size); return; }
#ifdef PROBE_TEST
  const int n = 1 + 5 + 4 + 2 * (1 + 3 * p.nsplit);
#else
  const int n = 5 + 4 + 2 * (1 + 3 * p.nsplit);
#endif
  hipMemsetAsync(p.bar, 0, XCD_BAR_WORDS * 4, stream);
#ifdef MULTI_LAUNCH
  for (int i = 0; i < n; ++i) hipLaunchKernelGGL(fwd_kernel, dim3(grid_blocks), dim3(NTHR), LDS_TOTAL, stream, p, i, i + 1, 0);
#else
  int lo = 0, hi = n, us = 1;
  void* args[] = {&p, &lo, &hi, &us};
  hipError_t e = hipLaunchCooperativeKernel((const void*)fwd_kernel, dim3(grid_blocks), dim3(NTHR), args, LDS_TOTAL, stream);
  if (e != hipSuccess) fprintf(stderr, "cooperative launch failed: %s (grid %d)\n", hipGetErrorString(e), grid_blocks);
#endif
}
```
